# Optimizing an MI355X kernel written in HIP

```python
import jax, jax.numpy as jnp
from jax import lax
import numpy as np

D_MODEL = 1024
BATCH = 8
SEQ = 4096
DEPTH = 1

HEAD_DIM = 64
ATT_GROUPS = ((128, 1), (512, 4), (2048, 16))
N_DIL = len(ATT_GROUPS)
HEADS_PER_GROUP = 4
N_ATT_HEADS = N_DIL * HEADS_PER_GROUP
ATT_W = N_ATT_HEADS * HEAD_DIM
ATT_OUT_W = HEADS_PER_GROUP * HEAD_DIM
BLK = 128
REL_BUCKETS = 32
REL_MAX_DIST = 2048
CHUNK = 128
GMLP_W = 768
GMLP_GROUPS = 12
GMLP_GD = GMLP_W // GMLP_GROUPS
N_BRANCH = 2
IN_W = 3 * ATT_W + 2 * GMLP_W + N_BRANCH * D_MODEL
N_EXPERTS = 32
TOP_K = 4
D_EXPERT = D_MODEL
SWIGLU_LIMIT = 7.0
SWIGLU_ALPHA = 1.702
MOE_BLK = 128
PLE_DIM = 256
EPS = 1e-6

kernel_name = "hybrid_dilated_gmlp_moe_block"


def _rmsnorm(x, g):
    xf = x.astype(jnp.float32)
    y = xf * lax.rsqrt(jnp.mean(xf * xf, axis=-1, keepdims=True) + EPS) * g.astype(jnp.float32)
    return y.astype(x.dtype)


def _t5_bucket(n):
    exact = REL_BUCKETS // 2
    nf = np.maximum(n, 1).astype(np.float32)
    large = exact + (np.log(nf / exact) / np.log(REL_MAX_DIST / exact) * (REL_BUCKETS - exact)).astype(np.int32)
    large = np.minimum(large, REL_BUCKETS - 1)
    return np.where(n < exact, n, large).astype(np.int32)


def _dilated_group(q, k, v, rel_bias_g, window, dilation):
    B, S, H, E = q.shape
    span = window // dilation
    unit = dilation * BLK
    Sp = -(-S // unit) * unit
    nb = Sp // unit

    def to_blocks(t):
        t = jnp.pad(t, ((0, 0), (0, Sp - S), (0, 0), (0, 0)))
        return t.reshape(B, nb, BLK, dilation, H, E)

    qb, kb, vb = to_blocks(q), to_blocks(k), to_blocks(v)

    def with_prev(t):
        prev = jnp.pad(t, ((0, 0), (1, 0), (0, 0), (0, 0), (0, 0), (0, 0)))[:, :-1]
        return jnp.concatenate([prev, t], axis=2)

    kk, vv = with_prev(kb), with_prev(vb)

    i = np.arange(BLK)[:, None]
    j = np.arange(2 * BLK)[None, :]
    dist = i + BLK - j
    band = (dist >= 0) & (dist <= span)
    bucket = _t5_bucket(np.clip(dist, 0, None) * dilation)
    bias = jnp.transpose(rel_bias_g[bucket], (2, 0, 1)).astype(jnp.float32)
    key_ok = (np.arange(nb)[:, None] * BLK + np.arange(2 * BLK)[None, :] - BLK) >= 0
    mask = jnp.asarray(band[None, :, :] & key_ok[:, None, :])

    logits = jnp.einsum('bnqrhe,bnkrhe->bnrhqk', qb, kk).astype(jnp.float32) * (E ** -0.5)
    logits = logits + bias[None, None, None]
    logits = jnp.where(mask[None, :, None, None], logits, -jnp.inf)
    m = jnp.max(logits, axis=-1, keepdims=True)
    w = jnp.exp(logits - m)
    den = jnp.sum(w, axis=-1)
    num = jnp.einsum('bnrhqk,bnkrhe->bnqrhe', w.astype(vv.dtype), vv).astype(jnp.float32)
    den_t = jnp.transpose(den, (0, 1, 4, 2, 3))
    lse = jnp.transpose(m[..., 0] + jnp.log(den), (0, 1, 4, 2, 3))
    out = (num / den_t[..., None]).reshape(B, Sp, H, E)[:, :S]
    lse = lse.reshape(B, Sp, H)[:, :S]
    return out, lse


def _dilated_attention(q, k, v, rel_bias):
    outs, lses = [], []
    for g, (window, dilation) in enumerate(ATT_GROUPS):
        o, l = _dilated_group(q[:, :, g], k[:, :, g], v[:, :, g],
                              rel_bias[:, g * HEADS_PER_GROUP:(g + 1) * HEADS_PER_GROUP], window, dilation)
        outs.append(o)
        lses.append(l)
    outs = jnp.stack(outs, axis=2)
    alpha = jax.nn.softmax(jnp.stack(lses, axis=2), axis=2)
    return jnp.sum(alpha[..., None] * outs, axis=2)


def _spatial_gating(u_raw, v_raw, ln_g, ln_b, w_s, b_s):
    B, S, _ = u_raw.shape
    zu = jax.nn.gelu(u_raw, approximate=False)
    zv = jax.nn.gelu(v_raw, approximate=False).astype(jnp.float32)
    mu = jnp.mean(zv, axis=-1, keepdims=True)
    var = jnp.mean(jnp.square(zv - mu), axis=-1, keepdims=True)
    vn = (zv - mu) * lax.rsqrt(var + EPS) * ln_g.astype(jnp.float32) + ln_b.astype(jnp.float32)
    vc = vn.reshape(B, S // CHUNK, CHUNK, GMLP_GROUPS, GMLP_GD)
    causal = jnp.asarray(np.tril(np.ones((CHUNK, CHUNK), np.float32)))
    w_c = w_s.astype(jnp.float32) * causal[None]
    mixed = jnp.einsum('gij,bcjgd->bcigd', w_c, vc) + b_s.astype(jnp.float32).T[None, None, :, :, None]
    return zu * mixed.reshape(B, S, GMLP_W).astype(zu.dtype)


def _moe(hn, w_router, b_router, w_gate_up, b_gate_up, w_down, b_down):
    B, S, D = hn.shape
    T = B * S
    xt = hn.reshape(T, D)
    logits = (xt @ w_router + b_router).astype(jnp.float32)
    top_val, top_idx = lax.top_k(logits, TOP_K)
    gate = jax.nn.softmax(top_val, axis=-1)
    A = T * TOP_K
    flat_e = top_idx.reshape(A).astype(jnp.int32)
    flat_tok = jnp.repeat(jnp.arange(T, dtype=jnp.int32), TOP_K)
    flat_gate = gate.reshape(A)
    order = jnp.argsort(flat_e)
    e_sorted = flat_e[order]
    counts = jnp.bincount(flat_e, length=N_EXPERTS).astype(jnp.int32)
    start = jnp.cumsum(counts) - counts
    blk_counts = (counts + MOE_BLK - 1) // MOE_BLK
    blk_end = jnp.cumsum(blk_counts)
    pad_start = (blk_end - blk_counts) * MOE_BLK
    rank = jnp.arange(A, dtype=jnp.int32) - start[e_sorted]
    dest = pad_start[e_sorted] + rank
    n_blocks = -(-A // MOE_BLK) + N_EXPERTS
    P = n_blocks * MOE_BLK
    slot_tok = jnp.full((P,), T, jnp.int32).at[dest].set(flat_tok[order])
    slot_gate = jnp.zeros((P,), jnp.float32).at[dest].set(flat_gate[order])
    block_expert = jnp.minimum(
        jnp.searchsorted(blk_end, jnp.arange(n_blocks, dtype=jnp.int32), side='right'), N_EXPERTS - 1)
    x_pad = jnp.concatenate([xt, jnp.zeros((1, D), xt.dtype)], axis=0)
    xb = x_pad[slot_tok].reshape(n_blocks, MOE_BLK, D)

    def expert_block(args):
        xe, e = args
        gu = xe @ w_gate_up[e] + b_gate_up[e]
        glu = jnp.minimum(gu[:, :D_EXPERT], SWIGLU_LIMIT)
        lin = jnp.clip(gu[:, D_EXPERT:], -SWIGLU_LIMIT, SWIGLU_LIMIT)
        act = glu * jax.nn.sigmoid(SWIGLU_ALPHA * glu) * (lin + 1.0)
        return act @ w_down[e] + b_down[e]

    yb = lax.map(expert_block, (xb, block_expert))
    y = yb.reshape(P, D) * slot_gate[:, None].astype(yb.dtype)
    out = jnp.zeros((T + 1, D), yb.dtype).at[slot_tok].add(y)[:T]
    return out.reshape(B, S, D)


def setup_inputs(seed: int = 0) -> dict:
    key = jax.random.key(seed)
    ks = jax.random.split(key, 24)
    f32 = jnp.float32
    nrm = lambda k, shape, s: jax.random.normal(k, shape, f32) * s
    L, D, E = DEPTH, D_MODEL, N_EXPERTS
    return {
        "x": nrm(ks[0], (BATCH, SEQ, D), 1.0),
        "p": nrm(ks[1], (DEPTH, BATCH, SEQ, PLE_DIM), 1.0),
        "g_mix": 1.0 + nrm(ks[2], (L, D), 0.05),
        "w_in": nrm(ks[3], (L, D, IN_W), D ** -0.5),
        "rel_bias": nrm(ks[4], (REL_BUCKETS, N_ATT_HEADS), 0.5),
        "w_att_out": nrm(ks[5], (L, ATT_OUT_W, D), ATT_OUT_W ** -0.5),
        "ln_v_g": 1.0 + nrm(ks[6], (L, GMLP_W), 0.05),
        "ln_v_b": nrm(ks[7], (L, GMLP_W), 0.02),
        "w_spatial": nrm(ks[8], (L, GMLP_GROUPS, CHUNK, CHUNK), CHUNK ** -0.5),
        "b_spatial": 1.0 + nrm(ks[9], (L, GMLP_GROUPS, CHUNK), 0.1),
        "w_gmlp_out": nrm(ks[10], (L, GMLP_W, D), GMLP_W ** -0.5),
        "w_out": nrm(ks[11], (L, D, D), D ** -0.5),
        "g_moe": 1.0 + nrm(ks[12], (L, D), 0.05),
        "w_router": nrm(ks[13], (L, D, E), D ** -0.5),
        "b_router": nrm(ks[14], (L, E), 0.01),
        "w_gate_up": nrm(ks[15], (L, E, D, 2 * D_EXPERT), D ** -0.5),
        "b_gate_up": nrm(ks[16], (L, E, 2 * D_EXPERT), 0.02),
        "w_down": nrm(ks[17], (L, E, D_EXPERT, D), D_EXPERT ** -0.5),
        "b_down": nrm(ks[18], (L, E, D), 0.02),
        "g_ple": 1.0 + nrm(ks[19], (L, D), 0.05),
        "w_ple_gate": nrm(ks[20], (L, D, D), D ** -0.5),
        "w_ple_proj": nrm(ks[21], (L, PLE_DIM, D), PLE_DIM ** -0.5),
        "g_final": 1.0 + nrm(ks[22], (D,), 0.05),
    }


def reference(x, p, g_mix, w_in, rel_bias, w_att_out, ln_v_g, ln_v_b, w_spatial, b_spatial,
              w_gmlp_out, w_out, g_moe, w_router, b_router, w_gate_up, b_gate_up, w_down, b_down,
              g_ple, w_ple_gate, w_ple_proj, g_final):
    B, S, D = x.shape
    splits = [int(c) for c in np.cumsum([ATT_W, ATT_W, ATT_W, GMLP_W, GMLP_W])]
    h = x
    for i in range(DEPTH):
        n1 = _rmsnorm(h, g_mix[i])
        z = n1 @ w_in[i]
        q, k, v, u_raw, v_raw, gate_logits = jnp.split(z, splits, axis=-1)
        hs = (B, S, N_DIL, HEADS_PER_GROUP, HEAD_DIM)
        att = _dilated_attention(q.reshape(hs), k.reshape(hs), v.reshape(hs), rel_bias)
        y_att = att.reshape(B, S, ATT_OUT_W).astype(h.dtype) @ w_att_out[i]
        y_gm = _spatial_gating(u_raw, v_raw, ln_v_g[i], ln_v_b[i], w_spatial[i], b_spatial[i]) @ w_gmlp_out[i]
        gates = jax.nn.sigmoid(gate_logits.reshape(B, S, N_BRANCH, D))
        merged = gates[:, :, 0] * y_att + gates[:, :, 1] * y_gm
        h = h + merged @ w_out[i]
        h = h + _moe(_rmsnorm(h, g_moe[i]), w_router[i], b_router[i], w_gate_up[i], b_gate_up[i],
                     w_down[i], b_down[i])
        ple_gate = jax.nn.sigmoid(_rmsnorm(h, g_ple[i]) @ w_ple_gate[i])
        h = h + ple_gate * (p[i] @ w_ple_proj[i])
    return _rmsnorm(h, g_final)
```

```cpp
#include <hip/hip_runtime.h>
#include <cstdio>
#include <cstdint>

#ifndef MK_N_LAUNCHES
#define MK_N_LAUNCHES 1
#endif

constexpr int NB = 8, SEQ = 4096, T = NB * SEQ, D = 1024;
constexpr int ATT_W = 768, GM_W = 768, IN_W = 5888, NE = 32, TOPK = 4, PLE = 256;
constexpr float EPS = 1e-6f;
constexpr float LOG2E = 1.4426950408889634f, LN2 = 0.6931471805599453f;
constexpr float QSCALE = 0.125f * LOG2E;

#define LAS __attribute__((address_space(3)))
#define GAS __attribute__((address_space(1)))
typedef unsigned short bf16;
typedef unsigned v4u __attribute__((ext_vector_type(4)));
typedef unsigned v2u __attribute__((ext_vector_type(2)));
typedef float f32x4 __attribute__((ext_vector_type(4)));
typedef float f32x2 __attribute__((ext_vector_type(2)));
typedef float f32x16 __attribute__((ext_vector_type(16)));
typedef short bf16x8 __attribute__((ext_vector_type(8)));
typedef short s16x4 __attribute__((ext_vector_type(4)));

__device__ __forceinline__ unsigned f2bf(float f) { unsigned u = __builtin_bit_cast(unsigned, f); return (u + 0x7fffu + ((u >> 16) & 1u)) >> 16; }
__device__ __forceinline__ unsigned pk2(float lo, float hi) { return f2bf(lo) | (f2bf(hi) << 16); }
__device__ __forceinline__ float bflo(unsigned w) { return __builtin_bit_cast(float, w << 16); }
__device__ __forceinline__ float bfhi(unsigned w) { return __builtin_bit_cast(float, w & 0xffff0000u); }
typedef __bf16 bf16x2_t __attribute__((ext_vector_type(2)));
__device__ __forceinline__ unsigned cvt_pk_bf16(float lo, float hi) { const f32x2 v = {lo, hi}; const bf16x2_t b = __builtin_convertvector(v, bf16x2_t); return __builtin_bit_cast(unsigned, b); }
__device__ __forceinline__ float sigmoidf_(float x) { return __builtin_amdgcn_rcpf(1.0f + __builtin_amdgcn_exp2f(-x * LOG2E)); }
__device__ __forceinline__ f32x2 gelu_pk(f32x2 v) {
    const f32x2 av = __builtin_elementwise_abs(v), d = av * 0.2316418882f + 1.0f;
    f32x2 t; t.x = __builtin_amdgcn_rcpf(d.x); t.y = __builtin_amdgcn_rcpf(d.y);
    f32x2 q = t * 0.5307027145f + (-0.7265760135f); q = q * t + 0.7107068705f; q = q * t + (-0.142248368f); q = q * t + 0.127414796f; q = q * t;
    const f32x2 s = (v * v) * (-0.72134752044f);
    f32x2 e; e.x = __builtin_amdgcn_exp2f(s.x); e.y = __builtin_amdgcn_exp2f(s.y);
    const f32x2 m = v * (q * e), r = v - m;
    f32x2 o; o.x = v.x < 0.f ? m.x : r.x; o.y = v.y < 0.f ? m.y : r.y; return o;
}
__device__ __forceinline__ f32x4 gelu4(f32x4 v) { f32x2 a = gelu_pk((f32x2){v[0], v[1]}), b = gelu_pk((f32x2){v[2], v[3]}); return (f32x4){a.x, a.y, b.x, b.y}; }
__device__ __forceinline__ f32x4 sigm4(f32x4 v) { return (f32x4){sigmoidf_(v[0]), sigmoidf_(v[1]), sigmoidf_(v[2]), sigmoidf_(v[3])}; }
__device__ __forceinline__ float wave_sum(float v) {
#pragma unroll
    for (int o = 1; o < 64; o <<= 1) v += __shfl_xor(v, o);
    return v;
}

constexpr size_t MiB = 1u << 20;
constexpr size_t WS_CTL = 0, CTL_ZERO_BYTES = 1 * MiB;
constexpr size_t WS_WIN = 2 * MiB;
constexpr size_t WS_WCAT = 14 * MiB;
constexpr size_t WS_WOUT = 17 * MiB;
constexpr size_t WS_WPG = 19 * MiB;
constexpr size_t WS_WPP = 21 * MiB;
constexpr size_t WS_WSP = 22 * MiB;
constexpr size_t WS_WRH = 23 * MiB;
constexpr size_t WS_WRL = 23 * MiB + 65536;
constexpr size_t WS_SRSTD = 980 * MiB;
constexpr size_t WS_WGU = 24 * MiB;
constexpr size_t WS_WD = 152 * MiB;
constexpr size_t WS_NX = 216 * MiB;
constexpr size_t WS_PB = 280 * MiB;
constexpr size_t WS_PP = 296 * MiB;
constexpr size_t WS_LIST = 360 * MiB;
constexpr size_t WS_SGATE = 364 * MiB;
constexpr size_t WS_POS = 368 * MiB;
constexpr size_t WS_LSE = 369 * MiB;
constexpr size_t WS_Q = 372 * MiB;
constexpr size_t WS_K = 420 * MiB;
constexpr size_t WS_VT = 468 * MiB;
constexpr size_t WS_ZU = 516 * MiB;
constexpr size_t WS_ZVT = 564 * MiB;
constexpr size_t WS_GA = 612 * MiB;
constexpr size_t WS_GG = 676 * MiB;
constexpr size_t WS_OG = 740 * MiB;
constexpr size_t WS_ATT = 788 * MiB;
constexpr size_t WS_G = 804 * MiB;
constexpr size_t WS_AG = 852 * MiB;
constexpr size_t WS_MRG = 916 * MiB;
constexpr size_t WS_ACT = 372 * MiB;
constexpr size_t WS_Y = 644 * MiB;
constexpr size_t WS_T1 = 372 * MiB;
constexpr size_t WS_END = 984 * MiB;
constexpr int PMAX_TILES = 544;

constexpr int CW_CNT = 64;
constexpr int CW_Q1 = 256, CW_Q2 = 320, CW_Q3 = 384, CW_Q4 = 448;
constexpr int CW_BAR = 4096;

constexpr int RING_BYTES = 131072;
constexpr int MISC_OFF = RING_BYTES + 320;
constexpr int TS_OFF = RING_BYTES + 1024;
constexpr int LDS_BYTES = 147456;

namespace pg8 {
typedef unsigned short bf16_t;
constexpr int BM = 256, BK = 64, HALF = 128, HTB = HALF * BK * 2, STAGE_BYTES = 8 * HTB, NXCD = 8, WGM = 8;
__host__ __device__ __forceinline__ int lds_byte(int r, int c) { const int st = (r >> 4) * 2 + (c >> 5), rr = r & 15, cc = c & 31, ob = rr * 64 + cc * 2; return st * 1024 + (ob ^ (((ob >> 9) & 1) << 5)); }
__host__ __device__ __forceinline__ void stage_rc(int b, int& R, int& C) { const int st = b / 1024, sb = b % 1024, swz = sb ^ (((sb >> 9) & 1) << 5); R = (st >> 1) * 16 + swz / 64; C = (st & 1) * 32 + (swz % 64) / 2; }
__host__ __device__ __forceinline__ int perm32(int rho) { const int n = rho >> 4, i = rho & 15; return 8 * (i >> 2) + 4 * n + (i & 3); }

struct Unit { const char* a; const char* b; int pm, pn, x0, x1; };

__device__ __forceinline__ bool static_order(int i, int G, int c, int nM, int nN, int& pm, int& pn) {
    const int nwg = nM * nN; const long L = (long)i * G + c; if (L >= nwg) return false;
    int wgid = (int)L; { const int q = nwg / NXCD, r = nwg % NXCD, xcd = wgid % NXCD, off = wgid / NXCD; wgid = (xcd < r ? xcd * (q + 1) : r * (q + 1) + (xcd - r) * q) + off; }
    const int nig = WGM * nN, gid = wgid / nig, fm = gid * WGM, gsz = (nM - fm) < WGM ? (nM - fm) : WGM;
    pm = fm + ((wgid % nig) % gsz); pn = (wgid % nig) / gsz; return true;
}

template <class Epi, class Sched>
__device__ __forceinline__ void gemm_phase(LAS unsigned char* lds, const int K, const Sched& S, const Epi& E) {
    const int tid = threadIdx.x, wid = __builtin_amdgcn_readfirstlane(tid >> 6), lane = tid & 63, wr = wid >> 2, wc = wid & 3, fr = lane & 15, fq = lane >> 4;
    const int nt = K / BK;
    int RA[2]; unsigned CB2[2], voffB[2];
#pragma unroll
    for (int i = 0; i < 2; ++i) { int R, C; stage_rc(tid * 16 + i * 8192, R, C); const int Rb = Epi::PERM ? ((R & ~31) + perm32(R & 31)) : R;
        RA[i] = R; CB2[i] = (unsigned)C * 2u; voffB[i] = (unsigned)(Rb * K + C) * 2u; }
    const size_t kstep = (size_t)(BK * 2);
    const size_t hstep = (size_t)HALF * K * 2;
    const unsigned ldsw = (unsigned)wid * 1024u;
    const int aoff = lds_byte(wr * 64 + fr, fq * 8), boff = lds_byte(wc * 32 + fr, fq * 8);
#define PG8_SA(b, h) (((b) * 2 + (h)) * HTB)
#define PG8_SB(b, h) ((4 + (b) * 2 + (h)) * HTB)
#define PG8_STAGE(bufoff, gbase, voff) do { _Pragma("unroll") for (int _i = 0; _i < 2; ++_i) \
        __builtin_amdgcn_global_load_lds((const unsigned*)((const char*)(gbase) + (voff)[_i]), (LAS unsigned*)(lds + (bufoff) + ldsw + _i * 8192), 16, 0, 0); } while (0)
#define PG8_LDA(dst, b, h) do { _Pragma("unroll") for (int m = 0; m < 4; ++m) _Pragma("unroll") for (int k = 0; k < 2; ++k) dst[m][k] = *(const LAS bf16x8*)(lds + PG8_SA(b, h) + aoff + m * 2048 + k * 1024); } while (0)
#define PG8_LDB(dst, b, h) do { _Pragma("unroll") for (int n = 0; n < 2; ++n) _Pragma("unroll") for (int k = 0; k < 2; ++k) dst[n][k] = *(const LAS bf16x8*)(lds + PG8_SB(b, h) + boff + n * 2048 + k * 1024); } while (0)
#define PG8_MMA(ai, bj, At, Bt) do { __builtin_amdgcn_s_setprio(1); _Pragma("unroll") for (int m = 0; m < 4; ++m) _Pragma("unroll") for (int n = 0; n < 2; ++n) _Pragma("unroll") for (int k = 0; k < 2; ++k) \
        acc[ai][bj][m][n] = __builtin_amdgcn_mfma_f32_16x16x32_bf16(Bt[n][k], At[m][k], acc[ai][bj][m][n], 0, 0, 0); __builtin_amdgcn_s_setprio(0); } while (0)
#define PG8_WAIT_V(n) asm volatile("s_waitcnt vmcnt(" #n ")" ::: "memory")
#define PG8_WAIT_L(n) asm volatile("s_waitcnt lgkmcnt(" #n ")" ::: "memory")
#define PG8_BAR __builtin_amdgcn_s_barrier()
#define PG8_SCHED __builtin_amdgcn_sched_barrier(0)
    Unit cur, nxt; int ui = 0;
    if (!S.next(0, cur)) return;
    f32x4 acc[2][2][4][2];
#pragma unroll
    for (int a = 0; a < 2; ++a)
#pragma unroll
        for (int b = 0; b < 2; ++b)
#pragma unroll
            for (int m = 0; m < 4; ++m)
#pragma unroll
                for (int n = 0; n < 2; ++n) acc[a][b][m][n] = (f32x4){0.f, 0.f, 0.f, 0.f};
    bf16x8 At[4][2], B0[2][2], B1[2][2];
    const char* cA = cur.a; const char* cB = cur.b;
    unsigned oA[2][2], nO[2][2];
#pragma unroll
    for (int h = 0; h < 2; ++h)
#pragma unroll
        for (int i = 0; i < 2; ++i) oA[h][i] = S.a_off(cur, h * HALF + RA[i], K) + CB2[i];
    PG8_STAGE(PG8_SB(0, 0), cB, voffB); PG8_STAGE(PG8_SB(0, 1), cB + hstep, voffB); PG8_STAGE(PG8_SA(0, 0), cA, oA[0]); PG8_STAGE(PG8_SA(0, 1), cA, oA[1]);
    if (wr == 1) PG8_BAR;
    PG8_WAIT_V(2); PG8_BAR;
    PG8_STAGE(PG8_SB(1, 0), cB + kstep, voffB); PG8_STAGE(PG8_SA(1, 0), cA + kstep, oA[0]); PG8_STAGE(PG8_SB(1, 1), cB + hstep + kstep, voffB);
    PG8_WAIT_V(6); PG8_BAR;
    for (;;) {
        const bool has_next = S.next(ui + 1, nxt);
        const char* nA = has_next ? nxt.a : cA; const char* nB = has_next ? nxt.b : cB;
#pragma unroll
        for (int h = 0; h < 2; ++h)
#pragma unroll
            for (int i = 0; i < 2; ++i) nO[h][i] = has_next ? (S.a_off(nxt, h * HALF + RA[i], K) + CB2[i]) : oA[h][i];
#pragma unroll 1
        for (int t = 0; t < nt; t += 2) {
            const bool last = (t == nt - 2);
            const char* a1 = cA + (size_t)(t + 1) * kstep;
            const char* a2 = last ? nA : cA + (size_t)(t + 2) * kstep; const char* b2 = last ? nB : cB + (size_t)(t + 2) * kstep;
            const char* a3 = a2 + kstep; const char* b3 = b2 + kstep;
            unsigned o2[2][2];
#pragma unroll
            for (int h = 0; h < 2; ++h)
#pragma unroll
                for (int i = 0; i < 2; ++i) o2[h][i] = last ? nO[h][i] : oA[h][i];
            PG8_LDB(B0, 0, 0); PG8_LDB(B1, 0, 1); PG8_SCHED; PG8_LDA(At, 0, 0); PG8_STAGE(PG8_SA(1, 1), a1, oA[1]);
            PG8_WAIT_V(8); PG8_WAIT_L(0); PG8_BAR; PG8_MMA(0, 0, At, B0); PG8_MMA(0, 1, At, B1); PG8_BAR; PG8_SCHED;
            PG8_LDA(At, 0, 1); PG8_STAGE(PG8_SB(0, 0), b2, voffB); PG8_STAGE(PG8_SB(0, 1), b2 + hstep, voffB); PG8_STAGE(PG8_SA(0, 0), a2, o2[0]);
            PG8_WAIT_V(8); PG8_WAIT_L(0); PG8_BAR; PG8_MMA(1, 0, At, B0); PG8_MMA(1, 1, At, B1); PG8_BAR; PG8_SCHED;
            PG8_LDB(B0, 1, 0); PG8_LDB(B1, 1, 1); PG8_SCHED; PG8_LDA(At, 1, 0); PG8_STAGE(PG8_SA(0, 1), a2, o2[1]);
            PG8_WAIT_V(8); PG8_WAIT_L(0); PG8_BAR; PG8_MMA(0, 0, At, B0); PG8_MMA(0, 1, At, B1); PG8_BAR; PG8_SCHED;
            PG8_LDA(At, 1, 1); PG8_STAGE(PG8_SB(1, 0), b3, voffB); PG8_STAGE(PG8_SB(1, 1), b3 + hstep, voffB); PG8_STAGE(PG8_SA(1, 0), a3, o2[0]);
            PG8_WAIT_V(8); PG8_WAIT_L(0); PG8_BAR; PG8_MMA(1, 0, At, B0); PG8_MMA(1, 1, At, B1); PG8_BAR; PG8_SCHED;
            if constexpr (Epi::HOOK_T >= 0) { if (t == Epi::HOOK_T) { E.mid(acc, cur, wr, wc, fr, fq); PG8_SCHED; } }
        }
        if (wr == 0) PG8_BAR;
        E(acc, cur, wr, wc, fr, fq);
        if (!has_next) break;
#pragma unroll
        for (int a = 0; a < 2; ++a)
#pragma unroll
            for (int b = 0; b < 2; ++b)
#pragma unroll
                for (int m = 0; m < 4; ++m)
#pragma unroll
                    for (int n = 0; n < 2; ++n) acc[a][b][m][n] = (f32x4){0.f, 0.f, 0.f, 0.f};
        cur = nxt; cA = nA; cB = nB; ++ui;
#pragma unroll
        for (int h = 0; h < 2; ++h)
#pragma unroll
            for (int i = 0; i < 2; ++i) oA[h][i] = nO[h][i];
        if (wr == 1) PG8_BAR;
    }
    PG8_WAIT_V(0);
    PG8_BAR;
#undef PG8_SA
#undef PG8_SB
#undef PG8_STAGE
#undef PG8_LDA
#undef PG8_LDB
#undef PG8_MMA
#undef PG8_WAIT_V
#undef PG8_WAIT_L
#undef PG8_BAR
#undef PG8_SCHED
}
}
using pg8::Unit;
typedef f32x4 Acc[2][2][4][2];

struct PlainSched {
    const char* A; const char* Bt; int nM, nN, K, G, c, rsh;
    __device__ __forceinline__ bool next(int i, Unit& u) const {
        int pm, pn; if (!pg8::static_order(i >> rsh, G, c, nM, nN, pm, pn)) return false;
        u.pm = pm; u.pn = pn; u.x0 = 0; u.x1 = 0; u.a = A + (size_t)pm * 256 * K * 2; u.b = Bt + (size_t)pn * 256 * K * 2; return true;
    }
    __device__ __forceinline__ unsigned a_off(const Unit&, int row, int K_) const { return (unsigned)(row * K_) * 2u; }
};
struct InProjSched {
    const char* NX; const char* Wt; int G, c, rsh;
    __device__ __forceinline__ bool next(int i, Unit& u) const {
        int pm, pn; if (!pg8::static_order(i >> rsh, G, c, T / 256, 23, pm, pn)) return false;
        u.pm = pm; u.pn = pn; u.x0 = 0; u.x1 = 0;
        const char* xa = NX + (size_t)pm * 256 * D * 2; const char* wb = Wt + (size_t)pn * 256 * D * 2;
        if (pn < 17) { u.a = xa; u.b = wb; } else { u.a = wb; u.b = xa; }
        return true;
    }
    __device__ __forceinline__ unsigned a_off(const Unit&, int row, int K_) const { return (unsigned)(row * K_) * 2u; }
};
struct MoeSched {
    const char* A; const char* Bt; const int* list; const LAS int* ts; int nN, K, G, c, gather, rsh;
    __device__ __forceinline__ bool next(int i, Unit& u) const {
        const int MT = ts[32];
        int pm, pn; if (!pg8::static_order(i >> rsh, G, c, MT, nN, pm, pn)) return false;
        int e = 0;
#pragma unroll
        for (int s = 16; s >= 1; s >>= 1) { if (ts[e + s] <= pm) e += s; }
        e = __builtin_amdgcn_readfirstlane(e);
        u.pm = pm; u.pn = pn; u.x0 = e; u.x1 = __builtin_amdgcn_readfirstlane(pm - ts[e]);
        u.a = gather ? A : A + (size_t)pm * 256 * K * 2;
        u.b = Bt + ((size_t)e * nN + pn) * 256 * K * 2;
        return true;
    }
    __device__ __forceinline__ unsigned a_off(const Unit& u, int row, int K_) const {
        if (!gather) return (unsigned)(row * K_) * 2u;
        const int slot = u.x1 * 256 + row, cnt = ts[40 + u.x0];
        const int tok = slot < cnt ? list[u.x0 * 32768 + slot] : 0;
        return (unsigned)(tok * K_) * 2u;
    }
};

__device__ __forceinline__ void st8(bf16* p, f32x4 v0, f32x4 v1) { v4u w; w.x = cvt_pk_bf16(v0[0], v0[1]); w.y = cvt_pk_bf16(v0[2], v0[3]); w.z = cvt_pk_bf16(v1[0], v1[1]); w.w = cvt_pk_bf16(v1[2], v1[3]); *(v4u*)p = w; }
__device__ __forceinline__ void ld8(const bf16* p, f32x4& v0, f32x4& v1) { const v4u w = *(const v4u*)p; v0 = (f32x4){bflo(w.x), bfhi(w.x), bflo(w.y), bfhi(w.y)}; v1 = (f32x4){bflo(w.z), bfhi(w.z), bflo(w.w), bfhi(w.w)}; }

struct EpiInProj {
    static constexpr bool PERM = true; static constexpr int HOOK_T = -1;
    bf16 *Q, *Kb, *ZU, *GA, *GG, *VT, *ZVT;
    template <int ACT> __device__ __forceinline__ void std_store(const Acc& acc, bf16* base, int ldc, int colt, int pm, int wr, int wc, int fr, int fq) const {
        const int row0 = pm * 256 + wr * 64 + fr, col0 = colt + wc * 32 + 8 * fq;
#pragma unroll
        for (int ai = 0; ai < 2; ++ai)
#pragma unroll
            for (int m = 0; m < 4; ++m) { bf16* rowp = base + (size_t)(row0 + ai * 128 + m * 16) * ldc + col0;
#pragma unroll
                for (int bj = 0; bj < 2; ++bj) { f32x4 v0 = acc[ai][bj][m][0], v1 = acc[ai][bj][m][1];
                    if (ACT == 1) { v0 = v0 * QSCALE; v1 = v1 * QSCALE; }
                    if (ACT == 2) { v0 = gelu4(v0); v1 = gelu4(v1); }
                    if (ACT == 3) { v0 = sigm4(v0); v1 = sigm4(v1); }
                    st8(rowp + bj * 128, v0, v1); } }
    }
    template <int ACT> __device__ __forceinline__ void tile_store(const Acc& acc, bf16* base, int g, int pm, int wr, int wc, int fr, int fq) const {
        const int dsh = 2 * g, row0 = pm * 256 + wr * 64 + fr;
#pragma unroll
        for (int ai = 0; ai < 2; ++ai)
#pragma unroll
            for (int m = 0; m < 4; ++m) { const int t = row0 + ai * 128 + m * 16, bb = t >> 12, sq = t & (SEQ - 1), r = sq & ((1 << dsh) - 1), i = sq >> dsh, kb = i >> 5, key = i & 31;
#pragma unroll
                for (int bj = 0; bj < 2; ++bj) { const int cw = bj * 128 + wc * 32 + 8 * fq, hh = cw >> 6, dd = cw & 63;
                    f32x4 v0 = acc[ai][bj][m][0], v1 = acc[ai][bj][m][1];
                    if (ACT == 1) { v0 = v0 * QSCALE; v1 = v1 * QSCALE; }
                    st8(base + ((size_t)((bb * 3 + g) * 4 + hh) * 128 + (size_t)((r << (7 - dsh)) + kb)) * 2048 + key * 64 + dd, v0, v1); } }
    }
    __device__ __forceinline__ void operator()(const Acc& acc, const Unit& u, int wr, int wc, int fr, int fq) const {
        const int pn = u.pn, pm = u.pm;
        if (pn < 3) tile_store<1>(acc, Q, pn, pm, wr, wc, fr, fq);
        else if (pn < 6) tile_store<0>(acc, Kb, pn - 3, pm, wr, wc, fr, fq);
        else if (pn < 9) std_store<2>(acc, ZU, GM_W, (pn - 6) * 256, pm, wr, wc, fr, fq);
        else if (pn < 13) std_store<3>(acc, GA, D, (pn - 9) * 256, pm, wr, wc, fr, fq);
        else if (pn < 17) std_store<3>(acc, GG, D, (pn - 13) * 256, pm, wr, wc, fr, fq);
        else if (pn < 20) {
            const int g = pn - 17, tok0 = pm * 256 + wc * 32 + 8 * fq;
#pragma unroll
            for (int ai = 0; ai < 2; ++ai)
#pragma unroll
                for (int m = 0; m < 4; ++m) { const int chl = ai * 128 + wr * 64 + m * 16 + fr, hh = chl >> 6, dd = chl & 63;
#pragma unroll
                    for (int bj = 0; bj < 2; ++bj) { const f32x4 v0 = acc[ai][bj][m][0], v1 = acc[ai][bj][m][1];
                        const int tk = tok0 + bj * 128, bb = tk >> 12, s0 = tk & (SEQ - 1);
                        bf16* hb = VT + (size_t)((bb * 3 + g) * 4 + hh) * (128 * 64 * 32) + dd * 32;
                        if (g == 0) { const int kb = s0 >> 5, k0 = s0 & 31, p0 = (k0 & 16) + 4 * ((k0 >> 3) & 1);
                            bf16* tp = hb + (size_t)kb * 2048 + p0;
                            v2u w0, w1; w0.x = cvt_pk_bf16(v0[0], v0[1]); w0.y = cvt_pk_bf16(v0[2], v0[3]); w1.x = cvt_pk_bf16(v1[0], v1[1]); w1.y = cvt_pk_bf16(v1[2], v1[3]);
                            *(v2u*)tp = w0; *(v2u*)(tp + 8) = w1;
                        } else if (g == 1) { const int i = s0 >> 2, kb = i >> 5, k = i & 31, ps = (k & 19) | ((k & 4) << 1) | ((k & 8) >> 1);
#pragma unroll
                            for (int r = 0; r < 4; ++r) *(unsigned*)(hb + (size_t)(r * 32 + kb) * 2048 + ps) = cvt_pk_bf16(v0[r], v1[r]);
                        } else { const int i = s0 >> 4, kb = i >> 5, k = i & 31, ps = (k & 19) | ((k & 4) << 1) | ((k & 8) >> 1), rb = s0 & 15;
#pragma unroll
                            for (int e = 0; e < 4; ++e) { hb[(size_t)((rb + e) * 8 + kb) * 2048 + ps] = (bf16)f2bf(v0[e]); hb[(size_t)((rb + 4 + e) * 8 + kb) * 2048 + ps] = (bf16)f2bf(v1[e]); }
                        } } }
        } else {
            const int ch0 = (pn - 20) * 256 + wr * 64 + fr, tin = wc * 32 + 8 * fq;
#pragma unroll
            for (int ai = 0; ai < 2; ++ai)
#pragma unroll
                for (int m = 0; m < 4; ++m) { const int ch = ch0 + ai * 128 + m * 16;
#pragma unroll
                    for (int bj = 0; bj < 2; ++bj) st8(ZVT + ((size_t)(2 * pm + bj) * GM_W + ch) * 128 + tin, gelu4(acc[ai][bj][m][0]), gelu4(acc[ai][bj][m][1])); }
        }
    }
};
template <int MODE> struct EpiBf {
    static constexpr bool PERM = true; static constexpr int HOOK_T = -1;
    bf16* O; const bf16* G1; const bf16* Y0;
    __device__ __forceinline__ void operator()(const Acc& acc, const Unit& u, int wr, int wc, int fr, int fq) const {
        const int row0 = u.pm * 256 + wr * 64 + fr, col0 = u.pn * 256 + wc * 32 + 8 * fq;
#pragma unroll
        for (int ai = 0; ai < 2; ++ai) {
            v4u gw[4][2], yw[4][2];
            if (MODE >= 1) {
#pragma unroll
                for (int m = 0; m < 4; ++m)
#pragma unroll
                    for (int bj = 0; bj < 2; ++bj) { const size_t off = (size_t)(row0 + ai * 128 + m * 16) * D + col0 + bj * 128; gw[m][bj] = *(const v4u*)(G1 + off); if (MODE == 2) yw[m][bj] = *(const v4u*)(Y0 + off); }
                __builtin_amdgcn_sched_barrier(0);
            }
#pragma unroll
            for (int m = 0; m < 4; ++m)
#pragma unroll
                for (int bj = 0; bj < 2; ++bj) { const size_t off = (size_t)(row0 + ai * 128 + m * 16) * D + col0 + bj * 128; f32x4 v0 = acc[ai][bj][m][0], v1 = acc[ai][bj][m][1];
                    if (MODE >= 1) { const v4u w = gw[m][bj]; v0 = v0 * (f32x4){bflo(w.x), bfhi(w.x), bflo(w.y), bfhi(w.y)}; v1 = v1 * (f32x4){bflo(w.z), bfhi(w.z), bflo(w.w), bfhi(w.w)}; }
                    if (MODE == 2) { const v4u w = yw[m][bj]; v0 = v0 + (f32x4){bflo(w.x), bfhi(w.x), bflo(w.y), bfhi(w.y)}; v1 = v1 + (f32x4){bflo(w.z), bfhi(w.z), bflo(w.w), bfhi(w.w)}; }
                    st8(O + off, v0, v1); }
            if (MODE >= 1) __builtin_amdgcn_sched_barrier(0);
        }
    }
};
template <int MODE> struct EpiF32 {
    static constexpr bool PERM = false; static constexpr int HOOK_T = -1;
    float* H; const float* X; const bf16* PP;
    __device__ __forceinline__ void operator()(const Acc& acc, const Unit& u, int wr, int wc, int fr, int fq) const {
        const int row0 = u.pm * 256 + wr * 64 + fr, col0 = u.pn * 256 + wc * 32 + 4 * fq;
        const float* src = MODE == 0 ? X : H;
        constexpr int MB = MODE == 0 ? 4 : 2;
#pragma unroll
        for (int ai = 0; ai < 2; ++ai)
#pragma unroll
            for (int mb = 0; mb < 4; mb += MB) {
                f32x4 xv[MB][2][2]; v2u pw[MB][2][2];
#pragma unroll
                for (int m = 0; m < MB; ++m)
#pragma unroll
                    for (int bj = 0; bj < 2; ++bj)
#pragma unroll
                        for (int n = 0; n < 2; ++n) { const size_t o = (size_t)(row0 + ai * 128 + (mb + m) * 16) * D + col0 + bj * 128 + n * 16; xv[m][bj][n] = *(const f32x4*)(src + o); if (MODE == 1) pw[m][bj][n] = *(const v2u*)(PP + o); }
                __builtin_amdgcn_sched_barrier(0);
#pragma unroll
                for (int m = 0; m < MB; ++m)
#pragma unroll
                    for (int bj = 0; bj < 2; ++bj)
#pragma unroll
                        for (int n = 0; n < 2; ++n) { const size_t o = (size_t)(row0 + ai * 128 + (mb + m) * 16) * D + col0 + bj * 128 + n * 16; f32x4 v = acc[ai][bj][mb + m][n];
                            if (MODE == 0) v = v + xv[m][bj][n];
                            else { const v2u w = pw[m][bj][n]; v = xv[m][bj][n] + sigm4(v) * (f32x4){bflo(w.x), bfhi(w.x), bflo(w.y), bfhi(w.y)}; }
                            *(f32x4*)(H + o) = v; }
                __builtin_amdgcn_sched_barrier(0);
            }
    }
};
struct EpiMerge {
    static constexpr bool PERM = true; static constexpr int HOOK_T = 2;
    bf16* O; const bf16* GA; const bf16* GG;
    __device__ __forceinline__ void mid(Acc& acc, const Unit& u, int wr, int wc, int fr, int fq) const {
        int row0 = u.pm * 256 + wr * 64 + fr; const int col0 = u.pn * 256 + wc * 32 + 8 * fq;
        asm volatile("" : "+v"(row0));
#pragma unroll
        for (int ai = 0; ai < 2; ++ai)
#pragma unroll
            for (int mb = 0; mb < 4; mb += 2) {
                v4u aw[2][2], gw[2][2];
#pragma unroll
                for (int m = 0; m < 2; ++m)
#pragma unroll
                    for (int bj = 0; bj < 2; ++bj) { const size_t off = (size_t)(row0 + ai * 128 + (mb + m) * 16) * D + col0 + bj * 128; aw[m][bj] = *(const v4u*)(GA + off); gw[m][bj] = *(const v4u*)(GG + off); }
                __builtin_amdgcn_sched_barrier(0);
#pragma unroll
                for (int m = 0; m < 2; ++m)
#pragma unroll
                    for (int bj = 0; bj < 2; ++bj) { const v4u a = aw[m][bj], g = gw[m][bj];
                        acc[ai][bj][mb + m][0] = acc[ai][bj][mb + m][0] * (f32x4){bflo(a.x) * __builtin_amdgcn_rcpf(fmaxf(bflo(g.x), 1e-30f)), bfhi(a.x) * __builtin_amdgcn_rcpf(fmaxf(bfhi(g.x), 1e-30f)), bflo(a.y) * __builtin_amdgcn_rcpf(fmaxf(bflo(g.y), 1e-30f)), bfhi(a.y) * __builtin_amdgcn_rcpf(fmaxf(bfhi(g.y), 1e-30f))};
                        acc[ai][bj][mb + m][1] = acc[ai][bj][mb + m][1] * (f32x4){bflo(a.z) * __builtin_amdgcn_rcpf(fmaxf(bflo(g.z), 1e-30f)), bfhi(a.z) * __builtin_amdgcn_rcpf(fmaxf(bfhi(g.z), 1e-30f)), bflo(a.w) * __builtin_amdgcn_rcpf(fmaxf(bflo(g.w), 1e-30f)), bfhi(a.w) * __builtin_amdgcn_rcpf(fmaxf(bfhi(g.w), 1e-30f))}; }
                __builtin_amdgcn_sched_barrier(0);
            }
    }
    __device__ __forceinline__ void operator()(const Acc& acc, const Unit& u, int wr, int wc, int fr, int fq) const {
        const int row0 = u.pm * 256 + wr * 64 + fr, col0 = u.pn * 256 + wc * 32 + 8 * fq;
#pragma unroll
        for (int ai = 0; ai < 2; ++ai) {
            v4u gw[4][2];
#pragma unroll
            for (int m = 0; m < 4; ++m)
#pragma unroll
                for (int bj = 0; bj < 2; ++bj) gw[m][bj] = *(const v4u*)(GG + (size_t)(row0 + ai * 128 + m * 16) * D + col0 + bj * 128);
            __builtin_amdgcn_sched_barrier(0);
#pragma unroll
            for (int m = 0; m < 4; ++m)
#pragma unroll
                for (int bj = 0; bj < 2; ++bj) { const v4u g = gw[m][bj];
                    st8(O + (size_t)(row0 + ai * 128 + m * 16) * D + col0 + bj * 128, acc[ai][bj][m][0] * (f32x4){bflo(g.x), bfhi(g.x), bflo(g.y), bfhi(g.y)}, acc[ai][bj][m][1] * (f32x4){bflo(g.z), bfhi(g.z), bflo(g.w), bfhi(g.w)}); }
            __builtin_amdgcn_sched_barrier(0);
        }
    }
};
struct EpiPle {
    static constexpr bool PERM = true; static constexpr int HOOK_T = -1;
    bf16* O; const bf16* PP;
    __device__ __forceinline__ void operator()(const Acc& acc, const Unit& u, int wr, int wc, int fr, int fq) const {
        const int row0 = u.pm * 256 + wr * 64 + fr, col0 = u.pn * 256 + wc * 32 + 8 * fq;
#pragma unroll
        for (int ai = 0; ai < 2; ++ai) {
            v4u pw[4][2];
#pragma unroll
            for (int m = 0; m < 4; ++m)
#pragma unroll
                for (int bj = 0; bj < 2; ++bj) pw[m][bj] = *(const v4u*)(PP + (size_t)(row0 + ai * 128 + m * 16) * D + col0 + bj * 128);
            __builtin_amdgcn_sched_barrier(0);
#pragma unroll
            for (int m = 0; m < 4; ++m)
#pragma unroll
                for (int bj = 0; bj < 2; ++bj) { const v4u w = pw[m][bj];
                    const f32x4 v0 = sigm4(acc[ai][bj][m][0]) * (f32x4){bflo(w.x), bfhi(w.x), bflo(w.y), bfhi(w.y)}, v1 = sigm4(acc[ai][bj][m][1]) * (f32x4){bflo(w.z), bfhi(w.z), bflo(w.w), bfhi(w.w)};
                    st8(O + (size_t)(row0 + ai * 128 + m * 16) * D + col0 + bj * 128, v0, v1); }
            __builtin_amdgcn_sched_barrier(0);
        }
    }
};
struct EpiMoeUp {
    static constexpr bool PERM = true; static constexpr int HOOK_T = -1;
    bf16* ACT; const float* bgu; const float* srstd; const LAS int* ts;
    __device__ __forceinline__ void operator()(const Acc& acc, const Unit& u, int wr, int wc, int fr, int fq) const {
        const int e = u.x0, cnt = ts[40 + e], srow0 = u.x1 * 256 + wr * 64 + fr;
        const int row0 = u.pm * 256 + wr * 64 + fr, hc = u.pn * 128 + wc * 32 + 8 * fq;
        const float* bg = bgu + (size_t)e * 2048 + hc;
        const f32x4 bg0 = *(const f32x4*)bg, bg1 = *(const f32x4*)(bg + 4), bl0 = *(const f32x4*)(bg + 1024), bl1 = *(const f32x4*)(bg + 1028);
        float rsv[2][4];
#pragma unroll
        for (int ai = 0; ai < 2; ++ai)
#pragma unroll
            for (int m = 0; m < 4; ++m) { const int slot = srow0 + ai * 128 + m * 16; rsv[ai][m] = slot < cnt ? srstd[e * 32768 + slot] : 0.f; }
        __builtin_amdgcn_sched_barrier(0);
#pragma unroll
        for (int ai = 0; ai < 2; ++ai)
#pragma unroll
            for (int m = 0; m < 4; ++m) { const float rs = rsv[ai][m];
                f32x4 o[2];
#pragma unroll
                for (int n = 0; n < 2; ++n) { const f32x4 gu = acc[ai][0][m][n] * rs + (n ? bg1 : bg0), li = acc[ai][1][m][n] * rs + (n ? bl1 : bl0);
#pragma unroll
                    for (int e2 = 0; e2 < 4; ++e2) { const float gl = fminf(gu[e2], 7.0f), ln = fminf(fmaxf(li[e2], -7.0f), 7.0f);
                        o[n][e2] = gl * __builtin_amdgcn_rcpf(1.0f + __builtin_amdgcn_exp2f(-1.702f * LOG2E * gl)) * (ln + 1.0f); } }
                st8(ACT + (size_t)(row0 + ai * 128 + m * 16) * D + hc, o[0], o[1]); }
    }
};
struct EpiMoeDown {
    static constexpr bool PERM = true; static constexpr int HOOK_T = -1;
    bf16* Y; const float* bd; const float* sgate; const LAS int* ts;
    __device__ __forceinline__ void operator()(const Acc& acc, const Unit& u, int wr, int wc, int fr, int fq) const {
        const int e = u.x0, cnt = ts[40 + e], srow0 = u.x1 * 256 + wr * 64 + fr, col0 = u.pn * 256 + wc * 32 + 8 * fq;
        const float* bp = bd + (size_t)e * D + col0;
        f32x4 bv[2][2];
#pragma unroll
        for (int bj = 0; bj < 2; ++bj) { bv[bj][0] = *(const f32x4*)(bp + bj * 128); bv[bj][1] = *(const f32x4*)(bp + bj * 128 + 4); }
        float gtv[2][4];
#pragma unroll
        for (int ai = 0; ai < 2; ++ai)
#pragma unroll
            for (int m = 0; m < 4; ++m) { const int slot = srow0 + ai * 128 + m * 16; gtv[ai][m] = slot < cnt ? sgate[e * 32768 + slot] : 0.f; }
        __builtin_amdgcn_sched_barrier(0);
#pragma unroll
        for (int ai = 0; ai < 2; ++ai)
#pragma unroll
            for (int m = 0; m < 4; ++m) { const float gt = gtv[ai][m];
                bf16* rowp = Y + (size_t)(u.pm * 256 + wr * 64 + fr + ai * 128 + m * 16) * D + col0;
#pragma unroll
                for (int bj = 0; bj < 2; ++bj) st8(rowp + bj * 128, (acc[ai][bj][m][0] + bv[bj][0]) * gt, (acc[ai][bj][m][1] + bv[bj][1]) * gt); }
    }
};

#define XB_TMO      128
#define XB_XCNT(j)  (256  + 64 * (j))
#define XB_XSUB(j)  (1280 + 64 * (j))
#define XB_XGEN(j)  (2304 + 64 * (j))
#define XB_TOP      3328
#define XB_TOPGEN   3392
#define XCD_BAR_WORDS 3456
#define XB_SPIN_CAP (1u << 18)
__device__ __forceinline__ unsigned xb_ld(unsigned* p)              { return __hip_atomic_load(p, __ATOMIC_RELAXED, __HIP_MEMORY_SCOPE_AGENT); }
__device__ __forceinline__ unsigned xb_add(unsigned* p, unsigned v) { return __hip_atomic_fetch_add(p, v, __ATOMIC_RELAXED, __HIP_MEMORY_SCOPE_AGENT); }
__device__ __forceinline__ unsigned xb_xcc_id() { return (unsigned)__builtin_amdgcn_s_getreg((3 << 11) | 20) & 0xFu; }
#define XB_SPIN(cond, bar) do { unsigned _sp = 0; while (cond) { __builtin_amdgcn_s_sleep(1); \
    if ((++_sp & 255u) == 0u) { if (xb_ld(&(bar)[XB_TMO])) break; if (_sp > XB_SPIN_CAP) { atomicAdd(&(bar)[XB_TMO], 1u); break; } } } } while (0)
struct XcdBarrier { unsigned* bar; unsigned x; volatile LAS unsigned* st; };
__device__ __forceinline__ XcdBarrier xcd_barrier_post(unsigned* bar, volatile LAS unsigned* st) {
    XcdBarrier b; b.bar = bar; b.x = xb_xcc_id(); b.st = st;
    if (threadIdx.x == 0) (void)xb_add(&bar[XB_XCNT(b.x)], 1u);
    return b;
}
__device__ __forceinline__ void xcd_barrier_complete(unsigned* bar, unsigned x, unsigned& nloc, unsigned& nx) {
    const unsigned G = gridDim.x * gridDim.y * gridDim.z;
    unsigned sum, cnt, mine, sp = 0u;
    for (;;) {
        sum = 0u; cnt = 0u; mine = 0u;
#pragma unroll
        for (unsigned j = 0; j < 16; ++j) { const unsigned c = xb_ld(&bar[XB_XCNT(j)]); sum += c; cnt += (c > 0u) ? 1u : 0u; mine = (j == x) ? c : mine; }
        if (sum == G) break;
        __builtin_amdgcn_s_sleep(1);
        if ((++sp & 255u) == 0u) { if (xb_ld(&bar[XB_TMO])) break; if (sp > XB_SPIN_CAP) { atomicAdd(&bar[XB_TMO], 1u); break; } }
    }
    nloc = mine > 0u ? mine : 1u; nx = cnt > 0u ? cnt : 1u;
}
__device__ __forceinline__ void xcd_barrier(const XcdBarrier& b) {
    asm volatile("s_waitcnt vmcnt(0)" ::: "memory");
    __syncthreads();
    if (threadIdx.x == 0) {
        unsigned* bar = b.bar;
        __builtin_amdgcn_s_waitcnt(0);
        unsigned nloc = b.st[0], nx = b.st[1];
        if (nloc == 0u) { xcd_barrier_complete(bar, b.x, nloc, nx); b.st[0] = nloc; b.st[1] = nx; }
        const unsigned old = xb_add(&bar[XB_XSUB(b.x)], 1u);
        const unsigned gen = old / nloc;
        if (old + 1u == (gen + 1u) * nloc) {
            __builtin_amdgcn_fence(__ATOMIC_RELEASE, "agent");
            asm volatile("s_waitcnt vmcnt(0)" ::: "memory");
            const unsigned og = xb_add(&bar[XB_TOP], 1u);
            const unsigned tg = og / nx;
            if (og + 1u == (tg + 1u) * nx) xb_add(&bar[XB_TOPGEN], 1u);
            else XB_SPIN(xb_ld(&bar[XB_TOPGEN]) == tg, bar);
            __builtin_amdgcn_fence(__ATOMIC_ACQUIRE, "agent");
            xb_add(&bar[XB_XGEN(b.x)], 1u);
            asm volatile("s_waitcnt vmcnt(0)" ::: "memory");
        } else {
            XB_SPIN(xb_ld(&bar[XB_XGEN(b.x)]) == gen, bar);
            __builtin_amdgcn_fence(__ATOMIC_ACQUIRE, "agent");
            asm volatile("s_waitcnt vmcnt(0)" ::: "memory");
        }
    }
    __syncthreads();
}

struct Args { const float* in[23]; float* out; unsigned char* ws; int ph_lo, ph_hi; };
struct Frame {
    LAS unsigned char* lds; int wave, vcu, G;
};
#define LDS_WAIT() asm volatile("s_waitcnt lgkmcnt(0)" ::: "memory")

__device__ __forceinline__ int t5_bucket(int n) {
    if (n < 16) return n;
    const int th[15] = {22, 30, 40, 54, 73, 99, 134, 182, 246, 332, 450, 609, 825, 1117, 1513};
    int b = 16;
#pragma unroll
    for (int k = 0; k < 15; ++k) b += (n >= th[k]) ? 1 : 0;
    return b;
}

__device__ __forceinline__ void transpose_item(const float* W, int K, int N, bf16* WT, int drow0, LAS float* scr, int k0, int n0, int lane, int kdst = 0) {
    const int q = lane & 15, kr = lane >> 4;
    f32x4 v[8];
#pragma unroll
    for (int i = 0; i < 8; ++i) v[i] = *(const f32x4*)(W + (size_t)(k0 + 4 * i + kr) * N + n0 + 4 * q);
#pragma unroll
    for (int i = 0; i < 8; ++i) { LAS float* d = scr + (4 * q) * 33 + 4 * i + kr; d[0] = v[i].x; d[33] = v[i].y; d[66] = v[i].z; d[99] = v[i].w; }
    LDS_WAIT(); asm volatile("" ::: "memory");
    const int c4 = lane & 3, nr = lane >> 2;
#pragma unroll
    for (int j = 0; j < 4; ++j) { const int n = nr + 16 * j; const LAS float* sp = scr + n * 33 + 8 * c4;
        v4u o; o.x = pk2(sp[0], sp[1]); o.y = pk2(sp[2], sp[3]); o.z = pk2(sp[4], sp[5]); o.w = pk2(sp[6], sp[7]);
        *(v4u*)(WT + (size_t)(drow0 + n) * K + kdst + k0 + 8 * c4) = o; }
    LDS_WAIT(); asm volatile("" ::: "memory");
}
constexpr int BG_GU = 32 * 32 * 32, BG_DN = 32 * 32 * 16, BG_N = BG_GU + BG_DN;
constexpr int BG_P1 = 32768;
struct BgItem { const float* W; bf16* WT; int N, k0, n0, drow0, pitch, kdst; };
constexpr int BG_X0 = BG_N, BG_X1 = BG_X0 + 8 * 16, BG_X2 = BG_X1 + 24 * 16, BG_X3 = BG_X2 + 32 * 16, BG_X4 = BG_X3 + 32 * 16, BG_ALL = BG_X4 + 8 * 16;
__device__ __forceinline__ BgItem bg_decode(const Args& A, int r) {
    BgItem it; it.pitch = D; it.kdst = 0;
    if (r < BG_GU) { const int e = r >> 10, q = r & 1023, kb = q >> 5, nb = q & 31, n0 = nb * 64;
        it.W = A.in[15] + (size_t)e * D * 2048; it.WT = (bf16*)(A.ws + WS_WGU) + (size_t)e * 2048 * D; it.N = 2048; it.k0 = kb * 32; it.n0 = n0;
        it.drow0 = n0 < 1024 ? 256 * (n0 >> 7) + (n0 & 127) : 256 * ((n0 - 1024) >> 7) + 128 + (n0 & 127);
    } else if (r < BG_N) { r -= BG_GU; const int e = r >> 9, q = r & 511, kb = q >> 4, nb = q & 15;
        it.W = A.in[17] + (size_t)e * D * D; it.WT = (bf16*)(A.ws + WS_WD) + (size_t)e * D * D; it.N = D; it.k0 = kb * 32; it.n0 = nb * 64; it.drow0 = nb * 64;
    } else { int src; bf16* dst;
        if (r < BG_X1) { r -= BG_X0; src = 5; dst = (bf16*)(A.ws + WS_WCAT); }
        else if (r < BG_X2) { r -= BG_X1; src = 10; dst = (bf16*)(A.ws + WS_WCAT); it.kdst = 256; }
        else if (r < BG_X3) { r -= BG_X2; src = 11; dst = (bf16*)(A.ws + WS_WOUT); }
        else if (r < BG_X4) { r -= BG_X3; src = 20; dst = (bf16*)(A.ws + WS_WPG); }
        else { r -= BG_X4; src = 21; dst = (bf16*)(A.ws + WS_WPP); it.pitch = PLE; }
        it.W = src == 5 ? A.in[5] : src == 10 ? A.in[10] : src == 11 ? A.in[11] : src == 20 ? A.in[20] : A.in[21];
        it.WT = dst; it.N = D; it.k0 = (r >> 4) * 32; it.n0 = (r & 15) * 64; it.drow0 = it.n0; }
    return it;
}
struct BgConv {
    int cur, next, stride, end; f32x4 v[8];
    __device__ __forceinline__ void init(int first, int stride_, int end_ = BG_ALL) { cur = -1; next = first; stride = stride_; end = end_; }
    __device__ __forceinline__ void issue(const Args& A, int lane) {
        if (next < end) { const BgItem it = bg_decode(A, next); const int q = lane & 15, kr = lane >> 4;
#pragma unroll
            for (int i = 0; i < 8; ++i) v[i] = *(const f32x4*)(it.W + (size_t)(it.k0 + 4 * i + kr) * it.N + it.n0 + 4 * q);
            cur = next; next += stride; } else cur = -1;
    }
    __device__ __forceinline__ void finish(const Args& A, LAS float* scr, int lane) {
        if (cur >= 0) { const BgItem it = bg_decode(A, cur); const int q = lane & 15, kr = lane >> 4;
#pragma unroll
            for (int i = 0; i < 8; ++i) { LAS float* d = scr + (4 * q) * 33 + 4 * i + kr; d[0] = v[i].x; d[33] = v[i].y; d[66] = v[i].z; d[99] = v[i].w; }
            LDS_WAIT(); asm volatile("" ::: "memory");
            const int c4 = lane & 3, nr = lane >> 2;
#pragma unroll
            for (int j = 0; j < 4; ++j) { const int n = nr + 16 * j; const LAS float* sp = scr + n * 33 + 8 * c4;
                v4u o; o.x = pk2(sp[0], sp[1]); o.y = pk2(sp[2], sp[3]); o.z = pk2(sp[4], sp[5]); o.w = pk2(sp[6], sp[7]);
                *(v4u*)(it.WT + (size_t)(it.drow0 + n) * it.pitch + it.kdst + it.k0 + 8 * c4) = o; }
            LDS_WAIT(); asm volatile("" ::: "memory");
            cur = -1; }
    }
};
__device__ __forceinline__ void convert_queue(const Frame& F, const Args& A, unsigned* ctr, int lo, int hi) {
    LAS float* scr = (LAS float*)(F.lds + F.wave * 8448);
    LAS int* qs = (LAS int*)(F.lds + RING_BYTES + 512);
    const int lane = (int)threadIdx.x & 63;
    BgConv c0, c1;
    for (;;) {
        __syncthreads();
        if (threadIdx.x == 0) *qs = (int)__hip_atomic_fetch_add(ctr, 64u, __ATOMIC_RELAXED, __HIP_MEMORY_SCOPE_AGENT);
        __syncthreads();
        const int base = __builtin_amdgcn_readfirstlane(*qs) + lo + F.wave * 8;
        if (base - F.wave * 8 >= hi) break;
        c0.init(base, 2, base + 8 < hi ? base + 8 : hi); c1.init(base + 1, 2, base + 8 < hi ? base + 8 : hi);
        c0.issue(A, lane); c1.issue(A, lane);
#pragma unroll 1
        for (int k = 0; k < 4; ++k) { c0.finish(A, scr, lane); c0.issue(A, lane); c1.finish(A, scr, lane); c1.issue(A, lane); }
    }
}
__device__ __forceinline__ void convert_p_queue(const Frame& F, const Args& A, unsigned* ctr) {
    const int lane = (int)threadIdx.x & 63; const float* p = A.in[1]; bf16* pb = (bf16*)(A.ws + WS_PB);
    LAS int* qs = (LAS int*)(F.lds + RING_BYTES + 512);
    for (;;) {
        __syncthreads();
        if (threadIdx.x == 0) *qs = (int)__hip_atomic_fetch_add(ctr, 8u, __ATOMIC_RELAXED, __HIP_MEMORY_SCOPE_AGENT);
        __syncthreads();
        const int ck0 = __builtin_amdgcn_readfirstlane(*qs);
        if (ck0 >= (T * PLE) / 8192) break;
        const size_t base = (size_t)(ck0 + F.wave) * 8192 + 8 * lane;
#pragma unroll 4
        for (int i = 0; i < 16; ++i) { const f32x4 a = *(const f32x4*)(p + base + 512 * i), b = *(const f32x4*)(p + base + 512 * i + 4); st8(pb + base + 512 * i, a, b); }
    }
}
constexpr int BG_SCR_OFF = 45056;
__device__ __forceinline__ int win_dest(int n0) {
    if (n0 < 1536) return n0;
    if (n0 < 2304) return 4352 + (n0 - 1536);
    if (n0 < 3072) return 1536 + (n0 - 2304);
    if (n0 < 3840) return 5120 + (n0 - 3072);
    return 2304 + (n0 - 3840);
}
template <int NR> __device__ __forceinline__ void rms_rows_to_bf16(const float* xrow, const float* gain, bf16* orow, int lane) {
    f32x4 v[NR][4]; float s[NR];
#pragma unroll
    for (int r = 0; r < NR; ++r)
#pragma unroll
        for (int j = 0; j < 4; ++j) v[r][j] = ((const f32x4*)(xrow + (size_t)r * D) + lane)[64 * j];
    f32x4 g[4];
#pragma unroll
    for (int j = 0; j < 4; ++j) g[j] = ((const f32x4*)gain + lane)[64 * j];
#pragma unroll
    for (int r = 0; r < NR; ++r) { float a = 0.f;
#pragma unroll
        for (int j = 0; j < 4; ++j) a += (v[r][j].x * v[r][j].x + v[r][j].y * v[r][j].y) + (v[r][j].z * v[r][j].z + v[r][j].w * v[r][j].w);
        s[r] = a; }
#pragma unroll
    for (int o = 1; o < 64; o <<= 1)
#pragma unroll
        for (int r = 0; r < NR; ++r) s[r] += __shfl_xor(s[r], o);
#pragma unroll
    for (int r = 0; r < NR; ++r) { const float rstd = 1.0f / sqrtf(s[r] * (1.f / D) + EPS);
        unsigned long long* o8 = (unsigned long long*)(orow + (size_t)r * D) + lane;
#pragma unroll
        for (int j = 0; j < 4; ++j) o8[64 * j] = (unsigned long long)pk2(v[r][j].x * rstd * g[j].x, v[r][j].y * rstd * g[j].y) | ((unsigned long long)pk2(v[r][j].z * rstd * g[j].z, v[r][j].w * rstd * g[j].w) << 32); }
}
__device__ __forceinline__ void p0_prologue(const Frame& F, const Args& A) {
    LAS float* scr = (LAS float*)(F.lds + F.wave * 16384);
    const int gw = F.vcu * 8 + F.wave, NGW = F.G * 8;
    unsigned char* ws = A.ws;
    for (int m = gw * 4; m < T; m += NGW * 4) rms_rows_to_bf16<4>(A.in[0] + (size_t)m * D, A.in[2], (bf16*)(ws + WS_NX) + (size_t)m * D, ((int)threadIdx.x & 63));
    { const float* wsp = A.in[8]; bf16* o = (bf16*)(ws + WS_WSP);
      for (int i = (blockIdx.x * 512 + ((int)threadIdx.x)) * 4; i < 12 * 128 * 128; i += F.G * 512 * 4) { const int col = i & 127, row = (i >> 7) & 127; const f32x4 a = *(const f32x4*)(wsp + i);
          v2u w; w.x = pk2(col <= row ? a.x : 0.f, col + 1 <= row ? a.y : 0.f); w.y = pk2(col + 2 <= row ? a.z : 0.f, col + 3 <= row ? a.w : 0.f); *(v2u*)(o + i) = w; } }
    { const float* wrt = A.in[13]; bf16* wh = (bf16*)(ws + WS_WRH); bf16* wl = (bf16*)(ws + WS_WRL);
      for (int i = blockIdx.x * 512 + ((int)threadIdx.x); i < 32 * 1024; i += F.G * 512) { const int e = i >> 10, k = i & 1023; const float w = wrt[k * 32 + e]; const unsigned h = f2bf(w); wh[i] = (bf16)h; wl[i] = (bf16)f2bf(w - bflo(h)); } }
    constexpr int I_IN = 32 * 92;
    for (int it = gw; it < I_IN; it += NGW) { const int kb = it / 92, nb = it % 92; transpose_item(A.in[3], D, IN_W, (bf16*)(ws + WS_WIN), win_dest(nb * 64), scr, kb * 32, nb * 64, ((int)threadIdx.x & 63)); }
}

__device__ __forceinline__ int crow(int r, int hi) { return (r & 3) + 8 * (r >> 2) + 4 * hi; }
struct AtU { int b, g, h, r, qb8, nqb; };
__device__ __forceinline__ AtU at_decode(int pr) { AtU u; const int slot = pr & 15; u.h = (pr >> 4) & 3; const int bgi = pr >> 6; u.g = bgi % 3; u.b = bgi / 3; u.nqb = 128 >> (2 * u.g);
    u.r = slot / (u.nqb >> 3); u.qb8 = slot % (u.nqb >> 3); return u; }
__device__ __forceinline__ void at_load(const AtU& u, const bf16* QT, const bf16* KT, const bf16* VT, int w, int r32, int hi, int q8, int t8, v4u (&stg)[12], bf16x8 (&qf)[4]) {
    const size_t tb0 = (size_t)((u.b * 3 + u.g) * 4 + u.h) * 128 + (size_t)(u.r * u.nqb);
    const bf16* qt = QT + (tb0 + u.qb8 * 8 + w) * 2048 + r32 * 64 + 8 * hi;
#pragma unroll
    for (int s = 0; s < 4; ++s) qf[s] = *(const bf16x8*)(qt + 16 * s);
#pragma unroll
    for (int i = 0; i < 12; ++i) { const int kv = i >= 6 ? 1 : 0, j = 2 * (i - 6 * kv) + t8; int kb = u.qb8 * 8 - 4 + j; kb = kb < 0 ? 0 : kb;
        stg[i] = *(const v4u*)((kv ? VT : KT) + (tb0 + kb) * 2048 + q8 * 8); }
}
__device__ __forceinline__ void attn_phase(const Frame& F, const Args& A) {
    LAS float* tb = (LAS float*)(F.lds + RING_BYTES + 2048);
    const float* rel_bias = A.in[4];
    for (int i = ((int)threadIdx.x); i < 12 * 192; i += 512) { const int gh = i / 192, dist = i % 192 - 31, g = gh >> 2; const int dil = g == 0 ? 1 : (g == 1 ? 4 : 16);
        tb[i] = (dist >= 0 && dist <= 128) ? rel_bias[t5_bucket(dist * dil) * 12 + gh] * LOG2E : -INFINITY; }
    __syncthreads();
    const bf16* QT = (const bf16*)(A.ws + WS_Q); const bf16* KT = (const bf16*)(A.ws + WS_K); const bf16* VT = (const bf16*)(A.ws + WS_VT);
    bf16* OG = (bf16*)(A.ws + WS_OG); float* LSE = (float*)(A.ws + WS_LSE);
    const int lane = ((int)threadIdx.x & 63), r32 = lane & 31, hi = lane >> 5, w = F.wave;
    const int q8 = ((int)threadIdx.x) & 255, t8 = ((int)threadIdx.x) >> 8;
    const int NU = NB * 3 * 4 * 16;
    v4u stg[12]; bf16x8 qf[4];
    if (F.vcu < NU) at_load(at_decode(F.vcu), QT, KT, VT, w, r32, hi, q8, t8, stg, qf);
    for (int pr = F.vcu; pr < NU; pr += F.G) {
        const AtU u = at_decode(pr);
        const int dsh = 2 * u.g, dil = 1 << dsh, g = u.g, h = u.h, b = u.b, r = u.r;
        const int qb = u.qb8 * 8 + w, i0 = qb * 32;
        __syncthreads();
        { const int keyk = q8 >> 3, posk = keyk * 8 + ((q8 & 7) ^ ((keyk >> 1) & 7)), dv = q8 >> 2, posv = dv * 4 + ((q8 & 3) ^ ((dv >> 2) & 3));
#pragma unroll
          for (int i = 0; i < 12; ++i) { const int kv = i >= 6 ? 1 : 0, j = 2 * (i - 6 * kv) + t8;
              *(LAS v4u*)(F.lds + kv * 49152 + j * 4096 + (kv ? posv : posk) * 16) = stg[i]; } }
        bf16x8 qc[4];
#pragma unroll
        for (int s = 0; s < 4; ++s) qc[s] = qf[s];
        __syncthreads();
        if (pr + F.G < NU) at_load(at_decode(pr + F.G), QT, KT, VT, w, r32, hi, q8, t8, stg, qf);
        __builtin_amdgcn_sched_barrier(0);
        const LAS unsigned char* kbase = F.lds + w * 4096 + (r32 * 8) * 16;
        const int kx = (r32 >> 1) & 7;
        f32x16 st[5];
#pragma unroll
        for (int kt = 0; kt < 5; ++kt) {
            f32x16 a = {};
#pragma unroll
            for (int s = 0; s < 4; ++s) { const bf16x8 kf = *(const LAS bf16x8*)(kbase + kt * 4096 + (((2 * s + hi) ^ kx) << 4)); a = __builtin_amdgcn_mfma_f32_32x32x16_bf16(kf, qc[s], a, 0, 0, 0); }
            st[kt] = a;
        }
        const LAS float* tbh = tb + (g * 4 + h) * 192;
        float mx = -INFINITY;
#pragma unroll
        for (int kt = 0; kt < 5; ++kt)
#pragma unroll
            for (int i = 0; i < 16; ++i) { const int kr = crow(i, hi), krel = -128 + 32 * kt + kr; const int dist = r32 - krel;
                float v = st[kt][i] + tbh[dist + 31]; v = (i0 + krel >= 0) ? v : -INFINITY; st[kt][i] = v; mx = fmaxf(mx, v); }
        mx = fmaxf(mx, __shfl_xor(mx, 32));
        float l = 0.f;
#pragma unroll
        for (int kt = 0; kt < 5; ++kt)
#pragma unroll
            for (int i = 0; i < 16; ++i) { const float p = __builtin_amdgcn_exp2f(st[kt][i] - mx); st[kt][i] = p; l += p; }
        l += __shfl_xor(l, 32);
        const LAS unsigned char* vbase = F.lds + 49152 + w * 4096;
        f32x16 o[2] = {};
#pragma unroll
        for (int kt = 0; kt < 5; ++kt)
#pragma unroll
            for (int s2 = 0; s2 < 2; ++s2) {
                v4u pw; pw.x = cvt_pk_bf16(st[kt][8 * s2 + 0], st[kt][8 * s2 + 1]); pw.y = cvt_pk_bf16(st[kt][8 * s2 + 2], st[kt][8 * s2 + 3]);
                pw.z = cvt_pk_bf16(st[kt][8 * s2 + 4], st[kt][8 * s2 + 5]); pw.w = cvt_pk_bf16(st[kt][8 * s2 + 6], st[kt][8 * s2 + 7]);
                const bf16x8 pf = __builtin_bit_cast(bf16x8, pw);
#pragma unroll
                for (int dt = 0; dt < 2; ++dt) { const int dd = 32 * dt + r32;
                    const bf16x8 vf = *(const LAS bf16x8*)(vbase + kt * 4096 + ((dd * 4 + ((2 * s2 + hi) ^ ((dd >> 2) & 3))) << 4));
                    o[dt] = __builtin_amdgcn_mfma_f32_32x32x16_bf16(vf, pf, o[dt], 0, 0, 0); }
            }
        const float rl = 1.0f / l;
        const size_t qrow = (size_t)b * SEQ + (size_t)(i0 + r32) * dil + r;
        bf16* op = OG + ((size_t)g * T + qrow) * 256 + h * 64;
#pragma unroll
        for (int dt = 0; dt < 2; ++dt)
#pragma unroll
            for (int gq = 0; gq < 4; ++gq) { v2u wv; wv.x = cvt_pk_bf16(o[dt][4 * gq] * rl, o[dt][4 * gq + 1] * rl); wv.y = cvt_pk_bf16(o[dt][4 * gq + 2] * rl, o[dt][4 * gq + 3] * rl);
                *(v2u*)(op + 32 * dt + 8 * gq + 4 * hi) = wv; }
        if (hi == 0) LSE[((size_t)g * T + qrow) * 4 + h] = (mx + __builtin_amdgcn_logf(l)) * LN2;
    }
    __syncthreads();
}

__device__ __forceinline__ void spatial_phase(const Frame& F, const Args& A) {
    const bf16* ZVT = (const bf16*)(A.ws + WS_ZVT); const bf16* ZU = (const bf16*)(A.ws + WS_ZU); const bf16* WSP = (const bf16*)(A.ws + WS_WSP);
    bf16* Gout = (bf16*)(A.ws + WS_AG) + 256;
    const float* lng = A.in[6]; const float* lnb = A.in[7]; const float* bsp = A.in[9];
    LAS float* red = (LAS float*)(F.lds + 10240);
    LAS float* stt = (LAS float*)(F.lds + 43008);
    LAS unsigned char* vn = F.lds + 49152;
    int lane = ((int)threadIdx.x & 63); asm volatile("" : "+v"(lane));
    const int r32 = lane & 31, hi = lane >> 5, w = F.wave;
    const int dr = 8 * w + (lane >> 3), ck = lane & 7;
    for (int c = F.vcu; c < T / 128; c += F.G) {
        v4u zr[2];
#pragma unroll
        for (int p = 0; p < 2; ++p) zr[p] = *(const v4u*)(ZVT + ((size_t)c * GM_W + dr) * 128 + 8 * (ck + 8 * p));
        {
            const int tg = ((int)threadIdx.x) & 15, rg = ((int)threadIdx.x) >> 4; float sm[8], q[8];
#pragma unroll
            for (int e = 0; e < 8; ++e) { sm[e] = 0.f; q[e] = 0.f; }
#pragma unroll 4
            for (int ch = rg; ch < GM_W; ch += 32) { const v4u wv = *(const v4u*)(ZVT + ((size_t)c * GM_W + ch) * 128 + 8 * tg);
                const float x[8] = {bflo(wv.x), bfhi(wv.x), bflo(wv.y), bfhi(wv.y), bflo(wv.z), bfhi(wv.z), bflo(wv.w), bfhi(wv.w)};
#pragma unroll
                for (int e = 0; e < 8; ++e) { sm[e] += x[e]; q[e] += x[e] * x[e]; } }
#pragma unroll
            for (int e = 0; e < 8; ++e) { red[(rg * 128 + 8 * tg + e) * 2] = sm[e]; red[(rg * 128 + 8 * tg + e) * 2 + 1] = q[e]; }
            __syncthreads();
            if (((int)threadIdx.x) < 128) { float ss = 0.f, qq = 0.f;
                for (int k = 0; k < 32; ++k) { ss += red[(k * 128 + ((int)threadIdx.x)) * 2]; qq += red[(k * 128 + ((int)threadIdx.x)) * 2 + 1]; }
                const float mu = ss * (1.f / GM_W), var = fmaxf(qq * (1.f / GM_W) - mu * mu, 0.f);
                stt[((int)threadIdx.x) * 2] = mu; stt[((int)threadIdx.x) * 2 + 1] = 1.0f / sqrtf(var + EPS); }
            __syncthreads();
        }
#define SP_GROUP(GI, ZR_CUR, ZU_CUR, ZR_NXT, ZU_NXT) do { \
            const int gi_ = (GI); const int dt = w & 1, it = ((w >> 1) + gi_) & 3, ti = 32 * it + r32;       \
              \
            bf16x8 bfr[8]; \
            { const bf16* wp = WSP + ((size_t)gi_ * 128 + ti) * 128 + 8 * hi; \
              _Pragma("unroll") for (int s = 0; s < 8; ++s) bfr[s] = *(const bf16x8*)(wp + 16 * s); } \
            const float bsv = bsp[gi_ * 128 + ti], gch = lng[gi_ * 64 + dr], bch = lnb[gi_ * 64 + dr]; \
            __builtin_amdgcn_sched_barrier(0); \
              \
            LAS unsigned char* tile = vn + (gi_ & 1) * 16384; \
            _Pragma("unroll") for (int p = 0; p < 2; ++p) { const int jb = 8 * (ck + 8 * p); const v4u z = ZR_CUR[p]; \
                float x[8] = {bflo(z.x), bfhi(z.x), bflo(z.y), bfhi(z.y), bflo(z.z), bfhi(z.z), bflo(z.w), bfhi(z.w)}; \
                _Pragma("unroll") for (int e = 0; e < 8; ++e) x[e] = (x[e] - stt[(jb + e) * 2]) * stt[(jb + e) * 2 + 1] * gch + bch; \
                v4u aw; aw.x = cvt_pk_bf16(x[0], x[1]); aw.y = cvt_pk_bf16(x[2], x[3]); aw.z = cvt_pk_bf16(x[4], x[5]); aw.w = cvt_pk_bf16(x[6], x[7]); \
                *(LAS v4u*)(tile + dr * 256 + (((ck + 8 * p) ^ (dr & 15)) << 4)) = aw; } \
            { const int gn = gi_ + 1 < 12 ? gi_ + 1 : 11;        \
              _Pragma("unroll") for (int p = 0; p < 2; ++p) ZR_NXT[p] = *(const v4u*)(ZVT + ((size_t)c * GM_W + gn * 64 + dr) * 128 + 8 * (ck + 8 * p)); \
              const int itn = ((w >> 1) + gn) & 3; const size_t orow = ((size_t)c * 128 + 32 * itn + r32) * GM_W + gn * 64 + 32 * dt + 4 * hi; \
              _Pragma("unroll") for (int gq = 0; gq < 4; ++gq) ZU_NXT[gq] = *(const v2u*)(ZU + orow + 8 * gq); } \
            __syncthreads();                                    \
            f32x16 acc = {}; \
            { const int dd = 32 * dt + r32; const LAS unsigned char* ar = tile + dd * 256; \
              _Pragma("unroll") for (int s = 0; s < 8; ++s) { const bf16x8 af = *(const LAS bf16x8*)(ar + (((2 * s + hi) ^ (dd & 15)) << 4)); acc = __builtin_amdgcn_mfma_f32_32x32x16_bf16(af, bfr[s], acc, 0, 0, 0); } } \
              \
            const size_t grow = ((size_t)c * 128 + ti) * D + gi_ * 64 + 32 * dt + 4 * hi; \
            _Pragma("unroll") for (int gq = 0; gq < 4; ++gq) { const v2u uw = ZU_CUR[gq]; \
                v2u o; o.x = cvt_pk_bf16(bflo(uw.x) * (acc[4 * gq] + bsv), bfhi(uw.x) * (acc[4 * gq + 1] + bsv)); o.y = cvt_pk_bf16(bflo(uw.y) * (acc[4 * gq + 2] + bsv), bfhi(uw.y) * (acc[4 * gq + 3] + bsv)); \
                *(v2u*)(Gout + grow + 8 * gq) = o; } \
        } while (0)
        v4u zrb[2]; v2u zua[4], zub[4];
        { const int it0 = (w >> 1) & 3; const size_t orow = ((size_t)c * 128 + 32 * it0 + r32) * GM_W + 32 * (w & 1) + 4 * hi;
#pragma unroll
          for (int gq = 0; gq < 4; ++gq) zua[gq] = *(const v2u*)(ZU + orow + 8 * gq); }
#pragma unroll 1
        for (int gi = 0; gi < 12; gi += 2) {
            SP_GROUP(gi, zr, zua, zrb, zub);
            SP_GROUP(gi + 1, zrb, zub, zr, zua);
        }
#undef SP_GROUP
        __syncthreads();
    }
}

__device__ __forceinline__ void merge_phase(const Frame& F, const Args& A) {
    const bf16* OG = (const bf16*)(A.ws + WS_OG); const float* LSE = (const float*)(A.ws + WS_LSE); bf16* ATT = (bf16*)(A.ws + WS_AG);
    const int gw = F.vcu * 8 + F.wave, NGW = F.G * 8, lane = ((int)threadIdx.x & 63), h = lane >> 4;
    for (int t = gw; t < T; t += NGW) {
        const float l0 = LSE[(size_t)t * 4 + h], l1 = LSE[((size_t)T + t) * 4 + h], l2 = LSE[((size_t)2 * T + t) * 4 + h];
        const float m = fmaxf(l0, fmaxf(l1, l2)); float a0 = __expf(l0 - m), a1 = __expf(l1 - m), a2 = __expf(l2 - m); const float inv = 1.0f / (a0 + a1 + a2); a0 *= inv; a1 *= inv; a2 *= inv;
        const v2u w0 = *(const v2u*)(OG + (size_t)t * 256 + 4 * lane), w1 = *(const v2u*)(OG + ((size_t)T + t) * 256 + 4 * lane), w2 = *(const v2u*)(OG + ((size_t)2 * T + t) * 256 + 4 * lane);
        v2u o; o.x = pk2(a0 * bflo(w0.x) + a1 * bflo(w1.x) + a2 * bflo(w2.x), a0 * bfhi(w0.x) + a1 * bfhi(w1.x) + a2 * bfhi(w2.x));
        o.y = pk2(a0 * bflo(w0.y) + a1 * bflo(w1.y) + a2 * bflo(w2.y), a0 * bfhi(w0.y) + a1 * bfhi(w1.y) + a2 * bfhi(w2.y));
        *(v2u*)(ATT + (size_t)t * D + 4 * lane) = o;
    }
}

__device__ __forceinline__ void router_phase(const Frame& F, const Args& A) {
    LAS unsigned char* L = F.lds;
    LAS int* hist = (LAS int*)(F.lds + RING_BYTES + 2048);
    LAS int* basee = hist + 32;
    LAS int* rec_e = hist + 64;
    LAS int* rec_r = rec_e + 512;
    LAS float* rec_g = (LAS float*)(rec_r + 512);
    LAS float* rec_s = rec_g + 512;
    const float* brt = A.in[14]; const float* gmoe = A.in[12];
    const float* H = A.out; bf16* NX = (bf16*)(A.ws + WS_NX);
    const bf16* WRH = (const bf16*)(A.ws + WS_WRH);
    int* LIST = (int*)(A.ws + WS_LIST); float* SGATE = (float*)(A.ws + WS_SGATE); float* SRSTD = (float*)(A.ws + WS_SRSTD); int* POS = (int*)(A.ws + WS_POS);
    unsigned* CNT = (unsigned*)(A.ws + WS_CTL) + CW_CNT;
    const int lane = ((int)threadIdx.x & 63), w = F.wave, r32 = lane & 31, hi = lane >> 5;
    for (int c = F.vcu; c < T / 128; c += F.G) {
        for (int q = ((int)threadIdx.x); q < 8192; q += 512) { const int mtx = q >> 12, rem = q & 4095, e = rem >> 7, ck = rem & 127;
            const v4u v = *(const v4u*)(WRH + (size_t)mtx * 32768 + e * 1024 + ck * 8);
            *(LAS v4u*)(L + mtx * 65536 + e * 2048 + ((ck ^ (e & 15)) << 4)) = v; }
        if (((int)threadIdx.x) < 32) hist[((int)threadIdx.x)] = 0;
        __syncthreads();
        const int tt = w & 3, kh = w >> 2;
        const size_t row = (size_t)c * 128 + tt * 32 + r32;
        const float* hrow = H + row * D + kh * 512 + 8 * hi; const float* grow = gmoe + kh * 512 + 8 * hi; bf16* nrow = NX + row * D + kh * 512 + 8 * hi;
        const LAS unsigned char* wb = L + r32 * 2048;
        f32x16 acc = {}; float ss = 0.f;
#pragma unroll 4
        for (int s = 0; s < 32; ++s) {
            const f32x4 h0 = *(const f32x4*)(hrow + 16 * s), h1 = *(const f32x4*)(hrow + 16 * s + 4), g0 = *(const f32x4*)(grow + 16 * s), g1 = *(const f32x4*)(grow + 16 * s + 4);
            ss += (h0.x * h0.x + h0.y * h0.y) + (h0.z * h0.z + h0.w * h0.w) + (h1.x * h1.x + h1.y * h1.y) + (h1.z * h1.z + h1.w * h1.w);
            const f32x4 x0 = h0 * g0, x1 = h1 * g1;
            v4u xh; xh.x = cvt_pk_bf16(x0.x, x0.y); xh.y = cvt_pk_bf16(x0.z, x0.w); xh.z = cvt_pk_bf16(x1.x, x1.y); xh.w = cvt_pk_bf16(x1.z, x1.w);
            v4u xl; xl.x = cvt_pk_bf16(x0.x - bflo(xh.x), x0.y - bfhi(xh.x)); xl.y = cvt_pk_bf16(x0.z - bflo(xh.y), x0.w - bfhi(xh.y));
            xl.z = cvt_pk_bf16(x1.x - bflo(xh.z), x1.y - bfhi(xh.z)); xl.w = cvt_pk_bf16(x1.z - bflo(xh.w), x1.w - bfhi(xh.w));
            *(v4u*)(nrow + 16 * s) = xh;
            const int ck = kh * 64 + 2 * s + hi;
            const bf16x8 wh = *(const LAS bf16x8*)(wb + ((ck ^ (r32 & 15)) << 4)), wl = *(const LAS bf16x8*)(wb + 65536 + ((ck ^ (r32 & 15)) << 4));
            const bf16x8 ah = __builtin_bit_cast(bf16x8, xh), al = __builtin_bit_cast(bf16x8, xl);
            acc = __builtin_amdgcn_mfma_f32_32x32x16_bf16(ah, wh, acc, 0, 0, 0);
            acc = __builtin_amdgcn_mfma_f32_32x32x16_bf16(al, wh, acc, 0, 0, 0);
            acc = __builtin_amdgcn_mfma_f32_32x32x16_bf16(ah, wl, acc, 0, 0, 0);
        }
        __syncthreads();
        { LAS float* LGp = (LAS float*)L + kh * (128 * 33);
#pragma unroll
          for (int i = 0; i < 16; ++i) LGp[(tt * 32 + crow(i, hi)) * 33 + r32] = acc[i];
          ((LAS float*)(L + 36864))[(kh * 2 + hi) * 128 + tt * 32 + r32] = ss; }
        __syncthreads();
        if (((int)threadIdx.x) < 128) {
            const int t = ((int)threadIdx.x); const LAS float* SS = (const LAS float*)(L + 36864);
            const float rstd = 1.0f / sqrtf(((SS[t] + SS[128 + t]) + (SS[256 + t] + SS[384 + t])) * (1.f / D) + EPS);
            const LAS float* l0 = (const LAS float*)L + t * 33; const LAS float* l1 = l0 + 128 * 33;
            float lg[32];
#pragma unroll
            for (int e = 0; e < 32; ++e) lg[e] = (l0[e] + l1[e]) * rstd + brt[e];
            unsigned taken = 0u; float tv[4]; int ti[4];
#pragma unroll
            for (int k = 0; k < 4; ++k) { float bv = -INFINITY; int bi = 0;
#pragma unroll
                for (int e = 0; e < 32; ++e) { const float cv = ((taken >> e) & 1u) ? -INFINITY : lg[e]; if (cv > bv) { bv = cv; bi = e; } }
                tv[k] = bv; ti[k] = bi; taken |= 1u << bi; }
            const float e1 = __expf(tv[1] - tv[0]), e2 = __expf(tv[2] - tv[0]), e3 = __expf(tv[3] - tv[0]); const float inv = 1.0f / (1.0f + e1 + e2 + e3);
            const float gk[4] = {inv, e1 * inv, e2 * inv, e3 * inv};
            rec_s[t] = rstd;
#pragma unroll
            for (int k = 0; k < 4; ++k) { const int lr = atomicAdd((int*)&hist[ti[k]], 1); rec_e[t * 4 + k] = ti[k]; rec_r[t * 4 + k] = lr; rec_g[t * 4 + k] = gk[k]; }
        }
        __syncthreads();
        if (((int)threadIdx.x) < 32) basee[((int)threadIdx.x)] = (int)__hip_atomic_fetch_add(CNT + ((int)threadIdx.x), (unsigned)hist[((int)threadIdx.x)], __ATOMIC_RELAXED, __HIP_MEMORY_SCOPE_AGENT);
        __syncthreads();
        { const int lrow = ((int)threadIdx.x) >> 2, k = ((int)threadIdx.x) & 3; const int e = rec_e[((int)threadIdx.x)], slot = basee[e] + rec_r[((int)threadIdx.x)]; const int t = c * 128 + lrow;
          LIST[e * 32768 + slot] = t; SGATE[e * 32768 + slot] = rec_g[((int)threadIdx.x)]; SRSTD[e * 32768 + slot] = rec_s[lrow]; POS[t * 4 + k] = (e << 16) | slot; }
        __syncthreads();
    }
}

__device__ __forceinline__ void load_tile_starts(const Frame& F, const Args& A) {
    LAS int* ts = (LAS int*)(F.lds + TS_OFF);
    if (((int)threadIdx.x) == 0) { const unsigned* CNT = (const unsigned*)(A.ws + WS_CTL) + CW_CNT; int acc = 0;
        for (int e = 0; e < 32; ++e) { const int c = (int)__hip_atomic_load(CNT + e, __ATOMIC_RELAXED, __HIP_MEMORY_SCOPE_AGENT); ts[e] = acc; ts[40 + e] = c; acc += (c + 255) >> 8; }
        ts[32] = acc; for (int e = 33; e < 40; ++e) ts[e] = 0x7fffffff; }
    __syncthreads();
}

__device__ __forceinline__ void combine_phase(const Frame& F, const Args& A) {
    const LAS int* ts = (const LAS int*)(F.lds + TS_OFF);
    const bf16* Y = (const bf16*)(A.ws + WS_Y); const int* POS = (const int*)(A.ws + WS_POS); float* H = A.out; bf16* NX = (bf16*)(A.ws + WS_NX);
    const float* gple = A.in[19];
    const int gw = F.vcu * 8 + F.wave, NGW = F.G * 8, lane = ((int)threadIdx.x & 63);
    for (int t = gw * 2; t < T; t += NGW * 2) {
        int pz[2][4];
#pragma unroll
        for (int r = 0; r < 2; ++r)
#pragma unroll
            for (int k = 0; k < 4; ++k) pz[r][k] = POS[(t + r) * 4 + k];
        f32x4 v[2][2][2];
#pragma unroll
        for (int r = 0; r < 2; ++r)
#pragma unroll
            for (int hf = 0; hf < 2; ++hf) { const float* hp = H + (size_t)(t + r) * D + hf * 512 + 8 * lane; v[r][hf][0] = *(const f32x4*)hp; v[r][hf][1] = *(const f32x4*)(hp + 4); }
        v4u yw[2][4][2];
#pragma unroll
        for (int r = 0; r < 2; ++r)
#pragma unroll
            for (int k = 0; k < 4; ++k) { const int e = pz[r][k] >> 16, slot = pz[r][k] & 0xffff; const bf16* yp = Y + ((size_t)ts[e] * 256 + slot) * D + 8 * lane;
                yw[r][k][0] = *(const v4u*)yp; yw[r][k][1] = *(const v4u*)(yp + 512); }
        float s[2];
#pragma unroll
        for (int r = 0; r < 2; ++r) { float a = 0.f;
#pragma unroll
            for (int hf = 0; hf < 2; ++hf) {
#pragma unroll
                for (int k = 0; k < 4; ++k) { const v4u w = yw[r][k][hf];
                    v[r][hf][0] = v[r][hf][0] + (f32x4){bflo(w.x), bfhi(w.x), bflo(w.y), bfhi(w.y)}; v[r][hf][1] = v[r][hf][1] + (f32x4){bflo(w.z), bfhi(w.z), bflo(w.w), bfhi(w.w)}; }
                float* hp = H + (size_t)(t + r) * D + hf * 512 + 8 * lane; *(f32x4*)hp = v[r][hf][0]; *(f32x4*)(hp + 4) = v[r][hf][1];
#pragma unroll
                for (int p = 0; p < 2; ++p) a += (v[r][hf][p].x * v[r][hf][p].x + v[r][hf][p].y * v[r][hf][p].y) + (v[r][hf][p].z * v[r][hf][p].z + v[r][hf][p].w * v[r][hf][p].w); }
            s[r] = a; }
#pragma unroll
        for (int o = 1; o < 64; o <<= 1) { s[0] += __shfl_xor(s[0], o); s[1] += __shfl_xor(s[1], o); }
#pragma unroll
        for (int r = 0; r < 2; ++r) { const float rstd = 1.0f / sqrtf(s[r] * (1.f / D) + EPS);
#pragma unroll
            for (int hf = 0; hf < 2; ++hf) { const float* gp = gple + hf * 512 + 8 * lane; const f32x4 g0 = *(const f32x4*)gp, g1 = *(const f32x4*)(gp + 4);
                st8(NX + (size_t)(t + r) * D + hf * 512 + 8 * lane, v[r][hf][0] * rstd * g0, v[r][hf][1] * rstd * g1); } }
    }
}
__device__ __forceinline__ void final_phase(const Frame& F, const Args& A) {
    float* H = A.out; const float* gf = A.in[22]; const bf16* T1 = (const bf16*)(A.ws + WS_T1);
    const int gw = F.vcu * 8 + F.wave, NGW = F.G * 8, lane = ((int)threadIdx.x & 63);
    for (int t = gw * 2; t < T; t += NGW * 2) {
        f32x4 v[2][4]; v2u tw[2][4]; float s[2];
#pragma unroll
        for (int r = 0; r < 2; ++r)
#pragma unroll
            for (int j = 0; j < 4; ++j) { v[r][j] = ((const f32x4*)(H + (size_t)(t + r) * D) + lane)[64 * j]; tw[r][j] = ((const v2u*)(T1 + (size_t)(t + r) * D) + lane)[64 * j]; }
#pragma unroll
        for (int r = 0; r < 2; ++r) { float a = 0.f;
#pragma unroll
            for (int j = 0; j < 4; ++j) { v[r][j] = v[r][j] + (f32x4){bflo(tw[r][j].x), bfhi(tw[r][j].x), bflo(tw[r][j].y), bfhi(tw[r][j].y)};
                a += (v[r][j].x * v[r][j].x + v[r][j].y * v[r][j].y) + (v[r][j].z * v[r][j].z + v[r][j].w * v[r][j].w); }
            s[r] = a; }
#pragma unroll
        for (int o = 1; o < 64; o <<= 1) { s[0] += __shfl_xor(s[0], o); s[1] += __shfl_xor(s[1], o); }
#pragma unroll
        for (int r = 0; r < 2; ++r) { const float rstd = 1.0f / sqrtf(s[r] * (1.f / D) + EPS);
#pragma unroll
            for (int j = 0; j < 4; ++j) ((f32x4*)(H + (size_t)(t + r) * D) + lane)[64 * j] = v[r][j] * rstd * ((const f32x4*)gf + lane)[64 * j]; }
    }
}

constexpr int NPHASE = 13;
#ifndef ONLY_PH
#define ONLY_PH -1
#endif
#define PH_ON(k) (ONLY_PH < 0 || ONLY_PH == (k))
__global__ void __launch_bounds__(512, 2) fwd_kernel(Args args) {
    extern __shared__ __attribute__((aligned(16))) unsigned char lds[];
    Frame F;
    F.lds = (LAS unsigned char*)lds; F.wave = __builtin_amdgcn_readfirstlane((int)threadIdx.x >> 6);
    F.G = gridDim.x; { const int bx = blockIdx.x; F.vcu = (F.G % 8 == 0) ? (bx % 8) * (F.G / 8) + bx / 8 : bx; }
    unsigned char* ws = args.ws;
    volatile LAS unsigned* MISC = (volatile LAS unsigned*)(F.lds + MISC_OFF);
    for (int u = ((int)threadIdx.x); u < (LDS_BYTES - RING_BYTES) / 4; u += 512) ((LAS unsigned*)(F.lds + RING_BYTES))[u] = 0u;
    __syncthreads();
    XcdBarrier bar; bar.bar = (unsigned*)(ws + WS_CTL) + CW_BAR; bar.x = 0; bar.st = nullptr;
    const bool multi = (args.ph_hi - args.ph_lo) > 1;
    if (multi) bar = xcd_barrier_post((unsigned*)(ws + WS_CTL) + CW_BAR, MISC + 8);
    const int bx = (int)blockIdx.x;
    const int lo = args.ph_lo, hi = args.ph_hi;
#ifndef REP_MASK
#define REP_MASK 0
#endif
#define IN(k) (PH_ON(k) && lo <= (k) && (k) < hi)
#define REPS(k) (((REP_MASK >> (k)) & 1) ? 2 : 1)
#define SEAM(k) do { if (lo <= (k) && (k) + 1 < hi) xcd_barrier(bar); } while (0)
    if (IN(0)) for (int rep_ = 0; rep_ < REPS(0); ++rep_) { p0_prologue(F, args); } SEAM(0);
    if (IN(1)) { const int nu1 = (T / 256) * 23, R1 = (nu1 + F.G - 1) / F.G + 1, GG = (nu1 + R1 - 1) / R1;
                 if (bx < GG) { InProjSched S{(const char*)(ws + WS_NX), (const char*)(ws + WS_WIN), GG, bx, REPS(1) - 1};
                 EpiInProj E{(bf16*)(ws + WS_Q), (bf16*)(ws + WS_K), (bf16*)(ws + WS_ZU), (bf16*)(ws + WS_GA), (bf16*)(ws + WS_GG), (bf16*)(ws + WS_VT), (bf16*)(ws + WS_ZVT)};
                 pg8::gemm_phase(F.lds, D, S, E); }
                 convert_queue(F, args, (unsigned*)(ws + WS_CTL) + CW_Q1, 0, BG_P1); convert_queue(F, args, (unsigned*)(ws + WS_CTL) + CW_Q3, BG_N, BG_ALL); convert_p_queue(F, args, (unsigned*)(ws + WS_CTL) + CW_Q4); } SEAM(1);
    if (IN(2)) { attn_phase(F, args); spatial_phase(F, args); } SEAM(2);
    if (IN(3)) { merge_phase(F, args); } SEAM(3);
    if (IN(4)) { PlainSched S{(const char*)(ws + WS_AG), (const char*)(ws + WS_WCAT), T / 256, 4, D, F.G, bx, REPS(4) - 1}; EpiMerge E{(bf16*)(ws + WS_MRG), (const bf16*)(ws + WS_GA), (const bf16*)(ws + WS_GG)};
                 pg8::gemm_phase(F.lds, D, S, E); } SEAM(5);
    if (IN(6)) { PlainSched S{(const char*)(ws + WS_MRG), (const char*)(ws + WS_WOUT), T / 256, 4, D, F.G, bx, REPS(6) - 1}; EpiF32<0> E{args.out, args.in[0], nullptr};
                 pg8::gemm_phase(F.lds, D, S, E); } SEAM(6);
    if (IN(7)) for (int rep_ = 0; rep_ < REPS(7); ++rep_) { router_phase(F, args); } SEAM(7);
    if (IN(8)) { load_tile_starts(F, args); const LAS int* ts = (const LAS int*)(F.lds + TS_OFF);
                 const int nu8 = ts[32] * 8, R8 = (nu8 + F.G - 1) / F.G, GG = R8 > 0 ? (nu8 + R8 - 1) / R8 : 1;
                 if (bx < GG) { MoeSched S{(const char*)(ws + WS_NX), (const char*)(ws + WS_WGU), (const int*)(ws + WS_LIST), ts, 8, D, GG, bx, 1, REPS(8) - 1}; EpiMoeUp E{(bf16*)(ws + WS_ACT), args.in[16], (const float*)(ws + WS_SRSTD), ts};
                 pg8::gemm_phase(F.lds, D, S, E); }
                 convert_queue(F, args, (unsigned*)(ws + WS_CTL) + CW_Q2, BG_GU, BG_N); } SEAM(8);
    if (IN(9)) { load_tile_starts(F, args); const LAS int* ts = (const LAS int*)(F.lds + TS_OFF);
                 const int nu9 = ts[32] * 4, R9 = (nu9 + F.G - 1) / F.G, GG = R9 > 0 ? (nu9 + R9 - 1) / R9 : 1, NH = F.G - GG;
                 if (bx < GG) { MoeSched S{(const char*)(ws + WS_ACT), (const char*)(ws + WS_WD), (const int*)(ws + WS_LIST), ts, 4, D, GG, bx, 0, REPS(9) - 1}; EpiMoeDown E{(bf16*)(ws + WS_Y), args.in[18], (const float*)(ws + WS_SGATE), ts};
                 pg8::gemm_phase(F.lds, D, S, E); }
                 if (NH >= 8 ? bx >= GG : true) { PlainSched S{(const char*)(ws + WS_PB), (const char*)(ws + WS_WPP), T / 256, 4, PLE, NH >= 8 ? NH : F.G, NH >= 8 ? bx - GG : bx, 0}; EpiBf<0> E{(bf16*)(ws + WS_PP), nullptr, nullptr};
                 pg8::gemm_phase(F.lds, PLE, S, E); } } SEAM(9);
    if (IN(10)) for (int rep_ = 0; rep_ < REPS(10); ++rep_) { load_tile_starts(F, args); combine_phase(F, args); } SEAM(10);
    if (IN(11)) { PlainSched S{(const char*)(ws + WS_NX), (const char*)(ws + WS_WPG), T / 256, 4, D, F.G, bx, REPS(11) - 1}; EpiPle E{(bf16*)(ws + WS_T1), (const bf16*)(ws + WS_PP)};
                  pg8::gemm_phase(F.lds, D, S, E); } SEAM(11);
    if (IN(12)) for (int rep_ = 0; rep_ < REPS(12); ++rep_) { final_phase(F, args); }
#undef IN
#undef SEAM
}

extern "C" void kernel_launch(void* const* d_in, const int* in_sizes, int n_in, void* d_out, int out_size, void* d_ws, size_t ws_size, hipStream_t stream) {
    static int grid = 0;
    if (grid == 0) {
        if (n_in != 23 || out_size != T * D || ws_size < WS_END) { fprintf(stderr, "kernel_launch: unexpected shapes (n_in %d out %d ws %zu)\n", n_in, out_size, ws_size); grid = -1; return; }
        int dev = 0, cus = 0, per_cu = 0;
        if (hipGetDevice(&dev) != hipSuccess || hipDeviceGetAttribute(&cus, hipDeviceAttributeMultiprocessorCount, dev) != hipSuccess) { grid = -1; return; }
        if (hipFuncSetAttribute((const void*)fwd_kernel, hipFuncAttributeMaxDynamicSharedMemorySize, LDS_BYTES) != hipSuccess) { fprintf(stderr, "kernel_launch: hipFuncSetAttribute failed\n"); grid = -1; return; }
        if (hipOccupancyMaxActiveBlocksPerMultiprocessor(&per_cu, (const void*)fwd_kernel, 512, LDS_BYTES) != hipSuccess || per_cu < 1) { fprintf(stderr, "kernel_launch: occupancy query says %d\n", per_cu); (void)hipGetLastError(); grid = -1; return; }
        grid = cus;
    }
    if (grid < 0) return;
    (void)hipMemsetAsync((char*)d_ws + WS_CTL, 0, CTL_ZERO_BYTES, stream);
    Args a{};
    for (int i = 0; i < 23; ++i) a.in[i] = (const float*)d_in[i];
    a.out = (float*)d_out; a.ws = (unsigned char*)d_ws;
#if MK_N_LAUNCHES == 1
    a.ph_lo = 0; a.ph_hi = NPHASE;
    hipLaunchKernelGGL(fwd_kernel, dim3(grid), dim3(512), LDS_BYTES, stream, a);
#else
    for (int ph = 0; ph < NPHASE; ++ph) { a.ph_lo = ph; a.ph_hi = ph + 1; hipLaunchKernelGGL(fwd_kernel, dim3(grid), dim3(512), LDS_BYTES, stream, a); }
#endif
}
```

```cpp
#include <hip/hip_runtime.h>
#include <cstdio>
#include <cstdint>

#ifndef MK_N_LAUNCHES
#define MK_N_LAUNCHES 1
#endif

constexpr int NB = 8, SEQ = 4096, T = NB * SEQ, D = 1024;
constexpr int ATT_W = 768, GM_W = 768, IN_W = 5888, NE = 32, TOPK = 4, PLE = 256;
constexpr float EPS = 1e-6f;
constexpr float LOG2E = 1.4426950408889634f, LN2 = 0.6931471805599453f;
constexpr float QSCALE = 0.125f * LOG2E;

#define LAS __attribute__((address_space(3)))
#define GAS __attribute__((address_space(1)))
typedef unsigned short bf16;
typedef unsigned v4u __attribute__((ext_vector_type(4)));
typedef unsigned v2u __attribute__((ext_vector_type(2)));
typedef float f32x4 __attribute__((ext_vector_type(4)));
typedef float f32x2 __attribute__((ext_vector_type(2)));
typedef float f32x16 __attribute__((ext_vector_type(16)));
typedef short bf16x8 __attribute__((ext_vector_type(8)));
typedef short s16x4 __attribute__((ext_vector_type(4)));

__device__ __forceinline__ unsigned f2bf(float f) { unsigned u = __builtin_bit_cast(unsigned, f); return (u + 0x7fffu + ((u >> 16) & 1u)) >> 16; }
__device__ __forceinline__ unsigned pk2(float lo, float hi) { return f2bf(lo) | (f2bf(hi) << 16); }
__device__ __forceinline__ float bflo(unsigned w) { return __builtin_bit_cast(float, w << 16); }
__device__ __forceinline__ float bfhi(unsigned w) { return __builtin_bit_cast(float, w & 0xffff0000u); }
typedef __bf16 bf16x2_t __attribute__((ext_vector_type(2)));
__device__ __forceinline__ unsigned cvt_pk_bf16(float lo, float hi) { const f32x2 v = {lo, hi}; const bf16x2_t b = __builtin_convertvector(v, bf16x2_t); return __builtin_bit_cast(unsigned, b); }
__device__ __forceinline__ float sigmoidf_(float x) { return __builtin_amdgcn_rcpf(1.0f + __builtin_amdgcn_exp2f(-x * LOG2E)); }
__device__ __forceinline__ f32x2 gelu_pk(f32x2 v) {
    const f32x2 av = __builtin_elementwise_abs(v), d = av * 0.2316418882f + 1.0f;
    f32x2 t; t.x = __builtin_amdgcn_rcpf(d.x); t.y = __builtin_amdgcn_rcpf(d.y);
    f32x2 q = t * 0.5307027145f + (-0.7265760135f); q = q * t + 0.7107068705f; q = q * t + (-0.142248368f); q = q * t + 0.127414796f; q = q * t;
    const f32x2 s = (v * v) * (-0.72134752044f);
    f32x2 e; e.x = __builtin_amdgcn_exp2f(s.x); e.y = __builtin_amdgcn_exp2f(s.y);
    const f32x2 m = v * (q * e), r = v - m;
    f32x2 o; o.x = v.x < 0.f ? m.x : r.x; o.y = v.y < 0.f ? m.y : r.y; return o;
}
__device__ __forceinline__ f32x4 gelu4(f32x4 v) { f32x2 a = gelu_pk((f32x2){v[0], v[1]}), b = gelu_pk((f32x2){v[2], v[3]}); return (f32x4){a.x, a.y, b.x, b.y}; }
__device__ __forceinline__ f32x4 sigm4(f32x4 v) { return (f32x4){sigmoidf_(v[0]), sigmoidf_(v[1]), sigmoidf_(v[2]), sigmoidf_(v[3])}; }
__device__ __forceinline__ float wave_sum(float v) {
#pragma unroll
    for (int o = 1; o < 64; o <<= 1) v += __shfl_xor(v, o);
    return v;
}

constexpr size_t MiB = 1u << 20;
constexpr size_t WS_CTL = 0, CTL_ZERO_BYTES = 1 * MiB;
constexpr size_t WS_WIN = 2 * MiB;
constexpr size_t WS_WCAT = 14 * MiB;
constexpr size_t WS_WOUT = 17 * MiB;
constexpr size_t WS_WPG = 19 * MiB;
constexpr size_t WS_WPP = 21 * MiB;
constexpr size_t WS_WSP = 22 * MiB;
constexpr size_t WS_WRH = 23 * MiB;
constexpr size_t WS_WRL = 23 * MiB + 65536;
constexpr size_t WS_SRSTD = 980 * MiB;
constexpr size_t WS_WGU = 24 * MiB;
constexpr size_t WS_WD = 152 * MiB;
constexpr size_t WS_NX = 216 * MiB;
constexpr size_t WS_PB = 280 * MiB;
constexpr size_t WS_PP = 296 * MiB;
constexpr size_t WS_LIST = 360 * MiB;
constexpr size_t WS_SGATE = 364 * MiB;
constexpr size_t WS_POS = 368 * MiB;
constexpr size_t WS_LSE = 369 * MiB;
constexpr size_t WS_Q = 372 * MiB;
constexpr size_t WS_K = 420 * MiB;
constexpr size_t WS_VT = 468 * MiB;
constexpr size_t WS_ZU = 516 * MiB;
constexpr size_t WS_ZVT = 564 * MiB;
constexpr size_t WS_GA = 612 * MiB;
constexpr size_t WS_GG = 676 * MiB;
constexpr size_t WS_OG = 740 * MiB;
constexpr size_t WS_ATT = 788 * MiB;
constexpr size_t WS_G = 804 * MiB;
constexpr size_t WS_AG = 852 * MiB;
constexpr size_t WS_MRG = 916 * MiB;
constexpr size_t WS_ACT = 372 * MiB;
constexpr size_t WS_Y = 644 * MiB;
constexpr size_t WS_H2 = 436 * MiB;
constexpr size_t WS_T1 = 372 * MiB;
constexpr size_t WS_END = 984 * MiB;
constexpr int PMAX_TILES = 544;

constexpr int CW_CNT = 64;
constexpr int CW_Q1 = 256, CW_Q2 = 320, CW_Q3 = 384, CW_Q4 = 448;
constexpr int CW_BAR = 4096;

constexpr int RING_BYTES = 131072;
constexpr int MISC_OFF = RING_BYTES + 320;
constexpr int TS_OFF = RING_BYTES + 1024;
constexpr int LDS_BYTES = 147456;

namespace pg8 {
typedef unsigned short bf16_t;
constexpr int BM = 256, BK = 64, HALF = 128, HTB = HALF * BK * 2, STAGE_BYTES = 8 * HTB, NXCD = 8, WGM = 8;
__host__ __device__ __forceinline__ int lds_byte(int r, int c) { const int st = (r >> 4) * 2 + (c >> 5), rr = r & 15, cc = c & 31, ob = rr * 64 + cc * 2; return st * 1024 + (ob ^ (((ob >> 9) & 1) << 5)); }
__host__ __device__ __forceinline__ void stage_rc(int b, int& R, int& C) { const int st = b / 1024, sb = b % 1024, swz = sb ^ (((sb >> 9) & 1) << 5); R = (st >> 1) * 16 + swz / 64; C = (st & 1) * 32 + (swz % 64) / 2; }
__host__ __device__ __forceinline__ int perm32(int rho) { const int n = rho >> 4, i = rho & 15; return 8 * (i >> 2) + 4 * n + (i & 3); }

struct Unit { const char* a; const char* b; int pm, pn, x0, x1; };

__device__ __forceinline__ bool static_order(int i, int G, int c, int nM, int nN, int& pm, int& pn) {
    const int nwg = nM * nN; const long L = (long)i * G + c; if (L >= nwg) return false;
    int wgid = (int)L; { const int q = nwg / NXCD, r = nwg % NXCD, xcd = wgid % NXCD, off = wgid / NXCD; wgid = (xcd < r ? xcd * (q + 1) : r * (q + 1) + (xcd - r) * q) + off; }
    const int nig = WGM * nN, gid = wgid / nig, fm = gid * WGM, gsz = (nM - fm) < WGM ? (nM - fm) : WGM;
    pm = fm + ((wgid % nig) % gsz); pn = (wgid % nig) / gsz; return true;
}

template <class Epi, class Sched>
__device__ __forceinline__ void gemm_phase(LAS unsigned char* lds, const int K, const Sched& S, const Epi& E) {
    const int tid = threadIdx.x, wid = __builtin_amdgcn_readfirstlane(tid >> 6), lane = tid & 63, wr = wid >> 2, wc = wid & 3, fr = lane & 15, fq = lane >> 4;
    const int nt = K / BK;
    int RA[2]; unsigned CB2[2], voffB[2];
#pragma unroll
    for (int i = 0; i < 2; ++i) { int R, C; stage_rc(tid * 16 + i * 8192, R, C); const int Rb = Epi::PERM ? ((R & ~31) + perm32(R & 31)) : R;
        RA[i] = R; CB2[i] = (unsigned)C * 2u; voffB[i] = (unsigned)(Rb * K + C) * 2u; }
    const size_t kstep = (size_t)(BK * 2);
    const size_t hstep = (size_t)HALF * K * 2;
    const unsigned ldsw = (unsigned)wid * 1024u;
    const int aoff = lds_byte(wr * 64 + fr, fq * 8), boff = lds_byte(wc * 32 + fr, fq * 8);
#define PG8_SA(b, h) (((b) * 2 + (h)) * HTB)
#define PG8_SB(b, h) ((4 + (b) * 2 + (h)) * HTB)
#define PG8_STAGE(bufoff, gbase, voff) do { _Pragma("unroll") for (int _i = 0; _i < 2; ++_i) \
        __builtin_amdgcn_global_load_lds((const unsigned*)((const char*)(gbase) + (voff)[_i]), (LAS unsigned*)(lds + (bufoff) + ldsw + _i * 8192), 16, 0, 0); } while (0)
#define PG8_LDA(dst, b, h) do { _Pragma("unroll") for (int m = 0; m < 4; ++m) _Pragma("unroll") for (int k = 0; k < 2; ++k) dst[m][k] = *(const LAS bf16x8*)(lds + PG8_SA(b, h) + aoff + m * 2048 + k * 1024); } while (0)
#define PG8_LDB(dst, b, h) do { _Pragma("unroll") for (int n = 0; n < 2; ++n) _Pragma("unroll") for (int k = 0; k < 2; ++k) dst[n][k] = *(const LAS bf16x8*)(lds + PG8_SB(b, h) + boff + n * 2048 + k * 1024); } while (0)
#define PG8_MMA(ai, bj, At, Bt) do { __builtin_amdgcn_s_setprio(1); _Pragma("unroll") for (int m = 0; m < 4; ++m) _Pragma("unroll") for (int n = 0; n < 2; ++n) _Pragma("unroll") for (int k = 0; k < 2; ++k) \
        acc[ai][bj][m][n] = __builtin_amdgcn_mfma_f32_16x16x32_bf16(Bt[n][k], At[m][k], acc[ai][bj][m][n], 0, 0, 0); __builtin_amdgcn_s_setprio(0); } while (0)
#define PG8_WAIT_V(n) asm volatile("s_waitcnt vmcnt(" #n ")" ::: "memory")
#define PG8_WAIT_L(n) asm volatile("s_waitcnt lgkmcnt(" #n ")" ::: "memory")
#define PG8_BAR __builtin_amdgcn_s_barrier()
#define PG8_SCHED __builtin_amdgcn_sched_barrier(0)
    Unit cur, nxt; int ui = 0;
    if (!S.next(0, cur)) return;
    f32x4 acc[2][2][4][2];
#pragma unroll
    for (int a = 0; a < 2; ++a)
#pragma unroll
        for (int b = 0; b < 2; ++b)
#pragma unroll
            for (int m = 0; m < 4; ++m)
#pragma unroll
                for (int n = 0; n < 2; ++n) acc[a][b][m][n] = (f32x4){0.f, 0.f, 0.f, 0.f};
    bf16x8 At[4][2], B0[2][2], B1[2][2];
    const char* cA = cur.a; const char* cB = cur.b;
    unsigned oA[2][2], nO[2][2];
#pragma unroll
    for (int h = 0; h < 2; ++h)
#pragma unroll
        for (int i = 0; i < 2; ++i) oA[h][i] = S.a_off(cur, h * HALF + RA[i], K) + CB2[i];
    PG8_STAGE(PG8_SB(0, 0), cB, voffB); PG8_STAGE(PG8_SB(0, 1), cB + hstep, voffB); PG8_STAGE(PG8_SA(0, 0), cA, oA[0]); PG8_STAGE(PG8_SA(0, 1), cA, oA[1]);
    if (wr == 1) PG8_BAR;
    PG8_WAIT_V(2); PG8_BAR;
    PG8_STAGE(PG8_SB(1, 0), cB + kstep, voffB); PG8_STAGE(PG8_SA(1, 0), cA + kstep, oA[0]); PG8_STAGE(PG8_SB(1, 1), cB + hstep + kstep, voffB);
    PG8_WAIT_V(6); PG8_BAR;
    for (;;) {
        const bool has_next = S.next(ui + 1, nxt);
        const char* nA = has_next ? nxt.a : cA; const char* nB = has_next ? nxt.b : cB;
#pragma unroll
        for (int h = 0; h < 2; ++h)
#pragma unroll
            for (int i = 0; i < 2; ++i) nO[h][i] = has_next ? (S.a_off(nxt, h * HALF + RA[i], K) + CB2[i]) : oA[h][i];
#pragma unroll 1
        for (int t = 0; t < nt; t += 2) {
            const bool last = (t == nt - 2);
            const char* a1 = cA + (size_t)(t + 1) * kstep;
            const char* a2 = last ? nA : cA + (size_t)(t + 2) * kstep; const char* b2 = last ? nB : cB + (size_t)(t + 2) * kstep;
            const char* a3 = a2 + kstep; const char* b3 = b2 + kstep;
            unsigned o2[2][2];
#pragma unroll
            for (int h = 0; h < 2; ++h)
#pragma unroll
                for (int i = 0; i < 2; ++i) o2[h][i] = last ? nO[h][i] : oA[h][i];
            PG8_LDB(B0, 0, 0); PG8_LDB(B1, 0, 1); PG8_SCHED; PG8_LDA(At, 0, 0); PG8_STAGE(PG8_SA(1, 1), a1, oA[1]);
            PG8_WAIT_V(8); PG8_WAIT_L(0); PG8_BAR; PG8_MMA(0, 0, At, B0); PG8_MMA(0, 1, At, B1); PG8_BAR; PG8_SCHED;
            PG8_LDA(At, 0, 1); PG8_STAGE(PG8_SB(0, 0), b2, voffB); PG8_STAGE(PG8_SB(0, 1), b2 + hstep, voffB); PG8_STAGE(PG8_SA(0, 0), a2, o2[0]);
            PG8_WAIT_V(8); PG8_WAIT_L(0); PG8_BAR; PG8_MMA(1, 0, At, B0); PG8_MMA(1, 1, At, B1); PG8_BAR; PG8_SCHED;
            PG8_LDB(B0, 1, 0); PG8_LDB(B1, 1, 1); PG8_SCHED; PG8_LDA(At, 1, 0); PG8_STAGE(PG8_SA(0, 1), a2, o2[1]);
            PG8_WAIT_V(8); PG8_WAIT_L(0); PG8_BAR; PG8_MMA(0, 0, At, B0); PG8_MMA(0, 1, At, B1); PG8_BAR; PG8_SCHED;
            PG8_LDA(At, 1, 1); PG8_STAGE(PG8_SB(1, 0), b3, voffB); PG8_STAGE(PG8_SB(1, 1), b3 + hstep, voffB); PG8_STAGE(PG8_SA(1, 0), a3, o2[0]);
            PG8_WAIT_V(8); PG8_WAIT_L(0); PG8_BAR; PG8_MMA(1, 0, At, B0); PG8_MMA(1, 1, At, B1); PG8_BAR; PG8_SCHED;
            if constexpr (Epi::HOOK_T >= 0) { if (t == Epi::HOOK_T) { E.mid(acc, cur, wr, wc, fr, fq); PG8_SCHED; } }
        }
        if (wr == 0) PG8_BAR;
        E(acc, cur, wr, wc, fr, fq);
        if (!has_next) break;
#pragma unroll
        for (int a = 0; a < 2; ++a)
#pragma unroll
            for (int b = 0; b < 2; ++b)
#pragma unroll
                for (int m = 0; m < 4; ++m)
#pragma unroll
                    for (int n = 0; n < 2; ++n) acc[a][b][m][n] = (f32x4){0.f, 0.f, 0.f, 0.f};
        cur = nxt; cA = nA; cB = nB; ++ui;
#pragma unroll
        for (int h = 0; h < 2; ++h)
#pragma unroll
            for (int i = 0; i < 2; ++i) oA[h][i] = nO[h][i];
        if (wr == 1) PG8_BAR;
    }
    PG8_WAIT_V(0);
    PG8_BAR;
#undef PG8_SA
#undef PG8_SB
#undef PG8_STAGE
#undef PG8_LDA
#undef PG8_LDB
#undef PG8_MMA
#undef PG8_WAIT_V
#undef PG8_WAIT_L
#undef PG8_BAR
#undef PG8_SCHED
}
}
using pg8::Unit;
typedef f32x4 Acc[2][2][4][2];

struct PlainSched {
    const char* A; const char* Bt; int nM, nN, K, G, c, rsh;
    __device__ __forceinline__ bool next(int i, Unit& u) const {
        int pm, pn; if (!pg8::static_order(i >> rsh, G, c, nM, nN, pm, pn)) return false;
        u.pm = pm; u.pn = pn; u.x0 = 0; u.x1 = 0; u.a = A + (size_t)pm * 256 * K * 2; u.b = Bt + (size_t)pn * 256 * K * 2; return true;
    }
    __device__ __forceinline__ unsigned a_off(const Unit&, int row, int K_) const { return (unsigned)(row * K_) * 2u; }
};
struct InProjSched {
    const char* NX; const char* Wt; int G, c, rsh;
    __device__ __forceinline__ bool next(int i, Unit& u) const {
        int pm, pn; if (!pg8::static_order(i >> rsh, G, c, T / 256, 23, pm, pn)) return false;
        u.pm = pm; u.pn = pn; u.x0 = 0; u.x1 = 0;
        const char* xa = NX + (size_t)pm * 256 * D * 2; const char* wb = Wt + (size_t)pn * 256 * D * 2;
        if (pn < 17) { u.a = xa; u.b = wb; } else { u.a = wb; u.b = xa; }
        return true;
    }
    __device__ __forceinline__ unsigned a_off(const Unit&, int row, int K_) const { return (unsigned)(row * K_) * 2u; }
};
struct MoeSched {
    const char* A; const char* Bt; const int* list; const LAS int* ts; int nN, K, G, c, gather, rsh;
    __device__ __forceinline__ bool next(int i, Unit& u) const {
        const int MT = ts[32];
        int pm, pn; if (!pg8::static_order(i >> rsh, G, c, MT, nN, pm, pn)) return false;
        int e = 0;
#pragma unroll
        for (int s = 16; s >= 1; s >>= 1) { if (ts[e + s] <= pm) e += s; }
        e = __builtin_amdgcn_readfirstlane(e);
        u.pm = pm; u.pn = pn; u.x0 = e; u.x1 = __builtin_amdgcn_readfirstlane(pm - ts[e]);
        u.a = gather ? A : A + (size_t)pm * 256 * K * 2;
        u.b = Bt + ((size_t)e * nN + pn) * 256 * K * 2;
        return true;
    }
    __device__ __forceinline__ unsigned a_off(const Unit& u, int row, int K_) const {
        if (!gather) return (unsigned)(row * K_) * 2u;
        const int slot = u.x1 * 256 + row, cnt = ts[40 + u.x0];
        const int tok = slot < cnt ? list[u.x0 * 32768 + slot] : 0;
        return (unsigned)(tok * K_) * 2u;
    }
};

__device__ __forceinline__ void st8(bf16* p, f32x4 v0, f32x4 v1) { v4u w; w.x = cvt_pk_bf16(v0[0], v0[1]); w.y = cvt_pk_bf16(v0[2], v0[3]); w.z = cvt_pk_bf16(v1[0], v1[1]); w.w = cvt_pk_bf16(v1[2], v1[3]); *(v4u*)p = w; }
__device__ __forceinline__ void ld8(const bf16* p, f32x4& v0, f32x4& v1) { const v4u w = *(const v4u*)p; v0 = (f32x4){bflo(w.x), bfhi(w.x), bflo(w.y), bfhi(w.y)}; v1 = (f32x4){bflo(w.z), bfhi(w.z), bflo(w.w), bfhi(w.w)}; }

struct EpiInProj {
    static constexpr bool PERM = true; static constexpr int HOOK_T = -1;
    bf16 *Q, *Kb, *ZU, *GA, *GG, *VT, *ZVT;
    template <int ACT> __device__ __forceinline__ void std_store(const Acc& acc, bf16* base, int ldc, int colt, int pm, int wr, int wc, int fr, int fq) const {
        const int row0 = pm * 256 + wr * 64 + fr, col0 = colt + wc * 32 + 8 * fq;
#pragma unroll
        for (int ai = 0; ai < 2; ++ai)
#pragma unroll
            for (int m = 0; m < 4; ++m) { bf16* rowp = base + (size_t)(row0 + ai * 128 + m * 16) * ldc + col0;
#pragma unroll
                for (int bj = 0; bj < 2; ++bj) { f32x4 v0 = acc[ai][bj][m][0], v1 = acc[ai][bj][m][1];
                    if (ACT == 1) { v0 = v0 * QSCALE; v1 = v1 * QSCALE; }
                    if (ACT == 2) { v0 = gelu4(v0); v1 = gelu4(v1); }
                    if (ACT == 3) { v0 = sigm4(v0); v1 = sigm4(v1); }
                    st8(rowp + bj * 128, v0, v1); } }
    }
    template <int ACT> __device__ __forceinline__ void tile_store(const Acc& acc, bf16* base, int g, int pm, int wr, int wc, int fr, int fq) const {
        const int dsh = 2 * g, row0 = pm * 256 + wr * 64 + fr;
#pragma unroll
        for (int ai = 0; ai < 2; ++ai)
#pragma unroll
            for (int m = 0; m < 4; ++m) { const int t = row0 + ai * 128 + m * 16, bb = t >> 12, sq = t & (SEQ - 1), r = sq & ((1 << dsh) - 1), i = sq >> dsh, kb = i >> 5, key = i & 31;
#pragma unroll
                for (int bj = 0; bj < 2; ++bj) { const int cw = bj * 128 + wc * 32 + 8 * fq, hh = cw >> 6, dd = cw & 63;
                    f32x4 v0 = acc[ai][bj][m][0], v1 = acc[ai][bj][m][1];
                    if (ACT == 1) { v0 = v0 * QSCALE; v1 = v1 * QSCALE; }
                    st8(base + ((size_t)((bb * 3 + g) * 4 + hh) * 128 + (size_t)((r << (7 - dsh)) + kb)) * 2048 + key * 64 + dd, v0, v1); } }
    }
    __device__ __forceinline__ void operator()(const Acc& acc, const Unit& u, int wr, int wc, int fr, int fq) const {
        const int pn = u.pn, pm = u.pm;
        if (pn < 3) tile_store<1>(acc, Q, pn, pm, wr, wc, fr, fq);
        else if (pn < 6) tile_store<0>(acc, Kb, pn - 3, pm, wr, wc, fr, fq);
        else if (pn < 9) std_store<2>(acc, ZU, GM_W, (pn - 6) * 256, pm, wr, wc, fr, fq);
        else if (pn < 13) std_store<3>(acc, GA, D, (pn - 9) * 256, pm, wr, wc, fr, fq);
        else if (pn < 17) std_store<3>(acc, GG, D, (pn - 13) * 256, pm, wr, wc, fr, fq);
        else if (pn < 20) {
            const int g = pn - 17, tok0 = pm * 256 + wc * 32 + 8 * fq;
#pragma unroll
            for (int ai = 0; ai < 2; ++ai)
#pragma unroll
                for (int m = 0; m < 4; ++m) { const int chl = ai * 128 + wr * 64 + m * 16 + fr, hh = chl >> 6, dd = chl & 63;
#pragma unroll
                    for (int bj = 0; bj < 2; ++bj) { const f32x4 v0 = acc[ai][bj][m][0], v1 = acc[ai][bj][m][1];
                        const int tk = tok0 + bj * 128, bb = tk >> 12, s0 = tk & (SEQ - 1);
                        bf16* hb = VT + (size_t)((bb * 3 + g) * 4 + hh) * (128 * 64 * 32) + dd * 32;
                        if (g == 0) { const int kb = s0 >> 5, k0 = s0 & 31, p0 = (k0 & 16) + 4 * ((k0 >> 3) & 1);
                            bf16* tp = hb + (size_t)kb * 2048 + p0;
                            v2u w0, w1; w0.x = cvt_pk_bf16(v0[0], v0[1]); w0.y = cvt_pk_bf16(v0[2], v0[3]); w1.x = cvt_pk_bf16(v1[0], v1[1]); w1.y = cvt_pk_bf16(v1[2], v1[3]);
                            *(v2u*)tp = w0; *(v2u*)(tp + 8) = w1;
                        } else if (g == 1) { const int i = s0 >> 2, kb = i >> 5, k = i & 31, ps = (k & 19) | ((k & 4) << 1) | ((k & 8) >> 1);
#pragma unroll
                            for (int r = 0; r < 4; ++r) *(unsigned*)(hb + (size_t)(r * 32 + kb) * 2048 + ps) = cvt_pk_bf16(v0[r], v1[r]);
                        } else { const int i = s0 >> 4, kb = i >> 5, k = i & 31, ps = (k & 19) | ((k & 4) << 1) | ((k & 8) >> 1), rb = s0 & 15;
#pragma unroll
                            for (int e = 0; e < 4; ++e) { hb[(size_t)((rb + e) * 8 + kb) * 2048 + ps] = (bf16)f2bf(v0[e]); hb[(size_t)((rb + 4 + e) * 8 + kb) * 2048 + ps] = (bf16)f2bf(v1[e]); }
                        } } }
        } else {
            const int ch0 = (pn - 20) * 256 + wr * 64 + fr, tin = wc * 32 + 8 * fq;
#pragma unroll
            for (int ai = 0; ai < 2; ++ai)
#pragma unroll
                for (int m = 0; m < 4; ++m) { const int ch = ch0 + ai * 128 + m * 16;
#pragma unroll
                    for (int bj = 0; bj < 2; ++bj) st8(ZVT + ((size_t)(2 * pm + bj) * GM_W + ch) * 128 + tin, gelu4(acc[ai][bj][m][0]), gelu4(acc[ai][bj][m][1])); }
        }
    }
};
template <int MODE> struct EpiBf {
    static constexpr bool PERM = true; static constexpr int HOOK_T = -1;
    bf16* O; const bf16* G1; const bf16* Y0;
    __device__ __forceinline__ void operator()(const Acc& acc, const Unit& u, int wr, int wc, int fr, int fq) const {
        const int row0 = u.pm * 256 + wr * 64 + fr, col0 = u.pn * 256 + wc * 32 + 8 * fq;
#pragma unroll
        for (int ai = 0; ai < 2; ++ai) {
            v4u gw[4][2], yw[4][2];
            if (MODE >= 1) {
#pragma unroll
                for (int m = 0; m < 4; ++m)
#pragma unroll
                    for (int bj = 0; bj < 2; ++bj) { const size_t off = (size_t)(row0 + ai * 128 + m * 16) * D + col0 + bj * 128; gw[m][bj] = *(const v4u*)(G1 + off); if (MODE == 2) yw[m][bj] = *(const v4u*)(Y0 + off); }
                __builtin_amdgcn_sched_barrier(0);
            }
#pragma unroll
            for (int m = 0; m < 4; ++m)
#pragma unroll
                for (int bj = 0; bj < 2; ++bj) { const size_t off = (size_t)(row0 + ai * 128 + m * 16) * D + col0 + bj * 128; f32x4 v0 = acc[ai][bj][m][0], v1 = acc[ai][bj][m][1];
                    if (MODE >= 1) { const v4u w = gw[m][bj]; v0 = v0 * (f32x4){bflo(w.x), bfhi(w.x), bflo(w.y), bfhi(w.y)}; v1 = v1 * (f32x4){bflo(w.z), bfhi(w.z), bflo(w.w), bfhi(w.w)}; }
                    if (MODE == 2) { const v4u w = yw[m][bj]; v0 = v0 + (f32x4){bflo(w.x), bfhi(w.x), bflo(w.y), bfhi(w.y)}; v1 = v1 + (f32x4){bflo(w.z), bfhi(w.z), bflo(w.w), bfhi(w.w)}; }
                    st8(O + off, v0, v1); }
            if (MODE >= 1) __builtin_amdgcn_sched_barrier(0);
        }
    }
};
template <int MODE> struct EpiF32 {
    static constexpr bool PERM = false; static constexpr int HOOK_T = -1;
    float* H; const float* X; const bf16* PP;
    __device__ __forceinline__ void operator()(const Acc& acc, const Unit& u, int wr, int wc, int fr, int fq) const {
        const int row0 = u.pm * 256 + wr * 64 + fr, col0 = u.pn * 256 + wc * 32 + 4 * fq;
        const float* src = MODE == 0 ? X : H;
        constexpr int MB = MODE == 0 ? 4 : 2;
#pragma unroll
        for (int ai = 0; ai < 2; ++ai)
#pragma unroll
            for (int mb = 0; mb < 4; mb += MB) {
                f32x4 xv[MB][2][2]; v2u pw[MB][2][2];
#pragma unroll
                for (int m = 0; m < MB; ++m)
#pragma unroll
                    for (int bj = 0; bj < 2; ++bj)
#pragma unroll
                        for (int n = 0; n < 2; ++n) { const size_t o = (size_t)(row0 + ai * 128 + (mb + m) * 16) * D + col0 + bj * 128 + n * 16; xv[m][bj][n] = *(const f32x4*)(src + o); if (MODE == 1) pw[m][bj][n] = *(const v2u*)(PP + o); }
                __builtin_amdgcn_sched_barrier(0);
#pragma unroll
                for (int m = 0; m < MB; ++m)
#pragma unroll
                    for (int bj = 0; bj < 2; ++bj)
#pragma unroll
                        for (int n = 0; n < 2; ++n) { const size_t o = (size_t)(row0 + ai * 128 + (mb + m) * 16) * D + col0 + bj * 128 + n * 16; f32x4 v = acc[ai][bj][mb + m][n];
                            if (MODE == 0) v = v + xv[m][bj][n];
                            else { const v2u w = pw[m][bj][n]; v = xv[m][bj][n] + sigm4(v) * (f32x4){bflo(w.x), bfhi(w.x), bflo(w.y), bfhi(w.y)}; }
                            *(f32x4*)(H + o) = v; }
                __builtin_amdgcn_sched_barrier(0);
            }
    }
};
struct EpiMerge {
    static constexpr bool PERM = true; static constexpr int HOOK_T = 2;
    bf16* O; const bf16* GA; const bf16* GG;
    __device__ __forceinline__ void mid(Acc& acc, const Unit& u, int wr, int wc, int fr, int fq) const {
        int row0 = u.pm * 256 + wr * 64 + fr; const int col0 = u.pn * 256 + wc * 32 + 8 * fq;
        asm volatile("" : "+v"(row0));
#pragma unroll
        for (int ai = 0; ai < 2; ++ai)
#pragma unroll
            for (int mb = 0; mb < 4; mb += 2) {
                v4u aw[2][2], gw[2][2];
#pragma unroll
                for (int m = 0; m < 2; ++m)
#pragma unroll
                    for (int bj = 0; bj < 2; ++bj) { const size_t off = (size_t)(row0 + ai * 128 + (mb + m) * 16) * D + col0 + bj * 128; aw[m][bj] = *(const v4u*)(GA + off); gw[m][bj] = *(const v4u*)(GG + off); }
                __builtin_amdgcn_sched_barrier(0);
#pragma unroll
                for (int m = 0; m < 2; ++m)
#pragma unroll
                    for (int bj = 0; bj < 2; ++bj) { const v4u a = aw[m][bj], g = gw[m][bj];
                        acc[ai][bj][mb + m][0] = acc[ai][bj][mb + m][0] * (f32x4){bflo(a.x) * __builtin_amdgcn_rcpf(fmaxf(bflo(g.x), 1e-30f)), bfhi(a.x) * __builtin_amdgcn_rcpf(fmaxf(bfhi(g.x), 1e-30f)), bflo(a.y) * __builtin_amdgcn_rcpf(fmaxf(bflo(g.y), 1e-30f)), bfhi(a.y) * __builtin_amdgcn_rcpf(fmaxf(bfhi(g.y), 1e-30f))};
                        acc[ai][bj][mb + m][1] = acc[ai][bj][mb + m][1] * (f32x4){bflo(a.z) * __builtin_amdgcn_rcpf(fmaxf(bflo(g.z), 1e-30f)), bfhi(a.z) * __builtin_amdgcn_rcpf(fmaxf(bfhi(g.z), 1e-30f)), bflo(a.w) * __builtin_amdgcn_rcpf(fmaxf(bflo(g.w), 1e-30f)), bfhi(a.w) * __builtin_amdgcn_rcpf(fmaxf(bfhi(g.w), 1e-30f))}; }
                __builtin_amdgcn_sched_barrier(0);
            }
    }
    __device__ __forceinline__ void operator()(const Acc& acc, const Unit& u, int wr, int wc, int fr, int fq) const {
        const int row0 = u.pm * 256 + wr * 64 + fr, col0 = u.pn * 256 + wc * 32 + 8 * fq;
#pragma unroll
        for (int ai = 0; ai < 2; ++ai) {
            v4u gw[4][2];
#pragma unroll
            for (int m = 0; m < 4; ++m)
#pragma unroll
                for (int bj = 0; bj < 2; ++bj) gw[m][bj] = *(const v4u*)(GG + (size_t)(row0 + ai * 128 + m * 16) * D + col0 + bj * 128);
            __builtin_amdgcn_sched_barrier(0);
#pragma unroll
            for (int m = 0; m < 4; ++m)
#pragma unroll
                for (int bj = 0; bj < 2; ++bj) { const v4u g = gw[m][bj];
                    st8(O + (size_t)(row0 + ai * 128 + m * 16) * D + col0 + bj * 128, acc[ai][bj][m][0] * (f32x4){bflo(g.x), bfhi(g.x), bflo(g.y), bfhi(g.y)}, acc[ai][bj][m][1] * (f32x4){bflo(g.z), bfhi(g.z), bflo(g.w), bfhi(g.w)}); }
            __builtin_amdgcn_sched_barrier(0);
        }
    }
};
struct EpiPle {
    static constexpr bool PERM = true; static constexpr int HOOK_T = -1;
    bf16* O; const bf16* PP;
    __device__ __forceinline__ void operator()(const Acc& acc, const Unit& u, int wr, int wc, int fr, int fq) const {
        const int row0 = u.pm * 256 + wr * 64 + fr, col0 = u.pn * 256 + wc * 32 + 8 * fq;
#pragma unroll
        for (int ai = 0; ai < 2; ++ai) {
            v4u pw[4][2];
#pragma unroll
            for (int m = 0; m < 4; ++m)
#pragma unroll
                for (int bj = 0; bj < 2; ++bj) pw[m][bj] = *(const v4u*)(PP + (size_t)(row0 + ai * 128 + m * 16) * D + col0 + bj * 128);
            __builtin_amdgcn_sched_barrier(0);
#pragma unroll
            for (int m = 0; m < 4; ++m)
#pragma unroll
                for (int bj = 0; bj < 2; ++bj) { const v4u w = pw[m][bj];
                    const f32x4 v0 = sigm4(acc[ai][bj][m][0]) * (f32x4){bflo(w.x), bfhi(w.x), bflo(w.y), bfhi(w.y)}, v1 = sigm4(acc[ai][bj][m][1]) * (f32x4){bflo(w.z), bfhi(w.z), bflo(w.w), bfhi(w.w)};
                    st8(O + (size_t)(row0 + ai * 128 + m * 16) * D + col0 + bj * 128, v0, v1); }
            __builtin_amdgcn_sched_barrier(0);
        }
    }
};
struct EpiMoeUp {
    static constexpr bool PERM = true; static constexpr int HOOK_T = -1;
    bf16* ACT; const float* bgu; const float* srstd; const LAS int* ts;
    __device__ __forceinline__ void operator()(const Acc& acc, const Unit& u, int wr, int wc, int fr, int fq) const {
        const int e = u.x0, cnt = ts[40 + e], srow0 = u.x1 * 256 + wr * 64 + fr;
        const int row0 = u.pm * 256 + wr * 64 + fr, hc = u.pn * 128 + wc * 32 + 8 * fq;
        const float* bg = bgu + (size_t)e * 2048 + hc;
        const f32x4 bg0 = *(const f32x4*)bg, bg1 = *(const f32x4*)(bg + 4), bl0 = *(const f32x4*)(bg + 1024), bl1 = *(const f32x4*)(bg + 1028);
        float rsv[2][4];
#pragma unroll
        for (int ai = 0; ai < 2; ++ai)
#pragma unroll
            for (int m = 0; m < 4; ++m) { const int slot = srow0 + ai * 128 + m * 16; rsv[ai][m] = slot < cnt ? srstd[e * 32768 + slot] : 0.f; }
        __builtin_amdgcn_sched_barrier(0);
#pragma unroll
        for (int ai = 0; ai < 2; ++ai)
#pragma unroll
            for (int m = 0; m < 4; ++m) { const float rs = rsv[ai][m];
                f32x4 o[2];
#pragma unroll
                for (int n = 0; n < 2; ++n) { const f32x4 gu = acc[ai][0][m][n] * rs + (n ? bg1 : bg0), li = acc[ai][1][m][n] * rs + (n ? bl1 : bl0);
#pragma unroll
                    for (int e2 = 0; e2 < 4; ++e2) { const float gl = fminf(gu[e2], 7.0f), ln = fminf(fmaxf(li[e2], -7.0f), 7.0f);
                        o[n][e2] = gl * __builtin_amdgcn_rcpf(1.0f + __builtin_amdgcn_exp2f(-1.702f * LOG2E * gl)) * (ln + 1.0f); } }
                st8(ACT + (size_t)(row0 + ai * 128 + m * 16) * D + hc, o[0], o[1]); }
    }
};
struct EpiMoeDown {
    static constexpr bool PERM = true; static constexpr int HOOK_T = -1;
    bf16* Y; const float* bd; const float* sgate; const LAS int* ts;
    __device__ __forceinline__ void operator()(const Acc& acc, const Unit& u, int wr, int wc, int fr, int fq) const {
        const int e = u.x0, cnt = ts[40 + e], srow0 = u.x1 * 256 + wr * 64 + fr, col0 = u.pn * 256 + wc * 32 + 8 * fq;
        const float* bp = bd + (size_t)e * D + col0;
        f32x4 bv[2][2];
#pragma unroll
        for (int bj = 0; bj < 2; ++bj) { bv[bj][0] = *(const f32x4*)(bp + bj * 128); bv[bj][1] = *(const f32x4*)(bp + bj * 128 + 4); }
        float gtv[2][4];
#pragma unroll
        for (int ai = 0; ai < 2; ++ai)
#pragma unroll
            for (int m = 0; m < 4; ++m) { const int slot = srow0 + ai * 128 + m * 16; gtv[ai][m] = slot < cnt ? sgate[e * 32768 + slot] : 0.f; }
        __builtin_amdgcn_sched_barrier(0);
#pragma unroll
        for (int ai = 0; ai < 2; ++ai)
#pragma unroll
            for (int m = 0; m < 4; ++m) { const float gt = gtv[ai][m];
                bf16* rowp = Y + (size_t)(u.pm * 256 + wr * 64 + fr + ai * 128 + m * 16) * D + col0;
#pragma unroll
                for (int bj = 0; bj < 2; ++bj) st8(rowp + bj * 128, (acc[ai][bj][m][0] + bv[bj][0]) * gt, (acc[ai][bj][m][1] + bv[bj][1]) * gt); }
    }
};

#define XB_TMO      128
#define XB_XCNT(j)  (256  + 64 * (j))
#define XB_XSUB(j)  (1280 + 64 * (j))
#define XB_XGEN(j)  (2304 + 64 * (j))
#define XB_TOP      3328
#define XB_TOPGEN   3392
#define XCD_BAR_WORDS 3456
#define XB_SPIN_CAP (1u << 18)
__device__ __forceinline__ unsigned xb_ld(unsigned* p)              { return __hip_atomic_load(p, __ATOMIC_RELAXED, __HIP_MEMORY_SCOPE_AGENT); }
__device__ __forceinline__ unsigned xb_add(unsigned* p, unsigned v) { return __hip_atomic_fetch_add(p, v, __ATOMIC_RELAXED, __HIP_MEMORY_SCOPE_AGENT); }
__device__ __forceinline__ unsigned xb_xcc_id() { return (unsigned)__builtin_amdgcn_s_getreg((3 << 11) | 20) & 0xFu; }
#define XB_SPIN(cond, bar) do { unsigned _sp = 0; while (cond) { __builtin_amdgcn_s_sleep(1); \
    if ((++_sp & 255u) == 0u) { if (xb_ld(&(bar)[XB_TMO])) break; if (_sp > XB_SPIN_CAP) { atomicAdd(&(bar)[XB_TMO], 1u); break; } } } } while (0)
struct XcdBarrier { unsigned* bar; unsigned x; volatile LAS unsigned* st; };
__device__ __forceinline__ XcdBarrier xcd_barrier_post(unsigned* bar, volatile LAS unsigned* st) {
    XcdBarrier b; b.bar = bar; b.x = xb_xcc_id(); b.st = st;
    if (threadIdx.x == 0) (void)xb_add(&bar[XB_XCNT(b.x)], 1u);
    return b;
}
__device__ __forceinline__ void xcd_barrier_complete(unsigned* bar, unsigned x, unsigned& nloc, unsigned& nx) {
    const unsigned G = gridDim.x * gridDim.y * gridDim.z;
    unsigned sum, cnt, mine, sp = 0u;
    for (;;) {
        sum = 0u; cnt = 0u; mine = 0u;
#pragma unroll
        for (unsigned j = 0; j < 16; ++j) { const unsigned c = xb_ld(&bar[XB_XCNT(j)]); sum += c; cnt += (c > 0u) ? 1u : 0u; mine = (j == x) ? c : mine; }
        if (sum == G) break;
        __builtin_amdgcn_s_sleep(1);
        if ((++sp & 255u) == 0u) { if (xb_ld(&bar[XB_TMO])) break; if (sp > XB_SPIN_CAP) { atomicAdd(&bar[XB_TMO], 1u); break; } }
    }
    nloc = mine > 0u ? mine : 1u; nx = cnt > 0u ? cnt : 1u;
}
__device__ __forceinline__ void xcd_barrier(const XcdBarrier& b) {
    asm volatile("s_waitcnt vmcnt(0)" ::: "memory");
    __syncthreads();
    if (threadIdx.x == 0) {
        unsigned* bar = b.bar;
        __builtin_amdgcn_s_waitcnt(0);
        unsigned nloc = b.st[0], nx = b.st[1];
        if (nloc == 0u) { xcd_barrier_complete(bar, b.x, nloc, nx); b.st[0] = nloc; b.st[1] = nx; }
        const unsigned old = xb_add(&bar[XB_XSUB(b.x)], 1u);
        const unsigned gen = old / nloc;
        if (old + 1u == (gen + 1u) * nloc) {
            __builtin_amdgcn_fence(__ATOMIC_RELEASE, "agent");
            asm volatile("s_waitcnt vmcnt(0)" ::: "memory");
            const unsigned og = xb_add(&bar[XB_TOP], 1u);
            const unsigned tg = og / nx;
            if (og + 1u == (tg + 1u) * nx) xb_add(&bar[XB_TOPGEN], 1u);
            else XB_SPIN(xb_ld(&bar[XB_TOPGEN]) == tg, bar);
            __builtin_amdgcn_fence(__ATOMIC_ACQUIRE, "agent");
            xb_add(&bar[XB_XGEN(b.x)], 1u);
            asm volatile("s_waitcnt vmcnt(0)" ::: "memory");
        } else {
            XB_SPIN(xb_ld(&bar[XB_XGEN(b.x)]) == gen, bar);
            __builtin_amdgcn_fence(__ATOMIC_ACQUIRE, "agent");
            asm volatile("s_waitcnt vmcnt(0)" ::: "memory");
        }
    }
    __syncthreads();
}

struct Args { const float* in[23]; float* out; unsigned char* ws; int ph_lo, ph_hi; };
struct Frame {
    LAS unsigned char* lds; int wave, vcu, G;
};
#define LDS_WAIT() asm volatile("s_waitcnt lgkmcnt(0)" ::: "memory")

__device__ __forceinline__ int t5_bucket(int n) {
    if (n < 16) return n;
    const int th[15] = {22, 30, 40, 54, 73, 99, 134, 182, 246, 332, 450, 609, 825, 1117, 1513};
    int b = 16;
#pragma unroll
    for (int k = 0; k < 15; ++k) b += (n >= th[k]) ? 1 : 0;
    return b;
}

__device__ __forceinline__ void transpose_item(const float* W, int K, int N, bf16* WT, int drow0, LAS float* scr, int k0, int n0, int lane, int kdst = 0) {
    const int q = lane & 15, kr = lane >> 4;
    f32x4 v[8];
#pragma unroll
    for (int i = 0; i < 8; ++i) v[i] = *(const f32x4*)(W + (size_t)(k0 + 4 * i + kr) * N + n0 + 4 * q);
#pragma unroll
    for (int i = 0; i < 8; ++i) { LAS float* d = scr + (4 * q) * 33 + 4 * i + kr; d[0] = v[i].x; d[33] = v[i].y; d[66] = v[i].z; d[99] = v[i].w; }
    LDS_WAIT(); asm volatile("" ::: "memory");
    const int c4 = lane & 3, nr = lane >> 2;
#pragma unroll
    for (int j = 0; j < 4; ++j) { const int n = nr + 16 * j; const LAS float* sp = scr + n * 33 + 8 * c4;
        v4u o; o.x = pk2(sp[0], sp[1]); o.y = pk2(sp[2], sp[3]); o.z = pk2(sp[4], sp[5]); o.w = pk2(sp[6], sp[7]);
        *(v4u*)(WT + (size_t)(drow0 + n) * K + kdst + k0 + 8 * c4) = o; }
    LDS_WAIT(); asm volatile("" ::: "memory");
}
constexpr int BG_GU = 32 * 32 * 32, BG_DN = 32 * 32 * 16, BG_N = BG_GU + BG_DN;
constexpr int BG_P1 = 32768;
struct BgItem { const float* W; bf16* WT; int N, k0, n0, drow0, pitch, kdst; };
constexpr int BG_X0 = BG_N, BG_X1 = BG_X0 + 8 * 16, BG_X2 = BG_X1 + 24 * 16, BG_X3 = BG_X2 + 32 * 16, BG_X4 = BG_X3 + 32 * 16, BG_ALL = BG_X4 + 8 * 16;
__device__ __forceinline__ BgItem bg_decode(const Args& A, int r) {
    BgItem it; it.pitch = D; it.kdst = 0;
    if (r < BG_GU) { const int e = r >> 10, q = r & 1023, kb = q >> 5, nb = q & 31, n0 = nb * 64;
        it.W = A.in[15] + (size_t)e * D * 2048; it.WT = (bf16*)(A.ws + WS_WGU) + (size_t)e * 2048 * D; it.N = 2048; it.k0 = kb * 32; it.n0 = n0;
        it.drow0 = n0 < 1024 ? 256 * (n0 >> 7) + (n0 & 127) : 256 * ((n0 - 1024) >> 7) + 128 + (n0 & 127);
    } else if (r < BG_N) { r -= BG_GU; const int e = r >> 9, q = r & 511, kb = q >> 4, nb = q & 15;
        it.W = A.in[17] + (size_t)e * D * D; it.WT = (bf16*)(A.ws + WS_WD) + (size_t)e * D * D; it.N = D; it.k0 = kb * 32; it.n0 = nb * 64; it.drow0 = nb * 64;
    } else { int src; bf16* dst;
        if (r < BG_X1) { r -= BG_X0; src = 5; dst = (bf16*)(A.ws + WS_WCAT); }
        else if (r < BG_X2) { r -= BG_X1; src = 10; dst = (bf16*)(A.ws + WS_WCAT); it.kdst = 256; }
        else if (r < BG_X3) { r -= BG_X2; src = 11; dst = (bf16*)(A.ws + WS_WOUT); }
        else if (r < BG_X4) { r -= BG_X3; src = 20; dst = (bf16*)(A.ws + WS_WPG); }
        else { r -= BG_X4; src = 21; dst = (bf16*)(A.ws + WS_WPP); it.pitch = PLE; }
        it.W = src == 5 ? A.in[5] : src == 10 ? A.in[10] : src == 11 ? A.in[11] : src == 20 ? A.in[20] : A.in[21];
        it.WT = dst; it.N = D; it.k0 = (r >> 4) * 32; it.n0 = (r & 15) * 64; it.drow0 = it.n0; }
    return it;
}
struct BgConv {
    int cur, next, stride, end; f32x4 v[8];
    __device__ __forceinline__ void init(int first, int stride_, int end_ = BG_ALL) { cur = -1; next = first; stride = stride_; end = end_; }
    __device__ __forceinline__ void issue(const Args& A, int lane) {
        if (next < end) { const BgItem it = bg_decode(A, next); const int q = lane & 15, kr = lane >> 4;
#pragma unroll
            for (int i = 0; i < 8; ++i) v[i] = *(const f32x4*)(it.W + (size_t)(it.k0 + 4 * i + kr) * it.N + it.n0 + 4 * q);
            cur = next; next += stride; } else cur = -1;
    }
    __device__ __forceinline__ void finish(const Args& A, LAS float* scr, int lane) {
        if (cur >= 0) { const BgItem it = bg_decode(A, cur); const int q = lane & 15, kr = lane >> 4;
#pragma unroll
            for (int i = 0; i < 8; ++i) { LAS float* d = scr + (4 * q) * 33 + 4 * i + kr; d[0] = v[i].x; d[33] = v[i].y; d[66] = v[i].z; d[99] = v[i].w; }
            LDS_WAIT(); asm volatile("" ::: "memory");
            const int c4 = lane & 3, nr = lane >> 2;
#pragma unroll
            for (int j = 0; j < 4; ++j) { const int n = nr + 16 * j; const LAS float* sp = scr + n * 33 + 8 * c4;
                v4u o; o.x = pk2(sp[0], sp[1]); o.y = pk2(sp[2], sp[3]); o.z = pk2(sp[4], sp[5]); o.w = pk2(sp[6], sp[7]);
                *(v4u*)(it.WT + (size_t)(it.drow0 + n) * it.pitch + it.kdst + it.k0 + 8 * c4) = o; }
            LDS_WAIT(); asm volatile("" ::: "memory");
            cur = -1; }
    }
};
__device__ __forceinline__ void convert_queue(const Frame& F, const Args& A, unsigned* ctr, int lo, int hi) {
    LAS float* scr = (LAS float*)(F.lds + F.wave * 8448);
    LAS int* qs = (LAS int*)(F.lds + RING_BYTES + 512);
    const int lane = (int)threadIdx.x & 63;
    BgConv c0, c1;
    for (;;) {
        __syncthreads();
        if (threadIdx.x == 0) *qs = (int)__hip_atomic_fetch_add(ctr, 64u, __ATOMIC_RELAXED, __HIP_MEMORY_SCOPE_AGENT);
        __syncthreads();
        const int base = __builtin_amdgcn_readfirstlane(*qs) + lo + F.wave * 8;
        if (base - F.wave * 8 >= hi) break;
        c0.init(base, 2, base + 8 < hi ? base + 8 : hi); c1.init(base + 1, 2, base + 8 < hi ? base + 8 : hi);
        c0.issue(A, lane); c1.issue(A, lane);
#pragma unroll 1
        for (int k = 0; k < 4; ++k) { c0.finish(A, scr, lane); c0.issue(A, lane); c1.finish(A, scr, lane); c1.issue(A, lane); }
    }
}
__device__ __forceinline__ void convert_p_queue(const Frame& F, const Args& A, unsigned* ctr) {
    const int lane = (int)threadIdx.x & 63; const float* p = A.in[1]; bf16* pb = (bf16*)(A.ws + WS_PB);
    LAS int* qs = (LAS int*)(F.lds + RING_BYTES + 512);
    for (;;) {
        __syncthreads();
        if (threadIdx.x == 0) *qs = (int)__hip_atomic_fetch_add(ctr, 8u, __ATOMIC_RELAXED, __HIP_MEMORY_SCOPE_AGENT);
        __syncthreads();
        const int ck0 = __builtin_amdgcn_readfirstlane(*qs);
        if (ck0 >= (T * PLE) / 8192) break;
        const size_t base = (size_t)(ck0 + F.wave) * 8192 + 8 * lane;
#pragma unroll 4
        for (int i = 0; i < 16; ++i) { const f32x4 a = *(const f32x4*)(p + base + 512 * i), b = *(const f32x4*)(p + base + 512 * i + 4); st8(pb + base + 512 * i, a, b); }
    }
}
constexpr int BG_SCR_OFF = 45056;
__device__ __forceinline__ int win_dest(int n0) {
    if (n0 < 1536) return n0;
    if (n0 < 2304) return 4352 + (n0 - 1536);
    if (n0 < 3072) return 1536 + (n0 - 2304);
    if (n0 < 3840) return 5120 + (n0 - 3072);
    return 2304 + (n0 - 3840);
}
template <int NR> __device__ __forceinline__ void rms_rows_to_bf16(const float* xrow, const float* gain, bf16* orow, int lane) {
    f32x4 v[NR][4]; float s[NR];
#pragma unroll
    for (int r = 0; r < NR; ++r)
#pragma unroll
        for (int j = 0; j < 4; ++j) v[r][j] = ((const f32x4*)(xrow + (size_t)r * D) + lane)[64 * j];
    f32x4 g[4];
#pragma unroll
    for (int j = 0; j < 4; ++j) g[j] = ((const f32x4*)gain + lane)[64 * j];
#pragma unroll
    for (int r = 0; r < NR; ++r) { float a = 0.f;
#pragma unroll
        for (int j = 0; j < 4; ++j) a += (v[r][j].x * v[r][j].x + v[r][j].y * v[r][j].y) + (v[r][j].z * v[r][j].z + v[r][j].w * v[r][j].w);
        s[r] = a; }
#pragma unroll
    for (int o = 1; o < 64; o <<= 1)
#pragma unroll
        for (int r = 0; r < NR; ++r) s[r] += __shfl_xor(s[r], o);
#pragma unroll
    for (int r = 0; r < NR; ++r) { const float rstd = 1.0f / sqrtf(s[r] * (1.f / D) + EPS);
        unsigned long long* o8 = (unsigned long long*)(orow + (size_t)r * D) + lane;
#pragma unroll
        for (int j = 0; j < 4; ++j) o8[64 * j] = (unsigned long long)pk2(v[r][j].x * rstd * g[j].x, v[r][j].y * rstd * g[j].y) | ((unsigned long long)pk2(v[r][j].z * rstd * g[j].z, v[r][j].w * rstd * g[j].w) << 32); }
}
__device__ __forceinline__ void p0_prologue(const Frame& F, const Args& A) {
    LAS float* scr = (LAS float*)(F.lds + F.wave * 16384);
    const int gw = F.vcu * 8 + F.wave, NGW = F.G * 8;
    unsigned char* ws = A.ws;
    for (int m = gw * 4; m < T; m += NGW * 4) rms_rows_to_bf16<4>(A.in[0] + (size_t)m * D, A.in[2], (bf16*)(ws + WS_NX) + (size_t)m * D, ((int)threadIdx.x & 63));
    { const float* wsp = A.in[8]; bf16* o = (bf16*)(ws + WS_WSP);
      for (int i = (blockIdx.x * 512 + ((int)threadIdx.x)) * 4; i < 12 * 128 * 128; i += F.G * 512 * 4) { const int col = i & 127, row = (i >> 7) & 127; const f32x4 a = *(const f32x4*)(wsp + i);
          v2u w; w.x = pk2(col <= row ? a.x : 0.f, col + 1 <= row ? a.y : 0.f); w.y = pk2(col + 2 <= row ? a.z : 0.f, col + 3 <= row ? a.w : 0.f); *(v2u*)(o + i) = w; } }
    { const float* wrt = A.in[13]; bf16* wh = (bf16*)(ws + WS_WRH); bf16* wl = (bf16*)(ws + WS_WRL);
      for (int i = blockIdx.x * 512 + ((int)threadIdx.x); i < 32 * 1024; i += F.G * 512) { const int e = i >> 10, k = i & 1023; const float w = wrt[k * 32 + e]; const unsigned h = f2bf(w); wh[i] = (bf16)h; wl[i] = (bf16)f2bf(w - bflo(h)); } }
    constexpr int I_IN = 32 * 92;
    for (int it = gw; it < I_IN; it += NGW) { const int kb = it / 92, nb = it % 92; transpose_item(A.in[3], D, IN_W, (bf16*)(ws + WS_WIN), win_dest(nb * 64), scr, kb * 32, nb * 64, ((int)threadIdx.x & 63)); }
}

__device__ __forceinline__ int crow(int r, int hi) { return (r & 3) + 8 * (r >> 2) + 4 * hi; }
struct AtU { int b, g, h, r, qb8, nqb; };
__device__ __forceinline__ AtU at_decode(int pr) { AtU u; const int slot = pr & 15; u.h = (pr >> 4) & 3; const int bgi = pr >> 6; u.g = bgi % 3; u.b = bgi / 3; u.nqb = 128 >> (2 * u.g);
    u.r = slot / (u.nqb >> 3); u.qb8 = slot % (u.nqb >> 3); return u; }
__device__ __forceinline__ void at_load(const AtU& u, const bf16* QT, const bf16* KT, const bf16* VT, int w, int r32, int hi, int q8, int t8, v4u (&stg)[12], bf16x8 (&qf)[4]) {
    const size_t tb0 = (size_t)((u.b * 3 + u.g) * 4 + u.h) * 128 + (size_t)(u.r * u.nqb);
    const bf16* qt = QT + (tb0 + u.qb8 * 8 + w) * 2048 + r32 * 64 + 8 * hi;
#pragma unroll
    for (int s = 0; s < 4; ++s) qf[s] = *(const bf16x8*)(qt + 16 * s);
#pragma unroll
    for (int i = 0; i < 12; ++i) { const int kv = i >= 6 ? 1 : 0, j = 2 * (i - 6 * kv) + t8; int kb = u.qb8 * 8 - 4 + j; kb = kb < 0 ? 0 : kb;
        stg[i] = *(const v4u*)((kv ? VT : KT) + (tb0 + kb) * 2048 + q8 * 8); }
}
__device__ __forceinline__ void attn_phase(const Frame& F, const Args& A) {
    LAS float* tb = (LAS float*)(F.lds + RING_BYTES + 2048);
    const float* rel_bias = A.in[4];
    for (int i = ((int)threadIdx.x); i < 12 * 192; i += 512) { const int gh = i / 192, dist = i % 192 - 31, g = gh >> 2; const int dil = g == 0 ? 1 : (g == 1 ? 4 : 16);
        tb[i] = (dist >= 0 && dist <= 128) ? rel_bias[t5_bucket(dist * dil) * 12 + gh] * LOG2E : -INFINITY; }
    __syncthreads();
    const bf16* QT = (const bf16*)(A.ws + WS_Q); const bf16* KT = (const bf16*)(A.ws + WS_K); const bf16* VT = (const bf16*)(A.ws + WS_VT);
    bf16* OG = (bf16*)(A.ws + WS_OG); float* LSE = (float*)(A.ws + WS_LSE);
    const int lane = ((int)threadIdx.x & 63), r32 = lane & 31, hi = lane >> 5, w = F.wave;
    const int q8 = ((int)threadIdx.x) & 255, t8 = ((int)threadIdx.x) >> 8;
    const int NU = NB * 3 * 4 * 16;
    v4u stg[12]; bf16x8 qf[4];
    if (F.vcu < NU) at_load(at_decode(F.vcu), QT, KT, VT, w, r32, hi, q8, t8, stg, qf);
    for (int pr = F.vcu; pr < NU; pr += F.G) {
        const AtU u = at_decode(pr);
        const int dsh = 2 * u.g, dil = 1 << dsh, g = u.g, h = u.h, b = u.b, r = u.r;
        const int qb = u.qb8 * 8 + w, i0 = qb * 32;
        __syncthreads();
        { const int keyk = q8 >> 3, posk = keyk * 8 + ((q8 & 7) ^ ((keyk >> 1) & 7)), dv = q8 >> 2, posv = dv * 4 + ((q8 & 3) ^ ((dv >> 2) & 3));
#pragma unroll
          for (int i = 0; i < 12; ++i) { const int kv = i >= 6 ? 1 : 0, j = 2 * (i - 6 * kv) + t8;
              *(LAS v4u*)(F.lds + kv * 49152 + j * 4096 + (kv ? posv : posk) * 16) = stg[i]; } }
        bf16x8 qc[4];
#pragma unroll
        for (int s = 0; s < 4; ++s) qc[s] = qf[s];
        __syncthreads();
        if (pr + F.G < NU) at_load(at_decode(pr + F.G), QT, KT, VT, w, r32, hi, q8, t8, stg, qf);
        __builtin_amdgcn_sched_barrier(0);
        const LAS unsigned char* kbase = F.lds + w * 4096 + (r32 * 8) * 16;
        const int kx = (r32 >> 1) & 7;
        f32x16 st[5];
#pragma unroll
        for (int kt = 0; kt < 5; ++kt) {
            f32x16 a = {};
#pragma unroll
            for (int s = 0; s < 4; ++s) { const bf16x8 kf = *(const LAS bf16x8*)(kbase + kt * 4096 + (((2 * s + hi) ^ kx) << 4)); a = __builtin_amdgcn_mfma_f32_32x32x16_bf16(kf, qc[s], a, 0, 0, 0); }
            st[kt] = a;
        }
        const LAS float* tbh = tb + (g * 4 + h) * 192;
        float mx = -INFINITY;
#pragma unroll
        for (int kt = 0; kt < 5; ++kt)
#pragma unroll
            for (int i = 0; i < 16; ++i) { const int kr = crow(i, hi), krel = -128 + 32 * kt + kr; const int dist = r32 - krel;
                float v = st[kt][i] + tbh[dist + 31]; v = (i0 + krel >= 0) ? v : -INFINITY; st[kt][i] = v; mx = fmaxf(mx, v); }
        mx = fmaxf(mx, __shfl_xor(mx, 32));
        float l = 0.f;
#pragma unroll
        for (int kt = 0; kt < 5; ++kt)
#pragma unroll
            for (int i = 0; i < 16; ++i) { const float p = __builtin_amdgcn_exp2f(st[kt][i] - mx); st[kt][i] = p; l += p; }
        l += __shfl_xor(l, 32);
        const LAS unsigned char* vbase = F.lds + 49152 + w * 4096;
        f32x16 o[2] = {};
#pragma unroll
        for (int kt = 0; kt < 5; ++kt)
#pragma unroll
            for (int s2 = 0; s2 < 2; ++s2) {
                v4u pw; pw.x = cvt_pk_bf16(st[kt][8 * s2 + 0], st[kt][8 * s2 + 1]); pw.y = cvt_pk_bf16(st[kt][8 * s2 + 2], st[kt][8 * s2 + 3]);
                pw.z = cvt_pk_bf16(st[kt][8 * s2 + 4], st[kt][8 * s2 + 5]); pw.w = cvt_pk_bf16(st[kt][8 * s2 + 6], st[kt][8 * s2 + 7]);
                const bf16x8 pf = __builtin_bit_cast(bf16x8, pw);
#pragma unroll
                for (int dt = 0; dt < 2; ++dt) { const int dd = 32 * dt + r32;
                    const bf16x8 vf = *(const LAS bf16x8*)(vbase + kt * 4096 + ((dd * 4 + ((2 * s2 + hi) ^ ((dd >> 2) & 3))) << 4));
                    o[dt] = __builtin_amdgcn_mfma_f32_32x32x16_bf16(vf, pf, o[dt], 0, 0, 0); }
            }
        const float rl = 1.0f / l;
        const size_t qrow = (size_t)b * SEQ + (size_t)(i0 + r32) * dil + r;
        bf16* op = OG + ((size_t)g * T + qrow) * 256 + h * 64;
#pragma unroll
        for (int dt = 0; dt < 2; ++dt)
#pragma unroll
            for (int gq = 0; gq < 4; ++gq) { v2u wv; wv.x = cvt_pk_bf16(o[dt][4 * gq] * rl, o[dt][4 * gq + 1] * rl); wv.y = cvt_pk_bf16(o[dt][4 * gq + 2] * rl, o[dt][4 * gq + 3] * rl);
                *(v2u*)(op + 32 * dt + 8 * gq + 4 * hi) = wv; }
        if (hi == 0) LSE[((size_t)g * T + qrow) * 4 + h] = (mx + __builtin_amdgcn_logf(l)) * LN2;
    }
    __syncthreads();
}

__device__ __forceinline__ void spatial_phase(const Frame& F, const Args& A) {
    const bf16* ZVT = (const bf16*)(A.ws + WS_ZVT); const bf16* ZU = (const bf16*)(A.ws + WS_ZU); const bf16* WSP = (const bf16*)(A.ws + WS_WSP);
    bf16* Gout = (bf16*)(A.ws + WS_AG) + 256;
    const float* lng = A.in[6]; const float* lnb = A.in[7]; const float* bsp = A.in[9];
    LAS float* red = (LAS float*)(F.lds + 10240);
    LAS float* stt = (LAS float*)(F.lds + 43008);
    LAS unsigned char* vn = F.lds + 49152;
    int lane = ((int)threadIdx.x & 63); asm volatile("" : "+v"(lane));
    const int r32 = lane & 31, hi = lane >> 5, w = F.wave;
    const int dr = 8 * w + (lane >> 3), ck = lane & 7;
    for (int c = F.vcu; c < T / 128; c += F.G) {
        v4u zr[2];
#pragma unroll
        for (int p = 0; p < 2; ++p) zr[p] = *(const v4u*)(ZVT + ((size_t)c * GM_W + dr) * 128 + 8 * (ck + 8 * p));
        {
            const int tg = ((int)threadIdx.x) & 15, rg = ((int)threadIdx.x) >> 4; float sm[8], q[8];
#pragma unroll
            for (int e = 0; e < 8; ++e) { sm[e] = 0.f; q[e] = 0.f; }
#pragma unroll 4
            for (int ch = rg; ch < GM_W; ch += 32) { const v4u wv = *(const v4u*)(ZVT + ((size_t)c * GM_W + ch) * 128 + 8 * tg);
                const float x[8] = {bflo(wv.x), bfhi(wv.x), bflo(wv.y), bfhi(wv.y), bflo(wv.z), bfhi(wv.z), bflo(wv.w), bfhi(wv.w)};
#pragma unroll
                for (int e = 0; e < 8; ++e) { sm[e] += x[e]; q[e] += x[e] * x[e]; } }
#pragma unroll
            for (int e = 0; e < 8; ++e) { red[(rg * 128 + 8 * tg + e) * 2] = sm[e]; red[(rg * 128 + 8 * tg + e) * 2 + 1] = q[e]; }
            __syncthreads();
            if (((int)threadIdx.x) < 128) { float ss = 0.f, qq = 0.f;
                for (int k = 0; k < 32; ++k) { ss += red[(k * 128 + ((int)threadIdx.x)) * 2]; qq += red[(k * 128 + ((int)threadIdx.x)) * 2 + 1]; }
                const float mu = ss * (1.f / GM_W), var = fmaxf(qq * (1.f / GM_W) - mu * mu, 0.f);
                stt[((int)threadIdx.x) * 2] = mu; stt[((int)threadIdx.x) * 2 + 1] = 1.0f / sqrtf(var + EPS); }
            __syncthreads();
        }
#define SP_GROUP(GI, ZR_CUR, ZU_CUR, ZR_NXT, ZU_NXT) do { \
            const int gi_ = (GI); const int dt = w & 1, it = ((w >> 1) + gi_) & 3, ti = 32 * it + r32;       \
              \
            bf16x8 bfr[8]; \
            { const bf16* wp = WSP + ((size_t)gi_ * 128 + ti) * 128 + 8 * hi; \
              _Pragma("unroll") for (int s = 0; s < 8; ++s) bfr[s] = *(const bf16x8*)(wp + 16 * s); } \
            const float bsv = bsp[gi_ * 128 + ti], gch = lng[gi_ * 64 + dr], bch = lnb[gi_ * 64 + dr]; \
            __builtin_amdgcn_sched_barrier(0); \
              \
            LAS unsigned char* tile = vn + (gi_ & 1) * 16384; \
            _Pragma("unroll") for (int p = 0; p < 2; ++p) { const int jb = 8 * (ck + 8 * p); const v4u z = ZR_CUR[p]; \
                float x[8] = {bflo(z.x), bfhi(z.x), bflo(z.y), bfhi(z.y), bflo(z.z), bfhi(z.z), bflo(z.w), bfhi(z.w)}; \
                _Pragma("unroll") for (int e = 0; e < 8; ++e) x[e] = (x[e] - stt[(jb + e) * 2]) * stt[(jb + e) * 2 + 1] * gch + bch; \
                v4u aw; aw.x = cvt_pk_bf16(x[0], x[1]); aw.y = cvt_pk_bf16(x[2], x[3]); aw.z = cvt_pk_bf16(x[4], x[5]); aw.w = cvt_pk_bf16(x[6], x[7]); \
                *(LAS v4u*)(tile + dr * 256 + (((ck + 8 * p) ^ (dr & 15)) << 4)) = aw; } \
            { const int gn = gi_ + 1 < 12 ? gi_ + 1 : 11;        \
              _Pragma("unroll") for (int p = 0; p < 2; ++p) ZR_NXT[p] = *(const v4u*)(ZVT + ((size_t)c * GM_W + gn * 64 + dr) * 128 + 8 * (ck + 8 * p)); \
              const int itn = ((w >> 1) + gn) & 3; const size_t orow = ((size_t)c * 128 + 32 * itn + r32) * GM_W + gn * 64 + 32 * dt + 4 * hi; \
              _Pragma("unroll") for (int gq = 0; gq < 4; ++gq) ZU_NXT[gq] = *(const v2u*)(ZU + orow + 8 * gq); } \
            __syncthreads();                                    \
            f32x16 acc = {}; \
            { const int dd = 32 * dt + r32; const LAS unsigned char* ar = tile + dd * 256; \
              _Pragma("unroll") for (int s = 0; s < 8; ++s) { const bf16x8 af = *(const LAS bf16x8*)(ar + (((2 * s + hi) ^ (dd & 15)) << 4)); acc = __builtin_amdgcn_mfma_f32_32x32x16_bf16(af, bfr[s], acc, 0, 0, 0); } } \
              \
            const size_t grow = ((size_t)c * 128 + ti) * D + gi_ * 64 + 32 * dt + 4 * hi; \
            _Pragma("unroll") for (int gq = 0; gq < 4; ++gq) { const v2u uw = ZU_CUR[gq]; \
                v2u o; o.x = cvt_pk_bf16(bflo(uw.x) * (acc[4 * gq] + bsv), bfhi(uw.x) * (acc[4 * gq + 1] + bsv)); o.y = cvt_pk_bf16(bflo(uw.y) * (acc[4 * gq + 2] + bsv), bfhi(uw.y) * (acc[4 * gq + 3] + bsv)); \
                *(v2u*)(Gout + grow + 8 * gq) = o; } \
        } while (0)
        v4u zrb[2]; v2u zua[4], zub[4];
        { const int it0 = (w >> 1) & 3; const size_t orow = ((size_t)c * 128 + 32 * it0 + r32) * GM_W + 32 * (w & 1) + 4 * hi;
#pragma unroll
          for (int gq = 0; gq < 4; ++gq) zua[gq] = *(const v2u*)(ZU + orow + 8 * gq); }
#pragma unroll 1
        for (int gi = 0; gi < 12; gi += 2) {
            SP_GROUP(gi, zr, zua, zrb, zub);
            SP_GROUP(gi + 1, zrb, zub, zr, zua);
        }
#undef SP_GROUP
        __syncthreads();
    }
}

__device__ __forceinline__ void merge_phase(const Frame& F, const Args& A) {
    const bf16* OG = (const bf16*)(A.ws + WS_OG); const float* LSE = (const float*)(A.ws + WS_LSE); bf16* ATT = (bf16*)(A.ws + WS_AG);
    const int gw = F.vcu * 8 + F.wave, NGW = F.G * 8, lane = ((int)threadIdx.x & 63), h = lane >> 4;
    for (int t = gw; t < T; t += NGW) {
        const float l0 = LSE[(size_t)t * 4 + h], l1 = LSE[((size_t)T + t) * 4 + h], l2 = LSE[((size_t)2 * T + t) * 4 + h];
        const float m = fmaxf(l0, fmaxf(l1, l2)); float a0 = __expf(l0 - m), a1 = __expf(l1 - m), a2 = __expf(l2 - m); const float inv = 1.0f / (a0 + a1 + a2); a0 *= inv; a1 *= inv; a2 *= inv;
        const v2u w0 = *(const v2u*)(OG + (size_t)t * 256 + 4 * lane), w1 = *(const v2u*)(OG + ((size_t)T + t) * 256 + 4 * lane), w2 = *(const v2u*)(OG + ((size_t)2 * T + t) * 256 + 4 * lane);
        v2u o; o.x = pk2(a0 * bflo(w0.x) + a1 * bflo(w1.x) + a2 * bflo(w2.x), a0 * bfhi(w0.x) + a1 * bfhi(w1.x) + a2 * bfhi(w2.x));
        o.y = pk2(a0 * bflo(w0.y) + a1 * bflo(w1.y) + a2 * bflo(w2.y), a0 * bfhi(w0.y) + a1 * bfhi(w1.y) + a2 * bfhi(w2.y));
        *(v2u*)(ATT + (size_t)t * D + 4 * lane) = o;
    }
}

__device__ __forceinline__ void router_phase(const Frame& F, const Args& A) {
    LAS unsigned char* L = F.lds;
    LAS int* hist = (LAS int*)(F.lds + RING_BYTES + 2048);
    LAS int* basee = hist + 32;
    LAS int* rec_e = hist + 64;
    LAS int* rec_r = rec_e + 512;
    LAS float* rec_g = (LAS float*)(rec_r + 512);
    LAS float* rec_s = rec_g + 512;
    const float* brt = A.in[14]; const float* gmoe = A.in[12];
    const float* H = A.out; bf16* NX = (bf16*)(A.ws + WS_NX);
    const bf16* WRH = (const bf16*)(A.ws + WS_WRH);
    int* LIST = (int*)(A.ws + WS_LIST); float* SGATE = (float*)(A.ws + WS_SGATE); float* SRSTD = (float*)(A.ws + WS_SRSTD); int* POS = (int*)(A.ws + WS_POS);
    unsigned* CNT = (unsigned*)(A.ws + WS_CTL) + CW_CNT;
    const int lane = ((int)threadIdx.x & 63), w = F.wave, r32 = lane & 31, hi = lane >> 5;
    for (int c = F.vcu; c < T / 128; c += F.G) {
        for (int q = ((int)threadIdx.x); q < 8192; q += 512) { const int mtx = q >> 12, rem = q & 4095, e = rem >> 7, ck = rem & 127;
            const v4u v = *(const v4u*)(WRH + (size_t)mtx * 32768 + e * 1024 + ck * 8);
            *(LAS v4u*)(L + mtx * 65536 + e * 2048 + ((ck ^ (e & 15)) << 4)) = v; }
        if (((int)threadIdx.x) < 32) hist[((int)threadIdx.x)] = 0;
        __syncthreads();
        const int tt = w & 3, kh = w >> 2;
        const size_t row = (size_t)c * 128 + tt * 32 + r32;
        const float* hrow = H + row * D + kh * 512 + 8 * hi; const float* grow = gmoe + kh * 512 + 8 * hi; bf16* nrow = NX + row * D + kh * 512 + 8 * hi;
        const LAS unsigned char* wb = L + r32 * 2048;
        f32x16 acc = {}; float ss = 0.f;
#pragma unroll 4
        for (int s = 0; s < 32; ++s) {
            const f32x4 h0 = *(const f32x4*)(hrow + 16 * s), h1 = *(const f32x4*)(hrow + 16 * s + 4), g0 = *(const f32x4*)(grow + 16 * s), g1 = *(const f32x4*)(grow + 16 * s + 4);
            ss += (h0.x * h0.x + h0.y * h0.y) + (h0.z * h0.z + h0.w * h0.w) + (h1.x * h1.x + h1.y * h1.y) + (h1.z * h1.z + h1.w * h1.w);
            const f32x4 x0 = h0 * g0, x1 = h1 * g1;
            v4u xh; xh.x = cvt_pk_bf16(x0.x, x0.y); xh.y = cvt_pk_bf16(x0.z, x0.w); xh.z = cvt_pk_bf16(x1.x, x1.y); xh.w = cvt_pk_bf16(x1.z, x1.w);
            v4u xl; xl.x = cvt_pk_bf16(x0.x - bflo(xh.x), x0.y - bfhi(xh.x)); xl.y = cvt_pk_bf16(x0.z - bflo(xh.y), x0.w - bfhi(xh.y));
            xl.z = cvt_pk_bf16(x1.x - bflo(xh.z), x1.y - bfhi(xh.z)); xl.w = cvt_pk_bf16(x1.z - bflo(xh.w), x1.w - bfhi(xh.w));
            *(v4u*)(nrow + 16 * s) = xh;
            const int ck = kh * 64 + 2 * s + hi;
            const bf16x8 wh = *(const LAS bf16x8*)(wb + ((ck ^ (r32 & 15)) << 4)), wl = *(const LAS bf16x8*)(wb + 65536 + ((ck ^ (r32 & 15)) << 4));
            const bf16x8 ah = __builtin_bit_cast(bf16x8, xh), al = __builtin_bit_cast(bf16x8, xl);
            acc = __builtin_amdgcn_mfma_f32_32x32x16_bf16(ah, wh, acc, 0, 0, 0);
            acc = __builtin_amdgcn_mfma_f32_32x32x16_bf16(al, wh, acc, 0, 0, 0);
            acc = __builtin_amdgcn_mfma_f32_32x32x16_bf16(ah, wl, acc, 0, 0, 0);
        }
        __syncthreads();
        { LAS float* LGp = (LAS float*)L + kh * (128 * 33);
#pragma unroll
          for (int i = 0; i < 16; ++i) LGp[(tt * 32 + crow(i, hi)) * 33 + r32] = acc[i];
          ((LAS float*)(L + 36864))[(kh * 2 + hi) * 128 + tt * 32 + r32] = ss; }
        __syncthreads();
        if (((int)threadIdx.x) < 128) {
            const int t = ((int)threadIdx.x); const LAS float* SS = (const LAS float*)(L + 36864);
            const float rstd = 1.0f / sqrtf(((SS[t] + SS[128 + t]) + (SS[256 + t] + SS[384 + t])) * (1.f / D) + EPS);
            const LAS float* l0 = (const LAS float*)L + t * 33; const LAS float* l1 = l0 + 128 * 33;
            float lg[32];
#pragma unroll
            for (int e = 0; e < 32; ++e) lg[e] = (l0[e] + l1[e]) * rstd + brt[e];
            unsigned taken = 0u; float tv[4]; int ti[4];
#pragma unroll
            for (int k = 0; k < 4; ++k) { float bv = -INFINITY; int bi = 0;
#pragma unroll
                for (int e = 0; e < 32; ++e) { const float cv = ((taken >> e) & 1u) ? -INFINITY : lg[e]; if (cv > bv) { bv = cv; bi = e; } }
                tv[k] = bv; ti[k] = bi; taken |= 1u << bi; }
            const float e1 = __expf(tv[1] - tv[0]), e2 = __expf(tv[2] - tv[0]), e3 = __expf(tv[3] - tv[0]); const float inv = 1.0f / (1.0f + e1 + e2 + e3);
            const float gk[4] = {inv, e1 * inv, e2 * inv, e3 * inv};
            rec_s[t] = rstd;
#pragma unroll
            for (int k = 0; k < 4; ++k) { const int lr = atomicAdd((int*)&hist[ti[k]], 1); rec_e[t * 4 + k] = ti[k]; rec_r[t * 4 + k] = lr; rec_g[t * 4 + k] = gk[k]; }
        }
        __syncthreads();
        if (((int)threadIdx.x) < 32) basee[((int)threadIdx.x)] = (int)__hip_atomic_fetch_add(CNT + ((int)threadIdx.x), (unsigned)hist[((int)threadIdx.x)], __ATOMIC_RELAXED, __HIP_MEMORY_SCOPE_AGENT);
        __syncthreads();
        { const int lrow = ((int)threadIdx.x) >> 2, k = ((int)threadIdx.x) & 3; const int e = rec_e[((int)threadIdx.x)], slot = basee[e] + rec_r[((int)threadIdx.x)]; const int t = c * 128 + lrow;
          LIST[e * 32768 + slot] = t; SGATE[e * 32768 + slot] = rec_g[((int)threadIdx.x)]; SRSTD[e * 32768 + slot] = rec_s[lrow]; POS[t * 4 + k] = (e << 16) | slot; }
        __syncthreads();
    }
}

__device__ __forceinline__ void load_tile_starts(const Frame& F, const Args& A) {
    LAS int* ts = (LAS int*)(F.lds + TS_OFF);
    if (((int)threadIdx.x) == 0) { const unsigned* CNT = (const unsigned*)(A.ws + WS_CTL) + CW_CNT; int acc = 0;
        for (int e = 0; e < 32; ++e) { const int c = (int)__hip_atomic_load(CNT + e, __ATOMIC_RELAXED, __HIP_MEMORY_SCOPE_AGENT); ts[e] = acc; ts[40 + e] = c; acc += (c + 255) >> 8; }
        ts[32] = acc; for (int e = 33; e < 40; ++e) ts[e] = 0x7fffffff; }
    __syncthreads();
}

__device__ __forceinline__ void combine_phase(const Frame& F, const Args& A) {
    const LAS int* ts = (const LAS int*)(F.lds + TS_OFF);
    const bf16* Y = (const bf16*)(A.ws + WS_Y); const int* POS = (const int*)(A.ws + WS_POS); const float* H = A.out; bf16* NX = (bf16*)(A.ws + WS_NX); bf16* H2 = (bf16*)(A.ws + WS_H2);
    const float* gple = A.in[19];
    const int gw = F.vcu * 8 + F.wave, NGW = F.G * 8, lane = ((int)threadIdx.x & 63);
    for (int t = gw * 2; t < T; t += NGW * 2) {
        int pz[2][4];
#pragma unroll
        for (int r = 0; r < 2; ++r)
#pragma unroll
            for (int k = 0; k < 4; ++k) pz[r][k] = POS[(t + r) * 4 + k];
        f32x4 v[2][2][2];
#pragma unroll
        for (int r = 0; r < 2; ++r)
#pragma unroll
            for (int hf = 0; hf < 2; ++hf) { const float* hp = H + (size_t)(t + r) * D + hf * 512 + 8 * lane; v[r][hf][0] = *(const f32x4*)hp; v[r][hf][1] = *(const f32x4*)(hp + 4); }
        v4u yw[2][4][2];
#pragma unroll
        for (int r = 0; r < 2; ++r)
#pragma unroll
            for (int k = 0; k < 4; ++k) { const int e = pz[r][k] >> 16, slot = pz[r][k] & 0xffff; const bf16* yp = Y + ((size_t)ts[e] * 256 + slot) * D + 8 * lane;
                yw[r][k][0] = *(const v4u*)yp; yw[r][k][1] = *(const v4u*)(yp + 512); }
        float s[2];
#pragma unroll
        for (int r = 0; r < 2; ++r) { float a = 0.f;
#pragma unroll
            for (int hf = 0; hf < 2; ++hf) {
#pragma unroll
                for (int k = 0; k < 4; ++k) { const v4u w = yw[r][k][hf];
                    v[r][hf][0] = v[r][hf][0] + (f32x4){bflo(w.x), bfhi(w.x), bflo(w.y), bfhi(w.y)}; v[r][hf][1] = v[r][hf][1] + (f32x4){bflo(w.z), bfhi(w.z), bflo(w.w), bfhi(w.w)}; }
                st8(H2 + (size_t)(t + r) * D + hf * 512 + 8 * lane, v[r][hf][0], v[r][hf][1]);
#pragma unroll
                for (int p = 0; p < 2; ++p) a += (v[r][hf][p].x * v[r][hf][p].x + v[r][hf][p].y * v[r][hf][p].y) + (v[r][hf][p].z * v[r][hf][p].z + v[r][hf][p].w * v[r][hf][p].w); }
            s[r] = a; }
#pragma unroll
        for (int o = 1; o < 64; o <<= 1) { s[0] += __shfl_xor(s[0], o); s[1] += __shfl_xor(s[1], o); }
#pragma unroll
        for (int r = 0; r < 2; ++r) { const float rstd = 1.0f / sqrtf(s[r] * (1.f / D) + EPS);
#pragma unroll
            for (int hf = 0; hf < 2; ++hf) { const float* gp = gple + hf * 512 + 8 * lane; const f32x4 g0 = *(const f32x4*)gp, g1 = *(const f32x4*)(gp + 4);
                st8(NX + (size_t)(t + r) * D + hf * 512 + 8 * lane, v[r][hf][0] * rstd * g0, v[r][hf][1] * rstd * g1); } }
    }
}
__device__ __forceinline__ void final_phase(const Frame& F, const Args& A) {
    float* OUT = A.out; const float* gf = A.in[22]; const bf16* T1 = (const bf16*)(A.ws + WS_T1); const bf16* H2 = (const bf16*)(A.ws + WS_H2);
    const int gw = F.vcu * 8 + F.wave, NGW = F.G * 8, lane = ((int)threadIdx.x & 63);
    f32x4 g[2][2];
#pragma unroll
    for (int hf = 0; hf < 2; ++hf) { const float* gp = gf + hf * 512 + 8 * lane; g[hf][0] = *(const f32x4*)gp; g[hf][1] = *(const f32x4*)(gp + 4); }
    for (int t = gw * 2; t < T; t += NGW * 2) {
        v4u hw[2][2], tw[2][2];
#pragma unroll
        for (int r = 0; r < 2; ++r)
#pragma unroll
            for (int hf = 0; hf < 2; ++hf) { const size_t o = (size_t)(t + r) * D + hf * 512 + 8 * lane; hw[r][hf] = *(const v4u*)(H2 + o); tw[r][hf] = *(const v4u*)(T1 + o); }
        f32x4 v[2][2][2]; float s[2];
#pragma unroll
        for (int r = 0; r < 2; ++r) { float a = 0.f;
#pragma unroll
            for (int hf = 0; hf < 2; ++hf) { const v4u h = hw[r][hf], w = tw[r][hf];
                v[r][hf][0] = (f32x4){bflo(h.x) + bflo(w.x), bfhi(h.x) + bfhi(w.x), bflo(h.y) + bflo(w.y), bfhi(h.y) + bfhi(w.y)};
                v[r][hf][1] = (f32x4){bflo(h.z) + bflo(w.z), bfhi(h.z) + bfhi(w.z), bflo(h.w) + bflo(w.w), bfhi(h.w) + bfhi(w.w)};
#pragma unroll
                for (int p = 0; p < 2; ++p) a += (v[r][hf][p].x * v[r][hf][p].x + v[r][hf][p].y * v[r][hf][p].y) + (v[r][hf][p].z * v[r][hf][p].z + v[r][hf][p].w * v[r][hf][p].w); }
            s[r] = a; }
#pragma unroll
        for (int o = 1; o < 64; o <<= 1) { s[0] += __shfl_xor(s[0], o); s[1] += __shfl_xor(s[1], o); }
#pragma unroll
        for (int r = 0; r < 2; ++r) { const float rstd = 1.0f / sqrtf(s[r] * (1.f / D) + EPS);
#pragma unroll
            for (int hf = 0; hf < 2; ++hf) { float* op = OUT + (size_t)(t + r) * D + hf * 512 + 8 * lane; *(f32x4*)op = v[r][hf][0] * rstd * g[hf][0]; *(f32x4*)(op + 4) = v[r][hf][1] * rstd * g[hf][1]; } }
    }
}

constexpr int NPHASE = 13;
#ifndef ONLY_PH
#define ONLY_PH -1
#endif
#define PH_ON(k) (ONLY_PH < 0 || ONLY_PH == (k))
__global__ void __launch_bounds__(512, 2) fwd_kernel(Args args) {
    extern __shared__ __attribute__((aligned(16))) unsigned char lds[];
    Frame F;
    F.lds = (LAS unsigned char*)lds; F.wave = __builtin_amdgcn_readfirstlane((int)threadIdx.x >> 6);
    F.G = gridDim.x; { const int bx = blockIdx.x; F.vcu = (F.G % 8 == 0) ? (bx % 8) * (F.G / 8) + bx / 8 : bx; }
    unsigned char* ws = args.ws;
    volatile LAS unsigned* MISC = (volatile LAS unsigned*)(F.lds + MISC_OFF);
    for (int u = ((int)threadIdx.x); u < (LDS_BYTES - RING_BYTES) / 4; u += 512) ((LAS unsigned*)(F.lds + RING_BYTES))[u] = 0u;
    __syncthreads();
    XcdBarrier bar; bar.bar = (unsigned*)(ws + WS_CTL) + CW_BAR; bar.x = 0; bar.st = nullptr;
    const bool multi = (args.ph_hi - args.ph_lo) > 1;
    if (multi) bar = xcd_barrier_post((unsigned*)(ws + WS_CTL) + CW_BAR, MISC + 8);
    const int bx = (int)blockIdx.x;
    const int lo = args.ph_lo, hi = args.ph_hi;
#ifndef REP_MASK
#define REP_MASK 0
#endif
#define IN(k) (PH_ON(k) && lo <= (k) && (k) < hi)
#define REPS(k) (((REP_MASK >> (k)) & 1) ? 2 : 1)
#define SEAM(k) do { if (lo <= (k) && (k) + 1 < hi) xcd_barrier(bar); } while (0)
    if (IN(0)) for (int rep_ = 0; rep_ < REPS(0); ++rep_) { p0_prologue(F, args); } SEAM(0);
    if (IN(1)) { const int nu1 = (T / 256) * 23, R1 = (nu1 + F.G - 1) / F.G + 1, GG = (nu1 + R1 - 1) / R1;
                 if (bx < GG) { InProjSched S{(const char*)(ws + WS_NX), (const char*)(ws + WS_WIN), GG, bx, REPS(1) - 1};
                 EpiInProj E{(bf16*)(ws + WS_Q), (bf16*)(ws + WS_K), (bf16*)(ws + WS_ZU), (bf16*)(ws + WS_GA), (bf16*)(ws + WS_GG), (bf16*)(ws + WS_VT), (bf16*)(ws + WS_ZVT)};
                 pg8::gemm_phase(F.lds, D, S, E); }
                 convert_queue(F, args, (unsigned*)(ws + WS_CTL) + CW_Q1, 0, BG_P1); convert_queue(F, args, (unsigned*)(ws + WS_CTL) + CW_Q3, BG_N, BG_ALL); convert_p_queue(F, args, (unsigned*)(ws + WS_CTL) + CW_Q4); } SEAM(1);
    if (IN(2)) { attn_phase(F, args); spatial_phase(F, args); } SEAM(2);
    if (IN(3)) { merge_phase(F, args); } SEAM(3);
    if (IN(4)) { PlainSched S{(const char*)(ws + WS_AG), (const char*)(ws + WS_WCAT), T / 256, 4, D, F.G, bx, REPS(4) - 1}; EpiMerge E{(bf16*)(ws + WS_MRG), (const bf16*)(ws + WS_GA), (const bf16*)(ws + WS_GG)};
                 pg8::gemm_phase(F.lds, D, S, E); } SEAM(5);
    if (IN(6)) { PlainSched S{(const char*)(ws + WS_MRG), (const char*)(ws + WS_WOUT), T / 256, 4, D, F.G, bx, REPS(6) - 1}; EpiF32<0> E{args.out, args.in[0], nullptr};
                 pg8::gemm_phase(F.lds, D, S, E); } SEAM(6);
    if (IN(7)) for (int rep_ = 0; rep_ < REPS(7); ++rep_) { router_phase(F, args); } SEAM(7);
    if (IN(8)) { load_tile_starts(F, args); const LAS int* ts = (const LAS int*)(F.lds + TS_OFF);
                 const int nu8 = ts[32] * 8, R8 = (nu8 + F.G - 1) / F.G, GG = R8 > 0 ? (nu8 + R8 - 1) / R8 : 1;
                 if (bx < GG) { MoeSched S{(const char*)(ws + WS_NX), (const char*)(ws + WS_WGU), (const int*)(ws + WS_LIST), ts, 8, D, GG, bx, 1, REPS(8) - 1}; EpiMoeUp E{(bf16*)(ws + WS_ACT), args.in[16], (const float*)(ws + WS_SRSTD), ts};
                 pg8::gemm_phase(F.lds, D, S, E); }
                 convert_queue(F, args, (unsigned*)(ws + WS_CTL) + CW_Q2, BG_GU, BG_N); } SEAM(8);
    if (IN(9)) { load_tile_starts(F, args); const LAS int* ts = (const LAS int*)(F.lds + TS_OFF);
                 const int nu9 = ts[32] * 4, R9 = (nu9 + F.G - 1) / F.G, GG = R9 > 0 ? (nu9 + R9 - 1) / R9 : 1, NH = F.G - GG;
                 if (bx < GG) { MoeSched S{(const char*)(ws + WS_ACT), (const char*)(ws + WS_WD), (const int*)(ws + WS_LIST), ts, 4, D, GG, bx, 0, REPS(9) - 1}; EpiMoeDown E{(bf16*)(ws + WS_Y), args.in[18], (const float*)(ws + WS_SGATE), ts};
                 pg8::gemm_phase(F.lds, D, S, E); }
                 if (NH >= 8 ? bx >= GG : true) { PlainSched S{(const char*)(ws + WS_PB), (const char*)(ws + WS_WPP), T / 256, 4, PLE, NH >= 8 ? NH : F.G, NH >= 8 ? bx - GG : bx, 0}; EpiBf<0> E{(bf16*)(ws + WS_PP), nullptr, nullptr};
                 pg8::gemm_phase(F.lds, PLE, S, E); } } SEAM(9);
    if (IN(10)) for (int rep_ = 0; rep_ < REPS(10); ++rep_) { load_tile_starts(F, args); combine_phase(F, args); } SEAM(10);
    if (IN(11)) { PlainSched S{(const char*)(ws + WS_NX), (const char*)(ws + WS_WPG), T / 256, 4, D, F.G, bx, REPS(11) - 1}; EpiPle E{(bf16*)(ws + WS_T1), (const bf16*)(ws + WS_PP)};
                  pg8::gemm_phase(F.lds, D, S, E); } SEAM(11);
    if (IN(12)) for (int rep_ = 0; rep_ < REPS(12); ++rep_) { final_phase(F, args); }
#undef IN
#undef SEAM
}

extern "C" void kernel_launch(void* const* d_in, const int* in_sizes, int n_in, void* d_out, int out_size, void* d_ws, size_t ws_size, hipStream_t stream) {
    static int grid = 0;
    if (grid == 0) {
        if (n_in != 23 || out_size != T * D || ws_size < WS_END) { fprintf(stderr, "kernel_launch: unexpected shapes (n_in %d out %d ws %zu)\n", n_in, out_size, ws_size); grid = -1; return; }
        int dev = 0, cus = 0, per_cu = 0;
        if (hipGetDevice(&dev) != hipSuccess || hipDeviceGetAttribute(&cus, hipDeviceAttributeMultiprocessorCount, dev) != hipSuccess) { grid = -1; return; }
        if (hipFuncSetAttribute((const void*)fwd_kernel, hipFuncAttributeMaxDynamicSharedMemorySize, LDS_BYTES) != hipSuccess) { fprintf(stderr, "kernel_launch: hipFuncSetAttribute failed\n"); grid = -1; return; }
        if (hipOccupancyMaxActiveBlocksPerMultiprocessor(&per_cu, (const void*)fwd_kernel, 512, LDS_BYTES) != hipSuccess || per_cu < 1) { fprintf(stderr, "kernel_launch: occupancy query says %d\n", per_cu); (void)hipGetLastError(); grid = -1; return; }
        grid = cus;
    }
    if (grid < 0) return;
    (void)hipMemsetAsync((char*)d_ws + WS_CTL, 0, CTL_ZERO_BYTES, stream);
    Args a{};
    for (int i = 0; i < 23; ++i) a.in[i] = (const float*)d_in[i];
    a.out = (float*)d_out; a.ws = (unsigned char*)d_ws;
#if MK_N_LAUNCHES == 1
    a.ph_lo = 0; a.ph_hi = NPHASE;
    hipLaunchKernelGGL(fwd_kernel, dim3(grid), dim3(512), LDS_BYTES, stream, a);
#else
    for (int ph = 0; ph < NPHASE; ++ph) { a.ph_lo = ph; a.ph_hi = ph + 1; hipLaunchKernelGGL(fwd_kernel, dim3(grid), dim3(512), LDS_BYTES, stream, a); }
#endif
}
```

```cpp
#include <hip/hip_runtime.h>
#include <cstdio>
#include <cstdint>

#ifndef MK_N_LAUNCHES
#define MK_N_LAUNCHES 1
#endif

constexpr int NB = 8, SEQ = 4096, T = NB * SEQ, D = 1024;
constexpr int ATT_W = 768, GM_W = 768, IN_W = 5888, NE = 32, TOPK = 4, PLE = 256;
constexpr float EPS = 1e-6f;
constexpr float LOG2E = 1.4426950408889634f, LN2 = 0.6931471805599453f;
constexpr float QSCALE = 0.125f * LOG2E;

#define LAS __attribute__((address_space(3)))
#define GAS __attribute__((address_space(1)))
typedef unsigned short bf16;
typedef unsigned v4u __attribute__((ext_vector_type(4)));
typedef unsigned v2u __attribute__((ext_vector_type(2)));
typedef float f32x4 __attribute__((ext_vector_type(4)));
typedef float f32x2 __attribute__((ext_vector_type(2)));
typedef float f32x16 __attribute__((ext_vector_type(16)));
typedef short bf16x8 __attribute__((ext_vector_type(8)));
typedef short s16x4 __attribute__((ext_vector_type(4)));

__device__ __forceinline__ unsigned f2bf(float f) { unsigned u = __builtin_bit_cast(unsigned, f); return (u + 0x7fffu + ((u >> 16) & 1u)) >> 16; }
__device__ __forceinline__ unsigned pk2(float lo, float hi) { return f2bf(lo) | (f2bf(hi) << 16); }
__device__ __forceinline__ float bflo(unsigned w) { return __builtin_bit_cast(float, w << 16); }
__device__ __forceinline__ float bfhi(unsigned w) { return __builtin_bit_cast(float, w & 0xffff0000u); }
typedef __bf16 bf16x2_t __attribute__((ext_vector_type(2)));
__device__ __forceinline__ unsigned cvt_pk_bf16(float lo, float hi) { const f32x2 v = {lo, hi}; const bf16x2_t b = __builtin_convertvector(v, bf16x2_t); return __builtin_bit_cast(unsigned, b); }
__device__ __forceinline__ float sigmoidf_(float x) { return __builtin_amdgcn_rcpf(1.0f + __builtin_amdgcn_exp2f(-x * LOG2E)); }
__device__ __forceinline__ f32x2 gelu_pk(f32x2 v) {
    const f32x2 av = __builtin_elementwise_abs(v), d = av * 0.2316418882f + 1.0f;
    f32x2 t; t.x = __builtin_amdgcn_rcpf(d.x); t.y = __builtin_amdgcn_rcpf(d.y);
    f32x2 q = t * 0.5307027145f + (-0.7265760135f); q = q * t + 0.7107068705f; q = q * t + (-0.142248368f); q = q * t + 0.127414796f; q = q * t;
    const f32x2 s = (v * v) * (-0.72134752044f);
    f32x2 e; e.x = __builtin_amdgcn_exp2f(s.x); e.y = __builtin_amdgcn_exp2f(s.y);
    const f32x2 m = v * (q * e), r = v - m;
    f32x2 o; o.x = v.x < 0.f ? m.x : r.x; o.y = v.y < 0.f ? m.y : r.y; return o;
}
__device__ __forceinline__ f32x4 gelu4(f32x4 v) { f32x2 a = gelu_pk((f32x2){v[0], v[1]}), b = gelu_pk((f32x2){v[2], v[3]}); return (f32x4){a.x, a.y, b.x, b.y}; }
__device__ __forceinline__ f32x4 sigm4(f32x4 v) { return (f32x4){sigmoidf_(v[0]), sigmoidf_(v[1]), sigmoidf_(v[2]), sigmoidf_(v[3])}; }
__device__ __forceinline__ int tid_opaque(int wave) {
    int l; asm volatile("v_mbcnt_lo_u32_b32 %0, -1, 0\n\tv_mbcnt_hi_u32_b32 %0, -1, %0" : "=v"(l));
    return wave * 64 + l;
}
__device__ __forceinline__ float wave_sum(float v) {
#pragma unroll
    for (int o = 1; o < 64; o <<= 1) v += __shfl_xor(v, o);
    return v;
}

constexpr size_t MiB = 1u << 20;
constexpr size_t WS_CTL = 0, CTL_ZERO_BYTES = 1 * MiB;
constexpr size_t WS_WIN = 2 * MiB;
constexpr size_t WS_WCAT = 14 * MiB;
constexpr size_t WS_WOUT = 17 * MiB;
constexpr size_t WS_WPG = 19 * MiB;
constexpr size_t WS_WPP = 21 * MiB;
constexpr size_t WS_WSP = 22 * MiB;
constexpr size_t WS_WRH = 23 * MiB;
constexpr size_t WS_WRL = 23 * MiB + 65536;
constexpr size_t WS_SRSTD = 980 * MiB;
constexpr size_t WS_WGU = 24 * MiB;
constexpr size_t WS_WD = 152 * MiB;
constexpr size_t WS_NX = 216 * MiB;
constexpr size_t WS_PB = 280 * MiB;
constexpr size_t WS_PP = 296 * MiB;
constexpr size_t WS_LIST = 360 * MiB;
constexpr size_t WS_SGATE = 364 * MiB;
constexpr size_t WS_POS = 368 * MiB;
constexpr size_t WS_LSE = 369 * MiB;
constexpr size_t WS_Q = 372 * MiB;
constexpr size_t WS_K = 420 * MiB;
constexpr size_t WS_VT = 468 * MiB;
constexpr size_t WS_ZU = 516 * MiB;
constexpr size_t WS_ZVT = 564 * MiB;
constexpr size_t WS_GA = 612 * MiB;
constexpr size_t WS_GG = 676 * MiB;
constexpr size_t WS_OG = 740 * MiB;
constexpr size_t WS_ATT = 788 * MiB;
constexpr size_t WS_G = 804 * MiB;
constexpr size_t WS_AG = 852 * MiB;
constexpr size_t WS_MRG = 916 * MiB;
constexpr size_t WS_ACT = 372 * MiB;
constexpr size_t WS_Y = 644 * MiB;
constexpr size_t WS_H2 = 436 * MiB;
constexpr size_t WS_T1 = 372 * MiB;
constexpr size_t WS_END = 984 * MiB;
constexpr int PMAX_TILES = 544;

constexpr int CW_CNT = 64;
constexpr int CW_Q1 = 256, CW_Q2 = 320, CW_Q3 = 384, CW_Q4 = 448;
constexpr int CW_BAR = 4096;

constexpr int RING_BYTES = 131072;
constexpr int MISC_OFF = RING_BYTES + 320;
constexpr int TS_OFF = RING_BYTES + 1024;
constexpr int LDS_BYTES = 147456;

namespace pg8 {
typedef unsigned short bf16_t;
constexpr int BM = 256, BK = 64, HALF = 128, HTB = HALF * BK * 2, STAGE_BYTES = 8 * HTB, NXCD = 8, WGM = 8;
__host__ __device__ __forceinline__ int lds_byte(int r, int c) { const int st = (r >> 4) * 2 + (c >> 5), rr = r & 15, cc = c & 31, ob = rr * 64 + cc * 2; return st * 1024 + (ob ^ (((ob >> 9) & 1) << 5)); }
__host__ __device__ __forceinline__ void stage_rc(int b, int& R, int& C) { const int st = b / 1024, sb = b % 1024, swz = sb ^ (((sb >> 9) & 1) << 5); R = (st >> 1) * 16 + swz / 64; C = (st & 1) * 32 + (swz % 64) / 2; }
__host__ __device__ __forceinline__ int perm32(int rho) { const int n = rho >> 4, i = rho & 15; return 8 * (i >> 2) + 4 * n + (i & 3); }

struct Unit { const char* a; const char* b; int pm, pn, x0, x1; };

__device__ __forceinline__ bool static_order(int i, int G, int c, int nM, int nN, int& pm, int& pn) {
    const int nwg = nM * nN; const long L = (long)i * G + c; if (L >= nwg) return false;
    int wgid = (int)L; { const int q = nwg / NXCD, r = nwg % NXCD, xcd = wgid % NXCD, off = wgid / NXCD; wgid = (xcd < r ? xcd * (q + 1) : r * (q + 1) + (xcd - r) * q) + off; }
    const int nig = WGM * nN, gid = wgid / nig, fm = gid * WGM, gsz = (nM - fm) < WGM ? (nM - fm) : WGM;
    pm = fm + ((wgid % nig) % gsz); pn = (wgid % nig) / gsz; return true;
}

template <class Epi, class Sched>
__device__ __forceinline__ void gemm_phase(LAS unsigned char* lds, const int K, const Sched& S, const Epi& E, const int wave) {
    const int wid = wave, tid = tid_opaque(wid), lane = tid & 63, wr = wid >> 2, wc = wid & 3, fr = lane & 15, fq = lane >> 4;
    const int nt = K / BK;
    int RA[2]; unsigned CB2[2], rbk[2];
#pragma unroll
    for (int i = 0; i < 2; ++i) { int R, C; stage_rc(tid * 16 + i * 8192, R, C); const int Rb = Epi::PERM ? ((R & ~31) + perm32(R & 31)) : R;
        RA[i] = R; CB2[i] = (unsigned)C * 2u; rbk[i] = (unsigned)(Rb * K) * 2u; }
    const size_t kstep = (size_t)(BK * 2);
    const size_t hstep = (size_t)HALF * K * 2;
    const unsigned ldsw = (unsigned)wid * 1024u;
    const int aoff = lds_byte(wr * 64 + fr, fq * 8), boff = lds_byte(wc * 32 + fr, fq * 8);
#define PG8_SA(b, h) (((b) * 2 + (h)) * HTB)
#define PG8_SB(b, h) ((4 + (b) * 2 + (h)) * HTB)
#define PG8_STAGE(bufoff, gbase, voff) do { _Pragma("unroll") for (int _i = 0; _i < 2; ++_i) \
        __builtin_amdgcn_global_load_lds((const unsigned*)((const char*)(gbase) + (voff)[_i]), (LAS unsigned*)(lds + (bufoff) + ldsw + _i * 8192), 16, 0, 0); } while (0)
#define PG8_LDA(dst, b, h) do { _Pragma("unroll") for (int m = 0; m < 4; ++m) _Pragma("unroll") for (int k = 0; k < 2; ++k) dst[m][k] = *(const LAS bf16x8*)(lds + PG8_SA(b, h) + aoff + m * 2048 + k * 1024); } while (0)
#define PG8_LDB(dst, b, h) do { _Pragma("unroll") for (int n = 0; n < 2; ++n) _Pragma("unroll") for (int k = 0; k < 2; ++k) dst[n][k] = *(const LAS bf16x8*)(lds + PG8_SB(b, h) + boff + n * 2048 + k * 1024); } while (0)
#define PG8_MMA(ai, bj, At, Bt) do { __builtin_amdgcn_s_setprio(1); _Pragma("unroll") for (int m = 0; m < 4; ++m) _Pragma("unroll") for (int n = 0; n < 2; ++n) _Pragma("unroll") for (int k = 0; k < 2; ++k) \
        acc[ai][bj][m][n] = __builtin_amdgcn_mfma_f32_16x16x32_bf16(Bt[n][k], At[m][k], acc[ai][bj][m][n], 0, 0, 0); __builtin_amdgcn_s_setprio(0); } while (0)
#define PG8_WAIT_V(n) asm volatile("s_waitcnt vmcnt(" #n ")" ::: "memory")
#define PG8_WAIT_L(n) asm volatile("s_waitcnt lgkmcnt(" #n ")" ::: "memory")
#define PG8_BAR __builtin_amdgcn_s_barrier()
#define PG8_SCHED __builtin_amdgcn_sched_barrier(0)
    Unit cur, nxt; int ui = 0;
    if (!S.next(0, cur)) return;
    f32x4 acc[2][2][4][2];
#pragma unroll
    for (int a = 0; a < 2; ++a)
#pragma unroll
        for (int b = 0; b < 2; ++b)
#pragma unroll
            for (int m = 0; m < 4; ++m)
#pragma unroll
                for (int n = 0; n < 2; ++n) acc[a][b][m][n] = (f32x4){0.f, 0.f, 0.f, 0.f};
    bf16x8 At[4][2], B0[2][2], B1[2][2];
    const char* cA = cur.a; const char* cB = cur.b;
    unsigned oA[2][2], nO[2][2];
#pragma unroll
    for (int h = 0; h < 2; ++h)
#pragma unroll
        for (int i = 0; i < 2; ++i) oA[h][i] = S.a_off(cur, h * HALF + RA[i], K) + CB2[i];
    int csh = S.b_shift(cur); unsigned vbc[2] = {(rbk[0] << csh) + CB2[0], (rbk[1] << csh) + CB2[1]}, vbn[2];
    PG8_STAGE(PG8_SB(0, 0), cB, vbc); PG8_STAGE(PG8_SB(0, 1), cB + (hstep << csh), vbc); PG8_STAGE(PG8_SA(0, 0), cA, oA[0]); PG8_STAGE(PG8_SA(0, 1), cA, oA[1]);
    if (wr == 1) PG8_BAR;
    PG8_WAIT_V(2); PG8_BAR;
    PG8_STAGE(PG8_SB(1, 0), cB + kstep, vbc); PG8_STAGE(PG8_SA(1, 0), cA + kstep, oA[0]); PG8_STAGE(PG8_SB(1, 1), cB + (hstep << csh) + kstep, vbc);
    PG8_WAIT_V(6); PG8_BAR;
    for (;;) {
        const bool has_next = S.next(ui + 1, nxt);
        const char* nA = has_next ? nxt.a : cA; const char* nB = has_next ? nxt.b : cB;
        const int nsh = has_next ? S.b_shift(nxt) : csh; vbn[0] = (rbk[0] << nsh) + CB2[0]; vbn[1] = (rbk[1] << nsh) + CB2[1];
#pragma unroll
        for (int h = 0; h < 2; ++h)
#pragma unroll
            for (int i = 0; i < 2; ++i) nO[h][i] = has_next ? (S.a_off(nxt, h * HALF + RA[i], K) + CB2[i]) : oA[h][i];
#pragma unroll 1
        for (int t = 0; t < nt; t += 2) {
            const bool last = (t == nt - 2);
            const char* a1 = cA + (size_t)(t + 1) * kstep;
            const char* a2 = last ? nA : cA + (size_t)(t + 2) * kstep; const char* b2 = last ? nB : cB + (size_t)(t + 2) * kstep;
            const char* a3 = a2 + kstep; const char* b3 = b2 + kstep;
            unsigned o2[2][2]; const unsigned vb2[2] = {last ? vbn[0] : vbc[0], last ? vbn[1] : vbc[1]}; const size_t hs2 = hstep << (last ? nsh : csh);
#pragma unroll
            for (int h = 0; h < 2; ++h)
#pragma unroll
                for (int i = 0; i < 2; ++i) o2[h][i] = last ? nO[h][i] : oA[h][i];
            PG8_LDB(B0, 0, 0); PG8_LDB(B1, 0, 1); PG8_SCHED; PG8_LDA(At, 0, 0); PG8_STAGE(PG8_SA(1, 1), a1, oA[1]);
            PG8_WAIT_V(8); PG8_WAIT_L(0); PG8_BAR; PG8_MMA(0, 0, At, B0); PG8_MMA(0, 1, At, B1); PG8_BAR; PG8_SCHED;
            PG8_LDA(At, 0, 1); PG8_STAGE(PG8_SB(0, 0), b2, vb2); PG8_STAGE(PG8_SB(0, 1), b2 + hs2, vb2); PG8_STAGE(PG8_SA(0, 0), a2, o2[0]);
            PG8_WAIT_V(8); PG8_WAIT_L(0); PG8_BAR; PG8_MMA(1, 0, At, B0); PG8_MMA(1, 1, At, B1); PG8_BAR; PG8_SCHED;
            PG8_LDB(B0, 1, 0); PG8_LDB(B1, 1, 1); PG8_SCHED; PG8_LDA(At, 1, 0); PG8_STAGE(PG8_SA(0, 1), a2, o2[1]);
            PG8_WAIT_V(8); PG8_WAIT_L(0); PG8_BAR; PG8_MMA(0, 0, At, B0); PG8_MMA(0, 1, At, B1); PG8_BAR; PG8_SCHED;
            PG8_LDA(At, 1, 1); PG8_STAGE(PG8_SB(1, 0), b3, vb2); PG8_STAGE(PG8_SB(1, 1), b3 + hs2, vb2); PG8_STAGE(PG8_SA(1, 0), a3, o2[0]);
            PG8_WAIT_V(8); PG8_WAIT_L(0); PG8_BAR; PG8_MMA(1, 0, At, B0); PG8_MMA(1, 1, At, B1); PG8_BAR; PG8_SCHED;
            if constexpr (Epi::HOOK_T >= 0) { if (t == Epi::HOOK_T) { E.mid(acc, cur, wr, wc, fr, fq); PG8_SCHED; } }
        }
        if (wr == 0) PG8_BAR;
        E(acc, cur, wr, wc, fr, fq);
        if (!has_next) break;
#pragma unroll
        for (int a = 0; a < 2; ++a)
#pragma unroll
            for (int b = 0; b < 2; ++b)
#pragma unroll
                for (int m = 0; m < 4; ++m)
#pragma unroll
                    for (int n = 0; n < 2; ++n) acc[a][b][m][n] = (f32x4){0.f, 0.f, 0.f, 0.f};
        cur = nxt; cA = nA; cB = nB; ++ui; csh = nsh; vbc[0] = vbn[0]; vbc[1] = vbn[1];
#pragma unroll
        for (int h = 0; h < 2; ++h)
#pragma unroll
            for (int i = 0; i < 2; ++i) oA[h][i] = nO[h][i];
        if (wr == 1) PG8_BAR;
    }
    PG8_WAIT_V(0);
    PG8_BAR;
#undef PG8_SA
#undef PG8_SB
#undef PG8_STAGE
#undef PG8_LDA
#undef PG8_LDB
#undef PG8_MMA
#undef PG8_WAIT_V
#undef PG8_WAIT_L
#undef PG8_BAR
#undef PG8_SCHED
}
}
using pg8::Unit;
typedef f32x4 Acc[2][2][4][2];

struct PlainSched {
    const char* A; const char* Bt; int nM, nN, K, G, c, rsh;
    __device__ __forceinline__ bool next(int i, Unit& u) const {
        int pm, pn; if (!pg8::static_order(i >> rsh, G, c, nM, nN, pm, pn)) return false;
        u.pm = pm; u.pn = pn; u.x0 = 0; u.x1 = 0; u.a = A + (size_t)pm * 256 * K * 2; u.b = Bt + (size_t)pn * 256 * K * 2; return true;
    }
    __device__ __forceinline__ unsigned a_off(const Unit&, int row, int K_) const { return (unsigned)(row * K_) * 2u; }
    __device__ __forceinline__ int b_shift(const Unit&) const { return 0; }
};
struct InProjSched {
    const char* NX; const char* Wt; int G, c, rsh;
    __device__ __forceinline__ bool next(int i, Unit& u) const {
        int pm, pn; if (!pg8::static_order(i >> rsh, G, c, T / 256, 23, pm, pn)) return false;
        u.pm = pm; u.pn = pn; u.x0 = 0; u.x1 = 0;
        const char* xa = NX + (size_t)pm * 256 * D * 2; const char* wb = Wt + (size_t)pn * 256 * D * 2;
        if (pn < 17) { u.a = xa; u.b = wb; } else { u.a = wb; u.b = xa;
            if (pn < 20) { const int sh = 2 * (pn - 17), j0 = (pm & 15) * 256, r = j0 >> (12 - sh), i0 = j0 & ((SEQ >> sh) - 1);
                u.x0 = sh; u.b = NX + ((size_t)(pm >> 4) * SEQ + ((size_t)i0 << sh) + r) * D * 2; } }
        return true;
    }
    __device__ __forceinline__ unsigned a_off(const Unit&, int row, int K_) const { return (unsigned)(row * K_) * 2u; }
    __device__ __forceinline__ int b_shift(const Unit& u) const { return u.x0; }
};
struct MoeSched {
    const char* A; const char* Bt; const int* list; const LAS int* ts; int nN, K, G, c, gather, rsh;
    __device__ __forceinline__ bool next(int i, Unit& u) const {
        const int MT = ts[32];
        int pm, pn; if (!pg8::static_order(i >> rsh, G, c, MT, nN, pm, pn)) return false;
        int e = 0;
#pragma unroll
        for (int s = 16; s >= 1; s >>= 1) { if (ts[e + s] <= pm) e += s; }
        e = __builtin_amdgcn_readfirstlane(e);
        u.pm = pm; u.pn = pn; u.x0 = e; u.x1 = __builtin_amdgcn_readfirstlane(pm - ts[e]);
        u.a = gather ? A : A + (size_t)pm * 256 * K * 2;
        u.b = Bt + ((size_t)e * nN + pn) * 256 * K * 2;
        return true;
    }
    __device__ __forceinline__ unsigned a_off(const Unit& u, int row, int K_) const {
        if (!gather) return (unsigned)(row * K_) * 2u;
        const int slot = u.x1 * 256 + row, cnt = ts[40 + u.x0];
        const int tok = slot < cnt ? list[u.x0 * 32768 + slot] : 0;
        return (unsigned)(tok * K_) * 2u;
    }
    __device__ __forceinline__ int b_shift(const Unit&) const { return 0; }
};

__device__ __forceinline__ void st8(bf16* p, f32x4 v0, f32x4 v1) { v4u w; w.x = cvt_pk_bf16(v0[0], v0[1]); w.y = cvt_pk_bf16(v0[2], v0[3]); w.z = cvt_pk_bf16(v1[0], v1[1]); w.w = cvt_pk_bf16(v1[2], v1[3]); *(v4u*)p = w; }
__device__ __forceinline__ void ld8(const bf16* p, f32x4& v0, f32x4& v1) { const v4u w = *(const v4u*)p; v0 = (f32x4){bflo(w.x), bfhi(w.x), bflo(w.y), bfhi(w.y)}; v1 = (f32x4){bflo(w.z), bfhi(w.z), bflo(w.w), bfhi(w.w)}; }

struct EpiInProj {
    static constexpr bool PERM = true; static constexpr int HOOK_T = -1;
    bf16 *Q, *Kb, *ZU, *GA, *GG, *VT, *ZVT;
    template <int ACT> __device__ __forceinline__ void std_store(const Acc& acc, bf16* base, int ldc, int colt, int pm, int wr, int wc, int fr, int fq) const {
        const int row0 = pm * 256 + wr * 64 + fr, col0 = colt + wc * 32 + 8 * fq;
#pragma unroll
        for (int ai = 0; ai < 2; ++ai)
#pragma unroll
            for (int m = 0; m < 4; ++m) { bf16* rowp = base + (size_t)(row0 + ai * 128 + m * 16) * ldc + col0;
#pragma unroll
                for (int bj = 0; bj < 2; ++bj) { f32x4 v0 = acc[ai][bj][m][0], v1 = acc[ai][bj][m][1];
                    if (ACT == 1) { v0 = v0 * QSCALE; v1 = v1 * QSCALE; }
                    if (ACT == 2) { v0 = gelu4(v0); v1 = gelu4(v1); }
                    if (ACT == 3) { v0 = sigm4(v0); v1 = sigm4(v1); }
                    st8(rowp + bj * 128, v0, v1); } }
    }
    template <int ACT> __device__ __forceinline__ void tile_store(const Acc& acc, bf16* base, int g, int pm, int wr, int wc, int fr, int fq) const {
        const int dsh = 2 * g, row0 = pm * 256 + wr * 64 + fr;
#pragma unroll
        for (int ai = 0; ai < 2; ++ai)
#pragma unroll
            for (int m = 0; m < 4; ++m) { const int t = row0 + ai * 128 + m * 16, bb = t >> 12, sq = t & (SEQ - 1), r = sq & ((1 << dsh) - 1), i = sq >> dsh, kb = i >> 5, key = i & 31;
#pragma unroll
                for (int bj = 0; bj < 2; ++bj) { const int cw = bj * 128 + wc * 32 + 8 * fq, hh = cw >> 6, dd = cw & 63;
                    f32x4 v0 = acc[ai][bj][m][0], v1 = acc[ai][bj][m][1];
                    if (ACT == 1) { v0 = v0 * QSCALE; v1 = v1 * QSCALE; }
                    st8(base + ((size_t)((bb * 3 + g) * 4 + hh) * 128 + (size_t)((r << (7 - dsh)) + kb)) * 2048 + key * 64 + dd, v0, v1); } }
    }
    __device__ __forceinline__ void operator()(const Acc& acc, const Unit& u, int wr, int wc, int fr, int fq) const {
        const int pn = u.pn, pm = u.pm;
        if (pn < 3) tile_store<1>(acc, Q, pn, pm, wr, wc, fr, fq);
        else if (pn < 6) tile_store<0>(acc, Kb, pn - 3, pm, wr, wc, fr, fq);
        else if (pn < 9) std_store<2>(acc, ZU, GM_W, (pn - 6) * 256, pm, wr, wc, fr, fq);
        else if (pn < 13) std_store<3>(acc, GA, D, (pn - 9) * 256, pm, wr, wc, fr, fq);
        else if (pn < 17) std_store<3>(acc, GG, D, (pn - 13) * 256, pm, wr, wc, fr, fq);
        else if (pn < 20) {
            const int g = pn - 17, sh = 2 * g, bb = pm >> 4, j0 = (pm & 15) * 256, r = j0 >> (12 - sh), i0 = j0 & ((SEQ >> sh) - 1), nKB = 128 >> sh;
#pragma unroll
            for (int ai = 0; ai < 2; ++ai)
#pragma unroll
                for (int m = 0; m < 4; ++m) { const int chl = ai * 128 + wr * 64 + m * 16 + fr, hh = chl >> 6, dd = chl & 63;
                    bf16* hb = VT + (size_t)((bb * 3 + g) * 4 + hh) * (128 * 64 * 32) + dd * 32;
#pragma unroll
                    for (int bj = 0; bj < 2; ++bj) { const int i = i0 + bj * 128 + wc * 32 + 8 * fq;
                        st8(hb + (size_t)(r * nKB + (i >> 5)) * 2048 + (i & 31), acc[ai][bj][m][0], acc[ai][bj][m][1]); } }
        } else {
            const int ch0 = (pn - 20) * 256 + wr * 64 + fr, tin = wc * 32 + 8 * fq;
#pragma unroll
            for (int ai = 0; ai < 2; ++ai)
#pragma unroll
                for (int m = 0; m < 4; ++m) { const int ch = ch0 + ai * 128 + m * 16;
#pragma unroll
                    for (int bj = 0; bj < 2; ++bj) st8(ZVT + ((size_t)(2 * pm + bj) * GM_W + ch) * 128 + tin, gelu4(acc[ai][bj][m][0]), gelu4(acc[ai][bj][m][1])); }
        }
    }
};
template <int MODE> struct EpiBf {
    static constexpr bool PERM = true; static constexpr int HOOK_T = -1;
    bf16* O; const bf16* G1; const bf16* Y0;
    __device__ __forceinline__ void operator()(const Acc& acc, const Unit& u, int wr, int wc, int fr, int fq) const {
        const int row0 = u.pm * 256 + wr * 64 + fr, col0 = u.pn * 256 + wc * 32 + 8 * fq;
#pragma unroll
        for (int ai = 0; ai < 2; ++ai) {
            v4u gw[4][2], yw[4][2];
            if (MODE >= 1) {
#pragma unroll
                for (int m = 0; m < 4; ++m)
#pragma unroll
                    for (int bj = 0; bj < 2; ++bj) { const size_t off = (size_t)(row0 + ai * 128 + m * 16) * D + col0 + bj * 128; gw[m][bj] = *(const v4u*)(G1 + off); if (MODE == 2) yw[m][bj] = *(const v4u*)(Y0 + off); }
                __builtin_amdgcn_sched_barrier(0);
            }
#pragma unroll
            for (int m = 0; m < 4; ++m)
#pragma unroll
                for (int bj = 0; bj < 2; ++bj) { const size_t off = (size_t)(row0 + ai * 128 + m * 16) * D + col0 + bj * 128; f32x4 v0 = acc[ai][bj][m][0], v1 = acc[ai][bj][m][1];
                    if (MODE >= 1) { const v4u w = gw[m][bj]; v0 = v0 * (f32x4){bflo(w.x), bfhi(w.x), bflo(w.y), bfhi(w.y)}; v1 = v1 * (f32x4){bflo(w.z), bfhi(w.z), bflo(w.w), bfhi(w.w)}; }
                    if (MODE == 2) { const v4u w = yw[m][bj]; v0 = v0 + (f32x4){bflo(w.x), bfhi(w.x), bflo(w.y), bfhi(w.y)}; v1 = v1 + (f32x4){bflo(w.z), bfhi(w.z), bflo(w.w), bfhi(w.w)}; }
                    st8(O + off, v0, v1); }
            if (MODE >= 1) __builtin_amdgcn_sched_barrier(0);
        }
    }
};
template <int MODE> struct EpiF32 {
    static constexpr bool PERM = false; static constexpr int HOOK_T = -1;
    float* H; const float* X; const bf16* PP;
    __device__ __forceinline__ void operator()(const Acc& acc, const Unit& u, int wr, int wc, int fr, int fq) const {
        const int row0 = u.pm * 256 + wr * 64 + fr, col0 = u.pn * 256 + wc * 32 + 4 * fq;
        const float* src = MODE == 0 ? X : H;
        constexpr int MB = MODE == 0 ? 4 : 2;
#pragma unroll
        for (int ai = 0; ai < 2; ++ai)
#pragma unroll
            for (int mb = 0; mb < 4; mb += MB) {
                f32x4 xv[MB][2][2]; v2u pw[MB][2][2];
#pragma unroll
                for (int m = 0; m < MB; ++m)
#pragma unroll
                    for (int bj = 0; bj < 2; ++bj)
#pragma unroll
                        for (int n = 0; n < 2; ++n) { const size_t o = (size_t)(row0 + ai * 128 + (mb + m) * 16) * D + col0 + bj * 128 + n * 16; xv[m][bj][n] = *(const f32x4*)(src + o); if (MODE == 1) pw[m][bj][n] = *(const v2u*)(PP + o); }
                __builtin_amdgcn_sched_barrier(0);
#pragma unroll
                for (int m = 0; m < MB; ++m)
#pragma unroll
                    for (int bj = 0; bj < 2; ++bj)
#pragma unroll
                        for (int n = 0; n < 2; ++n) { const size_t o = (size_t)(row0 + ai * 128 + (mb + m) * 16) * D + col0 + bj * 128 + n * 16; f32x4 v = acc[ai][bj][mb + m][n];
                            if (MODE == 0) v = v + xv[m][bj][n];
                            else { const v2u w = pw[m][bj][n]; v = xv[m][bj][n] + sigm4(v) * (f32x4){bflo(w.x), bfhi(w.x), bflo(w.y), bfhi(w.y)}; }
                            *(f32x4*)(H + o) = v; }
                __builtin_amdgcn_sched_barrier(0);
            }
    }
};
struct EpiMerge {
    static constexpr bool PERM = true; static constexpr int HOOK_T = 2;
    bf16* O; const bf16* GA; const bf16* GG;
    __device__ __forceinline__ void mid(Acc& acc, const Unit& u, int wr, int wc, int fr, int fq) const {
        int row0 = u.pm * 256 + wr * 64 + fr; const int col0 = u.pn * 256 + wc * 32 + 8 * fq;
        asm volatile("" : "+v"(row0));
#pragma unroll
        for (int ai = 0; ai < 2; ++ai)
#pragma unroll
            for (int mb = 0; mb < 4; mb += 2) {
                v4u aw[2][2], gw[2][2];
#pragma unroll
                for (int m = 0; m < 2; ++m)
#pragma unroll
                    for (int bj = 0; bj < 2; ++bj) { const size_t off = (size_t)(row0 + ai * 128 + (mb + m) * 16) * D + col0 + bj * 128; aw[m][bj] = *(const v4u*)(GA + off); gw[m][bj] = *(const v4u*)(GG + off); }
                __builtin_amdgcn_sched_barrier(0);
#pragma unroll
                for (int m = 0; m < 2; ++m)
#pragma unroll
                    for (int bj = 0; bj < 2; ++bj) { const v4u a = aw[m][bj], g = gw[m][bj];
                        acc[ai][bj][mb + m][0] = acc[ai][bj][mb + m][0] * (f32x4){bflo(a.x) * __builtin_amdgcn_rcpf(fmaxf(bflo(g.x), 1e-30f)), bfhi(a.x) * __builtin_amdgcn_rcpf(fmaxf(bfhi(g.x), 1e-30f)), bflo(a.y) * __builtin_amdgcn_rcpf(fmaxf(bflo(g.y), 1e-30f)), bfhi(a.y) * __builtin_amdgcn_rcpf(fmaxf(bfhi(g.y), 1e-30f))};
                        acc[ai][bj][mb + m][1] = acc[ai][bj][mb + m][1] * (f32x4){bflo(a.z) * __builtin_amdgcn_rcpf(fmaxf(bflo(g.z), 1e-30f)), bfhi(a.z) * __builtin_amdgcn_rcpf(fmaxf(bfhi(g.z), 1e-30f)), bflo(a.w) * __builtin_amdgcn_rcpf(fmaxf(bflo(g.w), 1e-30f)), bfhi(a.w) * __builtin_amdgcn_rcpf(fmaxf(bfhi(g.w), 1e-30f))}; }
                __builtin_amdgcn_sched_barrier(0);
            }
    }
    __device__ __forceinline__ void operator()(const Acc& acc, const Unit& u, int wr, int wc, int fr, int fq) const {
        const int row0 = u.pm * 256 + wr * 64 + fr, col0 = u.pn * 256 + wc * 32 + 8 * fq;
#pragma unroll
        for (int ai = 0; ai < 2; ++ai) {
            v4u gw[4][2];
#pragma unroll
            for (int m = 0; m < 4; ++m)
#pragma unroll
                for (int bj = 0; bj < 2; ++bj) gw[m][bj] = *(const v4u*)(GG + (size_t)(row0 + ai * 128 + m * 16) * D + col0 + bj * 128);
            __builtin_amdgcn_sched_barrier(0);
#pragma unroll
            for (int m = 0; m < 4; ++m)
#pragma unroll
                for (int bj = 0; bj < 2; ++bj) { const v4u g = gw[m][bj];
                    st8(O + (size_t)(row0 + ai * 128 + m * 16) * D + col0 + bj * 128, acc[ai][bj][m][0] * (f32x4){bflo(g.x), bfhi(g.x), bflo(g.y), bfhi(g.y)}, acc[ai][bj][m][1] * (f32x4){bflo(g.z), bfhi(g.z), bflo(g.w), bfhi(g.w)}); }
            __builtin_amdgcn_sched_barrier(0);
        }
    }
};
struct EpiPle {
    static constexpr bool PERM = true; static constexpr int HOOK_T = -1;
    bf16* O; const bf16* PP;
    __device__ __forceinline__ void operator()(const Acc& acc, const Unit& u, int wr, int wc, int fr, int fq) const {
        const int row0 = u.pm * 256 + wr * 64 + fr, col0 = u.pn * 256 + wc * 32 + 8 * fq;
#pragma unroll
        for (int ai = 0; ai < 2; ++ai) {
            v4u pw[4][2];
#pragma unroll
            for (int m = 0; m < 4; ++m)
#pragma unroll
                for (int bj = 0; bj < 2; ++bj) pw[m][bj] = *(const v4u*)(PP + (size_t)(row0 + ai * 128 + m * 16) * D + col0 + bj * 128);
            __builtin_amdgcn_sched_barrier(0);
#pragma unroll
            for (int m = 0; m < 4; ++m)
#pragma unroll
                for (int bj = 0; bj < 2; ++bj) { const v4u w = pw[m][bj];
                    const f32x4 v0 = sigm4(acc[ai][bj][m][0]) * (f32x4){bflo(w.x), bfhi(w.x), bflo(w.y), bfhi(w.y)}, v1 = sigm4(acc[ai][bj][m][1]) * (f32x4){bflo(w.z), bfhi(w.z), bflo(w.w), bfhi(w.w)};
                    st8(O + (size_t)(row0 + ai * 128 + m * 16) * D + col0 + bj * 128, v0, v1); }
            __builtin_amdgcn_sched_barrier(0);
        }
    }
};
struct EpiMoeUp {
    static constexpr bool PERM = true; static constexpr int HOOK_T = -1;
    bf16* ACT; const float* bgu; const float* srstd; const LAS int* ts;
    __device__ __forceinline__ void operator()(const Acc& acc, const Unit& u, int wr, int wc, int fr, int fq) const {
        const int e = u.x0, cnt = ts[40 + e], srow0 = u.x1 * 256 + wr * 64 + fr;
        const int row0 = u.pm * 256 + wr * 64 + fr, hc = u.pn * 128 + wc * 32 + 8 * fq;
        const float* bg = bgu + (size_t)e * 2048 + hc;
        const f32x4 bg0 = *(const f32x4*)bg, bg1 = *(const f32x4*)(bg + 4), bl0 = *(const f32x4*)(bg + 1024), bl1 = *(const f32x4*)(bg + 1028);
        float rsv[2][4];
#pragma unroll
        for (int ai = 0; ai < 2; ++ai)
#pragma unroll
            for (int m = 0; m < 4; ++m) { const int slot = srow0 + ai * 128 + m * 16; rsv[ai][m] = slot < cnt ? srstd[e * 32768 + slot] : 0.f; }
        __builtin_amdgcn_sched_barrier(0);
#pragma unroll
        for (int ai = 0; ai < 2; ++ai)
#pragma unroll
            for (int m = 0; m < 4; ++m) { const float rs = rsv[ai][m];
                f32x4 o[2];
#pragma unroll
                for (int n = 0; n < 2; ++n) { const f32x4 gu = acc[ai][0][m][n] * rs + (n ? bg1 : bg0), li = acc[ai][1][m][n] * rs + (n ? bl1 : bl0);
#pragma unroll
                    for (int e2 = 0; e2 < 4; ++e2) { const float gl = fminf(gu[e2], 7.0f), ln = fminf(fmaxf(li[e2], -7.0f), 7.0f);
                        o[n][e2] = gl * __builtin_amdgcn_rcpf(1.0f + __builtin_amdgcn_exp2f(-1.702f * LOG2E * gl)) * (ln + 1.0f); } }
                st8(ACT + (size_t)(row0 + ai * 128 + m * 16) * D + hc, o[0], o[1]); }
    }
};
struct EpiMoeDown {
    static constexpr bool PERM = true; static constexpr int HOOK_T = -1;
    bf16* Y; const float* bd; const float* sgate; const LAS int* ts;
    __device__ __forceinline__ void operator()(const Acc& acc, const Unit& u, int wr, int wc, int fr, int fq) const {
        const int e = u.x0, cnt = ts[40 + e], srow0 = u.x1 * 256 + wr * 64 + fr, col0 = u.pn * 256 + wc * 32 + 8 * fq;
        const float* bp = bd + (size_t)e * D + col0;
        f32x4 bv[2][2];
#pragma unroll
        for (int bj = 0; bj < 2; ++bj) { bv[bj][0] = *(const f32x4*)(bp + bj * 128); bv[bj][1] = *(const f32x4*)(bp + bj * 128 + 4); }
        float gtv[2][4];
#pragma unroll
        for (int ai = 0; ai < 2; ++ai)
#pragma unroll
            for (int m = 0; m < 4; ++m) { const int slot = srow0 + ai * 128 + m * 16; gtv[ai][m] = slot < cnt ? sgate[e * 32768 + slot] : 0.f; }
        __builtin_amdgcn_sched_barrier(0);
#pragma unroll
        for (int ai = 0; ai < 2; ++ai)
#pragma unroll
            for (int m = 0; m < 4; ++m) { const float gt = gtv[ai][m];
                bf16* rowp = Y + (size_t)(u.pm * 256 + wr * 64 + fr + ai * 128 + m * 16) * D + col0;
#pragma unroll
                for (int bj = 0; bj < 2; ++bj) st8(rowp + bj * 128, (acc[ai][bj][m][0] + bv[bj][0]) * gt, (acc[ai][bj][m][1] + bv[bj][1]) * gt); }
    }
};

#define XB_TMO      128
#define XB_XCNT(j)  (256  + 64 * (j))
#define XB_XSUB(j)  (1280 + 64 * (j))
#define XB_XGEN(j)  (2304 + 64 * (j))
#define XB_TOP      3328
#define XB_TOPGEN   3392
#define XCD_BAR_WORDS 3456
#define XB_SPIN_CAP (1u << 18)
__device__ __forceinline__ unsigned xb_ld(unsigned* p)              { return __hip_atomic_load(p, __ATOMIC_RELAXED, __HIP_MEMORY_SCOPE_AGENT); }
__device__ __forceinline__ unsigned xb_add(unsigned* p, unsigned v) { return __hip_atomic_fetch_add(p, v, __ATOMIC_RELAXED, __HIP_MEMORY_SCOPE_AGENT); }
__device__ __forceinline__ unsigned xb_xcc_id() { return (unsigned)__builtin_amdgcn_s_getreg((3 << 11) | 20) & 0xFu; }
#define XB_SPIN(cond, bar) do { unsigned _sp = 0; while (cond) { __builtin_amdgcn_s_sleep(1); \
    if ((++_sp & 255u) == 0u) { if (xb_ld(&(bar)[XB_TMO])) break; if (_sp > XB_SPIN_CAP) { atomicAdd(&(bar)[XB_TMO], 1u); break; } } } } while (0)
struct XcdBarrier { unsigned* bar; unsigned x; volatile LAS unsigned* st; int wave; };
__device__ __forceinline__ XcdBarrier xcd_barrier_post(unsigned* bar, volatile LAS unsigned* st, int wave) {
    XcdBarrier b; b.bar = bar; b.x = xb_xcc_id(); b.st = st; b.wave = wave;
    if (tid_opaque(wave) == 0) (void)xb_add(&bar[XB_XCNT(b.x)], 1u);
    return b;
}
__device__ __forceinline__ void xcd_barrier_complete(unsigned* bar, unsigned x, unsigned& nloc, unsigned& nx) {
    const unsigned G = gridDim.x * gridDim.y * gridDim.z;
    unsigned sum, cnt, mine, sp = 0u;
    for (;;) {
        sum = 0u; cnt = 0u; mine = 0u;
#pragma unroll
        for (unsigned j = 0; j < 16; ++j) { const unsigned c = xb_ld(&bar[XB_XCNT(j)]); sum += c; cnt += (c > 0u) ? 1u : 0u; mine = (j == x) ? c : mine; }
        if (sum == G) break;
        __builtin_amdgcn_s_sleep(1);
        if ((++sp & 255u) == 0u) { if (xb_ld(&bar[XB_TMO])) break; if (sp > XB_SPIN_CAP) { atomicAdd(&bar[XB_TMO], 1u); break; } }
    }
    nloc = mine > 0u ? mine : 1u; nx = cnt > 0u ? cnt : 1u;
}
__device__ __forceinline__ void xcd_barrier(const XcdBarrier& b) {
    asm volatile("s_waitcnt vmcnt(0)" ::: "memory");
    __syncthreads();
    if (tid_opaque(b.wave) == 0) {
        unsigned* bar = b.bar;
        __builtin_amdgcn_s_waitcnt(0);
        unsigned nloc = b.st[0], nx = b.st[1];
        if (nloc == 0u) { xcd_barrier_complete(bar, b.x, nloc, nx); b.st[0] = nloc; b.st[1] = nx; }
        const unsigned old = xb_add(&bar[XB_XSUB(b.x)], 1u);
        const unsigned gen = old / nloc;
        if (old + 1u == (gen + 1u) * nloc) {
            __builtin_amdgcn_fence(__ATOMIC_RELEASE, "agent");
            asm volatile("s_waitcnt vmcnt(0)" ::: "memory");
            const unsigned og = xb_add(&bar[XB_TOP], 1u);
            const unsigned tg = og / nx;
            if (og + 1u == (tg + 1u) * nx) xb_add(&bar[XB_TOPGEN], 1u);
            else XB_SPIN(xb_ld(&bar[XB_TOPGEN]) == tg, bar);
            __builtin_amdgcn_fence(__ATOMIC_ACQUIRE, "agent");
            xb_add(&bar[XB_XGEN(b.x)], 1u);
            asm volatile("s_waitcnt vmcnt(0)" ::: "memory");
        } else {
            XB_SPIN(xb_ld(&bar[XB_XGEN(b.x)]) == gen, bar);
            __builtin_amdgcn_fence(__ATOMIC_ACQUIRE, "agent");
            asm volatile("s_waitcnt vmcnt(0)" ::: "memory");
        }
    }
    __syncthreads();
}

struct Args { const float* in[23]; float* out; unsigned char* ws; int ph_lo, ph_hi; };
struct Frame {
    LAS unsigned char* lds; int wave, vcu, G;
};
#define LDS_WAIT() asm volatile("s_waitcnt lgkmcnt(0)" ::: "memory")

__device__ __forceinline__ int t5_bucket(int n) {
    if (n < 16) return n;
    const int th[15] = {22, 30, 40, 54, 73, 99, 134, 182, 246, 332, 450, 609, 825, 1117, 1513};
    int b = 16;
#pragma unroll
    for (int k = 0; k < 15; ++k) b += (n >= th[k]) ? 1 : 0;
    return b;
}

__device__ __forceinline__ void transpose_item(const float* W, int K, int N, bf16* WT, int drow0, LAS float* scr, int k0, int n0, int lane, int kdst = 0) {
    const int q = lane & 15, kr = lane >> 4;
    f32x4 v[8];
#pragma unroll
    for (int i = 0; i < 8; ++i) v[i] = *(const f32x4*)(W + (size_t)(k0 + 4 * i + kr) * N + n0 + 4 * q);
#pragma unroll
    for (int i = 0; i < 8; ++i) { LAS float* d = scr + (4 * q) * 33 + 4 * i + kr; d[0] = v[i].x; d[33] = v[i].y; d[66] = v[i].z; d[99] = v[i].w; }
    LDS_WAIT(); asm volatile("" ::: "memory");
    const int c4 = lane & 3, nr = lane >> 2;
#pragma unroll
    for (int j = 0; j < 4; ++j) { const int n = nr + 16 * j; const LAS float* sp = scr + n * 33 + 8 * c4;
        v4u o; o.x = pk2(sp[0], sp[1]); o.y = pk2(sp[2], sp[3]); o.z = pk2(sp[4], sp[5]); o.w = pk2(sp[6], sp[7]);
        *(v4u*)(WT + (size_t)(drow0 + n) * K + kdst + k0 + 8 * c4) = o; }
    LDS_WAIT(); asm volatile("" ::: "memory");
}
constexpr int BG_GU = 32 * 32 * 32, BG_DN = 32 * 32 * 16, BG_N = BG_GU + BG_DN;
constexpr int BG_P1 = 32768;
struct BgItem { const float* W; bf16* WT; int N, k0, n0, drow0, pitch, kdst; };
constexpr int BG_X0 = BG_N, BG_X1 = BG_X0 + 8 * 16, BG_X2 = BG_X1 + 24 * 16, BG_X3 = BG_X2 + 32 * 16, BG_X4 = BG_X3 + 32 * 16, BG_ALL = BG_X4 + 8 * 16;
__device__ __forceinline__ BgItem bg_decode(const Args& A, int r) {
    BgItem it; it.pitch = D; it.kdst = 0;
    if (r < BG_GU) { const int e = r >> 10, q = r & 1023, kb = q >> 5, nb = q & 31, n0 = nb * 64;
        it.W = A.in[15] + (size_t)e * D * 2048; it.WT = (bf16*)(A.ws + WS_WGU) + (size_t)e * 2048 * D; it.N = 2048; it.k0 = kb * 32; it.n0 = n0;
        it.drow0 = n0 < 1024 ? 256 * (n0 >> 7) + (n0 & 127) : 256 * ((n0 - 1024) >> 7) + 128 + (n0 & 127);
    } else if (r < BG_N) { r -= BG_GU; const int e = r >> 9, q = r & 511, kb = q >> 4, nb = q & 15;
        it.W = A.in[17] + (size_t)e * D * D; it.WT = (bf16*)(A.ws + WS_WD) + (size_t)e * D * D; it.N = D; it.k0 = kb * 32; it.n0 = nb * 64; it.drow0 = nb * 64;
    } else { int src; bf16* dst;
        if (r < BG_X1) { r -= BG_X0; src = 5; dst = (bf16*)(A.ws + WS_WCAT); }
        else if (r < BG_X2) { r -= BG_X1; src = 10; dst = (bf16*)(A.ws + WS_WCAT); it.kdst = 256; }
        else if (r < BG_X3) { r -= BG_X2; src = 11; dst = (bf16*)(A.ws + WS_WOUT); }
        else if (r < BG_X4) { r -= BG_X3; src = 20; dst = (bf16*)(A.ws + WS_WPG); }
        else { r -= BG_X4; src = 21; dst = (bf16*)(A.ws + WS_WPP); it.pitch = PLE; }
        it.W = src == 5 ? A.in[5] : src == 10 ? A.in[10] : src == 11 ? A.in[11] : src == 20 ? A.in[20] : A.in[21];
        it.WT = dst; it.N = D; it.k0 = (r >> 4) * 32; it.n0 = (r & 15) * 64; it.drow0 = it.n0; }
    return it;
}
struct BgConv {
    int cur, next, stride, end; f32x4 v[8];
    __device__ __forceinline__ void init(int first, int stride_, int end_ = BG_ALL) { cur = -1; next = first; stride = stride_; end = end_; }
    __device__ __forceinline__ void issue(const Args& A, int lane) {
        if (next < end) { const BgItem it = bg_decode(A, next); const int q = lane & 15, kr = lane >> 4;
#pragma unroll
            for (int i = 0; i < 8; ++i) v[i] = *(const f32x4*)(it.W + (size_t)(it.k0 + 4 * i + kr) * it.N + it.n0 + 4 * q);
            cur = next; next += stride; } else cur = -1;
    }
    __device__ __forceinline__ void finish(const Args& A, LAS float* scr, int lane) {
        if (cur >= 0) { const BgItem it = bg_decode(A, cur); const int q = lane & 15, kr = lane >> 4;
#pragma unroll
            for (int i = 0; i < 8; ++i) { LAS float* d = scr + (4 * q) * 33 + 4 * i + kr; d[0] = v[i].x; d[33] = v[i].y; d[66] = v[i].z; d[99] = v[i].w; }
            LDS_WAIT(); asm volatile("" ::: "memory");
            const int c4 = lane & 3, nr = lane >> 2;
#pragma unroll
            for (int j = 0; j < 4; ++j) { const int n = nr + 16 * j; const LAS float* sp = scr + n * 33 + 8 * c4;
                v4u o; o.x = pk2(sp[0], sp[1]); o.y = pk2(sp[2], sp[3]); o.z = pk2(sp[4], sp[5]); o.w = pk2(sp[6], sp[7]);
                *(v4u*)(it.WT + (size_t)(it.drow0 + n) * it.pitch + it.kdst + it.k0 + 8 * c4) = o; }
            LDS_WAIT(); asm volatile("" ::: "memory");
            cur = -1; }
    }
};
__device__ __forceinline__ void convert_queue(const Frame& F, const Args& A, unsigned* ctr, int lo, int hi) {
    const int tidx_ = tid_opaque(F.wave);
    LAS float* scr = (LAS float*)(F.lds + F.wave * 8448);
    LAS int* qs = (LAS int*)(F.lds + RING_BYTES + 512);
    const int lane = tidx_ & 63;
    BgConv c0, c1;
    for (;;) {
        __syncthreads();
        if (tidx_ == 0) *qs = (int)__hip_atomic_fetch_add(ctr, 64u, __ATOMIC_RELAXED, __HIP_MEMORY_SCOPE_AGENT);
        __syncthreads();
        const int base = __builtin_amdgcn_readfirstlane(*qs) + lo + F.wave * 8;
        if (base - F.wave * 8 >= hi) break;
        c0.init(base, 2, base + 8 < hi ? base + 8 : hi); c1.init(base + 1, 2, base + 8 < hi ? base + 8 : hi);
        c0.issue(A, lane); c1.issue(A, lane);
#pragma unroll 1
        for (int k = 0; k < 4; ++k) { c0.finish(A, scr, lane); c0.issue(A, lane); c1.finish(A, scr, lane); c1.issue(A, lane); }
    }
}
__device__ __forceinline__ void convert_p_queue(const Frame& F, const Args& A, unsigned* ctr) {
    const int tidx_ = tid_opaque(F.wave);
    const int lane = tidx_ & 63; const float* p = A.in[1]; bf16* pb = (bf16*)(A.ws + WS_PB);
    LAS int* qs = (LAS int*)(F.lds + RING_BYTES + 512);
    for (;;) {
        __syncthreads();
        if (tidx_ == 0) *qs = (int)__hip_atomic_fetch_add(ctr, 8u, __ATOMIC_RELAXED, __HIP_MEMORY_SCOPE_AGENT);
        __syncthreads();
        const int ck0 = __builtin_amdgcn_readfirstlane(*qs);
        if (ck0 >= (T * PLE) / 8192) break;
        const size_t base = (size_t)(ck0 + F.wave) * 8192 + 8 * lane;
#pragma unroll 4
        for (int i = 0; i < 16; ++i) { const f32x4 a = *(const f32x4*)(p + base + 512 * i), b = *(const f32x4*)(p + base + 512 * i + 4); st8(pb + base + 512 * i, a, b); }
    }
}
constexpr int BG_SCR_OFF = 45056;
__device__ __forceinline__ int win_dest(int n0) {
    if (n0 < 1536) return n0;
    if (n0 < 2304) return 4352 + (n0 - 1536);
    if (n0 < 3072) return 1536 + (n0 - 2304);
    if (n0 < 3840) return 5120 + (n0 - 3072);
    return 2304 + (n0 - 3840);
}
template <int NR> __device__ __forceinline__ void rms_rows_to_bf16(const float* xrow, const float* gain, bf16* orow, int lane) {
    f32x4 v[NR][4]; float s[NR];
#pragma unroll
    for (int r = 0; r < NR; ++r)
#pragma unroll
        for (int j = 0; j < 4; ++j) v[r][j] = ((const f32x4*)(xrow + (size_t)r * D) + lane)[64 * j];
    f32x4 g[4];
#pragma unroll
    for (int j = 0; j < 4; ++j) g[j] = ((const f32x4*)gain + lane)[64 * j];
#pragma unroll
    for (int r = 0; r < NR; ++r) { float a = 0.f;
#pragma unroll
        for (int j = 0; j < 4; ++j) a += (v[r][j].x * v[r][j].x + v[r][j].y * v[r][j].y) + (v[r][j].z * v[r][j].z + v[r][j].w * v[r][j].w);
        s[r] = a; }
#pragma unroll
    for (int o = 1; o < 64; o <<= 1)
#pragma unroll
        for (int r = 0; r < NR; ++r) s[r] += __shfl_xor(s[r], o);
#pragma unroll
    for (int r = 0; r < NR; ++r) { const float rstd = 1.0f / sqrtf(s[r] * (1.f / D) + EPS);
        unsigned long long* o8 = (unsigned long long*)(orow + (size_t)r * D) + lane;
#pragma unroll
        for (int j = 0; j < 4; ++j) o8[64 * j] = (unsigned long long)pk2(v[r][j].x * rstd * g[j].x, v[r][j].y * rstd * g[j].y) | ((unsigned long long)pk2(v[r][j].z * rstd * g[j].z, v[r][j].w * rstd * g[j].w) << 32); }
}
__device__ __forceinline__ void p0_prologue(const Frame& F, const Args& A) {
    const int tidx_ = tid_opaque(F.wave);
    LAS float* scr = (LAS float*)(F.lds + F.wave * 16384);
    const int gw = F.vcu * 8 + F.wave, NGW = F.G * 8;
    unsigned char* ws = A.ws;
    for (int m = gw * 4; m < T; m += NGW * 4) rms_rows_to_bf16<4>(A.in[0] + (size_t)m * D, A.in[2], (bf16*)(ws + WS_NX) + (size_t)m * D, (tidx_ & 63));
    { const float* wsp = A.in[8]; bf16* o = (bf16*)(ws + WS_WSP);
      for (int i = (blockIdx.x * 512 + tidx_) * 4; i < 12 * 128 * 128; i += F.G * 512 * 4) { const int col = i & 127, row = (i >> 7) & 127; const f32x4 a = *(const f32x4*)(wsp + i);
          v2u w; w.x = pk2(col <= row ? a.x : 0.f, col + 1 <= row ? a.y : 0.f); w.y = pk2(col + 2 <= row ? a.z : 0.f, col + 3 <= row ? a.w : 0.f); *(v2u*)(o + i) = w; } }
    { const float* wrt = A.in[13]; bf16* wh = (bf16*)(ws + WS_WRH); bf16* wl = (bf16*)(ws + WS_WRL);
      for (int i = blockIdx.x * 512 + tidx_; i < 32 * 1024; i += F.G * 512) { const int e = i >> 10, k = i & 1023; const float w = wrt[k * 32 + e]; const unsigned h = f2bf(w); wh[i] = (bf16)h; wl[i] = (bf16)f2bf(w - bflo(h)); } }
    constexpr int I_IN = 32 * 92;
    for (int it = gw; it < I_IN; it += NGW) { const int kb = it / 92, nb = it % 92; transpose_item(A.in[3], D, IN_W, (bf16*)(ws + WS_WIN), win_dest(nb * 64), scr, kb * 32, nb * 64, (tidx_ & 63)); }
}

__device__ __forceinline__ int crow(int r, int hi) { return (r & 3) + 8 * (r >> 2) + 4 * hi; }
struct AtU { int b, g, h, r, qb8, nqb; };
__device__ __forceinline__ AtU at_decode(int pr) { AtU u; const int slot = pr & 15; u.h = (pr >> 4) & 3; const int bgi = pr >> 6; u.g = bgi % 3; u.b = bgi / 3; u.nqb = 128 >> (2 * u.g);
    u.r = slot / (u.nqb >> 3); u.qb8 = slot % (u.nqb >> 3); return u; }
__device__ __forceinline__ void at_load(const AtU& u, const bf16* QT, const bf16* KT, const bf16* VT, int w, int r32, int hi, int q8, int t8, v4u (&stg)[12], bf16x8 (&qf)[4]) {
    const size_t tb0 = (size_t)((u.b * 3 + u.g) * 4 + u.h) * 128 + (size_t)(u.r * u.nqb);
    const bf16* qt = QT + (tb0 + u.qb8 * 8 + w) * 2048 + r32 * 64 + 8 * hi;
#pragma unroll
    for (int s = 0; s < 4; ++s) qf[s] = *(const bf16x8*)(qt + 16 * s);
#pragma unroll
    for (int i = 0; i < 12; ++i) { const int kv = i >= 6 ? 1 : 0, j = 2 * (i - 6 * kv) + t8; int kb = u.qb8 * 8 - 4 + j; kb = kb < 0 ? 0 : kb;
        stg[i] = *(const v4u*)((kv ? VT : KT) + (tb0 + kb) * 2048 + q8 * 8); }
}
__device__ __forceinline__ void attn_phase(const Frame& F, const Args& A) {
    const int tidx_ = tid_opaque(F.wave);
    LAS float* tb = (LAS float*)(F.lds + RING_BYTES + 2048);
    const float* rel_bias = A.in[4];
    for (int i = tidx_; i < 12 * 192; i += 512) { const int gh = i / 192, dist = i % 192 - 31, g = gh >> 2; const int dil = g == 0 ? 1 : (g == 1 ? 4 : 16);
        tb[i] = (dist >= 0 && dist <= 128) ? rel_bias[t5_bucket(dist * dil) * 12 + gh] * LOG2E : -INFINITY; }
    __syncthreads();
    const bf16* QT = (const bf16*)(A.ws + WS_Q); const bf16* KT = (const bf16*)(A.ws + WS_K); const bf16* VT = (const bf16*)(A.ws + WS_VT);
    bf16* OG = (bf16*)(A.ws + WS_OG); float* LSE = (float*)(A.ws + WS_LSE);
    const int lane = (tidx_ & 63), r32 = lane & 31, hi = lane >> 5, w = F.wave;
    const int q8 = tidx_ & 255, t8 = tidx_ >> 8;
    const int NU = NB * 3 * 4 * 16;
    v4u stg[12]; bf16x8 qf[4];
    if (F.vcu < NU) at_load(at_decode(F.vcu), QT, KT, VT, w, r32, hi, q8, t8, stg, qf);
    for (int pr = F.vcu; pr < NU; pr += F.G) {
        const AtU u = at_decode(pr);
        const int dsh = 2 * u.g, dil = 1 << dsh, g = u.g, h = u.h, b = u.b, r = u.r;
        const int qb = u.qb8 * 8 + w, i0 = qb * 32;
        __syncthreads();
        { const int keyk = q8 >> 3, posk = keyk * 8 + ((q8 & 7) ^ ((keyk >> 1) & 7)), dv = q8 >> 2, posv = dv * 4 + ((q8 & 3) ^ ((dv >> 2) & 3));
#pragma unroll
          for (int i = 0; i < 12; ++i) { const int kv = i >= 6 ? 1 : 0, j = 2 * (i - 6 * kv) + t8;
              *(LAS v4u*)(F.lds + kv * 49152 + j * 4096 + (kv ? posv : posk) * 16) = stg[i]; } }
        bf16x8 qc[4];
#pragma unroll
        for (int s = 0; s < 4; ++s) qc[s] = qf[s];
        __syncthreads();
        if (pr + F.G < NU) at_load(at_decode(pr + F.G), QT, KT, VT, w, r32, hi, q8, t8, stg, qf);
        __builtin_amdgcn_sched_barrier(0);
        const LAS unsigned char* kbase = F.lds + w * 4096 + (r32 * 8) * 16;
        const int kx = (r32 >> 1) & 7;
        f32x16 st[5];
#pragma unroll
        for (int kt = 0; kt < 5; ++kt) {
            f32x16 a = {};
#pragma unroll
            for (int s = 0; s < 4; ++s) { const bf16x8 kf = *(const LAS bf16x8*)(kbase + kt * 4096 + (((2 * s + hi) ^ kx) << 4)); a = __builtin_amdgcn_mfma_f32_32x32x16_bf16(kf, qc[s], a, 0, 0, 0); }
            st[kt] = a;
        }
        const LAS float* tbh = tb + (g * 4 + h) * 192;
        float mx = -INFINITY;
#pragma unroll
        for (int kt = 0; kt < 5; ++kt)
#pragma unroll
            for (int i = 0; i < 16; ++i) { const int kr = crow(i, hi), krel = -128 + 32 * kt + kr; const int dist = r32 - krel;
                float v = st[kt][i] + tbh[dist + 31]; v = (i0 + krel >= 0) ? v : -INFINITY; st[kt][i] = v; mx = fmaxf(mx, v); }
        mx = fmaxf(mx, __shfl_xor(mx, 32));
        float l = 0.f;
#pragma unroll
        for (int kt = 0; kt < 5; ++kt)
#pragma unroll
            for (int i = 0; i < 16; ++i) { const float p = __builtin_amdgcn_exp2f(st[kt][i] - mx); st[kt][i] = p; l += p; }
        l += __shfl_xor(l, 32);
        const LAS unsigned char* vbase = F.lds + 49152 + w * 4096;
        f32x16 o[2] = {};
#pragma unroll
        for (int kt = 0; kt < 5; ++kt)
#pragma unroll
            for (int s2 = 0; s2 < 2; ++s2) {
                v4u pw; pw.x = cvt_pk_bf16(st[kt][8 * s2 + 0], st[kt][8 * s2 + 1]); pw.y = cvt_pk_bf16(st[kt][8 * s2 + 2], st[kt][8 * s2 + 3]);
                pw.z = cvt_pk_bf16(st[kt][8 * s2 + 4], st[kt][8 * s2 + 5]); pw.w = cvt_pk_bf16(st[kt][8 * s2 + 6], st[kt][8 * s2 + 7]);
                const bf16x8 pf = __builtin_bit_cast(bf16x8, pw);
#pragma unroll
                for (int dt = 0; dt < 2; ++dt) { const int dd = 32 * dt + r32;
                    const LAS unsigned char* vr = vbase + kt * 4096 + dd * 64 + 8 * hi; const int vx = (dd >> 2) & 3;
                    const v2u p1 = *(const LAS v2u*)(vr + (((2 * s2) ^ vx) << 4)), p2 = *(const LAS v2u*)(vr + (((2 * s2 + 1) ^ vx) << 4));
                    v4u vw; vw.x = p1.x; vw.y = p1.y; vw.z = p2.x; vw.w = p2.y;
                    o[dt] = __builtin_amdgcn_mfma_f32_32x32x16_bf16(__builtin_bit_cast(bf16x8, vw), pf, o[dt], 0, 0, 0); }
            }
        const float rl = 1.0f / l;
        const size_t qrow = (size_t)b * SEQ + (size_t)(i0 + r32) * dil + r;
        bf16* op = OG + ((size_t)g * T + qrow) * 256 + h * 64;
#pragma unroll
        for (int dt = 0; dt < 2; ++dt)
#pragma unroll
            for (int gq = 0; gq < 4; ++gq) { v2u wv; wv.x = cvt_pk_bf16(o[dt][4 * gq] * rl, o[dt][4 * gq + 1] * rl); wv.y = cvt_pk_bf16(o[dt][4 * gq + 2] * rl, o[dt][4 * gq + 3] * rl);
                *(v2u*)(op + 32 * dt + 8 * gq + 4 * hi) = wv; }
        if (hi == 0) LSE[((size_t)g * T + qrow) * 4 + h] = (mx + __builtin_amdgcn_logf(l)) * LN2;
    }
    __syncthreads();
}

__device__ __forceinline__ void spatial_phase(const Frame& F, const Args& A) {
    const int tidx_ = tid_opaque(F.wave);
    const bf16* ZVT = (const bf16*)(A.ws + WS_ZVT); const bf16* ZU = (const bf16*)(A.ws + WS_ZU); const bf16* WSP = (const bf16*)(A.ws + WS_WSP);
    bf16* Gout = (bf16*)(A.ws + WS_AG) + 256;
    const float* lng = A.in[6]; const float* lnb = A.in[7]; const float* bsp = A.in[9];
    LAS float* red = (LAS float*)(F.lds + 10240);
    LAS float* stt = (LAS float*)(F.lds + 43008);
    LAS unsigned char* vn = F.lds + 49152;
    int lane = (tidx_ & 63); asm volatile("" : "+v"(lane));
    const int r32 = lane & 31, hi = lane >> 5, w = F.wave;
    const int dr = 8 * w + (lane >> 3), ck = lane & 7;
    for (int c = F.vcu; c < T / 128; c += F.G) {
        v4u zr[2];
#pragma unroll
        for (int p = 0; p < 2; ++p) zr[p] = *(const v4u*)(ZVT + ((size_t)c * GM_W + dr) * 128 + 8 * (ck + 8 * p));
        {
            const int tg = tidx_ & 15, rg = tidx_ >> 4; float sm[8], q[8];
#pragma unroll
            for (int e = 0; e < 8; ++e) { sm[e] = 0.f; q[e] = 0.f; }
#pragma unroll 4
            for (int ch = rg; ch < GM_W; ch += 32) { const v4u wv = *(const v4u*)(ZVT + ((size_t)c * GM_W + ch) * 128 + 8 * tg);
                const float x[8] = {bflo(wv.x), bfhi(wv.x), bflo(wv.y), bfhi(wv.y), bflo(wv.z), bfhi(wv.z), bflo(wv.w), bfhi(wv.w)};
#pragma unroll
                for (int e = 0; e < 8; ++e) { sm[e] += x[e]; q[e] += x[e] * x[e]; } }
#pragma unroll
            for (int e = 0; e < 8; ++e) { red[(rg * 128 + 8 * tg + e) * 2] = sm[e]; red[(rg * 128 + 8 * tg + e) * 2 + 1] = q[e]; }
            __syncthreads();
            if (tidx_ < 128) { float ss = 0.f, qq = 0.f;
                for (int k = 0; k < 32; ++k) { ss += red[(k * 128 + tidx_) * 2]; qq += red[(k * 128 + tidx_) * 2 + 1]; }
                const float mu = ss * (1.f / GM_W), var = fmaxf(qq * (1.f / GM_W) - mu * mu, 0.f);
                stt[tidx_ * 2] = mu; stt[tidx_ * 2 + 1] = 1.0f / sqrtf(var + EPS); }
            __syncthreads();
        }
#define SP_GROUP(GI, ZR_CUR, ZU_CUR, ZR_NXT, ZU_NXT) do { \
            const int gi_ = (GI); const int dt = w & 1, it = ((w >> 1) + gi_) & 3, ti = 32 * it + r32;       \
              \
            bf16x8 bfr[8]; \
            { const bf16* wp = WSP + ((size_t)gi_ * 128 + ti) * 128 + 8 * hi; \
              _Pragma("unroll") for (int s = 0; s < 8; ++s) bfr[s] = *(const bf16x8*)(wp + 16 * s); } \
            const float bsv = bsp[gi_ * 128 + ti], gch = lng[gi_ * 64 + dr], bch = lnb[gi_ * 64 + dr]; \
            __builtin_amdgcn_sched_barrier(0); \
              \
            LAS unsigned char* tile = vn + (gi_ & 1) * 16384; \
            _Pragma("unroll") for (int p = 0; p < 2; ++p) { const int jb = 8 * (ck + 8 * p); const v4u z = ZR_CUR[p]; \
                float x[8] = {bflo(z.x), bfhi(z.x), bflo(z.y), bfhi(z.y), bflo(z.z), bfhi(z.z), bflo(z.w), bfhi(z.w)}; \
                _Pragma("unroll") for (int e = 0; e < 8; ++e) x[e] = (x[e] - stt[(jb + e) * 2]) * stt[(jb + e) * 2 + 1] * gch + bch; \
                v4u aw; aw.x = cvt_pk_bf16(x[0], x[1]); aw.y = cvt_pk_bf16(x[2], x[3]); aw.z = cvt_pk_bf16(x[4], x[5]); aw.w = cvt_pk_bf16(x[6], x[7]); \
                *(LAS v4u*)(tile + dr * 256 + (((ck + 8 * p) ^ (dr & 15)) << 4)) = aw; } \
            { const int gn = gi_ + 1 < 12 ? gi_ + 1 : 11;        \
              _Pragma("unroll") for (int p = 0; p < 2; ++p) ZR_NXT[p] = *(const v4u*)(ZVT + ((size_t)c * GM_W + gn * 64 + dr) * 128 + 8 * (ck + 8 * p)); \
              const int itn = ((w >> 1) + gn) & 3; const size_t orow = ((size_t)c * 128 + 32 * itn + r32) * GM_W + gn * 64 + 32 * dt + 4 * hi; \
              _Pragma("unroll") for (int gq = 0; gq < 4; ++gq) ZU_NXT[gq] = *(const v2u*)(ZU + orow + 8 * gq); } \
            __syncthreads();                                    \
            f32x16 acc = {}; \
            { const int dd = 32 * dt + r32; const LAS unsigned char* ar = tile + dd * 256; \
              _Pragma("unroll") for (int s = 0; s < 8; ++s) { const bf16x8 af = *(const LAS bf16x8*)(ar + (((2 * s + hi) ^ (dd & 15)) << 4)); acc = __builtin_amdgcn_mfma_f32_32x32x16_bf16(af, bfr[s], acc, 0, 0, 0); } } \
              \
            const size_t grow = ((size_t)c * 128 + ti) * D + gi_ * 64 + 32 * dt + 4 * hi; \
            _Pragma("unroll") for (int gq = 0; gq < 4; ++gq) { const v2u uw = ZU_CUR[gq]; \
                v2u o; o.x = cvt_pk_bf16(bflo(uw.x) * (acc[4 * gq] + bsv), bfhi(uw.x) * (acc[4 * gq + 1] + bsv)); o.y = cvt_pk_bf16(bflo(uw.y) * (acc[4 * gq + 2] + bsv), bfhi(uw.y) * (acc[4 * gq + 3] + bsv)); \
                *(v2u*)(Gout + grow + 8 * gq) = o; } \
        } while (0)
        v4u zrb[2]; v2u zua[4], zub[4];
        { const int it0 = (w >> 1) & 3; const size_t orow = ((size_t)c * 128 + 32 * it0 + r32) * GM_W + 32 * (w & 1) + 4 * hi;
#pragma unroll
          for (int gq = 0; gq < 4; ++gq) zua[gq] = *(const v2u*)(ZU + orow + 8 * gq); }
#pragma unroll 1
        for (int gi = 0; gi < 12; gi += 2) {
            SP_GROUP(gi, zr, zua, zrb, zub);
            SP_GROUP(gi + 1, zrb, zub, zr, zua);
        }
#undef SP_GROUP
        __syncthreads();
    }
}

__device__ __forceinline__ void merge_phase(const Frame& F, const Args& A) {
    const int tidx_ = tid_opaque(F.wave);
    const bf16* OG = (const bf16*)(A.ws + WS_OG); const float* LSE = (const float*)(A.ws + WS_LSE); bf16* ATT = (bf16*)(A.ws + WS_AG);
    const int gw = F.vcu * 8 + F.wave, NGW = F.G * 8, lane = (tidx_ & 63), h = lane >> 4;
    for (int t = gw; t < T; t += NGW) {
        const float l0 = LSE[(size_t)t * 4 + h], l1 = LSE[((size_t)T + t) * 4 + h], l2 = LSE[((size_t)2 * T + t) * 4 + h];
        const float m = fmaxf(l0, fmaxf(l1, l2)); float a0 = __expf(l0 - m), a1 = __expf(l1 - m), a2 = __expf(l2 - m); const float inv = 1.0f / (a0 + a1 + a2); a0 *= inv; a1 *= inv; a2 *= inv;
        const v2u w0 = *(const v2u*)(OG + (size_t)t * 256 + 4 * lane), w1 = *(const v2u*)(OG + ((size_t)T + t) * 256 + 4 * lane), w2 = *(const v2u*)(OG + ((size_t)2 * T + t) * 256 + 4 * lane);
        v2u o; o.x = pk2(a0 * bflo(w0.x) + a1 * bflo(w1.x) + a2 * bflo(w2.x), a0 * bfhi(w0.x) + a1 * bfhi(w1.x) + a2 * bfhi(w2.x));
        o.y = pk2(a0 * bflo(w0.y) + a1 * bflo(w1.y) + a2 * bflo(w2.y), a0 * bfhi(w0.y) + a1 * bfhi(w1.y) + a2 * bfhi(w2.y));
        *(v2u*)(ATT + (size_t)t * D + 4 * lane) = o;
    }
}

__device__ __forceinline__ void router_phase(const Frame& F, const Args& A) {
    const int tidx_ = tid_opaque(F.wave);
    LAS unsigned char* L = F.lds;
    LAS int* hist = (LAS int*)(F.lds + RING_BYTES + 2048);
    LAS int* basee = hist + 32;
    LAS int* rec_e = hist + 64;
    LAS int* rec_r = rec_e + 512;
    LAS float* rec_g = (LAS float*)(rec_r + 512);
    LAS float* rec_s = rec_g + 512;
    const float* brt = A.in[14]; const float* gmoe = A.in[12];
    const float* H = A.out; bf16* NX = (bf16*)(A.ws + WS_NX);
    const bf16* WRH = (const bf16*)(A.ws + WS_WRH);
    int* LIST = (int*)(A.ws + WS_LIST); float* SGATE = (float*)(A.ws + WS_SGATE); float* SRSTD = (float*)(A.ws + WS_SRSTD); int* POS = (int*)(A.ws + WS_POS);
    unsigned* CNT = (unsigned*)(A.ws + WS_CTL) + CW_CNT;
    const int lane = (tidx_ & 63), w = F.wave, r32 = lane & 31, hi = lane >> 5;
    for (int c = F.vcu; c < T / 128; c += F.G) {
        for (int q = tidx_; q < 8192; q += 512) { const int mtx = q >> 12, rem = q & 4095, e = rem >> 7, ck = rem & 127;
            const v4u v = *(const v4u*)(WRH + (size_t)mtx * 32768 + e * 1024 + ck * 8);
            *(LAS v4u*)(L + mtx * 65536 + e * 2048 + ((ck ^ (e & 15)) << 4)) = v; }
        if (tidx_ < 32) hist[tidx_] = 0;
        __syncthreads();
        const int tt = w & 3, kh = w >> 2;
        const size_t row = (size_t)c * 128 + tt * 32 + r32;
        const float* hrow = H + row * D + kh * 512 + 8 * hi; const float* grow = gmoe + kh * 512 + 8 * hi; bf16* nrow = NX + row * D + kh * 512 + 8 * hi;
        const LAS unsigned char* wb = L + r32 * 2048;
        f32x16 acc = {}; float ss = 0.f;
#pragma unroll 4
        for (int s = 0; s < 32; ++s) {
            const f32x4 h0 = *(const f32x4*)(hrow + 16 * s), h1 = *(const f32x4*)(hrow + 16 * s + 4), g0 = *(const f32x4*)(grow + 16 * s), g1 = *(const f32x4*)(grow + 16 * s + 4);
            ss += (h0.x * h0.x + h0.y * h0.y) + (h0.z * h0.z + h0.w * h0.w) + (h1.x * h1.x + h1.y * h1.y) + (h1.z * h1.z + h1.w * h1.w);
            const f32x4 x0 = h0 * g0, x1 = h1 * g1;
            v4u xh; xh.x = cvt_pk_bf16(x0.x, x0.y); xh.y = cvt_pk_bf16(x0.z, x0.w); xh.z = cvt_pk_bf16(x1.x, x1.y); xh.w = cvt_pk_bf16(x1.z, x1.w);
            v4u xl; xl.x = cvt_pk_bf16(x0.x - bflo(xh.x), x0.y - bfhi(xh.x)); xl.y = cvt_pk_bf16(x0.z - bflo(xh.y), x0.w - bfhi(xh.y));
            xl.z = cvt_pk_bf16(x1.x - bflo(xh.z), x1.y - bfhi(xh.z)); xl.w = cvt_pk_bf16(x1.z - bflo(xh.w), x1.w - bfhi(xh.w));
            *(v4u*)(nrow + 16 * s) = xh;
            const int ck = kh * 64 + 2 * s + hi;
            const bf16x8 wh = *(const LAS bf16x8*)(wb + ((ck ^ (r32 & 15)) << 4)), wl = *(const LAS bf16x8*)(wb + 65536 + ((ck ^ (r32 & 15)) << 4));
            const bf16x8 ah = __builtin_bit_cast(bf16x8, xh), al = __builtin_bit_cast(bf16x8, xl);
            acc = __builtin_amdgcn_mfma_f32_32x32x16_bf16(ah, wh, acc, 0, 0, 0);
            acc = __builtin_amdgcn_mfma_f32_32x32x16_bf16(al, wh, acc, 0, 0, 0);
            acc = __builtin_amdgcn_mfma_f32_32x32x16_bf16(ah, wl, acc, 0, 0, 0);
        }
        __syncthreads();
        { LAS float* LGp = (LAS float*)L + kh * (128 * 33);
#pragma unroll
          for (int i = 0; i < 16; ++i) LGp[(tt * 32 + crow(i, hi)) * 33 + r32] = acc[i];
          ((LAS float*)(L + 36864))[(kh * 2 + hi) * 128 + tt * 32 + r32] = ss; }
        __syncthreads();
        if (tidx_ < 128) {
            const int t = tidx_; const LAS float* SS = (const LAS float*)(L + 36864);
            const float rstd = 1.0f / sqrtf(((SS[t] + SS[128 + t]) + (SS[256 + t] + SS[384 + t])) * (1.f / D) + EPS);
            const LAS float* l0 = (const LAS float*)L + t * 33; const LAS float* l1 = l0 + 128 * 33;
            float lg[32];
#pragma unroll
            for (int e = 0; e < 32; ++e) lg[e] = (l0[e] + l1[e]) * rstd + brt[e];
            unsigned taken = 0u; float tv[4]; int ti[4];
#pragma unroll
            for (int k = 0; k < 4; ++k) { float bv = -INFINITY; int bi = 0;
#pragma unroll
                for (int e = 0; e < 32; ++e) { const float cv = ((taken >> e) & 1u) ? -INFINITY : lg[e]; if (cv > bv) { bv = cv; bi = e; } }
                tv[k] = bv; ti[k] = bi; taken |= 1u << bi; }
            const float e1 = __expf(tv[1] - tv[0]), e2 = __expf(tv[2] - tv[0]), e3 = __expf(tv[3] - tv[0]); const float inv = 1.0f / (1.0f + e1 + e2 + e3);
            const float gk[4] = {inv, e1 * inv, e2 * inv, e3 * inv};
            rec_s[t] = rstd;
#pragma unroll
            for (int k = 0; k < 4; ++k) { const int lr = atomicAdd((int*)&hist[ti[k]], 1); rec_e[t * 4 + k] = ti[k]; rec_r[t * 4 + k] = lr; rec_g[t * 4 + k] = gk[k]; }
        }
        __syncthreads();
        if (tidx_ < 32) basee[tidx_] = (int)__hip_atomic_fetch_add(CNT + tidx_, (unsigned)hist[tidx_], __ATOMIC_RELAXED, __HIP_MEMORY_SCOPE_AGENT);
        __syncthreads();
        { const int lrow = tidx_ >> 2, k = tidx_ & 3; const int e = rec_e[tidx_], slot = basee[e] + rec_r[tidx_]; const int t = c * 128 + lrow;
          LIST[e * 32768 + slot] = t; SGATE[e * 32768 + slot] = rec_g[tidx_]; SRSTD[e * 32768 + slot] = rec_s[lrow]; POS[t * 4 + k] = (e << 16) | slot; }
        __syncthreads();
    }
}

__device__ __forceinline__ void load_tile_starts(const Frame& F, const Args& A) {
    const int tidx_ = tid_opaque(F.wave);
    LAS int* ts = (LAS int*)(F.lds + TS_OFF);
    if (tidx_ == 0) { const unsigned* CNT = (const unsigned*)(A.ws + WS_CTL) + CW_CNT; int acc = 0;
        for (int e = 0; e < 32; ++e) { const int c = (int)__hip_atomic_load(CNT + e, __ATOMIC_RELAXED, __HIP_MEMORY_SCOPE_AGENT); ts[e] = acc; ts[40 + e] = c; acc += (c + 255) >> 8; }
        ts[32] = acc; for (int e = 33; e < 40; ++e) ts[e] = 0x7fffffff; }
    __syncthreads();
}

__device__ __forceinline__ void combine_phase(const Frame& F, const Args& A) {
    const int tidx_ = tid_opaque(F.wave);
    const LAS int* ts = (const LAS int*)(F.lds + TS_OFF);
    const bf16* Y = (const bf16*)(A.ws + WS_Y); const int* POS = (const int*)(A.ws + WS_POS); const float* H = A.out; bf16* NX = (bf16*)(A.ws + WS_NX); bf16* H2 = (bf16*)(A.ws + WS_H2);
    const float* gple = A.in[19];
    const int gw = F.vcu * 8 + F.wave, NGW = F.G * 8, lane = (tidx_ & 63);
    for (int t = gw * 2; t < T; t += NGW * 2) {
        int pz[2][4];
#pragma unroll
        for (int r = 0; r < 2; ++r)
#pragma unroll
            for (int k = 0; k < 4; ++k) pz[r][k] = POS[(t + r) * 4 + k];
        f32x4 v[2][2][2];
#pragma unroll
        for (int r = 0; r < 2; ++r)
#pragma unroll
            for (int hf = 0; hf < 2; ++hf) { const float* hp = H + (size_t)(t + r) * D + hf * 512 + 8 * lane; v[r][hf][0] = *(const f32x4*)hp; v[r][hf][1] = *(const f32x4*)(hp + 4); }
        v4u yw[2][4][2];
#pragma unroll
        for (int r = 0; r < 2; ++r)
#pragma unroll
            for (int k = 0; k < 4; ++k) { const int e = pz[r][k] >> 16, slot = pz[r][k] & 0xffff; const bf16* yp = Y + ((size_t)ts[e] * 256 + slot) * D + 8 * lane;
                yw[r][k][0] = *(const v4u*)yp; yw[r][k][1] = *(const v4u*)(yp + 512); }
        float s[2];
#pragma unroll
        for (int r = 0; r < 2; ++r) { float a = 0.f;
#pragma unroll
            for (int hf = 0; hf < 2; ++hf) {
#pragma unroll
                for (int k = 0; k < 4; ++k) { const v4u w = yw[r][k][hf];
                    v[r][hf][0] = v[r][hf][0] + (f32x4){bflo(w.x), bfhi(w.x), bflo(w.y), bfhi(w.y)}; v[r][hf][1] = v[r][hf][1] + (f32x4){bflo(w.z), bfhi(w.z), bflo(w.w), bfhi(w.w)}; }
                st8(H2 + (size_t)(t + r) * D + hf * 512 + 8 * lane, v[r][hf][0], v[r][hf][1]);
#pragma unroll
                for (int p = 0; p < 2; ++p) a += (v[r][hf][p].x * v[r][hf][p].x + v[r][hf][p].y * v[r][hf][p].y) + (v[r][hf][p].z * v[r][hf][p].z + v[r][hf][p].w * v[r][hf][p].w); }
            s[r] = a; }
#pragma unroll
        for (int o = 1; o < 64; o <<= 1) { s[0] += __shfl_xor(s[0], o); s[1] += __shfl_xor(s[1], o); }
#pragma unroll
        for (int r = 0; r < 2; ++r) { const float rstd = 1.0f / sqrtf(s[r] * (1.f / D) + EPS);
#pragma unroll
            for (int hf = 0; hf < 2; ++hf) { const float* gp = gple + hf * 512 + 8 * lane; const f32x4 g0 = *(const f32x4*)gp, g1 = *(const f32x4*)(gp + 4);
                st8(NX + (size_t)(t + r) * D + hf * 512 + 8 * lane, v[r][hf][0] * rstd * g0, v[r][hf][1] * rstd * g1); } }
    }
}
__device__ __forceinline__ void final_phase(const Frame& F, const Args& A) {
    const int tidx_ = tid_opaque(F.wave);
    float* OUT = A.out; const float* gf = A.in[22]; const bf16* T1 = (const bf16*)(A.ws + WS_T1); const bf16* H2 = (const bf16*)(A.ws + WS_H2);
    const int gw = F.vcu * 8 + F.wave, NGW = F.G * 8, lane = (tidx_ & 63);
    f32x4 g[2][2];
#pragma unroll
    for (int hf = 0; hf < 2; ++hf) { const float* gp = gf + hf * 512 + 8 * lane; g[hf][0] = *(const f32x4*)gp; g[hf][1] = *(const f32x4*)(gp + 4); }
    for (int t = gw * 2; t < T; t += NGW * 2) {
        v4u hw[2][2], tw[2][2];
#pragma unroll
        for (int r = 0; r < 2; ++r)
#pragma unroll
            for (int hf = 0; hf < 2; ++hf) { const size_t o = (size_t)(t + r) * D + hf * 512 + 8 * lane; hw[r][hf] = *(const v4u*)(H2 + o); tw[r][hf] = *(const v4u*)(T1 + o); }
        f32x4 v[2][2][2]; float s[2];
#pragma unroll
        for (int r = 0; r < 2; ++r) { float a = 0.f;
#pragma unroll
            for (int hf = 0; hf < 2; ++hf) { const v4u h = hw[r][hf], w = tw[r][hf];
                v[r][hf][0] = (f32x4){bflo(h.x) + bflo(w.x), bfhi(h.x) + bfhi(w.x), bflo(h.y) + bflo(w.y), bfhi(h.y) + bfhi(w.y)};
                v[r][hf][1] = (f32x4){bflo(h.z) + bflo(w.z), bfhi(h.z) + bfhi(w.z), bflo(h.w) + bflo(w.w), bfhi(h.w) + bfhi(w.w)};
#pragma unroll
                for (int p = 0; p < 2; ++p) a += (v[r][hf][p].x * v[r][hf][p].x + v[r][hf][p].y * v[r][hf][p].y) + (v[r][hf][p].z * v[r][hf][p].z + v[r][hf][p].w * v[r][hf][p].w); }
            s[r] = a; }
#pragma unroll
        for (int o = 1; o < 64; o <<= 1) { s[0] += __shfl_xor(s[0], o); s[1] += __shfl_xor(s[1], o); }
#pragma unroll
        for (int r = 0; r < 2; ++r) { const float rstd = 1.0f / sqrtf(s[r] * (1.f / D) + EPS);
#pragma unroll
            for (int hf = 0; hf < 2; ++hf) { float* op = OUT + (size_t)(t + r) * D + hf * 512 + 8 * lane; *(f32x4*)op = v[r][hf][0] * rstd * g[hf][0]; *(f32x4*)(op + 4) = v[r][hf][1] * rstd * g[hf][1]; } }
    }
}

constexpr int NPHASE = 13;
#ifndef ONLY_PH
#define ONLY_PH -1
#endif
#define PH_ON(k) (ONLY_PH < 0 || ONLY_PH == (k))
__global__ void __launch_bounds__(512, 2) fwd_kernel(Args args) {
    extern __shared__ __attribute__((aligned(16))) unsigned char lds[];
    Frame F;
    F.lds = (LAS unsigned char*)lds; F.wave = __builtin_amdgcn_readfirstlane((int)threadIdx.x >> 6);
    F.G = gridDim.x; { const int bx = blockIdx.x; F.vcu = (F.G % 8 == 0) ? (bx % 8) * (F.G / 8) + bx / 8 : bx; }
    unsigned char* ws = args.ws;
    volatile LAS unsigned* MISC = (volatile LAS unsigned*)(F.lds + MISC_OFF);
    for (int u = tid_opaque(F.wave); u < (LDS_BYTES - RING_BYTES) / 4; u += 512) ((LAS unsigned*)(F.lds + RING_BYTES))[u] = 0u;
    __syncthreads();
    const bool multi = (args.ph_hi - args.ph_lo) > 1;
    if (multi) (void)xcd_barrier_post((unsigned*)(ws + WS_CTL) + CW_BAR, MISC + 8, F.wave);
    const int bx = (int)blockIdx.x;
#if MK_N_LAUNCHES == 1
    constexpr int lo = 0, hi = NPHASE;
#else
    const int lo = args.ph_lo, hi = args.ph_hi;
#endif
#ifndef REP_MASK
#define REP_MASK 0
#endif
#define IN(k) (PH_ON(k) && lo <= (k) && (k) < hi)
#define REPS(k) (((REP_MASK >> (k)) & 1) ? 2 : 1)
#define SEAM(k) do { if (lo <= (k) && (k) + 1 < hi) { XcdBarrier b_; b_.bar = (unsigned*)(args.ws + WS_CTL) + CW_BAR; b_.x = xb_xcc_id(); b_.st = (volatile LAS unsigned*)(F.lds + MISC_OFF) + 8; b_.wave = F.wave; xcd_barrier(b_); } } while (0)
    if (IN(0)) for (int rep_ = 0; rep_ < REPS(0); ++rep_) { p0_prologue(F, args); } SEAM(0);
    if (IN(1)) { const int nu1 = (T / 256) * 23, R1 = (nu1 + F.G - 1) / F.G + 1, GG = (nu1 + R1 - 1) / R1;
                 if (bx < GG) { InProjSched S{(const char*)(ws + WS_NX), (const char*)(ws + WS_WIN), GG, bx, REPS(1) - 1};
                 EpiInProj E{(bf16*)(ws + WS_Q), (bf16*)(ws + WS_K), (bf16*)(ws + WS_ZU), (bf16*)(ws + WS_GA), (bf16*)(ws + WS_GG), (bf16*)(ws + WS_VT), (bf16*)(ws + WS_ZVT)};
                 pg8::gemm_phase(F.lds, D, S, E, F.wave); }
                 convert_queue(F, args, (unsigned*)(ws + WS_CTL) + CW_Q1, 0, BG_P1); convert_queue(F, args, (unsigned*)(ws + WS_CTL) + CW_Q3, BG_N, BG_ALL); convert_p_queue(F, args, (unsigned*)(ws + WS_CTL) + CW_Q4); } SEAM(1);
    if (IN(2)) { attn_phase(F, args); spatial_phase(F, args); } SEAM(2);
    if (IN(3)) { merge_phase(F, args); } SEAM(3);
    if (IN(4)) { PlainSched S{(const char*)(ws + WS_AG), (const char*)(ws + WS_WCAT), T / 256, 4, D, F.G, bx, REPS(4) - 1}; EpiMerge E{(bf16*)(ws + WS_MRG), (const bf16*)(ws + WS_GA), (const bf16*)(ws + WS_GG)};
                 pg8::gemm_phase(F.lds, D, S, E, F.wave); } SEAM(5);
    if (IN(6)) { PlainSched S{(const char*)(ws + WS_MRG), (const char*)(ws + WS_WOUT), T / 256, 4, D, F.G, bx, REPS(6) - 1}; EpiF32<0> E{args.out, args.in[0], nullptr};
                 pg8::gemm_phase(F.lds, D, S, E, F.wave); } SEAM(6);
    if (IN(7)) for (int rep_ = 0; rep_ < REPS(7); ++rep_) { router_phase(F, args); } SEAM(7);
    if (IN(8)) { load_tile_starts(F, args); const LAS int* ts = (const LAS int*)(F.lds + TS_OFF);
                 const int nu8 = ts[32] * 8, R8 = (nu8 + F.G - 1) / F.G, GG = R8 > 0 ? (nu8 + R8 - 1) / R8 : 1;
                 if (bx < GG) { MoeSched S{(const char*)(ws + WS_NX), (const char*)(ws + WS_WGU), (const int*)(ws + WS_LIST), ts, 8, D, GG, bx, 1, REPS(8) - 1}; EpiMoeUp E{(bf16*)(ws + WS_ACT), args.in[16], (const float*)(ws + WS_SRSTD), ts};
                 pg8::gemm_phase(F.lds, D, S, E, F.wave); }
                 convert_queue(F, args, (unsigned*)(ws + WS_CTL) + CW_Q2, BG_GU, BG_N); } SEAM(8);
    if (IN(9)) { load_tile_starts(F, args); const LAS int* ts = (const LAS int*)(F.lds + TS_OFF);
                 const int nu9 = ts[32] * 4, R9 = (nu9 + F.G - 1) / F.G, GG = R9 > 0 ? (nu9 + R9 - 1) / R9 : 1, NH = F.G - GG;
                 if (bx < GG) { MoeSched S{(const char*)(ws + WS_ACT), (const char*)(ws + WS_WD), (const int*)(ws + WS_LIST), ts, 4, D, GG, bx, 0, REPS(9) - 1}; EpiMoeDown E{(bf16*)(ws + WS_Y), args.in[18], (const float*)(ws + WS_SGATE), ts};
                 pg8::gemm_phase(F.lds, D, S, E, F.wave); }
                 if (NH >= 8 ? bx >= GG : true) { PlainSched S{(const char*)(ws + WS_PB), (const char*)(ws + WS_WPP), T / 256, 4, PLE, NH >= 8 ? NH : F.G, NH >= 8 ? bx - GG : bx, 0}; EpiBf<0> E{(bf16*)(ws + WS_PP), nullptr, nullptr};
                 pg8::gemm_phase(F.lds, PLE, S, E, F.wave); } } SEAM(9);
    if (IN(10)) for (int rep_ = 0; rep_ < REPS(10); ++rep_) { load_tile_starts(F, args); combine_phase(F, args); } SEAM(10);
    if (IN(11)) { PlainSched S{(const char*)(ws + WS_NX), (const char*)(ws + WS_WPG), T / 256, 4, D, F.G, bx, REPS(11) - 1}; EpiPle E{(bf16*)(ws + WS_T1), (const bf16*)(ws + WS_PP)};
                  pg8::gemm_phase(F.lds, D, S, E, F.wave); } SEAM(11);
    if (IN(12)) for (int rep_ = 0; rep_ < REPS(12); ++rep_) { final_phase(F, args); }
#undef IN
#undef SEAM
}

extern "C" void kernel_launch(void* const* d_in, const int* in_sizes, int n_in, void* d_out, int out_size, void* d_ws, size_t ws_size, hipStream_t stream) {
    static int grid = 0;
    if (grid == 0) {
        if (n_in != 23 || out_size != T * D || ws_size < WS_END) { fprintf(stderr, "kernel_launch: unexpected shapes (n_in %d out %d ws %zu)\n", n_in, out_size, ws_size); grid = -1; return; }
        int dev = 0, cus = 0, per_cu = 0;
        if (hipGetDevice(&dev) != hipSuccess || hipDeviceGetAttribute(&cus, hipDeviceAttributeMultiprocessorCount, dev) != hipSuccess) { grid = -1; return; }
        if (hipFuncSetAttribute((const void*)fwd_kernel, hipFuncAttributeMaxDynamicSharedMemorySize, LDS_BYTES) != hipSuccess) { fprintf(stderr, "kernel_launch: hipFuncSetAttribute failed\n"); grid = -1; return; }
        if (hipOccupancyMaxActiveBlocksPerMultiprocessor(&per_cu, (const void*)fwd_kernel, 512, LDS_BYTES) != hipSuccess || per_cu < 1) { fprintf(stderr, "kernel_launch: occupancy query says %d\n", per_cu); (void)hipGetLastError(); grid = -1; return; }
        grid = cus;
    }
    if (grid < 0) return;
    (void)hipMemsetAsync((char*)d_ws + WS_CTL, 0, CTL_ZERO_BYTES, stream);
    Args a{};
    for (int i = 0; i < 23; ++i) a.in[i] = (const float*)d_in[i];
    a.out = (float*)d_out; a.ws = (unsigned char*)d_ws;
#if MK_N_LAUNCHES == 1
    a.ph_lo = 0; a.ph_hi = NPHASE;
    hipLaunchKernelGGL(fwd_kernel, dim3(grid), dim3(512), LDS_BYTES, stream, a);
#else
    for (int ph = 0; ph < NPHASE; ++ph) { a.ph_lo = ph; a.ph_hi = ph + 1; hipLaunchKernelGGL(fwd_kernel, dim3(grid), dim3(512), LDS_BYTES, stream, a); }
#endif
}
```

```cpp
#include <hip/hip_runtime.h>
#include <cstdio>
#include <cstdint>

#ifndef MK_N_LAUNCHES
#define MK_N_LAUNCHES 1
#endif

constexpr int NB = 8, SEQ = 4096, T = NB * SEQ, D = 1024;
constexpr int ATT_W = 768, GM_W = 768, IN_W = 5888, NE = 32, TOPK = 4, PLE = 256;
constexpr float EPS = 1e-6f;
constexpr float LOG2E = 1.4426950408889634f, LN2 = 0.6931471805599453f;
constexpr float QSCALE = 0.125f * LOG2E;

#define LAS __attribute__((address_space(3)))
#define GAS __attribute__((address_space(1)))
typedef unsigned short bf16;
typedef unsigned v4u __attribute__((ext_vector_type(4)));
typedef unsigned v2u __attribute__((ext_vector_type(2)));
typedef float f32x4 __attribute__((ext_vector_type(4)));
typedef float f32x2 __attribute__((ext_vector_type(2)));
typedef float f32x16 __attribute__((ext_vector_type(16)));
typedef short bf16x8 __attribute__((ext_vector_type(8)));
typedef short s16x4 __attribute__((ext_vector_type(4)));

__device__ __forceinline__ unsigned f2bf(float f) { unsigned u = __builtin_bit_cast(unsigned, f); return (u + 0x7fffu + ((u >> 16) & 1u)) >> 16; }
__device__ __forceinline__ unsigned pk2(float lo, float hi) { return f2bf(lo) | (f2bf(hi) << 16); }
__device__ __forceinline__ float bflo(unsigned w) { return __builtin_bit_cast(float, w << 16); }
__device__ __forceinline__ float bfhi(unsigned w) { return __builtin_bit_cast(float, w & 0xffff0000u); }
typedef __bf16 bf16x2_t __attribute__((ext_vector_type(2)));
__device__ __forceinline__ unsigned cvt_pk_bf16(float lo, float hi) { const f32x2 v = {lo, hi}; const bf16x2_t b = __builtin_convertvector(v, bf16x2_t); return __builtin_bit_cast(unsigned, b); }
__device__ __forceinline__ float sigmoidf_(float x) { return __builtin_amdgcn_rcpf(1.0f + __builtin_amdgcn_exp2f(-x * LOG2E)); }
__device__ __forceinline__ f32x2 gelu_pk(f32x2 v) {
    const f32x2 av = __builtin_elementwise_abs(v), d = av * 0.2316418882f + 1.0f;
    f32x2 t; t.x = __builtin_amdgcn_rcpf(d.x); t.y = __builtin_amdgcn_rcpf(d.y);
    f32x2 q = t * 0.5307027145f + (-0.7265760135f); q = q * t + 0.7107068705f; q = q * t + (-0.142248368f); q = q * t + 0.127414796f; q = q * t;
    const f32x2 s = (v * v) * (-0.72134752044f);
    f32x2 e; e.x = __builtin_amdgcn_exp2f(s.x); e.y = __builtin_amdgcn_exp2f(s.y);
    const f32x2 m = v * (q * e), r = v - m;
    f32x2 o; o.x = v.x < 0.f ? m.x : r.x; o.y = v.y < 0.f ? m.y : r.y; return o;
}
__device__ __forceinline__ f32x4 gelu4(f32x4 v) { f32x2 a = gelu_pk((f32x2){v[0], v[1]}), b = gelu_pk((f32x2){v[2], v[3]}); return (f32x4){a.x, a.y, b.x, b.y}; }
__device__ __forceinline__ f32x4 sigm4(f32x4 v) { return (f32x4){sigmoidf_(v[0]), sigmoidf_(v[1]), sigmoidf_(v[2]), sigmoidf_(v[3])}; }
__device__ __forceinline__ int tid_opaque(int wave) {
    int l; asm volatile("v_mbcnt_lo_u32_b32 %0, -1, 0\n\tv_mbcnt_hi_u32_b32 %0, -1, %0" : "=v"(l));
    return wave * 64 + l;
}
__device__ __forceinline__ float wave_sum(float v) {
#pragma unroll
    for (int o = 1; o < 64; o <<= 1) v += __shfl_xor(v, o);
    return v;
}

constexpr size_t MiB = 1u << 20;
constexpr size_t WS_CTL = 0, CTL_ZERO_BYTES = 1 * MiB;
constexpr size_t WS_WIN = 2 * MiB;
constexpr size_t WS_WCAT = 14 * MiB;
constexpr size_t WS_WOUT = 17 * MiB;
constexpr size_t WS_WPG = 19 * MiB;
constexpr size_t WS_WPP = 21 * MiB;
constexpr size_t WS_WSP = 22 * MiB;
constexpr size_t WS_WRH = 23 * MiB;
constexpr size_t WS_WRL = 23 * MiB + 65536;
constexpr size_t WS_SRSTD = 980 * MiB;
constexpr size_t WS_WGU = 24 * MiB;
constexpr size_t WS_WD = 152 * MiB;
constexpr size_t WS_NX = 216 * MiB;
constexpr size_t WS_PB = 280 * MiB;
constexpr size_t WS_PP = 296 * MiB;
constexpr size_t WS_LIST = 360 * MiB;
constexpr size_t WS_SGATE = 364 * MiB;
constexpr size_t WS_POS = 368 * MiB;
constexpr size_t WS_LSE = 369 * MiB;
constexpr size_t WS_Q = 372 * MiB;
constexpr size_t WS_K = 420 * MiB;
constexpr size_t WS_VT = 468 * MiB;
constexpr size_t WS_ZU = 516 * MiB;
constexpr size_t WS_ZVT = 564 * MiB;
constexpr size_t WS_GA = 612 * MiB;
constexpr size_t WS_GG = 676 * MiB;
constexpr size_t WS_OG = 740 * MiB;
constexpr size_t WS_ATT = 788 * MiB;
constexpr size_t WS_G = 804 * MiB;
constexpr size_t WS_AG = 852 * MiB;
constexpr size_t WS_MRG = 916 * MiB;
constexpr size_t WS_ACT = 372 * MiB;
constexpr size_t WS_Y = 644 * MiB;
constexpr size_t WS_H2 = 436 * MiB;
constexpr size_t WS_T1 = 372 * MiB;
constexpr size_t WS_END = 984 * MiB;
constexpr int PMAX_TILES = 544;

constexpr int CW_CNT = 64;
constexpr int CW_Q1 = 256, CW_Q2 = 320, CW_Q3 = 384, CW_Q4 = 448;
constexpr int CW_BAR = 4096;

constexpr int RING_BYTES = 131072;
constexpr int MISC_OFF = RING_BYTES + 320;
constexpr int TS_OFF = RING_BYTES + 1024;
constexpr int LDS_BYTES = 147456;

namespace pg8 {
typedef unsigned short bf16_t;
constexpr int BM = 256, BK = 64, HALF = 128, HTB = HALF * BK * 2, STAGE_BYTES = 8 * HTB, NXCD = 8, WGM = 8;
__host__ __device__ __forceinline__ int lds_byte(int r, int c) { const int st = (r >> 4) * 2 + (c >> 5), rr = r & 15, cc = c & 31, ob = rr * 64 + cc * 2; return st * 1024 + (ob ^ (((ob >> 9) & 1) << 5)); }
__host__ __device__ __forceinline__ void stage_rc(int b, int& R, int& C) { const int st = b / 1024, sb = b % 1024, swz = sb ^ (((sb >> 9) & 1) << 5); R = (st >> 1) * 16 + swz / 64; C = (st & 1) * 32 + (swz % 64) / 2; }
__host__ __device__ __forceinline__ int perm32(int rho) { const int n = rho >> 4, i = rho & 15; return 8 * (i >> 2) + 4 * n + (i & 3); }

struct Unit { const char* a; const char* b; int pm, pn, x0, x1; };

__device__ __forceinline__ bool static_order(int i, int G, int c, int nM, int nN, int& pm, int& pn) {
    const int nwg = nM * nN; const long L = (long)i * G + c; if (L >= nwg) return false;
    int wgid = (int)L; { const int q = nwg / NXCD, r = nwg % NXCD, xcd = wgid % NXCD, off = wgid / NXCD; wgid = (xcd < r ? xcd * (q + 1) : r * (q + 1) + (xcd - r) * q) + off; }
    const int nig = WGM * nN, gid = wgid / nig, fm = gid * WGM, gsz = (nM - fm) < WGM ? (nM - fm) : WGM;
    pm = fm + ((wgid % nig) % gsz); pn = (wgid % nig) / gsz; return true;
}

template <class Epi, class Sched>
__device__ __forceinline__ void gemm_phase(LAS unsigned char* lds, const int K, const Sched& S, const Epi& E, const int wave) {
    const int wid = wave, tid = tid_opaque(wid), lane = tid & 63, wr = wid >> 2, wc = wid & 3, fr = lane & 15, fq = lane >> 4;
    const int nt = K / BK;
    int RA[2]; unsigned CB2[2], rbk[2];
#pragma unroll
    for (int i = 0; i < 2; ++i) { int R, C; stage_rc(tid * 16 + i * 8192, R, C); const int Rb = Epi::PERM ? ((R & ~31) + perm32(R & 31)) : R;
        RA[i] = R; CB2[i] = (unsigned)C * 2u; rbk[i] = (unsigned)(Rb * K) * 2u; }
    const size_t kstep = (size_t)(BK * 2);
    const size_t hstep = (size_t)HALF * K * 2;
    const unsigned ldsw = (unsigned)wid * 1024u;
    const int aoff = lds_byte(wr * 64 + fr, fq * 8), boff = lds_byte(wc * 32 + fr, fq * 8);
#define PG8_SA(b, h) (((b) * 2 + (h)) * HTB)
#define PG8_SB(b, h) ((4 + (b) * 2 + (h)) * HTB)
#define PG8_STAGE(bufoff, gbase, voff) do { _Pragma("unroll") for (int _i = 0; _i < 2; ++_i) \
        __builtin_amdgcn_global_load_lds((const unsigned*)((const char*)(gbase) + (voff)[_i]), (LAS unsigned*)(lds + (bufoff) + ldsw + _i * 8192), 16, 0, 0); } while (0)
#define PG8_LDA(dst, b, h) do { _Pragma("unroll") for (int m = 0; m < 4; ++m) _Pragma("unroll") for (int k = 0; k < 2; ++k) dst[m][k] = *(const LAS bf16x8*)(lds + PG8_SA(b, h) + aoff + m * 2048 + k * 1024); } while (0)
#define PG8_LDB(dst, b, h) do { _Pragma("unroll") for (int n = 0; n < 2; ++n) _Pragma("unroll") for (int k = 0; k < 2; ++k) dst[n][k] = *(const LAS bf16x8*)(lds + PG8_SB(b, h) + boff + n * 2048 + k * 1024); } while (0)
#define PG8_MMA(ai, bj, At, Bt) do { __builtin_amdgcn_s_setprio(1); _Pragma("unroll") for (int m = 0; m < 4; ++m) _Pragma("unroll") for (int n = 0; n < 2; ++n) _Pragma("unroll") for (int k = 0; k < 2; ++k) \
        acc[ai][bj][m][n] = __builtin_amdgcn_mfma_f32_16x16x32_bf16(Bt[n][k], At[m][k], acc[ai][bj][m][n], 0, 0, 0); __builtin_amdgcn_s_setprio(0); } while (0)
#define PG8_WAIT_V(n) asm volatile("s_waitcnt vmcnt(" #n ")" ::: "memory")
#define PG8_WAIT_L(n) asm volatile("s_waitcnt lgkmcnt(" #n ")" ::: "memory")
#define PG8_BAR __builtin_amdgcn_s_barrier()
#define PG8_SCHED __builtin_amdgcn_sched_barrier(0)
    Unit cur, nxt; int ui = 0;
    if (!S.next(0, cur)) return;
    f32x4 acc[2][2][4][2];
#pragma unroll
    for (int a = 0; a < 2; ++a)
#pragma unroll
        for (int b = 0; b < 2; ++b)
#pragma unroll
            for (int m = 0; m < 4; ++m)
#pragma unroll
                for (int n = 0; n < 2; ++n) acc[a][b][m][n] = (f32x4){0.f, 0.f, 0.f, 0.f};
    bf16x8 At[4][2], B0[2][2], B1[2][2];
    const char* cA = cur.a; const char* cB = cur.b;
    unsigned oA[2][2], nO[2][2];
#pragma unroll
    for (int h = 0; h < 2; ++h)
#pragma unroll
        for (int i = 0; i < 2; ++i) oA[h][i] = S.a_off(cur, h * HALF + RA[i], K) + CB2[i];
    int csh = S.b_shift(cur); unsigned vbc[2] = {(rbk[0] << csh) + CB2[0], (rbk[1] << csh) + CB2[1]}, vbn[2];
    PG8_STAGE(PG8_SB(0, 0), cB, vbc); PG8_STAGE(PG8_SB(0, 1), cB + (hstep << csh), vbc); PG8_STAGE(PG8_SA(0, 0), cA, oA[0]); PG8_STAGE(PG8_SA(0, 1), cA, oA[1]);
    if (wr == 1) PG8_BAR;
    PG8_WAIT_V(2); PG8_BAR;
    PG8_STAGE(PG8_SB(1, 0), cB + kstep, vbc); PG8_STAGE(PG8_SA(1, 0), cA + kstep, oA[0]); PG8_STAGE(PG8_SB(1, 1), cB + (hstep << csh) + kstep, vbc);
    PG8_WAIT_V(6); PG8_BAR;
    for (;;) {
        const bool has_next = S.next(ui + 1, nxt);
        const char* nA = has_next ? nxt.a : cA; const char* nB = has_next ? nxt.b : cB;
        const int nsh = has_next ? S.b_shift(nxt) : csh; vbn[0] = (rbk[0] << nsh) + CB2[0]; vbn[1] = (rbk[1] << nsh) + CB2[1];
#pragma unroll
        for (int h = 0; h < 2; ++h)
#pragma unroll
            for (int i = 0; i < 2; ++i) nO[h][i] = has_next ? (S.a_off(nxt, h * HALF + RA[i], K) + CB2[i]) : oA[h][i];
#pragma unroll 1
        for (int t = 0; t < nt; t += 2) {
            const bool last = (t == nt - 2);
            const char* a1 = cA + (size_t)(t + 1) * kstep;
            const char* a2 = last ? nA : cA + (size_t)(t + 2) * kstep; const char* b2 = last ? nB : cB + (size_t)(t + 2) * kstep;
            const char* a3 = a2 + kstep; const char* b3 = b2 + kstep;
            unsigned o2[2][2]; const unsigned vb2[2] = {last ? vbn[0] : vbc[0], last ? vbn[1] : vbc[1]}; const size_t hs2 = hstep << (last ? nsh : csh);
#pragma unroll
            for (int h = 0; h < 2; ++h)
#pragma unroll
                for (int i = 0; i < 2; ++i) o2[h][i] = last ? nO[h][i] : oA[h][i];
            PG8_LDB(B0, 0, 0); PG8_LDB(B1, 0, 1); PG8_SCHED; PG8_LDA(At, 0, 0); PG8_STAGE(PG8_SA(1, 1), a1, oA[1]);
            PG8_WAIT_V(8); PG8_WAIT_L(0); PG8_BAR; PG8_MMA(0, 0, At, B0); PG8_MMA(0, 1, At, B1); PG8_BAR; PG8_SCHED;
            PG8_LDA(At, 0, 1); PG8_STAGE(PG8_SB(0, 0), b2, vb2); PG8_STAGE(PG8_SB(0, 1), b2 + hs2, vb2); PG8_STAGE(PG8_SA(0, 0), a2, o2[0]);
            PG8_WAIT_V(8); PG8_WAIT_L(0); PG8_BAR; PG8_MMA(1, 0, At, B0); PG8_MMA(1, 1, At, B1); PG8_BAR; PG8_SCHED;
            PG8_LDB(B0, 1, 0); PG8_LDB(B1, 1, 1); PG8_SCHED; PG8_LDA(At, 1, 0); PG8_STAGE(PG8_SA(0, 1), a2, o2[1]);
            PG8_WAIT_V(8); PG8_WAIT_L(0); PG8_BAR; PG8_MMA(0, 0, At, B0); PG8_MMA(0, 1, At, B1); PG8_BAR; PG8_SCHED;
            PG8_LDA(At, 1, 1); PG8_STAGE(PG8_SB(1, 0), b3, vb2); PG8_STAGE(PG8_SB(1, 1), b3 + hs2, vb2); PG8_STAGE(PG8_SA(1, 0), a3, o2[0]);
            PG8_WAIT_V(8); PG8_WAIT_L(0); PG8_BAR; PG8_MMA(1, 0, At, B0); PG8_MMA(1, 1, At, B1); PG8_BAR; PG8_SCHED;
            if constexpr (Epi::HOOK_T >= 0) { if (t == Epi::HOOK_T) { E.mid(acc, cur, wr, wc, fr, fq); PG8_SCHED; } }
        }
        if (wr == 0) PG8_BAR;
        E(acc, cur, wr, wc, fr, fq);
        if (!has_next) break;
#pragma unroll
        for (int a = 0; a < 2; ++a)
#pragma unroll
            for (int b = 0; b < 2; ++b)
#pragma unroll
                for (int m = 0; m < 4; ++m)
#pragma unroll
                    for (int n = 0; n < 2; ++n) acc[a][b][m][n] = (f32x4){0.f, 0.f, 0.f, 0.f};
        cur = nxt; cA = nA; cB = nB; ++ui; csh = nsh; vbc[0] = vbn[0]; vbc[1] = vbn[1];
#pragma unroll
        for (int h = 0; h < 2; ++h)
#pragma unroll
            for (int i = 0; i < 2; ++i) oA[h][i] = nO[h][i];
        if (wr == 1) PG8_BAR;
    }
    PG8_WAIT_V(0);
    PG8_BAR;
#undef PG8_SA
#undef PG8_SB
#undef PG8_STAGE
#undef PG8_LDA
#undef PG8_LDB
#undef PG8_MMA
#undef PG8_WAIT_V
#undef PG8_WAIT_L
#undef PG8_BAR
#undef PG8_SCHED
}
}
using pg8::Unit;
typedef f32x4 Acc[2][2][4][2];

struct PlainSched {
    const char* A; const char* Bt; int nM, nN, K, G, c, rsh;
    __device__ __forceinline__ bool next(int i, Unit& u) const {
        int pm, pn; if (!pg8::static_order(i >> rsh, G, c, nM, nN, pm, pn)) return false;
        u.pm = pm; u.pn = pn; u.x0 = 0; u.x1 = 0; u.a = A + (size_t)pm * 256 * K * 2; u.b = Bt + (size_t)pn * 256 * K * 2; return true;
    }
    __device__ __forceinline__ unsigned a_off(const Unit&, int row, int K_) const { return (unsigned)(row * K_) * 2u; }
    __device__ __forceinline__ int b_shift(const Unit&) const { return 0; }
};
struct InProjSched {
    const char* NX; const char* Wt; int G, c, rsh;
    __device__ __forceinline__ bool next(int i, Unit& u) const {
        int pm, pn; if (!pg8::static_order(i >> rsh, G, c, T / 256, 23, pm, pn)) return false;
        u.pm = pm; u.pn = pn; u.x0 = 0; u.x1 = 0;
        const char* xa = NX + (size_t)pm * 256 * D * 2; const char* wb = Wt + (size_t)pn * 256 * D * 2;
        if (pn < 17) { u.a = xa; u.b = wb; } else { u.a = wb; u.b = xa;
            if (pn < 20) { const int sh = 2 * (pn - 17), j0 = (pm & 15) * 256, r = j0 >> (12 - sh), i0 = j0 & ((SEQ >> sh) - 1);
                u.x0 = sh; u.b = NX + ((size_t)(pm >> 4) * SEQ + ((size_t)i0 << sh) + r) * D * 2; } }
        return true;
    }
    __device__ __forceinline__ unsigned a_off(const Unit&, int row, int K_) const { return (unsigned)(row * K_) * 2u; }
    __device__ __forceinline__ int b_shift(const Unit& u) const { return u.x0; }
};
struct MoeSched {
    const char* A; const char* Bt; const int* list; const LAS int* ts; int nN, K, G, c, gather, rsh;
    __device__ __forceinline__ bool next(int i, Unit& u) const {
        const int MT = ts[32];
        int pm, pn; if (!pg8::static_order(i >> rsh, G, c, MT, nN, pm, pn)) return false;
        int e = 0;
#pragma unroll
        for (int s = 16; s >= 1; s >>= 1) { if (ts[e + s] <= pm) e += s; }
        e = __builtin_amdgcn_readfirstlane(e);
        u.pm = pm; u.pn = pn; u.x0 = e; u.x1 = __builtin_amdgcn_readfirstlane(pm - ts[e]);
        u.a = gather ? A : A + (size_t)pm * 256 * K * 2;
        u.b = Bt + ((size_t)e * nN + pn) * 256 * K * 2;
        return true;
    }
    __device__ __forceinline__ unsigned a_off(const Unit& u, int row, int K_) const {
        if (!gather) return (unsigned)(row * K_) * 2u;
        const int slot = u.x1 * 256 + row, cnt = ts[40 + u.x0];
        const int tok = slot < cnt ? list[u.x0 * 32768 + slot] : 0;
        return (unsigned)(tok * K_) * 2u;
    }
    __device__ __forceinline__ int b_shift(const Unit&) const { return 0; }
};

__device__ __forceinline__ void st8(bf16* p, f32x4 v0, f32x4 v1) { v4u w; w.x = cvt_pk_bf16(v0[0], v0[1]); w.y = cvt_pk_bf16(v0[2], v0[3]); w.z = cvt_pk_bf16(v1[0], v1[1]); w.w = cvt_pk_bf16(v1[2], v1[3]); *(v4u*)p = w; }
__device__ __forceinline__ v4u widen_pair(v2u a, v2u b) {
    auto rx = __builtin_amdgcn_permlane32_swap(a.x, b.x, false, false); auto ry = __builtin_amdgcn_permlane32_swap(a.y, b.y, false, false);
    v4u w; w.x = rx[0]; w.y = ry[0]; w.z = rx[1]; w.w = ry[1]; return w;
}
__device__ __forceinline__ void ld8(const bf16* p, f32x4& v0, f32x4& v1) { const v4u w = *(const v4u*)p; v0 = (f32x4){bflo(w.x), bfhi(w.x), bflo(w.y), bfhi(w.y)}; v1 = (f32x4){bflo(w.z), bfhi(w.z), bflo(w.w), bfhi(w.w)}; }

struct EpiInProj {
    static constexpr bool PERM = true; static constexpr int HOOK_T = -1;
    bf16 *Q, *Kb, *ZU, *GA, *GG, *VT, *ZVT;
    template <int ACT> __device__ __forceinline__ void std_store(const Acc& acc, bf16* base, int ldc, int colt, int pm, int wr, int wc, int fr, int fq) const {
        const int row0 = pm * 256 + wr * 64 + fr, col0 = colt + wc * 32 + 8 * fq;
#pragma unroll
        for (int ai = 0; ai < 2; ++ai)
#pragma unroll
            for (int m = 0; m < 4; ++m) { bf16* rowp = base + (size_t)(row0 + ai * 128 + m * 16) * ldc + col0;
#pragma unroll
                for (int bj = 0; bj < 2; ++bj) { f32x4 v0 = acc[ai][bj][m][0], v1 = acc[ai][bj][m][1];
                    if (ACT == 1) { v0 = v0 * QSCALE; v1 = v1 * QSCALE; }
                    if (ACT == 2) { v0 = gelu4(v0); v1 = gelu4(v1); }
                    if (ACT == 3) { v0 = sigm4(v0); v1 = sigm4(v1); }
                    st8(rowp + bj * 128, v0, v1); } }
    }
    template <int ACT> __device__ __forceinline__ void tile_store(const Acc& acc, bf16* base, int g, int pm, int wr, int wc, int fr, int fq) const {
        const int dsh = 2 * g, row0 = pm * 256 + wr * 64 + fr;
#pragma unroll
        for (int ai = 0; ai < 2; ++ai)
#pragma unroll
            for (int m = 0; m < 4; ++m) { const int t = row0 + ai * 128 + m * 16, bb = t >> 12, sq = t & (SEQ - 1), r = sq & ((1 << dsh) - 1), i = sq >> dsh, kb = i >> 5, key = i & 31;
#pragma unroll
                for (int bj = 0; bj < 2; ++bj) { const int cw = bj * 128 + wc * 32 + 8 * fq, hh = cw >> 6, dd = cw & 63;
                    f32x4 v0 = acc[ai][bj][m][0], v1 = acc[ai][bj][m][1];
                    if (ACT == 1) { v0 = v0 * QSCALE; v1 = v1 * QSCALE; }
                    st8(base + ((size_t)((bb * 3 + g) * 4 + hh) * 128 + (size_t)((r << (7 - dsh)) + kb)) * 2048 + key * 64 + dd, v0, v1); } }
    }
    __device__ __forceinline__ void operator()(const Acc& acc, const Unit& u, int wr, int wc, int fr, int fq) const {
        const int pn = u.pn, pm = u.pm;
        if (pn < 3) tile_store<1>(acc, Q, pn, pm, wr, wc, fr, fq);
        else if (pn < 6) tile_store<0>(acc, Kb, pn - 3, pm, wr, wc, fr, fq);
        else if (pn < 9) std_store<2>(acc, ZU, GM_W, (pn - 6) * 256, pm, wr, wc, fr, fq);
        else if (pn < 13) std_store<3>(acc, GA, D, (pn - 9) * 256, pm, wr, wc, fr, fq);
        else if (pn < 17) std_store<3>(acc, GG, D, (pn - 13) * 256, pm, wr, wc, fr, fq);
        else if (pn < 20) {
            const int g = pn - 17, sh = 2 * g, bb = pm >> 4, j0 = (pm & 15) * 256, r = j0 >> (12 - sh), i0 = j0 & ((SEQ >> sh) - 1), nKB = 128 >> sh;
#pragma unroll
            for (int ai = 0; ai < 2; ++ai)
#pragma unroll
                for (int m = 0; m < 4; ++m) { const int chl = ai * 128 + wr * 64 + m * 16 + fr, hh = chl >> 6, dd = chl & 63;
                    bf16* hb = VT + (size_t)((bb * 3 + g) * 4 + hh) * (128 * 64 * 32) + dd * 32;
#pragma unroll
                    for (int bj = 0; bj < 2; ++bj) { const int i = i0 + bj * 128 + wc * 32 + 8 * fq;
                        st8(hb + (size_t)(r * nKB + (i >> 5)) * 2048 + (i & 31), acc[ai][bj][m][0], acc[ai][bj][m][1]); } }
        } else {
            const int ch0 = (pn - 20) * 256 + wr * 64 + fr, tin = wc * 32 + 8 * fq;
#pragma unroll
            for (int ai = 0; ai < 2; ++ai)
#pragma unroll
                for (int m = 0; m < 4; ++m) { const int ch = ch0 + ai * 128 + m * 16;
#pragma unroll
                    for (int bj = 0; bj < 2; ++bj) st8(ZVT + ((size_t)(2 * pm + bj) * GM_W + ch) * 128 + tin, gelu4(acc[ai][bj][m][0]), gelu4(acc[ai][bj][m][1])); }
        }
    }
};
template <int MODE> struct EpiBf {
    static constexpr bool PERM = true; static constexpr int HOOK_T = -1;
    bf16* O; const bf16* G1; const bf16* Y0;
    __device__ __forceinline__ void operator()(const Acc& acc, const Unit& u, int wr, int wc, int fr, int fq) const {
        const int row0 = u.pm * 256 + wr * 64 + fr, col0 = u.pn * 256 + wc * 32 + 8 * fq;
#pragma unroll
        for (int ai = 0; ai < 2; ++ai) {
            v4u gw[4][2], yw[4][2];
            if (MODE >= 1) {
#pragma unroll
                for (int m = 0; m < 4; ++m)
#pragma unroll
                    for (int bj = 0; bj < 2; ++bj) { const size_t off = (size_t)(row0 + ai * 128 + m * 16) * D + col0 + bj * 128; gw[m][bj] = *(const v4u*)(G1 + off); if (MODE == 2) yw[m][bj] = *(const v4u*)(Y0 + off); }
                __builtin_amdgcn_sched_barrier(0);
            }
#pragma unroll
            for (int m = 0; m < 4; ++m)
#pragma unroll
                for (int bj = 0; bj < 2; ++bj) { const size_t off = (size_t)(row0 + ai * 128 + m * 16) * D + col0 + bj * 128; f32x4 v0 = acc[ai][bj][m][0], v1 = acc[ai][bj][m][1];
                    if (MODE >= 1) { const v4u w = gw[m][bj]; v0 = v0 * (f32x4){bflo(w.x), bfhi(w.x), bflo(w.y), bfhi(w.y)}; v1 = v1 * (f32x4){bflo(w.z), bfhi(w.z), bflo(w.w), bfhi(w.w)}; }
                    if (MODE == 2) { const v4u w = yw[m][bj]; v0 = v0 + (f32x4){bflo(w.x), bfhi(w.x), bflo(w.y), bfhi(w.y)}; v1 = v1 + (f32x4){bflo(w.z), bfhi(w.z), bflo(w.w), bfhi(w.w)}; }
                    st8(O + off, v0, v1); }
            if (MODE >= 1) __builtin_amdgcn_sched_barrier(0);
        }
    }
};
template <int MODE> struct EpiF32 {
    static constexpr bool PERM = false; static constexpr int HOOK_T = -1;
    float* H; const float* X; const bf16* PP;
    __device__ __forceinline__ void operator()(const Acc& acc, const Unit& u, int wr, int wc, int fr, int fq) const {
        const int row0 = u.pm * 256 + wr * 64 + fr, col0 = u.pn * 256 + wc * 32 + 4 * fq;
        const float* src = MODE == 0 ? X : H;
        constexpr int MB = MODE == 0 ? 4 : 2;
#pragma unroll
        for (int ai = 0; ai < 2; ++ai)
#pragma unroll
            for (int mb = 0; mb < 4; mb += MB) {
                f32x4 xv[MB][2][2]; v2u pw[MB][2][2];
#pragma unroll
                for (int m = 0; m < MB; ++m)
#pragma unroll
                    for (int bj = 0; bj < 2; ++bj)
#pragma unroll
                        for (int n = 0; n < 2; ++n) { const size_t o = (size_t)(row0 + ai * 128 + (mb + m) * 16) * D + col0 + bj * 128 + n * 16; xv[m][bj][n] = *(const f32x4*)(src + o); if (MODE == 1) pw[m][bj][n] = *(const v2u*)(PP + o); }
                __builtin_amdgcn_sched_barrier(0);
#pragma unroll
                for (int m = 0; m < MB; ++m)
#pragma unroll
                    for (int bj = 0; bj < 2; ++bj)
#pragma unroll
                        for (int n = 0; n < 2; ++n) { const size_t o = (size_t)(row0 + ai * 128 + (mb + m) * 16) * D + col0 + bj * 128 + n * 16; f32x4 v = acc[ai][bj][mb + m][n];
                            if (MODE == 0) v = v + xv[m][bj][n];
                            else { const v2u w = pw[m][bj][n]; v = xv[m][bj][n] + sigm4(v) * (f32x4){bflo(w.x), bfhi(w.x), bflo(w.y), bfhi(w.y)}; }
                            *(f32x4*)(H + o) = v; }
                __builtin_amdgcn_sched_barrier(0);
            }
    }
};
struct EpiMerge {
    static constexpr bool PERM = true; static constexpr int HOOK_T = 2;
    bf16* O; const bf16* GA; const bf16* GG;
    __device__ __forceinline__ void mid(Acc& acc, const Unit& u, int wr, int wc, int fr, int fq) const {
        int row0 = u.pm * 256 + wr * 64 + fr; const int col0 = u.pn * 256 + wc * 32 + 8 * fq;
        asm volatile("" : "+v"(row0));
#pragma unroll
        for (int ai = 0; ai < 2; ++ai)
#pragma unroll
            for (int mb = 0; mb < 4; mb += 2) {
                v4u aw[2][2], gw[2][2];
#pragma unroll
                for (int m = 0; m < 2; ++m)
#pragma unroll
                    for (int bj = 0; bj < 2; ++bj) { const size_t off = (size_t)(row0 + ai * 128 + (mb + m) * 16) * D + col0 + bj * 128; aw[m][bj] = *(const v4u*)(GA + off); gw[m][bj] = *(const v4u*)(GG + off); }
                __builtin_amdgcn_sched_barrier(0);
#pragma unroll
                for (int m = 0; m < 2; ++m)
#pragma unroll
                    for (int bj = 0; bj < 2; ++bj) { const v4u a = aw[m][bj], g = gw[m][bj];
                        acc[ai][bj][mb + m][0] = acc[ai][bj][mb + m][0] * (f32x4){bflo(a.x) * __builtin_amdgcn_rcpf(fmaxf(bflo(g.x), 1e-30f)), bfhi(a.x) * __builtin_amdgcn_rcpf(fmaxf(bfhi(g.x), 1e-30f)), bflo(a.y) * __builtin_amdgcn_rcpf(fmaxf(bflo(g.y), 1e-30f)), bfhi(a.y) * __builtin_amdgcn_rcpf(fmaxf(bfhi(g.y), 1e-30f))};
                        acc[ai][bj][mb + m][1] = acc[ai][bj][mb + m][1] * (f32x4){bflo(a.z) * __builtin_amdgcn_rcpf(fmaxf(bflo(g.z), 1e-30f)), bfhi(a.z) * __builtin_amdgcn_rcpf(fmaxf(bfhi(g.z), 1e-30f)), bflo(a.w) * __builtin_amdgcn_rcpf(fmaxf(bflo(g.w), 1e-30f)), bfhi(a.w) * __builtin_amdgcn_rcpf(fmaxf(bfhi(g.w), 1e-30f))}; }
                __builtin_amdgcn_sched_barrier(0);
            }
    }
    __device__ __forceinline__ void operator()(const Acc& acc, const Unit& u, int wr, int wc, int fr, int fq) const {
        const int row0 = u.pm * 256 + wr * 64 + fr, col0 = u.pn * 256 + wc * 32 + 8 * fq;
#pragma unroll
        for (int ai = 0; ai < 2; ++ai) {
            v4u gw[4][2];
#pragma unroll
            for (int m = 0; m < 4; ++m)
#pragma unroll
                for (int bj = 0; bj < 2; ++bj) gw[m][bj] = *(const v4u*)(GG + (size_t)(row0 + ai * 128 + m * 16) * D + col0 + bj * 128);
            __builtin_amdgcn_sched_barrier(0);
#pragma unroll
            for (int m = 0; m < 4; ++m)
#pragma unroll
                for (int bj = 0; bj < 2; ++bj) { const v4u g = gw[m][bj];
                    st8(O + (size_t)(row0 + ai * 128 + m * 16) * D + col0 + bj * 128, acc[ai][bj][m][0] * (f32x4){bflo(g.x), bfhi(g.x), bflo(g.y), bfhi(g.y)}, acc[ai][bj][m][1] * (f32x4){bflo(g.z), bfhi(g.z), bflo(g.w), bfhi(g.w)}); }
            __builtin_amdgcn_sched_barrier(0);
        }
    }
};
struct EpiPle {
    static constexpr bool PERM = true; static constexpr int HOOK_T = -1;
    bf16* O; const bf16* PP;
    __device__ __forceinline__ void operator()(const Acc& acc, const Unit& u, int wr, int wc, int fr, int fq) const {
        const int row0 = u.pm * 256 + wr * 64 + fr, col0 = u.pn * 256 + wc * 32 + 8 * fq;
#pragma unroll
        for (int ai = 0; ai < 2; ++ai) {
            v4u pw[4][2];
#pragma unroll
            for (int m = 0; m < 4; ++m)
#pragma unroll
                for (int bj = 0; bj < 2; ++bj) pw[m][bj] = *(const v4u*)(PP + (size_t)(row0 + ai * 128 + m * 16) * D + col0 + bj * 128);
            __builtin_amdgcn_sched_barrier(0);
#pragma unroll
            for (int m = 0; m < 4; ++m)
#pragma unroll
                for (int bj = 0; bj < 2; ++bj) { const v4u w = pw[m][bj];
                    const f32x4 v0 = sigm4(acc[ai][bj][m][0]) * (f32x4){bflo(w.x), bfhi(w.x), bflo(w.y), bfhi(w.y)}, v1 = sigm4(acc[ai][bj][m][1]) * (f32x4){bflo(w.z), bfhi(w.z), bflo(w.w), bfhi(w.w)};
                    st8(O + (size_t)(row0 + ai * 128 + m * 16) * D + col0 + bj * 128, v0, v1); }
            __builtin_amdgcn_sched_barrier(0);
        }
    }
};
struct EpiMoeUp {
    static constexpr bool PERM = true; static constexpr int HOOK_T = -1;
    bf16* ACT; const float* bgu; const float* srstd; const LAS int* ts;
    __device__ __forceinline__ void operator()(const Acc& acc, const Unit& u, int wr, int wc, int fr, int fq) const {
        const int e = u.x0, cnt = ts[40 + e], srow0 = u.x1 * 256 + wr * 64 + fr;
        const int row0 = u.pm * 256 + wr * 64 + fr, hc = u.pn * 128 + wc * 32 + 8 * fq;
        const float* bg = bgu + (size_t)e * 2048 + hc;
        const f32x4 bg0 = *(const f32x4*)bg, bg1 = *(const f32x4*)(bg + 4), bl0 = *(const f32x4*)(bg + 1024), bl1 = *(const f32x4*)(bg + 1028);
        float rsv[2][4];
#pragma unroll
        for (int ai = 0; ai < 2; ++ai)
#pragma unroll
            for (int m = 0; m < 4; ++m) { const int slot = srow0 + ai * 128 + m * 16; rsv[ai][m] = slot < cnt ? srstd[e * 32768 + slot] : 0.f; }
        __builtin_amdgcn_sched_barrier(0);
#pragma unroll
        for (int ai = 0; ai < 2; ++ai)
#pragma unroll
            for (int m = 0; m < 4; ++m) { const float rs = rsv[ai][m];
                f32x4 o[2];
#pragma unroll
                for (int n = 0; n < 2; ++n) { const f32x4 gu = acc[ai][0][m][n] * rs + (n ? bg1 : bg0), li = acc[ai][1][m][n] * rs + (n ? bl1 : bl0);
#pragma unroll
                    for (int e2 = 0; e2 < 4; ++e2) { const float gl = fminf(gu[e2], 7.0f), ln = fminf(fmaxf(li[e2], -7.0f), 7.0f);
                        o[n][e2] = gl * __builtin_amdgcn_rcpf(1.0f + __builtin_amdgcn_exp2f(-1.702f * LOG2E * gl)) * (ln + 1.0f); } }
                st8(ACT + (size_t)(row0 + ai * 128 + m * 16) * D + hc, o[0], o[1]); }
    }
};
struct EpiMoeDown {
    static constexpr bool PERM = true; static constexpr int HOOK_T = -1;
    bf16* Y; const float* bd; const float* sgate; const LAS int* ts;
    __device__ __forceinline__ void operator()(const Acc& acc, const Unit& u, int wr, int wc, int fr, int fq) const {
        const int e = u.x0, cnt = ts[40 + e], srow0 = u.x1 * 256 + wr * 64 + fr, col0 = u.pn * 256 + wc * 32 + 8 * fq;
        const float* bp = bd + (size_t)e * D + col0;
        f32x4 bv[2][2];
#pragma unroll
        for (int bj = 0; bj < 2; ++bj) { bv[bj][0] = *(const f32x4*)(bp + bj * 128); bv[bj][1] = *(const f32x4*)(bp + bj * 128 + 4); }
        float gtv[2][4];
#pragma unroll
        for (int ai = 0; ai < 2; ++ai)
#pragma unroll
            for (int m = 0; m < 4; ++m) { const int slot = srow0 + ai * 128 + m * 16; gtv[ai][m] = slot < cnt ? sgate[e * 32768 + slot] : 0.f; }
        __builtin_amdgcn_sched_barrier(0);
#pragma unroll
        for (int ai = 0; ai < 2; ++ai)
#pragma unroll
            for (int m = 0; m < 4; ++m) { const float gt = gtv[ai][m];
                bf16* rowp = Y + (size_t)(u.pm * 256 + wr * 64 + fr + ai * 128 + m * 16) * D + col0;
#pragma unroll
                for (int bj = 0; bj < 2; ++bj) st8(rowp + bj * 128, (acc[ai][bj][m][0] + bv[bj][0]) * gt, (acc[ai][bj][m][1] + bv[bj][1]) * gt); }
    }
};

#define XB_TMO      128
#define XB_XCNT(j)  (256  + 64 * (j))
#define XB_XSUB(j)  (1280 + 64 * (j))
#define XB_XGEN(j)  (2304 + 64 * (j))
#define XB_TOP      3328
#define XB_TOPGEN   3392
#define XCD_BAR_WORDS 3456
#define XB_SPIN_CAP (1u << 18)
__device__ __forceinline__ unsigned xb_ld(unsigned* p)              { return __hip_atomic_load(p, __ATOMIC_RELAXED, __HIP_MEMORY_SCOPE_AGENT); }
__device__ __forceinline__ unsigned xb_add(unsigned* p, unsigned v) { return __hip_atomic_fetch_add(p, v, __ATOMIC_RELAXED, __HIP_MEMORY_SCOPE_AGENT); }
__device__ __forceinline__ unsigned xb_xcc_id() { return (unsigned)__builtin_amdgcn_s_getreg((3 << 11) | 20) & 0xFu; }
#define XB_SPIN(cond, bar) do { unsigned _sp = 0; while (cond) { __builtin_amdgcn_s_sleep(1); \
    if ((++_sp & 255u) == 0u) { if (xb_ld(&(bar)[XB_TMO])) break; if (_sp > XB_SPIN_CAP) { atomicAdd(&(bar)[XB_TMO], 1u); break; } } } } while (0)
struct XcdBarrier { unsigned* bar; unsigned x; volatile LAS unsigned* st; int wave; };
__device__ __forceinline__ XcdBarrier xcd_barrier_post(unsigned* bar, volatile LAS unsigned* st, int wave) {
    XcdBarrier b; b.bar = bar; b.x = xb_xcc_id(); b.st = st; b.wave = wave;
    if (tid_opaque(wave) == 0) (void)xb_add(&bar[XB_XCNT(b.x)], 1u);
    return b;
}
__device__ __forceinline__ void xcd_barrier_complete(unsigned* bar, unsigned x, unsigned& nloc, unsigned& nx) {
    const unsigned G = gridDim.x * gridDim.y * gridDim.z;
    unsigned sum, cnt, mine, sp = 0u;
    for (;;) {
        sum = 0u; cnt = 0u; mine = 0u;
#pragma unroll
        for (unsigned j = 0; j < 16; ++j) { const unsigned c = xb_ld(&bar[XB_XCNT(j)]); sum += c; cnt += (c > 0u) ? 1u : 0u; mine = (j == x) ? c : mine; }
        if (sum == G) break;
        __builtin_amdgcn_s_sleep(1);
        if ((++sp & 255u) == 0u) { if (xb_ld(&bar[XB_TMO])) break; if (sp > XB_SPIN_CAP) { atomicAdd(&bar[XB_TMO], 1u); break; } }
    }
    nloc = mine > 0u ? mine : 1u; nx = cnt > 0u ? cnt : 1u;
}
__device__ __forceinline__ void xcd_barrier(const XcdBarrier& b) {
    asm volatile("s_waitcnt vmcnt(0)" ::: "memory");
    __syncthreads();
    if (tid_opaque(b.wave) == 0) {
        unsigned* bar = b.bar;
        __builtin_amdgcn_s_waitcnt(0);
        unsigned nloc = b.st[0], nx = b.st[1];
        if (nloc == 0u) { xcd_barrier_complete(bar, b.x, nloc, nx); b.st[0] = nloc; b.st[1] = nx; }
        const unsigned old = xb_add(&bar[XB_XSUB(b.x)], 1u);
        const unsigned gen = old / nloc;
        if (old + 1u == (gen + 1u) * nloc) {
            __builtin_amdgcn_fence(__ATOMIC_RELEASE, "agent");
            asm volatile("s_waitcnt vmcnt(0)" ::: "memory");
            const unsigned og = xb_add(&bar[XB_TOP], 1u);
            const unsigned tg = og / nx;
            if (og + 1u == (tg + 1u) * nx) xb_add(&bar[XB_TOPGEN], 1u);
            else XB_SPIN(xb_ld(&bar[XB_TOPGEN]) == tg, bar);
            __builtin_amdgcn_fence(__ATOMIC_ACQUIRE, "agent");
            xb_add(&bar[XB_XGEN(b.x)], 1u);
            asm volatile("s_waitcnt vmcnt(0)" ::: "memory");
        } else {
            XB_SPIN(xb_ld(&bar[XB_XGEN(b.x)]) == gen, bar);
            __builtin_amdgcn_fence(__ATOMIC_ACQUIRE, "agent");
            asm volatile("s_waitcnt vmcnt(0)" ::: "memory");
        }
    }
    __syncthreads();
}

struct Args { const float* in[23]; float* out; unsigned char* ws; int ph_lo, ph_hi; };
struct Frame {
    LAS unsigned char* lds; int wave, vcu, G;
};
#define LDS_WAIT() asm volatile("s_waitcnt lgkmcnt(0)" ::: "memory")

__device__ __forceinline__ int t5_bucket(int n) {
    if (n < 16) return n;
    const int th[15] = {22, 30, 40, 54, 73, 99, 134, 182, 246, 332, 450, 609, 825, 1117, 1513};
    int b = 16;
#pragma unroll
    for (int k = 0; k < 15; ++k) b += (n >= th[k]) ? 1 : 0;
    return b;
}

__device__ __forceinline__ void transpose_item(const float* W, int K, int N, bf16* WT, int drow0, LAS float* scr, int k0, int n0, int lane, int kdst = 0) {
    const int q = lane & 15, kr = lane >> 4;
    f32x4 v[8];
#pragma unroll
    for (int i = 0; i < 8; ++i) v[i] = *(const f32x4*)(W + (size_t)(k0 + 4 * i + kr) * N + n0 + 4 * q);
#pragma unroll
    for (int i = 0; i < 8; ++i) { LAS float* d = scr + (4 * q) * 33 + 4 * i + kr; d[0] = v[i].x; d[33] = v[i].y; d[66] = v[i].z; d[99] = v[i].w; }
    LDS_WAIT(); asm volatile("" ::: "memory");
    const int c4 = lane & 3, nr = lane >> 2;
#pragma unroll
    for (int j = 0; j < 4; ++j) { const int n = nr + 16 * j; const LAS float* sp = scr + n * 33 + 8 * c4;
        v4u o; o.x = pk2(sp[0], sp[1]); o.y = pk2(sp[2], sp[3]); o.z = pk2(sp[4], sp[5]); o.w = pk2(sp[6], sp[7]);
        *(v4u*)(WT + (size_t)(drow0 + n) * K + kdst + k0 + 8 * c4) = o; }
    LDS_WAIT(); asm volatile("" ::: "memory");
}
constexpr int BG_GU = 32 * 32 * 32, BG_DN = 32 * 32 * 16, BG_N = BG_GU + BG_DN;
constexpr int BG_P1 = 32768;
struct BgItem { const float* W; bf16* WT; int N, k0, n0, drow0, pitch, kdst; };
constexpr int BG_X0 = BG_N, BG_X1 = BG_X0 + 8 * 16, BG_X2 = BG_X1 + 24 * 16, BG_X3 = BG_X2 + 32 * 16, BG_X4 = BG_X3 + 32 * 16, BG_ALL = BG_X4 + 8 * 16;
__device__ __forceinline__ BgItem bg_decode(const Args& A, int r) {
    BgItem it; it.pitch = D; it.kdst = 0;
    if (r < BG_GU) { const int e = r >> 10, q = r & 1023, kb = q >> 5, nb = q & 31, n0 = nb * 64;
        it.W = A.in[15] + (size_t)e * D * 2048; it.WT = (bf16*)(A.ws + WS_WGU) + (size_t)e * 2048 * D; it.N = 2048; it.k0 = kb * 32; it.n0 = n0;
        it.drow0 = n0 < 1024 ? 256 * (n0 >> 7) + (n0 & 127) : 256 * ((n0 - 1024) >> 7) + 128 + (n0 & 127);
    } else if (r < BG_N) { r -= BG_GU; const int e = r >> 9, q = r & 511, kb = q >> 4, nb = q & 15;
        it.W = A.in[17] + (size_t)e * D * D; it.WT = (bf16*)(A.ws + WS_WD) + (size_t)e * D * D; it.N = D; it.k0 = kb * 32; it.n0 = nb * 64; it.drow0 = nb * 64;
    } else { int src; bf16* dst;
        if (r < BG_X1) { r -= BG_X0; src = 5; dst = (bf16*)(A.ws + WS_WCAT); }
        else if (r < BG_X2) { r -= BG_X1; src = 10; dst = (bf16*)(A.ws + WS_WCAT); it.kdst = 256; }
        else if (r < BG_X3) { r -= BG_X2; src = 11; dst = (bf16*)(A.ws + WS_WOUT); }
        else if (r < BG_X4) { r -= BG_X3; src = 20; dst = (bf16*)(A.ws + WS_WPG); }
        else { r -= BG_X4; src = 21; dst = (bf16*)(A.ws + WS_WPP); it.pitch = PLE; }
        it.W = src == 5 ? A.in[5] : src == 10 ? A.in[10] : src == 11 ? A.in[11] : src == 20 ? A.in[20] : A.in[21];
        it.WT = dst; it.N = D; it.k0 = (r >> 4) * 32; it.n0 = (r & 15) * 64; it.drow0 = it.n0; }
    return it;
}
struct BgConv {
    int cur, next, stride, end; f32x4 v[8];
    __device__ __forceinline__ void init(int first, int stride_, int end_ = BG_ALL) { cur = -1; next = first; stride = stride_; end = end_; }
    __device__ __forceinline__ void issue(const Args& A, int lane) {
        if (next < end) { const BgItem it = bg_decode(A, next); const int q = lane & 15, kr = lane >> 4;
#pragma unroll
            for (int i = 0; i < 8; ++i) v[i] = *(const f32x4*)(it.W + (size_t)(it.k0 + 4 * i + kr) * it.N + it.n0 + 4 * q);
            cur = next; next += stride; } else cur = -1;
    }
    __device__ __forceinline__ void finish(const Args& A, LAS float* scr, int lane) {
        if (cur >= 0) { const BgItem it = bg_decode(A, cur); const int q = lane & 15, kr = lane >> 4;
#pragma unroll
            for (int i = 0; i < 8; ++i) { LAS float* d = scr + (4 * q) * 33 + 4 * i + kr; d[0] = v[i].x; d[33] = v[i].y; d[66] = v[i].z; d[99] = v[i].w; }
            LDS_WAIT(); asm volatile("" ::: "memory");
            const int c4 = lane & 3, nr = lane >> 2;
#pragma unroll
            for (int j = 0; j < 4; ++j) { const int n = nr + 16 * j; const LAS float* sp = scr + n * 33 + 8 * c4;
                v4u o; o.x = pk2(sp[0], sp[1]); o.y = pk2(sp[2], sp[3]); o.z = pk2(sp[4], sp[5]); o.w = pk2(sp[6], sp[7]);
                *(v4u*)(it.WT + (size_t)(it.drow0 + n) * it.pitch + it.kdst + it.k0 + 8 * c4) = o; }
            LDS_WAIT(); asm volatile("" ::: "memory");
            cur = -1; }
    }
};
__device__ __forceinline__ void convert_queue(const Frame& F, const Args& A, unsigned* ctr, int lo, int hi) {
    const int tidx_ = tid_opaque(F.wave);
    LAS float* scr = (LAS float*)(F.lds + F.wave * 8448);
    LAS int* qs = (LAS int*)(F.lds + RING_BYTES + 512);
    const int lane = tidx_ & 63;
    BgConv c0, c1;
    for (;;) {
        __syncthreads();
        if (tidx_ == 0) *qs = (int)__hip_atomic_fetch_add(ctr, 64u, __ATOMIC_RELAXED, __HIP_MEMORY_SCOPE_AGENT);
        __syncthreads();
        const int base = __builtin_amdgcn_readfirstlane(*qs) + lo + F.wave * 8;
        if (base - F.wave * 8 >= hi) break;
        c0.init(base, 2, base + 8 < hi ? base + 8 : hi); c1.init(base + 1, 2, base + 8 < hi ? base + 8 : hi);
        c0.issue(A, lane); c1.issue(A, lane);
#pragma unroll 1
        for (int k = 0; k < 4; ++k) { c0.finish(A, scr, lane); c0.issue(A, lane); c1.finish(A, scr, lane); c1.issue(A, lane); }
    }
}
__device__ __forceinline__ void convert_p_queue(const Frame& F, const Args& A, unsigned* ctr) {
    const int tidx_ = tid_opaque(F.wave);
    const int lane = tidx_ & 63; const float* p = A.in[1]; bf16* pb = (bf16*)(A.ws + WS_PB);
    LAS int* qs = (LAS int*)(F.lds + RING_BYTES + 512);
    for (;;) {
        __syncthreads();
        if (tidx_ == 0) *qs = (int)__hip_atomic_fetch_add(ctr, 8u, __ATOMIC_RELAXED, __HIP_MEMORY_SCOPE_AGENT);
        __syncthreads();
        const int ck0 = __builtin_amdgcn_readfirstlane(*qs);
        if (ck0 >= (T * PLE) / 8192) break;
        const size_t base = (size_t)(ck0 + F.wave) * 8192 + 8 * lane;
#pragma unroll 4
        for (int i = 0; i < 16; ++i) { const f32x4 a = *(const f32x4*)(p + base + 512 * i), b = *(const f32x4*)(p + base + 512 * i + 4); st8(pb + base + 512 * i, a, b); }
    }
}
constexpr int BG_SCR_OFF = 45056;
__device__ __forceinline__ int win_dest(int n0) {
    if (n0 < 1536) return n0;
    if (n0 < 2304) return 4352 + (n0 - 1536);
    if (n0 < 3072) return 1536 + (n0 - 2304);
    if (n0 < 3840) return 5120 + (n0 - 3072);
    return 2304 + (n0 - 3840);
}
template <int NR> __device__ __forceinline__ void rms_rows_to_bf16(const float* xrow, const float* gain, bf16* orow, int lane) {
    f32x4 v[NR][4]; float s[NR];
#pragma unroll
    for (int r = 0; r < NR; ++r)
#pragma unroll
        for (int j = 0; j < 4; ++j) v[r][j] = ((const f32x4*)(xrow + (size_t)r * D) + lane)[64 * j];
    f32x4 g[4];
#pragma unroll
    for (int j = 0; j < 4; ++j) g[j] = ((const f32x4*)gain + lane)[64 * j];
#pragma unroll
    for (int r = 0; r < NR; ++r) { float a = 0.f;
#pragma unroll
        for (int j = 0; j < 4; ++j) a += (v[r][j].x * v[r][j].x + v[r][j].y * v[r][j].y) + (v[r][j].z * v[r][j].z + v[r][j].w * v[r][j].w);
        s[r] = a; }
#pragma unroll
    for (int o = 1; o < 64; o <<= 1)
#pragma unroll
        for (int r = 0; r < NR; ++r) s[r] += __shfl_xor(s[r], o);
#pragma unroll
    for (int r = 0; r < NR; ++r) { const float rstd = 1.0f / sqrtf(s[r] * (1.f / D) + EPS);
        unsigned long long* o8 = (unsigned long long*)(orow + (size_t)r * D) + lane;
#pragma unroll
        for (int j = 0; j < 4; ++j) o8[64 * j] = (unsigned long long)pk2(v[r][j].x * rstd * g[j].x, v[r][j].y * rstd * g[j].y) | ((unsigned long long)pk2(v[r][j].z * rstd * g[j].z, v[r][j].w * rstd * g[j].w) << 32); }
}
__device__ __forceinline__ void p0_prologue(const Frame& F, const Args& A) {
    const int tidx_ = tid_opaque(F.wave);
    LAS float* scr = (LAS float*)(F.lds + F.wave * 16384);
    const int gw = F.vcu * 8 + F.wave, NGW = F.G * 8;
    unsigned char* ws = A.ws;
    for (int m = gw * 4; m < T; m += NGW * 4) rms_rows_to_bf16<4>(A.in[0] + (size_t)m * D, A.in[2], (bf16*)(ws + WS_NX) + (size_t)m * D, (tidx_ & 63));
    { const float* wsp = A.in[8]; bf16* o = (bf16*)(ws + WS_WSP);
      for (int i = (blockIdx.x * 512 + tidx_) * 4; i < 12 * 128 * 128; i += F.G * 512 * 4) { const int col = i & 127, row = (i >> 7) & 127; const f32x4 a = *(const f32x4*)(wsp + i);
          v2u w; w.x = pk2(col <= row ? a.x : 0.f, col + 1 <= row ? a.y : 0.f); w.y = pk2(col + 2 <= row ? a.z : 0.f, col + 3 <= row ? a.w : 0.f); *(v2u*)(o + i) = w; } }
    { const float* wrt = A.in[13]; bf16* wh = (bf16*)(ws + WS_WRH); bf16* wl = (bf16*)(ws + WS_WRL);
      for (int i = blockIdx.x * 512 + tidx_; i < 32 * 1024; i += F.G * 512) { const int e = i >> 10, k = i & 1023; const float w = wrt[k * 32 + e]; const unsigned h = f2bf(w); wh[i] = (bf16)h; wl[i] = (bf16)f2bf(w - bflo(h)); } }
    constexpr int I_IN = 32 * 92;
    for (int it = gw; it < I_IN; it += NGW) { const int kb = it / 92, nb = it % 92; transpose_item(A.in[3], D, IN_W, (bf16*)(ws + WS_WIN), win_dest(nb * 64), scr, kb * 32, nb * 64, (tidx_ & 63)); }
}

__device__ __forceinline__ int crow(int r, int hi) { return (r & 3) + 8 * (r >> 2) + 4 * hi; }
struct AtU { int b, g, h, r, qb8, nqb; };
__device__ __forceinline__ AtU at_decode(int pr) { AtU u; const int slot = pr & 15; u.h = (pr >> 4) & 3; const int bgi = pr >> 6; u.g = bgi % 3; u.b = bgi / 3; u.nqb = 128 >> (2 * u.g);
    u.r = slot / (u.nqb >> 3); u.qb8 = slot % (u.nqb >> 3); return u; }
__device__ __forceinline__ void at_load(const AtU& u, const bf16* QT, const bf16* KT, const bf16* VT, int w, int r32, int hi, int q8, int t8, v4u (&stg)[12], bf16x8 (&qf)[4]) {
    const size_t tb0 = (size_t)((u.b * 3 + u.g) * 4 + u.h) * 128 + (size_t)(u.r * u.nqb);
    const bf16* qt = QT + (tb0 + u.qb8 * 8 + w) * 2048 + r32 * 64 + 8 * hi;
#pragma unroll
    for (int s = 0; s < 4; ++s) qf[s] = *(const bf16x8*)(qt + 16 * s);
#pragma unroll
    for (int i = 0; i < 12; ++i) { const int kv = i >= 6 ? 1 : 0, j = 2 * (i - 6 * kv) + t8; int kb = u.qb8 * 8 - 4 + j; kb = kb < 0 ? 0 : kb;
        stg[i] = *(const v4u*)((kv ? VT : KT) + (tb0 + kb) * 2048 + q8 * 8); }
}
__device__ __forceinline__ void attn_phase(const Frame& F, const Args& A) {
    const int tidx_ = tid_opaque(F.wave);
    LAS float* tb = (LAS float*)(F.lds + RING_BYTES + 2048);
    const float* rel_bias = A.in[4];
    for (int i = tidx_; i < 12 * 192; i += 512) { const int gh = i / 192, dist = i % 192 - 31, g = gh >> 2; const int dil = g == 0 ? 1 : (g == 1 ? 4 : 16);
        tb[i] = (dist >= 0 && dist <= 128) ? rel_bias[t5_bucket(dist * dil) * 12 + gh] * LOG2E : -INFINITY; }
    __syncthreads();
    const bf16* QT = (const bf16*)(A.ws + WS_Q); const bf16* KT = (const bf16*)(A.ws + WS_K); const bf16* VT = (const bf16*)(A.ws + WS_VT);
    bf16* OG = (bf16*)(A.ws + WS_OG); float* LSE = (float*)(A.ws + WS_LSE);
    const int lane = (tidx_ & 63), r32 = lane & 31, hi = lane >> 5, w = F.wave;
    const int q8 = tidx_ & 255, t8 = tidx_ >> 8;
    const int NU = NB * 3 * 4 * 16;
    v4u stg[12]; bf16x8 qf[4];
    if (F.vcu < NU) at_load(at_decode(F.vcu), QT, KT, VT, w, r32, hi, q8, t8, stg, qf);
    for (int pr = F.vcu; pr < NU; pr += F.G) {
        const AtU u = at_decode(pr);
        const int dsh = 2 * u.g, dil = 1 << dsh, g = u.g, h = u.h, b = u.b, r = u.r;
        const int qb = u.qb8 * 8 + w, i0 = qb * 32;
        __syncthreads();
        { const int keyk = q8 >> 3, posk = keyk * 8 + ((q8 & 7) ^ ((keyk >> 1) & 7)), dv = q8 >> 2, posv = dv * 4 + ((q8 & 3) ^ ((dv >> 2) & 3));
#pragma unroll
          for (int i = 0; i < 12; ++i) { const int kv = i >= 6 ? 1 : 0, j = 2 * (i - 6 * kv) + t8;
              *(LAS v4u*)(F.lds + kv * 49152 + j * 4096 + (kv ? posv : posk) * 16) = stg[i]; } }
        bf16x8 qc[4];
#pragma unroll
        for (int s = 0; s < 4; ++s) qc[s] = qf[s];
        __syncthreads();
        if (pr + F.G < NU) at_load(at_decode(pr + F.G), QT, KT, VT, w, r32, hi, q8, t8, stg, qf);
        __builtin_amdgcn_sched_barrier(0);
        const LAS unsigned char* kbase = F.lds + w * 4096 + (r32 * 8) * 16;
        const int kx = (r32 >> 1) & 7;
        f32x16 st[5];
#pragma unroll
        for (int kt = 0; kt < 5; ++kt) {
            f32x16 a = {};
#pragma unroll
            for (int s = 0; s < 4; ++s) { const bf16x8 kf = *(const LAS bf16x8*)(kbase + kt * 4096 + (((2 * s + hi) ^ kx) << 4)); a = __builtin_amdgcn_mfma_f32_32x32x16_bf16(kf, qc[s], a, 0, 0, 0); }
            st[kt] = a;
        }
        const LAS float* tbh = tb + (g * 4 + h) * 192;
        float mx = -INFINITY;
#pragma unroll
        for (int kt = 0; kt < 5; ++kt)
#pragma unroll
            for (int i = 0; i < 16; ++i) { const int kr = crow(i, hi), krel = -128 + 32 * kt + kr; const int dist = r32 - krel;
                float v = st[kt][i] + tbh[dist + 31]; v = (i0 + krel >= 0) ? v : -INFINITY; st[kt][i] = v; mx = fmaxf(mx, v); }
        mx = fmaxf(mx, __shfl_xor(mx, 32));
        float l = 0.f;
#pragma unroll
        for (int kt = 0; kt < 5; ++kt)
#pragma unroll
            for (int i = 0; i < 16; ++i) { const float p = __builtin_amdgcn_exp2f(st[kt][i] - mx); st[kt][i] = p; l += p; }
        l += __shfl_xor(l, 32);
        const LAS unsigned char* vbase = F.lds + 49152 + w * 4096;
        f32x16 o[2] = {};
#pragma unroll
        for (int kt = 0; kt < 5; ++kt)
#pragma unroll
            for (int s2 = 0; s2 < 2; ++s2) {
                v4u pw; pw.x = cvt_pk_bf16(st[kt][8 * s2 + 0], st[kt][8 * s2 + 1]); pw.y = cvt_pk_bf16(st[kt][8 * s2 + 2], st[kt][8 * s2 + 3]);
                pw.z = cvt_pk_bf16(st[kt][8 * s2 + 4], st[kt][8 * s2 + 5]); pw.w = cvt_pk_bf16(st[kt][8 * s2 + 6], st[kt][8 * s2 + 7]);
                const bf16x8 pf = __builtin_bit_cast(bf16x8, pw);
#pragma unroll
                for (int dt = 0; dt < 2; ++dt) { const int dd = 32 * dt + r32;
                    const LAS unsigned char* vr = vbase + kt * 4096 + dd * 64 + 8 * hi; const int vx = (dd >> 2) & 3;
                    const v2u p1 = *(const LAS v2u*)(vr + (((2 * s2) ^ vx) << 4)), p2 = *(const LAS v2u*)(vr + (((2 * s2 + 1) ^ vx) << 4));
                    v4u vw; vw.x = p1.x; vw.y = p1.y; vw.z = p2.x; vw.w = p2.y;
                    o[dt] = __builtin_amdgcn_mfma_f32_32x32x16_bf16(__builtin_bit_cast(bf16x8, vw), pf, o[dt], 0, 0, 0); }
            }
        const float rl = 1.0f / l;
        const size_t qrow = (size_t)b * SEQ + (size_t)(i0 + r32) * dil + r;
        bf16* op = OG + ((size_t)g * T + qrow) * 256 + h * 64;
#pragma unroll
        for (int dt = 0; dt < 2; ++dt)
#pragma unroll
            for (int gp = 0; gp < 2; ++gp) { v2u wa, wb;
                wa.x = cvt_pk_bf16(o[dt][8 * gp] * rl, o[dt][8 * gp + 1] * rl); wa.y = cvt_pk_bf16(o[dt][8 * gp + 2] * rl, o[dt][8 * gp + 3] * rl);
                wb.x = cvt_pk_bf16(o[dt][8 * gp + 4] * rl, o[dt][8 * gp + 5] * rl); wb.y = cvt_pk_bf16(o[dt][8 * gp + 6] * rl, o[dt][8 * gp + 7] * rl);
                *(v4u*)(op + 32 * dt + 16 * gp + 8 * hi) = widen_pair(wa, wb); }
        if (hi == 0) LSE[((size_t)g * T + qrow) * 4 + h] = (mx + __builtin_amdgcn_logf(l)) * LN2;
    }
    __syncthreads();
}

__device__ __forceinline__ void spatial_phase(const Frame& F, const Args& A) {
    const int tidx_ = tid_opaque(F.wave);
    const bf16* ZVT = (const bf16*)(A.ws + WS_ZVT); const bf16* ZU = (const bf16*)(A.ws + WS_ZU); const bf16* WSP = (const bf16*)(A.ws + WS_WSP);
    bf16* Gout = (bf16*)(A.ws + WS_AG) + 256;
    const float* lng = A.in[6]; const float* lnb = A.in[7]; const float* bsp = A.in[9];
    LAS float* red = (LAS float*)(F.lds + 10240);
    LAS float* stt = (LAS float*)(F.lds + 43008);
    LAS unsigned char* vn = F.lds + 49152;
    int lane = (tidx_ & 63); asm volatile("" : "+v"(lane));
    const int r32 = lane & 31, hi = lane >> 5, w = F.wave;
    const int dr = 8 * w + (lane >> 3), ck = lane & 7;
    for (int c = F.vcu; c < T / 128; c += F.G) {
        v4u zr[2];
#pragma unroll
        for (int p = 0; p < 2; ++p) zr[p] = *(const v4u*)(ZVT + ((size_t)c * GM_W + dr) * 128 + 8 * (ck + 8 * p));
        {
            const int tg = tidx_ & 15, rg = tidx_ >> 4; float sm[8], q[8];
#pragma unroll
            for (int e = 0; e < 8; ++e) { sm[e] = 0.f; q[e] = 0.f; }
#pragma unroll 4
            for (int ch = rg; ch < GM_W; ch += 32) { const v4u wv = *(const v4u*)(ZVT + ((size_t)c * GM_W + ch) * 128 + 8 * tg);
                const float x[8] = {bflo(wv.x), bfhi(wv.x), bflo(wv.y), bfhi(wv.y), bflo(wv.z), bfhi(wv.z), bflo(wv.w), bfhi(wv.w)};
#pragma unroll
                for (int e = 0; e < 8; ++e) { sm[e] += x[e]; q[e] += x[e] * x[e]; } }
#pragma unroll
            for (int e = 0; e < 8; ++e) { red[(rg * 128 + 8 * tg + e) * 2] = sm[e]; red[(rg * 128 + 8 * tg + e) * 2 + 1] = q[e]; }
            __syncthreads();
            if (tidx_ < 128) { float ss = 0.f, qq = 0.f;
                for (int k = 0; k < 32; ++k) { ss += red[(k * 128 + tidx_) * 2]; qq += red[(k * 128 + tidx_) * 2 + 1]; }
                const float mu = ss * (1.f / GM_W), var = fmaxf(qq * (1.f / GM_W) - mu * mu, 0.f);
                stt[tidx_ * 2] = mu; stt[tidx_ * 2 + 1] = 1.0f / sqrtf(var + EPS); }
            __syncthreads();
        }
#define SP_GROUP(GI, ZR_CUR, ZU_CUR, ZR_NXT, ZU_NXT) do { \
            const int gi_ = (GI); const int dt = w & 1, it = ((w >> 1) + gi_) & 3, ti = 32 * it + r32;       \
              \
            bf16x8 bfr[8]; \
            { const bf16* wp = WSP + ((size_t)gi_ * 128 + ti) * 128 + 8 * hi; \
              _Pragma("unroll") for (int s = 0; s < 8; ++s) bfr[s] = *(const bf16x8*)(wp + 16 * s); } \
            const float bsv = bsp[gi_ * 128 + ti], gch = lng[gi_ * 64 + dr], bch = lnb[gi_ * 64 + dr]; \
            __builtin_amdgcn_sched_barrier(0); \
              \
            LAS unsigned char* tile = vn + (gi_ & 1) * 16384; \
            _Pragma("unroll") for (int p = 0; p < 2; ++p) { const int jb = 8 * (ck + 8 * p); const v4u z = ZR_CUR[p]; \
                float x[8] = {bflo(z.x), bfhi(z.x), bflo(z.y), bfhi(z.y), bflo(z.z), bfhi(z.z), bflo(z.w), bfhi(z.w)}; \
                _Pragma("unroll") for (int e = 0; e < 8; ++e) x[e] = (x[e] - stt[(jb + e) * 2]) * stt[(jb + e) * 2 + 1] * gch + bch; \
                v4u aw; aw.x = cvt_pk_bf16(x[0], x[1]); aw.y = cvt_pk_bf16(x[2], x[3]); aw.z = cvt_pk_bf16(x[4], x[5]); aw.w = cvt_pk_bf16(x[6], x[7]); \
                *(LAS v4u*)(tile + dr * 256 + (((ck + 8 * p) ^ (dr & 15)) << 4)) = aw; } \
            { const int gn = gi_ + 1 < 12 ? gi_ + 1 : 11;        \
              _Pragma("unroll") for (int p = 0; p < 2; ++p) ZR_NXT[p] = *(const v4u*)(ZVT + ((size_t)c * GM_W + gn * 64 + dr) * 128 + 8 * (ck + 8 * p)); \
              const int itn = ((w >> 1) + gn) & 3; const size_t orow = ((size_t)c * 128 + 32 * itn + r32) * GM_W + gn * 64 + 32 * dt + 4 * hi; \
              _Pragma("unroll") for (int gq = 0; gq < 4; ++gq) ZU_NXT[gq] = *(const v2u*)(ZU + orow + 8 * gq); } \
            __syncthreads();                                    \
            f32x16 acc = {}; \
            { const int dd = 32 * dt + r32; const LAS unsigned char* ar = tile + dd * 256; \
              _Pragma("unroll") for (int s = 0; s < 8; ++s) { const bf16x8 af = *(const LAS bf16x8*)(ar + (((2 * s + hi) ^ (dd & 15)) << 4)); acc = __builtin_amdgcn_mfma_f32_32x32x16_bf16(af, bfr[s], acc, 0, 0, 0); } } \
              \
            const size_t groww = ((size_t)c * 128 + ti) * D + gi_ * 64 + 32 * dt + 8 * hi; \
            _Pragma("unroll") for (int gp = 0; gp < 2; ++gp) { v2u oo[2]; \
                _Pragma("unroll") for (int q2 = 0; q2 < 2; ++q2) { const int gq = 2 * gp + q2; const v2u uw = ZU_CUR[gq]; \
                    oo[q2].x = cvt_pk_bf16(bflo(uw.x) * (acc[4 * gq] + bsv), bfhi(uw.x) * (acc[4 * gq + 1] + bsv)); oo[q2].y = cvt_pk_bf16(bflo(uw.y) * (acc[4 * gq + 2] + bsv), bfhi(uw.y) * (acc[4 * gq + 3] + bsv)); } \
                *(v4u*)(Gout + groww + 16 * gp) = widen_pair(oo[0], oo[1]); } \
        } while (0)
        v4u zrb[2]; v2u zua[4], zub[4];
        { const int it0 = (w >> 1) & 3; const size_t orow = ((size_t)c * 128 + 32 * it0 + r32) * GM_W + 32 * (w & 1) + 4 * hi;
#pragma unroll
          for (int gq = 0; gq < 4; ++gq) zua[gq] = *(const v2u*)(ZU + orow + 8 * gq); }
#pragma unroll 1
        for (int gi = 0; gi < 12; gi += 2) {
            SP_GROUP(gi, zr, zua, zrb, zub);
            SP_GROUP(gi + 1, zrb, zub, zr, zua);
        }
#undef SP_GROUP
        __syncthreads();
    }
}

__device__ __forceinline__ void merge_phase(const Frame& F, const Args& A) {
    const int tidx_ = tid_opaque(F.wave);
    const bf16* OG = (const bf16*)(A.ws + WS_OG); const float* LSE = (const float*)(A.ws + WS_LSE); bf16* ATT = (bf16*)(A.ws + WS_AG);
    const int gw = F.vcu * 8 + F.wave, NGW = F.G * 8, lane = (tidx_ & 63), h = lane >> 4;
    for (int t = gw; t < T; t += NGW) {
        const float l0 = LSE[(size_t)t * 4 + h], l1 = LSE[((size_t)T + t) * 4 + h], l2 = LSE[((size_t)2 * T + t) * 4 + h];
        const float m = fmaxf(l0, fmaxf(l1, l2)); float a0 = __expf(l0 - m), a1 = __expf(l1 - m), a2 = __expf(l2 - m); const float inv = 1.0f / (a0 + a1 + a2); a0 *= inv; a1 *= inv; a2 *= inv;
        const v2u w0 = *(const v2u*)(OG + (size_t)t * 256 + 4 * lane), w1 = *(const v2u*)(OG + ((size_t)T + t) * 256 + 4 * lane), w2 = *(const v2u*)(OG + ((size_t)2 * T + t) * 256 + 4 * lane);
        v2u o; o.x = pk2(a0 * bflo(w0.x) + a1 * bflo(w1.x) + a2 * bflo(w2.x), a0 * bfhi(w0.x) + a1 * bfhi(w1.x) + a2 * bfhi(w2.x));
        o.y = pk2(a0 * bflo(w0.y) + a1 * bflo(w1.y) + a2 * bflo(w2.y), a0 * bfhi(w0.y) + a1 * bfhi(w1.y) + a2 * bfhi(w2.y));
        *(v2u*)(ATT + (size_t)t * D + 4 * lane) = o;
    }
}

__device__ __forceinline__ void router_phase(const Frame& F, const Args& A) {
    const int tidx_ = tid_opaque(F.wave);
    LAS unsigned char* L = F.lds;
    LAS int* hist = (LAS int*)(F.lds + RING_BYTES + 2048);
    LAS int* basee = hist + 32;
    LAS int* rec_e = hist + 64;
    LAS int* rec_r = rec_e + 512;
    LAS float* rec_g = (LAS float*)(rec_r + 512);
    LAS float* rec_s = rec_g + 512;
    const float* brt = A.in[14]; const float* gmoe = A.in[12];
    const float* H = A.out; bf16* NX = (bf16*)(A.ws + WS_NX);
    const bf16* WRH = (const bf16*)(A.ws + WS_WRH);
    int* LIST = (int*)(A.ws + WS_LIST); float* SGATE = (float*)(A.ws + WS_SGATE); float* SRSTD = (float*)(A.ws + WS_SRSTD); int* POS = (int*)(A.ws + WS_POS);
    unsigned* CNT = (unsigned*)(A.ws + WS_CTL) + CW_CNT;
    const int lane = (tidx_ & 63), w = F.wave, r32 = lane & 31, hi = lane >> 5;
    for (int c = F.vcu; c < T / 128; c += F.G) {
        for (int q = tidx_; q < 8192; q += 512) { const int mtx = q >> 12, rem = q & 4095, e = rem >> 7, ck = rem & 127;
            const v4u v = *(const v4u*)(WRH + (size_t)mtx * 32768 + e * 1024 + ck * 8);
            *(LAS v4u*)(L + mtx * 65536 + e * 2048 + ((ck ^ (e & 15)) << 4)) = v; }
        if (tidx_ < 32) hist[tidx_] = 0;
        __syncthreads();
        const int tt = w & 3, kh = w >> 2;
        const size_t row = (size_t)c * 128 + tt * 32 + r32;
        const float* hrow = H + row * D + kh * 512 + 8 * hi; const float* grow = gmoe + kh * 512 + 8 * hi; bf16* nrow = NX + row * D + kh * 512 + 8 * hi;
        const LAS unsigned char* wb = L + r32 * 2048;
        f32x16 acc = {}; float ss = 0.f;
#pragma unroll 4
        for (int s = 0; s < 32; ++s) {
            const f32x4 h0 = *(const f32x4*)(hrow + 16 * s), h1 = *(const f32x4*)(hrow + 16 * s + 4), g0 = *(const f32x4*)(grow + 16 * s), g1 = *(const f32x4*)(grow + 16 * s + 4);
            ss += (h0.x * h0.x + h0.y * h0.y) + (h0.z * h0.z + h0.w * h0.w) + (h1.x * h1.x + h1.y * h1.y) + (h1.z * h1.z + h1.w * h1.w);
            const f32x4 x0 = h0 * g0, x1 = h1 * g1;
            v4u xh; xh.x = cvt_pk_bf16(x0.x, x0.y); xh.y = cvt_pk_bf16(x0.z, x0.w); xh.z = cvt_pk_bf16(x1.x, x1.y); xh.w = cvt_pk_bf16(x1.z, x1.w);
            v4u xl; xl.x = cvt_pk_bf16(x0.x - bflo(xh.x), x0.y - bfhi(xh.x)); xl.y = cvt_pk_bf16(x0.z - bflo(xh.y), x0.w - bfhi(xh.y));
            xl.z = cvt_pk_bf16(x1.x - bflo(xh.z), x1.y - bfhi(xh.z)); xl.w = cvt_pk_bf16(x1.z - bflo(xh.w), x1.w - bfhi(xh.w));
            *(v4u*)(nrow + 16 * s) = xh;
            const int ck = kh * 64 + 2 * s + hi;
            const bf16x8 wh = *(const LAS bf16x8*)(wb + ((ck ^ (r32 & 15)) << 4)), wl = *(const LAS bf16x8*)(wb + 65536 + ((ck ^ (r32 & 15)) << 4));
            const bf16x8 ah = __builtin_bit_cast(bf16x8, xh), al = __builtin_bit_cast(bf16x8, xl);
            acc = __builtin_amdgcn_mfma_f32_32x32x16_bf16(ah, wh, acc, 0, 0, 0);
            acc = __builtin_amdgcn_mfma_f32_32x32x16_bf16(al, wh, acc, 0, 0, 0);
            acc = __builtin_amdgcn_mfma_f32_32x32x16_bf16(ah, wl, acc, 0, 0, 0);
        }
        __syncthreads();
        { LAS float* LGp = (LAS float*)L + kh * (128 * 33);
#pragma unroll
          for (int i = 0; i < 16; ++i) LGp[(tt * 32 + crow(i, hi)) * 33 + r32] = acc[i];
          ((LAS float*)(L + 36864))[(kh * 2 + hi) * 128 + tt * 32 + r32] = ss; }
        __syncthreads();
        if (tidx_ < 128) {
            const int t = tidx_; const LAS float* SS = (const LAS float*)(L + 36864);
            const float rstd = 1.0f / sqrtf(((SS[t] + SS[128 + t]) + (SS[256 + t] + SS[384 + t])) * (1.f / D) + EPS);
            const LAS float* l0 = (const LAS float*)L + t * 33; const LAS float* l1 = l0 + 128 * 33;
            float lg[32];
#pragma unroll
            for (int e = 0; e < 32; ++e) lg[e] = (l0[e] + l1[e]) * rstd + brt[e];
            unsigned taken = 0u; float tv[4]; int ti[4];
#pragma unroll
            for (int k = 0; k < 4; ++k) { float bv = -INFINITY; int bi = 0;
#pragma unroll
                for (int e = 0; e < 32; ++e) { const float cv = ((taken >> e) & 1u) ? -INFINITY : lg[e]; if (cv > bv) { bv = cv; bi = e; } }
                tv[k] = bv; ti[k] = bi; taken |= 1u << bi; }
            const float e1 = __expf(tv[1] - tv[0]), e2 = __expf(tv[2] - tv[0]), e3 = __expf(tv[3] - tv[0]); const float inv = 1.0f / (1.0f + e1 + e2 + e3);
            const float gk[4] = {inv, e1 * inv, e2 * inv, e3 * inv};
            rec_s[t] = rstd;
#pragma unroll
            for (int k = 0; k < 4; ++k) { const int lr = atomicAdd((int*)&hist[ti[k]], 1); rec_e[t * 4 + k] = ti[k]; rec_r[t * 4 + k] = lr; rec_g[t * 4 + k] = gk[k]; }
        }
        __syncthreads();
        if (tidx_ < 32) basee[tidx_] = (int)__hip_atomic_fetch_add(CNT + tidx_, (unsigned)hist[tidx_], __ATOMIC_RELAXED, __HIP_MEMORY_SCOPE_AGENT);
        __syncthreads();
        { const int lrow = tidx_ >> 2, k = tidx_ & 3; const int e = rec_e[tidx_], slot = basee[e] + rec_r[tidx_]; const int t = c * 128 + lrow;
          LIST[e * 32768 + slot] = t; SGATE[e * 32768 + slot] = rec_g[tidx_]; SRSTD[e * 32768 + slot] = rec_s[lrow]; POS[t * 4 + k] = (e << 16) | slot; }
        __syncthreads();
    }
}

__device__ __forceinline__ void load_tile_starts(const Frame& F, const Args& A) {
    const int tidx_ = tid_opaque(F.wave);
    LAS int* ts = (LAS int*)(F.lds + TS_OFF);
    if (tidx_ == 0) { const unsigned* CNT = (const unsigned*)(A.ws + WS_CTL) + CW_CNT; int acc = 0;
        for (int e = 0; e < 32; ++e) { const int c = (int)__hip_atomic_load(CNT + e, __ATOMIC_RELAXED, __HIP_MEMORY_SCOPE_AGENT); ts[e] = acc; ts[40 + e] = c; acc += (c + 255) >> 8; }
        ts[32] = acc; for (int e = 33; e < 40; ++e) ts[e] = 0x7fffffff; }
    __syncthreads();
}

__device__ __forceinline__ void combine_phase(const Frame& F, const Args& A) {
    const int tidx_ = tid_opaque(F.wave);
    const LAS int* ts = (const LAS int*)(F.lds + TS_OFF);
    const bf16* Y = (const bf16*)(A.ws + WS_Y); const int* POS = (const int*)(A.ws + WS_POS); const float* H = A.out; bf16* NX = (bf16*)(A.ws + WS_NX); bf16* H2 = (bf16*)(A.ws + WS_H2);
    const float* gple = A.in[19];
    const int gw = F.vcu * 8 + F.wave, NGW = F.G * 8, lane = (tidx_ & 63);
    for (int t = gw * 2; t < T; t += NGW * 2) {
        int pz[2][4];
#pragma unroll
        for (int r = 0; r < 2; ++r)
#pragma unroll
            for (int k = 0; k < 4; ++k) pz[r][k] = POS[(t + r) * 4 + k];
        f32x4 v[2][2][2];
#pragma unroll
        for (int r = 0; r < 2; ++r)
#pragma unroll
            for (int hf = 0; hf < 2; ++hf) { const float* hp = H + (size_t)(t + r) * D + hf * 512 + 8 * lane; v[r][hf][0] = *(const f32x4*)hp; v[r][hf][1] = *(const f32x4*)(hp + 4); }
        v4u yw[2][4][2];
#pragma unroll
        for (int r = 0; r < 2; ++r)
#pragma unroll
            for (int k = 0; k < 4; ++k) { const int e = pz[r][k] >> 16, slot = pz[r][k] & 0xffff; const bf16* yp = Y + ((size_t)ts[e] * 256 + slot) * D + 8 * lane;
                yw[r][k][0] = *(const v4u*)yp; yw[r][k][1] = *(const v4u*)(yp + 512); }
        float s[2];
#pragma unroll
        for (int r = 0; r < 2; ++r) { float a = 0.f;
#pragma unroll
            for (int hf = 0; hf < 2; ++hf) {
#pragma unroll
                for (int k = 0; k < 4; ++k) { const v4u w = yw[r][k][hf];
                    v[r][hf][0] = v[r][hf][0] + (f32x4){bflo(w.x), bfhi(w.x), bflo(w.y), bfhi(w.y)}; v[r][hf][1] = v[r][hf][1] + (f32x4){bflo(w.z), bfhi(w.z), bflo(w.w), bfhi(w.w)}; }
                st8(H2 + (size_t)(t + r) * D + hf * 512 + 8 * lane, v[r][hf][0], v[r][hf][1]);
#pragma unroll
                for (int p = 0; p < 2; ++p) a += (v[r][hf][p].x * v[r][hf][p].x + v[r][hf][p].y * v[r][hf][p].y) + (v[r][hf][p].z * v[r][hf][p].z + v[r][hf][p].w * v[r][hf][p].w); }
            s[r] = a; }
#pragma unroll
        for (int o = 1; o < 64; o <<= 1) { s[0] += __shfl_xor(s[0], o); s[1] += __shfl_xor(s[1], o); }
#pragma unroll
        for (int r = 0; r < 2; ++r) { const float rstd = 1.0f / sqrtf(s[r] * (1.f / D) + EPS);
#pragma unroll
            for (int hf = 0; hf < 2; ++hf) { const float* gp = gple + hf * 512 + 8 * lane; const f32x4 g0 = *(const f32x4*)gp, g1 = *(const f32x4*)(gp + 4);
                st8(NX + (size_t)(t + r) * D + hf * 512 + 8 * lane, v[r][hf][0] * rstd * g0, v[r][hf][1] * rstd * g1); } }
    }
}
__device__ __forceinline__ void final_phase(const Frame& F, const Args& A) {
    const int tidx_ = tid_opaque(F.wave);
    float* OUT = A.out; const float* gf = A.in[22]; const bf16* T1 = (const bf16*)(A.ws + WS_T1); const bf16* H2 = (const bf16*)(A.ws + WS_H2);
    const int gw = F.vcu * 8 + F.wave, NGW = F.G * 8, lane = (tidx_ & 63);
    f32x4 g[2][2];
#pragma unroll
    for (int hf = 0; hf < 2; ++hf) { const float* gp = gf + hf * 512 + 8 * lane; g[hf][0] = *(const f32x4*)gp; g[hf][1] = *(const f32x4*)(gp + 4); }
    for (int t = gw * 2; t < T; t += NGW * 2) {
        v4u hw[2][2], tw[2][2];
#pragma unroll
        for (int r = 0; r < 2; ++r)
#pragma unroll
            for (int hf = 0; hf < 2; ++hf) { const size_t o = (size_t)(t + r) * D + hf * 512 + 8 * lane; hw[r][hf] = *(const v4u*)(H2 + o); tw[r][hf] = *(const v4u*)(T1 + o); }
        f32x4 v[2][2][2]; float s[2];
#pragma unroll
        for (int r = 0; r < 2; ++r) { float a = 0.f;
#pragma unroll
            for (int hf = 0; hf < 2; ++hf) { const v4u h = hw[r][hf], w = tw[r][hf];
                v[r][hf][0] = (f32x4){bflo(h.x) + bflo(w.x), bfhi(h.x) + bfhi(w.x), bflo(h.y) + bflo(w.y), bfhi(h.y) + bfhi(w.y)};
                v[r][hf][1] = (f32x4){bflo(h.z) + bflo(w.z), bfhi(h.z) + bfhi(w.z), bflo(h.w) + bflo(w.w), bfhi(h.w) + bfhi(w.w)};
#pragma unroll
                for (int p = 0; p < 2; ++p) a += (v[r][hf][p].x * v[r][hf][p].x + v[r][hf][p].y * v[r][hf][p].y) + (v[r][hf][p].z * v[r][hf][p].z + v[r][hf][p].w * v[r][hf][p].w); }
            s[r] = a; }
#pragma unroll
        for (int o = 1; o < 64; o <<= 1) { s[0] += __shfl_xor(s[0], o); s[1] += __shfl_xor(s[1], o); }
#pragma unroll
        for (int r = 0; r < 2; ++r) { const float rstd = 1.0f / sqrtf(s[r] * (1.f / D) + EPS);
#pragma unroll
            for (int hf = 0; hf < 2; ++hf) { float* op = OUT + (size_t)(t + r) * D + hf * 512 + 8 * lane; *(f32x4*)op = v[r][hf][0] * rstd * g[hf][0]; *(f32x4*)(op + 4) = v[r][hf][1] * rstd * g[hf][1]; } }
    }
}

constexpr int NPHASE = 13;
#ifndef ONLY_PH
#define ONLY_PH -1
#endif
#define PH_ON(k) (ONLY_PH < 0 || ONLY_PH == (k))
__global__ void __launch_bounds__(512, 2) fwd_kernel(Args args) {
    extern __shared__ __attribute__((aligned(16))) unsigned char lds[];
    Frame F;
    F.lds = (LAS unsigned char*)lds; F.wave = __builtin_amdgcn_readfirstlane((int)threadIdx.x >> 6);
    F.G = gridDim.x; { const int bx = blockIdx.x; F.vcu = (F.G % 8 == 0) ? (bx % 8) * (F.G / 8) + bx / 8 : bx; }
    unsigned char* ws = args.ws;
    volatile LAS unsigned* MISC = (volatile LAS unsigned*)(F.lds + MISC_OFF);
    for (int u = tid_opaque(F.wave); u < (LDS_BYTES - RING_BYTES) / 4; u += 512) ((LAS unsigned*)(F.lds + RING_BYTES))[u] = 0u;
    __syncthreads();
    const bool multi = (args.ph_hi - args.ph_lo) > 1;
    if (multi) (void)xcd_barrier_post((unsigned*)(ws + WS_CTL) + CW_BAR, MISC + 8, F.wave);
    const int bx = (int)blockIdx.x;
#if MK_N_LAUNCHES == 1
    constexpr int lo = 0, hi = NPHASE;
#else
    const int lo = args.ph_lo, hi = args.ph_hi;
#endif
#ifndef REP_MASK
#define REP_MASK 0
#endif
#define IN(k) (PH_ON(k) && lo <= (k) && (k) < hi)
#define REPS(k) (((REP_MASK >> (k)) & 1) ? 2 : 1)
#define SEAM(k) do { if (lo <= (k) && (k) + 1 < hi) { XcdBarrier b_; b_.bar = (unsigned*)(args.ws + WS_CTL) + CW_BAR; b_.x = xb_xcc_id(); b_.st = (volatile LAS unsigned*)(F.lds + MISC_OFF) + 8; b_.wave = F.wave; xcd_barrier(b_); } } while (0)
    if (IN(0)) for (int rep_ = 0; rep_ < REPS(0); ++rep_) { p0_prologue(F, args); } SEAM(0);
    if (IN(1)) { const int nu1 = (T / 256) * 23, R1 = (nu1 + F.G - 1) / F.G + 1, GG = (nu1 + R1 - 1) / R1;
                 if (bx < GG) { InProjSched S{(const char*)(ws + WS_NX), (const char*)(ws + WS_WIN), GG, bx, REPS(1) - 1};
                 EpiInProj E{(bf16*)(ws + WS_Q), (bf16*)(ws + WS_K), (bf16*)(ws + WS_ZU), (bf16*)(ws + WS_GA), (bf16*)(ws + WS_GG), (bf16*)(ws + WS_VT), (bf16*)(ws + WS_ZVT)};
                 pg8::gemm_phase(F.lds, D, S, E, F.wave); }
                 convert_queue(F, args, (unsigned*)(ws + WS_CTL) + CW_Q1, 0, BG_P1); convert_queue(F, args, (unsigned*)(ws + WS_CTL) + CW_Q3, BG_N, BG_ALL); convert_p_queue(F, args, (unsigned*)(ws + WS_CTL) + CW_Q4); } SEAM(1);
    if (IN(2)) { attn_phase(F, args); spatial_phase(F, args); } SEAM(2);
    if (IN(3)) { merge_phase(F, args); } SEAM(3);
    if (IN(4)) { PlainSched S{(const char*)(ws + WS_AG), (const char*)(ws + WS_WCAT), T / 256, 4, D, F.G, bx, REPS(4) - 1}; EpiMerge E{(bf16*)(ws + WS_MRG), (const bf16*)(ws + WS_GA), (const bf16*)(ws + WS_GG)};
                 pg8::gemm_phase(F.lds, D, S, E, F.wave); } SEAM(5);
    if (IN(6)) { PlainSched S{(const char*)(ws + WS_MRG), (const char*)(ws + WS_WOUT), T / 256, 4, D, F.G, bx, REPS(6) - 1}; EpiF32<0> E{args.out, args.in[0], nullptr};
                 pg8::gemm_phase(F.lds, D, S, E, F.wave); } SEAM(6);
    if (IN(7)) for (int rep_ = 0; rep_ < REPS(7); ++rep_) { router_phase(F, args); } SEAM(7);
    if (IN(8)) { load_tile_starts(F, args); const LAS int* ts = (const LAS int*)(F.lds + TS_OFF);
                 const int nu8 = ts[32] * 8, R8 = (nu8 + F.G - 1) / F.G, GG = R8 > 0 ? (nu8 + R8 - 1) / R8 : 1;
                 if (bx < GG) { MoeSched S{(const char*)(ws + WS_NX), (const char*)(ws + WS_WGU), (const int*)(ws + WS_LIST), ts, 8, D, GG, bx, 1, REPS(8) - 1}; EpiMoeUp E{(bf16*)(ws + WS_ACT), args.in[16], (const float*)(ws + WS_SRSTD), ts};
                 pg8::gemm_phase(F.lds, D, S, E, F.wave); }
                 convert_queue(F, args, (unsigned*)(ws + WS_CTL) + CW_Q2, BG_GU, BG_N); } SEAM(8);
    if (IN(9)) { load_tile_starts(F, args); const LAS int* ts = (const LAS int*)(F.lds + TS_OFF);
                 const int nu9 = ts[32] * 4, R9 = (nu9 + F.G - 1) / F.G, GG = R9 > 0 ? (nu9 + R9 - 1) / R9 : 1, NH = F.G - GG;
                 if (bx < GG) { MoeSched S{(const char*)(ws + WS_ACT), (const char*)(ws + WS_WD), (const int*)(ws + WS_LIST), ts, 4, D, GG, bx, 0, REPS(9) - 1}; EpiMoeDown E{(bf16*)(ws + WS_Y), args.in[18], (const float*)(ws + WS_SGATE), ts};
                 pg8::gemm_phase(F.lds, D, S, E, F.wave); }
                 if (NH >= 8 ? bx >= GG : true) { PlainSched S{(const char*)(ws + WS_PB), (const char*)(ws + WS_WPP), T / 256, 4, PLE, NH >= 8 ? NH : F.G, NH >= 8 ? bx - GG : bx, 0}; EpiBf<0> E{(bf16*)(ws + WS_PP), nullptr, nullptr};
                 pg8::gemm_phase(F.lds, PLE, S, E, F.wave); } } SEAM(9);
    if (IN(10)) for (int rep_ = 0; rep_ < REPS(10); ++rep_) { load_tile_starts(F, args); combine_phase(F, args); } SEAM(10);
    if (IN(11)) { PlainSched S{(const char*)(ws + WS_NX), (const char*)(ws + WS_WPG), T / 256, 4, D, F.G, bx, REPS(11) - 1}; EpiPle E{(bf16*)(ws + WS_T1), (const bf16*)(ws + WS_PP)};
                  pg8::gemm_phase(F.lds, D, S, E, F.wave); } SEAM(11);
    if (IN(12)) for (int rep_ = 0; rep_ < REPS(12); ++rep_) { final_phase(F, args); }
#undef IN
#undef SEAM
}

extern "C" void kernel_launch(void* const* d_in, const int* in_sizes, int n_in, void* d_out, int out_size, void* d_ws, size_t ws_size, hipStream_t stream) {
    static int grid = 0;
    if (grid == 0) {
        if (n_in != 23 || out_size != T * D || ws_size < WS_END) { fprintf(stderr, "kernel_launch: unexpected shapes (n_in %d out %d ws %zu)\n", n_in, out_size, ws_size); grid = -1; return; }
        int dev = 0, cus = 0, per_cu = 0;
        if (hipGetDevice(&dev) != hipSuccess || hipDeviceGetAttribute(&cus, hipDeviceAttributeMultiprocessorCount, dev) != hipSuccess) { grid = -1; return; }
        if (hipFuncSetAttribute((const void*)fwd_kernel, hipFuncAttributeMaxDynamicSharedMemorySize, LDS_BYTES) != hipSuccess) { fprintf(stderr, "kernel_launch: hipFuncSetAttribute failed\n"); grid = -1; return; }
        if (hipOccupancyMaxActiveBlocksPerMultiprocessor(&per_cu, (const void*)fwd_kernel, 512, LDS_BYTES) != hipSuccess || per_cu < 1) { fprintf(stderr, "kernel_launch: occupancy query says %d\n", per_cu); (void)hipGetLastError(); grid = -1; return; }
        grid = cus;
    }
    if (grid < 0) return;
    (void)hipMemsetAsync((char*)d_ws + WS_CTL, 0, CTL_ZERO_BYTES, stream);
    Args a{};
    for (int i = 0; i < 23; ++i) a.in[i] = (const float*)d_in[i];
    a.out = (float*)d_out; a.ws = (unsigned char*)d_ws;
#if MK_N_LAUNCHES == 1
    a.ph_lo = 0; a.ph_hi = NPHASE;
    hipLaunchKernelGGL(fwd_kernel, dim3(grid), dim3(512), LDS_BYTES, stream, a);
#else
    for (int ph = 0; ph < NPHASE; ++ph) { a.ph_lo = ph; a.ph_hi = ph + 1; hipLaunchKernelGGL(fwd_kernel, dim3(grid), dim3(512), LDS_BYTES, stream, a); }
#endif
}
```

```cpp
#include <hip/hip_runtime.h>
#include <cstdio>
#include <cstdint>

#ifndef MK_N_LAUNCHES
#define MK_N_LAUNCHES 1
#endif

constexpr int NB = 8, SEQ = 4096, T = NB * SEQ, D = 1024;
constexpr int ATT_W = 768, GM_W = 768, IN_W = 5888, NE = 32, TOPK = 4, PLE = 256;
constexpr float EPS = 1e-6f;
constexpr float LOG2E = 1.4426950408889634f, LN2 = 0.6931471805599453f;
constexpr float QSCALE = 0.125f * LOG2E;

#define LAS __attribute__((address_space(3)))
#define GAS __attribute__((address_space(1)))
typedef unsigned short bf16;
typedef unsigned v4u __attribute__((ext_vector_type(4)));
typedef unsigned v2u __attribute__((ext_vector_type(2)));
typedef float f32x4 __attribute__((ext_vector_type(4)));
typedef float f32x2 __attribute__((ext_vector_type(2)));
typedef float f32x16 __attribute__((ext_vector_type(16)));
typedef short bf16x8 __attribute__((ext_vector_type(8)));
typedef short s16x4 __attribute__((ext_vector_type(4)));

__device__ __forceinline__ unsigned f2bf(float f) { unsigned u = __builtin_bit_cast(unsigned, f); return (u + 0x7fffu + ((u >> 16) & 1u)) >> 16; }
__device__ __forceinline__ unsigned pk2(float lo, float hi) { return f2bf(lo) | (f2bf(hi) << 16); }
__device__ __forceinline__ float bflo(unsigned w) { return __builtin_bit_cast(float, w << 16); }
__device__ __forceinline__ float bfhi(unsigned w) { return __builtin_bit_cast(float, w & 0xffff0000u); }
typedef __bf16 bf16x2_t __attribute__((ext_vector_type(2)));
__device__ __forceinline__ unsigned cvt_pk_bf16(float lo, float hi) { const f32x2 v = {lo, hi}; const bf16x2_t b = __builtin_convertvector(v, bf16x2_t); return __builtin_bit_cast(unsigned, b); }
__device__ __forceinline__ float sigmoidf_(float x) { return __builtin_amdgcn_rcpf(1.0f + __builtin_amdgcn_exp2f(-x * LOG2E)); }
__device__ __forceinline__ f32x2 gelu_pk(f32x2 v) {
    const f32x2 av = __builtin_elementwise_abs(v), d = av * 0.2316418882f + 1.0f;
    f32x2 t; t.x = __builtin_amdgcn_rcpf(d.x); t.y = __builtin_amdgcn_rcpf(d.y);
    f32x2 q = t * 0.5307027145f + (-0.7265760135f); q = q * t + 0.7107068705f; q = q * t + (-0.142248368f); q = q * t + 0.127414796f; q = q * t;
    const f32x2 s = (v * v) * (-0.72134752044f);
    f32x2 e; e.x = __builtin_amdgcn_exp2f(s.x); e.y = __builtin_amdgcn_exp2f(s.y);
    const f32x2 m = v * (q * e), r = v - m;
    f32x2 o; o.x = v.x < 0.f ? m.x : r.x; o.y = v.y < 0.f ? m.y : r.y; return o;
}
__device__ __forceinline__ f32x4 gelu4(f32x4 v) { f32x2 a = gelu_pk((f32x2){v[0], v[1]}), b = gelu_pk((f32x2){v[2], v[3]}); return (f32x4){a.x, a.y, b.x, b.y}; }
__device__ __forceinline__ f32x4 sigm4(f32x4 v) { return (f32x4){sigmoidf_(v[0]), sigmoidf_(v[1]), sigmoidf_(v[2]), sigmoidf_(v[3])}; }
__device__ __forceinline__ int tid_opaque(int wave) {
    int l; asm volatile("v_mbcnt_lo_u32_b32 %0, -1, 0\n\tv_mbcnt_hi_u32_b32 %0, -1, %0" : "=v"(l));
    return wave * 64 + l;
}
__device__ __forceinline__ float wave_sum(float v) {
#pragma unroll
    for (int o = 1; o < 64; o <<= 1) v += __shfl_xor(v, o);
    return v;
}

constexpr size_t MiB = 1u << 20;
constexpr size_t WS_CTL = 0, CTL_ZERO_BYTES = 1 * MiB;
constexpr size_t WS_WIN = 2 * MiB;
constexpr size_t WS_WCAT = 14 * MiB;
constexpr size_t WS_WOUT = 17 * MiB;
constexpr size_t WS_WPG = 19 * MiB;
constexpr size_t WS_WPP = 21 * MiB;
constexpr size_t WS_WSP = 22 * MiB;
constexpr size_t WS_WRH = 23 * MiB;
constexpr size_t WS_WRL = 23 * MiB + 65536;
constexpr size_t WS_SRSTD = 980 * MiB;
constexpr size_t WS_WGU = 24 * MiB;
constexpr size_t WS_WD = 152 * MiB;
constexpr size_t WS_NX = 216 * MiB;
constexpr size_t WS_PB = 280 * MiB;
constexpr size_t WS_PP = 296 * MiB;
constexpr size_t WS_LIST = 360 * MiB;
constexpr size_t WS_SGATE = 364 * MiB;
constexpr size_t WS_POS = 368 * MiB;
constexpr size_t WS_LSE = 369 * MiB;
constexpr size_t WS_Q = 372 * MiB;
constexpr size_t WS_K = 420 * MiB;
constexpr size_t WS_VT = 468 * MiB;
constexpr size_t WS_ZU = 516 * MiB;
constexpr size_t WS_ZVT = 564 * MiB;
constexpr size_t WS_GA = 612 * MiB;
constexpr size_t WS_GG = 676 * MiB;
constexpr size_t WS_OG = 740 * MiB;
constexpr size_t WS_ATT = 788 * MiB;
constexpr size_t WS_G = 804 * MiB;
constexpr size_t WS_AG = 852 * MiB;
constexpr size_t WS_MRG = 916 * MiB;
constexpr size_t WS_ACT = 372 * MiB;
constexpr size_t WS_Y = 644 * MiB;
constexpr size_t WS_H2 = 436 * MiB;
constexpr size_t WS_T1 = 372 * MiB;
constexpr size_t WS_END = 984 * MiB;
constexpr int PMAX_TILES = 544;

constexpr int CW_CNT = 64;
constexpr int CW_Q1 = 256, CW_Q2 = 320, CW_Q3 = 384, CW_Q4 = 448;
constexpr int CW_BAR = 4096;

constexpr int RING_BYTES = 131072;
constexpr int MISC_OFF = RING_BYTES + 320;
constexpr int TS_OFF = RING_BYTES + 1024;
constexpr int LDS_BYTES = 147456;

namespace pg8 {
typedef unsigned short bf16_t;
constexpr int BM = 256, BK = 64, HALF = 128, HTB = HALF * BK * 2, STAGE_BYTES = 8 * HTB, NXCD = 8, WGM = 8;
__host__ __device__ __forceinline__ int lds_byte(int r, int c) { const int st = (r >> 4) * 2 + (c >> 5), rr = r & 15, cc = c & 31, ob = rr * 64 + cc * 2; return st * 1024 + (ob ^ (((ob >> 9) & 1) << 5)); }
__host__ __device__ __forceinline__ void stage_rc(int b, int& R, int& C) { const int st = b / 1024, sb = b % 1024, swz = sb ^ (((sb >> 9) & 1) << 5); R = (st >> 1) * 16 + swz / 64; C = (st & 1) * 32 + (swz % 64) / 2; }
__host__ __device__ __forceinline__ int perm32(int rho) { const int n = rho >> 4, i = rho & 15; return 8 * (i >> 2) + 4 * n + (i & 3); }

struct Unit { const char* a; const char* b; int pm, pn, x0, x1; };

__device__ __forceinline__ bool static_order(int i, int G, int c, int nM, int nN, int& pm, int& pn) {
    const int nwg = nM * nN; const long L = (long)i * G + c; if (L >= nwg) return false;
    int wgid = (int)L; { const int q = nwg / NXCD, r = nwg % NXCD, xcd = wgid % NXCD, off = wgid / NXCD; wgid = (xcd < r ? xcd * (q + 1) : r * (q + 1) + (xcd - r) * q) + off; }
    const int nig = WGM * nN, gid = wgid / nig, fm = gid * WGM, gsz = (nM - fm) < WGM ? (nM - fm) : WGM;
    pm = fm + ((wgid % nig) % gsz); pn = (wgid % nig) / gsz; return true;
}

template <class Epi, class Sched>
__device__ __forceinline__ void gemm_phase(LAS unsigned char* lds, const int K, const Sched& S, const Epi& E, const int wave) {
    const int wid = wave, tid = tid_opaque(wid), lane = tid & 63, wr = wid >> 2, wc = wid & 3, fr = lane & 15, fq = lane >> 4;
    const int nt = K / BK;
    int RA[2]; unsigned CB2[2], rbk[2];
#pragma unroll
    for (int i = 0; i < 2; ++i) { int R, C; stage_rc(tid * 16 + i * 8192, R, C); const int Rb = Epi::PERM ? ((R & ~31) + perm32(R & 31)) : R;
        RA[i] = R; CB2[i] = (unsigned)C * 2u; rbk[i] = (unsigned)(Rb * K) * 2u; }
    const size_t kstep = (size_t)(BK * 2);
    const size_t hstep = (size_t)HALF * K * 2;
    const unsigned ldsw = (unsigned)wid * 1024u;
    const int aoff = lds_byte(wr * 64 + fr, fq * 8), boff = lds_byte(wc * 32 + fr, fq * 8);
#define PG8_SA(b, h) (((b) * 2 + (h)) * HTB)
#define PG8_SB(b, h) ((4 + (b) * 2 + (h)) * HTB)
#define PG8_STAGE(bufoff, gbase, voff) do { _Pragma("unroll") for (int _i = 0; _i < 2; ++_i) \
        __builtin_amdgcn_global_load_lds((const unsigned*)((const char*)(gbase) + (voff)[_i]), (LAS unsigned*)(lds + (bufoff) + ldsw + _i * 8192), 16, 0, 0); } while (0)
#define PG8_LDA(dst, b, h) do { _Pragma("unroll") for (int m = 0; m < 4; ++m) _Pragma("unroll") for (int k = 0; k < 2; ++k) dst[m][k] = *(const LAS bf16x8*)(lds + PG8_SA(b, h) + aoff + m * 2048 + k * 1024); } while (0)
#define PG8_LDB(dst, b, h) do { _Pragma("unroll") for (int n = 0; n < 2; ++n) _Pragma("unroll") for (int k = 0; k < 2; ++k) dst[n][k] = *(const LAS bf16x8*)(lds + PG8_SB(b, h) + boff + n * 2048 + k * 1024); } while (0)
#define PG8_MMA(ai, bj, At, Bt) do { __builtin_amdgcn_s_setprio(1); _Pragma("unroll") for (int m = 0; m < 4; ++m) _Pragma("unroll") for (int n = 0; n < 2; ++n) _Pragma("unroll") for (int k = 0; k < 2; ++k) \
        acc[ai][bj][m][n] = __builtin_amdgcn_mfma_f32_16x16x32_bf16(Bt[n][k], At[m][k], acc[ai][bj][m][n], 0, 0, 0); __builtin_amdgcn_s_setprio(0); } while (0)
#define PG8_WAIT_V(n) asm volatile("s_waitcnt vmcnt(" #n ")" ::: "memory")
#define PG8_WAIT_L(n) asm volatile("s_waitcnt lgkmcnt(" #n ")" ::: "memory")
#define PG8_BAR __builtin_amdgcn_s_barrier()
#define PG8_SCHED __builtin_amdgcn_sched_barrier(0)
    Unit cur, nxt; int ui = 0;
    if (!S.next(0, cur)) return;
    f32x4 acc[2][2][4][2];
#pragma unroll
    for (int a = 0; a < 2; ++a)
#pragma unroll
        for (int b = 0; b < 2; ++b)
#pragma unroll
            for (int m = 0; m < 4; ++m)
#pragma unroll
                for (int n = 0; n < 2; ++n) acc[a][b][m][n] = (f32x4){0.f, 0.f, 0.f, 0.f};
    bf16x8 At[4][2], B0[2][2], B1[2][2];
    const char* cA = cur.a; const char* cB = cur.b;
    unsigned oA[2][2], nO[2][2];
#pragma unroll
    for (int h = 0; h < 2; ++h)
#pragma unroll
        for (int i = 0; i < 2; ++i) oA[h][i] = S.a_off(cur, h * HALF + RA[i], K) + CB2[i];
    int csh = S.b_shift(cur); unsigned vbc[2] = {(rbk[0] << csh) + CB2[0], (rbk[1] << csh) + CB2[1]}, vbn[2];
    PG8_STAGE(PG8_SB(0, 0), cB, vbc); PG8_STAGE(PG8_SB(0, 1), cB + (hstep << csh), vbc); PG8_STAGE(PG8_SA(0, 0), cA, oA[0]); PG8_STAGE(PG8_SA(0, 1), cA, oA[1]);
    if (wr == 1) PG8_BAR;
    PG8_WAIT_V(2); PG8_BAR;
    PG8_STAGE(PG8_SB(1, 0), cB + kstep, vbc); PG8_STAGE(PG8_SA(1, 0), cA + kstep, oA[0]); PG8_STAGE(PG8_SB(1, 1), cB + (hstep << csh) + kstep, vbc);
    PG8_WAIT_V(6); PG8_BAR;
    for (;;) {
        const bool has_next = S.next(ui + 1, nxt);
        const char* nA = has_next ? nxt.a : cA; const char* nB = has_next ? nxt.b : cB;
        const int nsh = has_next ? S.b_shift(nxt) : csh; vbn[0] = (rbk[0] << nsh) + CB2[0]; vbn[1] = (rbk[1] << nsh) + CB2[1];
#pragma unroll
        for (int h = 0; h < 2; ++h)
#pragma unroll
            for (int i = 0; i < 2; ++i) nO[h][i] = has_next ? (S.a_off(nxt, h * HALF + RA[i], K) + CB2[i]) : oA[h][i];
#pragma unroll 1
        for (int t = 0; t < nt; t += 2) {
            const bool last = (t == nt - 2);
            const char* a1 = cA + (size_t)(t + 1) * kstep;
            const char* a2 = last ? nA : cA + (size_t)(t + 2) * kstep; const char* b2 = last ? nB : cB + (size_t)(t + 2) * kstep;
            const char* a3 = a2 + kstep; const char* b3 = b2 + kstep;
            unsigned o2[2][2]; const unsigned vb2[2] = {last ? vbn[0] : vbc[0], last ? vbn[1] : vbc[1]}; const size_t hs2 = hstep << (last ? nsh : csh);
#pragma unroll
            for (int h = 0; h < 2; ++h)
#pragma unroll
                for (int i = 0; i < 2; ++i) o2[h][i] = last ? nO[h][i] : oA[h][i];
            PG8_LDB(B0, 0, 0); PG8_LDB(B1, 0, 1); PG8_SCHED; PG8_LDA(At, 0, 0); PG8_STAGE(PG8_SA(1, 1), a1, oA[1]);
            PG8_WAIT_V(8); PG8_WAIT_L(0); PG8_BAR; PG8_MMA(0, 0, At, B0); PG8_MMA(0, 1, At, B1); PG8_BAR; PG8_SCHED;
            PG8_LDA(At, 0, 1); PG8_STAGE(PG8_SB(0, 0), b2, vb2); PG8_STAGE(PG8_SB(0, 1), b2 + hs2, vb2); PG8_STAGE(PG8_SA(0, 0), a2, o2[0]);
            PG8_WAIT_V(8); PG8_WAIT_L(0); PG8_BAR; PG8_MMA(1, 0, At, B0); PG8_MMA(1, 1, At, B1); PG8_BAR; PG8_SCHED;
            PG8_LDB(B0, 1, 0); PG8_LDB(B1, 1, 1); PG8_SCHED; PG8_LDA(At, 1, 0); PG8_STAGE(PG8_SA(0, 1), a2, o2[1]);
            PG8_WAIT_V(8); PG8_WAIT_L(0); PG8_BAR; PG8_MMA(0, 0, At, B0); PG8_MMA(0, 1, At, B1); PG8_BAR; PG8_SCHED;
            PG8_LDA(At, 1, 1); PG8_STAGE(PG8_SB(1, 0), b3, vb2); PG8_STAGE(PG8_SB(1, 1), b3 + hs2, vb2); PG8_STAGE(PG8_SA(1, 0), a3, o2[0]);
            PG8_WAIT_V(8); PG8_WAIT_L(0); PG8_BAR; PG8_MMA(1, 0, At, B0); PG8_MMA(1, 1, At, B1); PG8_BAR; PG8_SCHED;
            if constexpr (Epi::HOOK_T >= 0) { if (t == Epi::HOOK_T) { E.mid(acc, cur, wr, wc, fr, fq); PG8_SCHED; } }
        }
        if (wr == 0) PG8_BAR;
        E(acc, cur, wr, wc, fr, fq);
        if (!has_next) break;
#pragma unroll
        for (int a = 0; a < 2; ++a)
#pragma unroll
            for (int b = 0; b < 2; ++b)
#pragma unroll
                for (int m = 0; m < 4; ++m)
#pragma unroll
                    for (int n = 0; n < 2; ++n) acc[a][b][m][n] = (f32x4){0.f, 0.f, 0.f, 0.f};
        cur = nxt; cA = nA; cB = nB; ++ui; csh = nsh; vbc[0] = vbn[0]; vbc[1] = vbn[1];
#pragma unroll
        for (int h = 0; h < 2; ++h)
#pragma unroll
            for (int i = 0; i < 2; ++i) oA[h][i] = nO[h][i];
        if (wr == 1) PG8_BAR;
    }
    PG8_WAIT_V(0);
    PG8_BAR;
#undef PG8_SA
#undef PG8_SB
#undef PG8_STAGE
#undef PG8_LDA
#undef PG8_LDB
#undef PG8_MMA
#undef PG8_WAIT_V
#undef PG8_WAIT_L
#undef PG8_BAR
#undef PG8_SCHED
}
}
using pg8::Unit;
typedef f32x4 Acc[2][2][4][2];

struct PlainSched {
    const char* A; const char* Bt; int nM, nN, K, G, c, rsh;
    __device__ __forceinline__ bool next(int i, Unit& u) const {
        int pm, pn; if (!pg8::static_order(i >> rsh, G, c, nM, nN, pm, pn)) return false;
        u.pm = pm; u.pn = pn; u.x0 = 0; u.x1 = 0; u.a = A + (size_t)pm * 256 * K * 2; u.b = Bt + (size_t)pn * 256 * K * 2; return true;
    }
    __device__ __forceinline__ unsigned a_off(const Unit&, int row, int K_) const { return (unsigned)(row * K_) * 2u; }
    __device__ __forceinline__ int b_shift(const Unit&) const { return 0; }
};
struct InProjSched {
    const char* NX; const char* Wt; int G, c, rsh;
    __device__ __forceinline__ bool next(int i, Unit& u) const {
        int pm, pn; if (!pg8::static_order(i >> rsh, G, c, T / 256, 23, pm, pn)) return false;
        u.pm = pm; u.pn = pn; u.x0 = 0; u.x1 = 0;
        const char* xa = NX + (size_t)pm * 256 * D * 2; const char* wb = Wt + (size_t)pn * 256 * D * 2;
        if (pn < 17) { u.a = xa; u.b = wb; } else { u.a = wb; u.b = xa;
            if (pn < 20) { const int sh = 2 * (pn - 17), j0 = (pm & 15) * 256, r = j0 >> (12 - sh), i0 = j0 & ((SEQ >> sh) - 1);
                u.x0 = sh; u.b = NX + ((size_t)(pm >> 4) * SEQ + ((size_t)i0 << sh) + r) * D * 2; } }
        return true;
    }
    __device__ __forceinline__ unsigned a_off(const Unit&, int row, int K_) const { return (unsigned)(row * K_) * 2u; }
    __device__ __forceinline__ int b_shift(const Unit& u) const { return u.x0; }
};
struct MoeSched {
    const char* A; const char* Bt; const int* list; const LAS int* ts; int nN, K, G, c, gather, rsh;
    __device__ __forceinline__ bool next(int i, Unit& u) const {
        const int MT = ts[32];
        int pm, pn; if (!pg8::static_order(i >> rsh, G, c, MT, nN, pm, pn)) return false;
        int e = 0;
#pragma unroll
        for (int s = 16; s >= 1; s >>= 1) { if (ts[e + s] <= pm) e += s; }
        e = __builtin_amdgcn_readfirstlane(e);
        u.pm = pm; u.pn = pn; u.x0 = e; u.x1 = __builtin_amdgcn_readfirstlane(pm - ts[e]);
        u.a = gather ? A : A + (size_t)pm * 256 * K * 2;
        u.b = Bt + ((size_t)e * nN + pn) * 256 * K * 2;
        return true;
    }
    __device__ __forceinline__ unsigned a_off(const Unit& u, int row, int K_) const {
        if (!gather) return (unsigned)(row * K_) * 2u;
        const int slot = u.x1 * 256 + row, cnt = ts[40 + u.x0];
        const int tok = slot < cnt ? list[u.x0 * 32768 + slot] : 0;
        return (unsigned)(tok * K_) * 2u;
    }
    __device__ __forceinline__ int b_shift(const Unit&) const { return 0; }
};

__device__ __forceinline__ void st8(bf16* p, f32x4 v0, f32x4 v1) { v4u w; w.x = cvt_pk_bf16(v0[0], v0[1]); w.y = cvt_pk_bf16(v0[2], v0[3]); w.z = cvt_pk_bf16(v1[0], v1[1]); w.w = cvt_pk_bf16(v1[2], v1[3]); *(v4u*)p = w; }
__device__ __forceinline__ v4u widen_pair(v2u a, v2u b) {
    auto rx = __builtin_amdgcn_permlane32_swap(a.x, b.x, false, false); auto ry = __builtin_amdgcn_permlane32_swap(a.y, b.y, false, false);
    v4u w; w.x = rx[0]; w.y = ry[0]; w.z = rx[1]; w.w = ry[1]; return w;
}
__device__ __forceinline__ void ld8(const bf16* p, f32x4& v0, f32x4& v1) { const v4u w = *(const v4u*)p; v0 = (f32x4){bflo(w.x), bfhi(w.x), bflo(w.y), bfhi(w.y)}; v1 = (f32x4){bflo(w.z), bfhi(w.z), bflo(w.w), bfhi(w.w)}; }

struct EpiInProj {
    static constexpr bool PERM = true; static constexpr int HOOK_T = -1;
    bf16 *Q, *Kb, *ZU, *GA, *GG, *VT, *ZVT;
    template <int ACT> __device__ __forceinline__ void std_store(const Acc& acc, bf16* base, int ldc, int colt, int pm, int wr, int wc, int fr, int fq) const {
        const int row0 = pm * 256 + wr * 64 + fr, col0 = colt + wc * 32 + 8 * fq;
#pragma unroll
        for (int ai = 0; ai < 2; ++ai)
#pragma unroll
            for (int m = 0; m < 4; ++m) { bf16* rowp = base + (size_t)(row0 + ai * 128 + m * 16) * ldc + col0;
#pragma unroll
                for (int bj = 0; bj < 2; ++bj) { f32x4 v0 = acc[ai][bj][m][0], v1 = acc[ai][bj][m][1];
                    if (ACT == 1) { v0 = v0 * QSCALE; v1 = v1 * QSCALE; }
                    if (ACT == 2) { v0 = gelu4(v0); v1 = gelu4(v1); }
                    if (ACT == 3) { v0 = sigm4(v0); v1 = sigm4(v1); }
                    st8(rowp + bj * 128, v0, v1); } }
    }
    template <int ACT> __device__ __forceinline__ void tile_store(const Acc& acc, bf16* base, int g, int pm, int wr, int wc, int fr, int fq) const {
        const int dsh = 2 * g, row0 = pm * 256 + wr * 64 + fr;
#pragma unroll
        for (int ai = 0; ai < 2; ++ai)
#pragma unroll
            for (int m = 0; m < 4; ++m) { const int t = row0 + ai * 128 + m * 16, bb = t >> 12, sq = t & (SEQ - 1), r = sq & ((1 << dsh) - 1), i = sq >> dsh, kb = i >> 5, key = i & 31;
#pragma unroll
                for (int bj = 0; bj < 2; ++bj) { const int cw = bj * 128 + wc * 32 + 8 * fq, hh = cw >> 6, dd = cw & 63;
                    f32x4 v0 = acc[ai][bj][m][0], v1 = acc[ai][bj][m][1];
                    if (ACT == 1) { v0 = v0 * QSCALE; v1 = v1 * QSCALE; }
                    st8(base + ((size_t)((bb * 3 + g) * 4 + hh) * 128 + (size_t)((r << (7 - dsh)) + kb)) * 2048 + key * 64 + dd, v0, v1); } }
    }
    __device__ __forceinline__ void operator()(const Acc& acc, const Unit& u, int wr, int wc, int fr, int fq) const {
        const int pn = u.pn, pm = u.pm;
        if (pn < 3) tile_store<1>(acc, Q, pn, pm, wr, wc, fr, fq);
        else if (pn < 6) tile_store<0>(acc, Kb, pn - 3, pm, wr, wc, fr, fq);
        else if (pn < 9) std_store<2>(acc, ZU, GM_W, (pn - 6) * 256, pm, wr, wc, fr, fq);
        else if (pn < 13) std_store<3>(acc, GA, D, (pn - 9) * 256, pm, wr, wc, fr, fq);
        else if (pn < 17) std_store<3>(acc, GG, D, (pn - 13) * 256, pm, wr, wc, fr, fq);
        else if (pn < 20) {
            const int g = pn - 17, sh = 2 * g, bb = pm >> 4, j0 = (pm & 15) * 256, r = j0 >> (12 - sh), i0 = j0 & ((SEQ >> sh) - 1), nKB = 128 >> sh;
#pragma unroll
            for (int ai = 0; ai < 2; ++ai)
#pragma unroll
                for (int m = 0; m < 4; ++m) { const int chl = ai * 128 + wr * 64 + m * 16 + fr, hh = chl >> 6, dd = chl & 63;
                    bf16* hb = VT + (size_t)((bb * 3 + g) * 4 + hh) * (128 * 64 * 32) + dd * 32;
#pragma unroll
                    for (int bj = 0; bj < 2; ++bj) { const int i = i0 + bj * 128 + wc * 32 + 8 * fq;
                        st8(hb + (size_t)(r * nKB + (i >> 5)) * 2048 + (i & 31), acc[ai][bj][m][0], acc[ai][bj][m][1]); } }
        } else {
            const int ch0 = (pn - 20) * 256 + wr * 64 + fr, tin = wc * 32 + 8 * fq;
#pragma unroll
            for (int ai = 0; ai < 2; ++ai)
#pragma unroll
                for (int m = 0; m < 4; ++m) { const int ch = ch0 + ai * 128 + m * 16;
#pragma unroll
                    for (int bj = 0; bj < 2; ++bj) st8(ZVT + ((size_t)(2 * pm + bj) * GM_W + ch) * 128 + tin, gelu4(acc[ai][bj][m][0]), gelu4(acc[ai][bj][m][1])); }
        }
    }
};
template <int MODE> struct EpiBf {
    static constexpr bool PERM = true; static constexpr int HOOK_T = -1;
    bf16* O; const bf16* G1; const bf16* Y0;
    __device__ __forceinline__ void operator()(const Acc& acc, const Unit& u, int wr, int wc, int fr, int fq) const {
        const int row0 = u.pm * 256 + wr * 64 + fr, col0 = u.pn * 256 + wc * 32 + 8 * fq;
#pragma unroll
        for (int ai = 0; ai < 2; ++ai) {
            v4u gw[4][2], yw[4][2];
            if (MODE >= 1) {
#pragma unroll
                for (int m = 0; m < 4; ++m)
#pragma unroll
                    for (int bj = 0; bj < 2; ++bj) { const size_t off = (size_t)(row0 + ai * 128 + m * 16) * D + col0 + bj * 128; gw[m][bj] = *(const v4u*)(G1 + off); if (MODE == 2) yw[m][bj] = *(const v4u*)(Y0 + off); }
                __builtin_amdgcn_sched_barrier(0);
            }
#pragma unroll
            for (int m = 0; m < 4; ++m)
#pragma unroll
                for (int bj = 0; bj < 2; ++bj) { const size_t off = (size_t)(row0 + ai * 128 + m * 16) * D + col0 + bj * 128; f32x4 v0 = acc[ai][bj][m][0], v1 = acc[ai][bj][m][1];
                    if (MODE >= 1) { const v4u w = gw[m][bj]; v0 = v0 * (f32x4){bflo(w.x), bfhi(w.x), bflo(w.y), bfhi(w.y)}; v1 = v1 * (f32x4){bflo(w.z), bfhi(w.z), bflo(w.w), bfhi(w.w)}; }
                    if (MODE == 2) { const v4u w = yw[m][bj]; v0 = v0 + (f32x4){bflo(w.x), bfhi(w.x), bflo(w.y), bfhi(w.y)}; v1 = v1 + (f32x4){bflo(w.z), bfhi(w.z), bflo(w.w), bfhi(w.w)}; }
                    st8(O + off, v0, v1); }
            if (MODE >= 1) __builtin_amdgcn_sched_barrier(0);
        }
    }
};
template <int MODE> struct EpiF32 {
    static constexpr bool PERM = false; static constexpr int HOOK_T = -1;
    float* H; const float* X; const bf16* PP;
    __device__ __forceinline__ void operator()(const Acc& acc, const Unit& u, int wr, int wc, int fr, int fq) const {
        const int row0 = u.pm * 256 + wr * 64 + fr, col0 = u.pn * 256 + wc * 32 + 4 * fq;
        const float* src = MODE == 0 ? X : H;
        constexpr int MB = MODE == 0 ? 4 : 2;
#pragma unroll
        for (int ai = 0; ai < 2; ++ai)
#pragma unroll
            for (int mb = 0; mb < 4; mb += MB) {
                f32x4 xv[MB][2][2]; v2u pw[MB][2][2];
#pragma unroll
                for (int m = 0; m < MB; ++m)
#pragma unroll
                    for (int bj = 0; bj < 2; ++bj)
#pragma unroll
                        for (int n = 0; n < 2; ++n) { const size_t o = (size_t)(row0 + ai * 128 + (mb + m) * 16) * D + col0 + bj * 128 + n * 16; xv[m][bj][n] = *(const f32x4*)(src + o); if (MODE == 1) pw[m][bj][n] = *(const v2u*)(PP + o); }
                __builtin_amdgcn_sched_barrier(0);
#pragma unroll
                for (int m = 0; m < MB; ++m)
#pragma unroll
                    for (int bj = 0; bj < 2; ++bj)
#pragma unroll
                        for (int n = 0; n < 2; ++n) { const size_t o = (size_t)(row0 + ai * 128 + (mb + m) * 16) * D + col0 + bj * 128 + n * 16; f32x4 v = acc[ai][bj][mb + m][n];
                            if (MODE == 0) v = v + xv[m][bj][n];
                            else { const v2u w = pw[m][bj][n]; v = xv[m][bj][n] + sigm4(v) * (f32x4){bflo(w.x), bfhi(w.x), bflo(w.y), bfhi(w.y)}; }
                            *(f32x4*)(H + o) = v; }
                __builtin_amdgcn_sched_barrier(0);
            }
    }
};
struct EpiH1 {
    static constexpr bool PERM = true; static constexpr int HOOK_T = -1;
    bf16* O; const float* X;
    __device__ __forceinline__ void operator()(const Acc& acc, const Unit& u, int wr, int wc, int fr, int fq) const {
        const int row0 = u.pm * 256 + wr * 64 + fr, col0 = u.pn * 256 + wc * 32 + 8 * fq;
#pragma unroll
        for (int ai = 0; ai < 2; ++ai) {
            f32x4 xv[4][2][2];
#pragma unroll
            for (int m = 0; m < 4; ++m)
#pragma unroll
                for (int bj = 0; bj < 2; ++bj) { const float* xp = X + (size_t)(row0 + ai * 128 + m * 16) * D + col0 + bj * 128; xv[m][bj][0] = *(const f32x4*)xp; xv[m][bj][1] = *(const f32x4*)(xp + 4); }
            __builtin_amdgcn_sched_barrier(0);
#pragma unroll
            for (int m = 0; m < 4; ++m)
#pragma unroll
                for (int bj = 0; bj < 2; ++bj) st8(O + (size_t)(row0 + ai * 128 + m * 16) * D + col0 + bj * 128, acc[ai][bj][m][0] + xv[m][bj][0], acc[ai][bj][m][1] + xv[m][bj][1]);
            __builtin_amdgcn_sched_barrier(0);
        }
    }
};
struct EpiMerge {
    static constexpr bool PERM = true; static constexpr int HOOK_T = 2;
    bf16* O; const bf16* GA; const bf16* GG;
    __device__ __forceinline__ void mid(Acc& acc, const Unit& u, int wr, int wc, int fr, int fq) const {
        int row0 = u.pm * 256 + wr * 64 + fr; const int col0 = u.pn * 256 + wc * 32 + 8 * fq;
        asm volatile("" : "+v"(row0));
#pragma unroll
        for (int ai = 0; ai < 2; ++ai)
#pragma unroll
            for (int mb = 0; mb < 4; mb += 2) {
                v4u aw[2][2], gw[2][2];
#pragma unroll
                for (int m = 0; m < 2; ++m)
#pragma unroll
                    for (int bj = 0; bj < 2; ++bj) { const size_t off = (size_t)(row0 + ai * 128 + (mb + m) * 16) * D + col0 + bj * 128; aw[m][bj] = *(const v4u*)(GA + off); gw[m][bj] = *(const v4u*)(GG + off); }
                __builtin_amdgcn_sched_barrier(0);
#pragma unroll
                for (int m = 0; m < 2; ++m)
#pragma unroll
                    for (int bj = 0; bj < 2; ++bj) { const v4u a = aw[m][bj], g = gw[m][bj];
                        acc[ai][bj][mb + m][0] = acc[ai][bj][mb + m][0] * (f32x4){bflo(a.x) * __builtin_amdgcn_rcpf(fmaxf(bflo(g.x), 1e-30f)), bfhi(a.x) * __builtin_amdgcn_rcpf(fmaxf(bfhi(g.x), 1e-30f)), bflo(a.y) * __builtin_amdgcn_rcpf(fmaxf(bflo(g.y), 1e-30f)), bfhi(a.y) * __builtin_amdgcn_rcpf(fmaxf(bfhi(g.y), 1e-30f))};
                        acc[ai][bj][mb + m][1] = acc[ai][bj][mb + m][1] * (f32x4){bflo(a.z) * __builtin_amdgcn_rcpf(fmaxf(bflo(g.z), 1e-30f)), bfhi(a.z) * __builtin_amdgcn_rcpf(fmaxf(bfhi(g.z), 1e-30f)), bflo(a.w) * __builtin_amdgcn_rcpf(fmaxf(bflo(g.w), 1e-30f)), bfhi(a.w) * __builtin_amdgcn_rcpf(fmaxf(bfhi(g.w), 1e-30f))}; }
                __builtin_amdgcn_sched_barrier(0);
            }
    }
    __device__ __forceinline__ void operator()(const Acc& acc, const Unit& u, int wr, int wc, int fr, int fq) const {
        const int row0 = u.pm * 256 + wr * 64 + fr, col0 = u.pn * 256 + wc * 32 + 8 * fq;
#pragma unroll
        for (int ai = 0; ai < 2; ++ai) {
            v4u gw[4][2];
#pragma unroll
            for (int m = 0; m < 4; ++m)
#pragma unroll
                for (int bj = 0; bj < 2; ++bj) gw[m][bj] = *(const v4u*)(GG + (size_t)(row0 + ai * 128 + m * 16) * D + col0 + bj * 128);
            __builtin_amdgcn_sched_barrier(0);
#pragma unroll
            for (int m = 0; m < 4; ++m)
#pragma unroll
                for (int bj = 0; bj < 2; ++bj) { const v4u g = gw[m][bj];
                    st8(O + (size_t)(row0 + ai * 128 + m * 16) * D + col0 + bj * 128, acc[ai][bj][m][0] * (f32x4){bflo(g.x), bfhi(g.x), bflo(g.y), bfhi(g.y)}, acc[ai][bj][m][1] * (f32x4){bflo(g.z), bfhi(g.z), bflo(g.w), bfhi(g.w)}); }
            __builtin_amdgcn_sched_barrier(0);
        }
    }
};
struct EpiPle {
    static constexpr bool PERM = true; static constexpr int HOOK_T = -1;
    bf16* O; const bf16* PP;
    __device__ __forceinline__ void operator()(const Acc& acc, const Unit& u, int wr, int wc, int fr, int fq) const {
        const int row0 = u.pm * 256 + wr * 64 + fr, col0 = u.pn * 256 + wc * 32 + 8 * fq;
#pragma unroll
        for (int ai = 0; ai < 2; ++ai) {
            v4u pw[4][2];
#pragma unroll
            for (int m = 0; m < 4; ++m)
#pragma unroll
                for (int bj = 0; bj < 2; ++bj) pw[m][bj] = *(const v4u*)(PP + (size_t)(row0 + ai * 128 + m * 16) * D + col0 + bj * 128);
            __builtin_amdgcn_sched_barrier(0);
#pragma unroll
            for (int m = 0; m < 4; ++m)
#pragma unroll
                for (int bj = 0; bj < 2; ++bj) { const v4u w = pw[m][bj];
                    const f32x4 v0 = sigm4(acc[ai][bj][m][0]) * (f32x4){bflo(w.x), bfhi(w.x), bflo(w.y), bfhi(w.y)}, v1 = sigm4(acc[ai][bj][m][1]) * (f32x4){bflo(w.z), bfhi(w.z), bflo(w.w), bfhi(w.w)};
                    st8(O + (size_t)(row0 + ai * 128 + m * 16) * D + col0 + bj * 128, v0, v1); }
            __builtin_amdgcn_sched_barrier(0);
        }
    }
};
struct EpiMoeUp {
    static constexpr bool PERM = true; static constexpr int HOOK_T = -1;
    bf16* ACT; const float* bgu; const float* srstd; const LAS int* ts;
    __device__ __forceinline__ void operator()(const Acc& acc, const Unit& u, int wr, int wc, int fr, int fq) const {
        const int e = u.x0, cnt = ts[40 + e], srow0 = u.x1 * 256 + wr * 64 + fr;
        const int row0 = u.pm * 256 + wr * 64 + fr, hc = u.pn * 128 + wc * 32 + 8 * fq;
        const float* bg = bgu + (size_t)e * 2048 + hc;
        const f32x4 bg0 = *(const f32x4*)bg, bg1 = *(const f32x4*)(bg + 4), bl0 = *(const f32x4*)(bg + 1024), bl1 = *(const f32x4*)(bg + 1028);
        float rsv[2][4];
#pragma unroll
        for (int ai = 0; ai < 2; ++ai)
#pragma unroll
            for (int m = 0; m < 4; ++m) { const int slot = srow0 + ai * 128 + m * 16; rsv[ai][m] = slot < cnt ? srstd[e * 32768 + slot] : 0.f; }
        __builtin_amdgcn_sched_barrier(0);
#pragma unroll
        for (int ai = 0; ai < 2; ++ai)
#pragma unroll
            for (int m = 0; m < 4; ++m) { const float rs = rsv[ai][m];
                f32x4 o[2];
#pragma unroll
                for (int n = 0; n < 2; ++n) { const f32x4 gu = acc[ai][0][m][n] * rs + (n ? bg1 : bg0), li = acc[ai][1][m][n] * rs + (n ? bl1 : bl0);
#pragma unroll
                    for (int e2 = 0; e2 < 4; ++e2) { const float gl = fminf(gu[e2], 7.0f), ln = fminf(fmaxf(li[e2], -7.0f), 7.0f);
                        o[n][e2] = gl * __builtin_amdgcn_rcpf(1.0f + __builtin_amdgcn_exp2f(-1.702f * LOG2E * gl)) * (ln + 1.0f); } }
                st8(ACT + (size_t)(row0 + ai * 128 + m * 16) * D + hc, o[0], o[1]); }
    }
};
struct EpiMoeDown {
    static constexpr bool PERM = true; static constexpr int HOOK_T = -1;
    bf16* Y; const float* bd; const float* sgate; const LAS int* ts;
    __device__ __forceinline__ void operator()(const Acc& acc, const Unit& u, int wr, int wc, int fr, int fq) const {
        const int e = u.x0, cnt = ts[40 + e], srow0 = u.x1 * 256 + wr * 64 + fr, col0 = u.pn * 256 + wc * 32 + 8 * fq;
        const float* bp = bd + (size_t)e * D + col0;
        f32x4 bv[2][2];
#pragma unroll
        for (int bj = 0; bj < 2; ++bj) { bv[bj][0] = *(const f32x4*)(bp + bj * 128); bv[bj][1] = *(const f32x4*)(bp + bj * 128 + 4); }
        float gtv[2][4];
#pragma unroll
        for (int ai = 0; ai < 2; ++ai)
#pragma unroll
            for (int m = 0; m < 4; ++m) { const int slot = srow0 + ai * 128 + m * 16; gtv[ai][m] = slot < cnt ? sgate[e * 32768 + slot] : 0.f; }
        __builtin_amdgcn_sched_barrier(0);
#pragma unroll
        for (int ai = 0; ai < 2; ++ai)
#pragma unroll
            for (int m = 0; m < 4; ++m) { const float gt = gtv[ai][m];
                bf16* rowp = Y + (size_t)(u.pm * 256 + wr * 64 + fr + ai * 128 + m * 16) * D + col0;
#pragma unroll
                for (int bj = 0; bj < 2; ++bj) st8(rowp + bj * 128, (acc[ai][bj][m][0] + bv[bj][0]) * gt, (acc[ai][bj][m][1] + bv[bj][1]) * gt); }
    }
};

#define XB_TMO      128
#define XB_XCNT(j)  (256  + 64 * (j))
#define XB_XSUB(j)  (1280 + 64 * (j))
#define XB_XGEN(j)  (2304 + 64 * (j))
#define XB_TOP      3328
#define XB_TOPGEN   3392
#define XCD_BAR_WORDS 3456
#define XB_SPIN_CAP (1u << 18)
__device__ __forceinline__ unsigned xb_ld(unsigned* p)              { return __hip_atomic_load(p, __ATOMIC_RELAXED, __HIP_MEMORY_SCOPE_AGENT); }
__device__ __forceinline__ unsigned xb_add(unsigned* p, unsigned v) { return __hip_atomic_fetch_add(p, v, __ATOMIC_RELAXED, __HIP_MEMORY_SCOPE_AGENT); }
__device__ __forceinline__ unsigned xb_xcc_id() { return (unsigned)__builtin_amdgcn_s_getreg((3 << 11) | 20) & 0xFu; }
#define XB_SPIN(cond, bar) do { unsigned _sp = 0; while (cond) { __builtin_amdgcn_s_sleep(1); \
    if ((++_sp & 255u) == 0u) { if (xb_ld(&(bar)[XB_TMO])) break; if (_sp > XB_SPIN_CAP) { atomicAdd(&(bar)[XB_TMO], 1u); break; } } } } while (0)
struct XcdBarrier { unsigned* bar; unsigned x; volatile LAS unsigned* st; int wave; };
__device__ __forceinline__ XcdBarrier xcd_barrier_post(unsigned* bar, volatile LAS unsigned* st, int wave) {
    XcdBarrier b; b.bar = bar; b.x = xb_xcc_id(); b.st = st; b.wave = wave;
    if (tid_opaque(wave) == 0) (void)xb_add(&bar[XB_XCNT(b.x)], 1u);
    return b;
}
__device__ __forceinline__ void xcd_barrier_complete(unsigned* bar, unsigned x, unsigned& nloc, unsigned& nx) {
    const unsigned G = gridDim.x * gridDim.y * gridDim.z;
    unsigned sum, cnt, mine, sp = 0u;
    for (;;) {
        sum = 0u; cnt = 0u; mine = 0u;
#pragma unroll
        for (unsigned j = 0; j < 16; ++j) { const unsigned c = xb_ld(&bar[XB_XCNT(j)]); sum += c; cnt += (c > 0u) ? 1u : 0u; mine = (j == x) ? c : mine; }
        if (sum == G) break;
        __builtin_amdgcn_s_sleep(1);
        if ((++sp & 255u) == 0u) { if (xb_ld(&bar[XB_TMO])) break; if (sp > XB_SPIN_CAP) { atomicAdd(&bar[XB_TMO], 1u); break; } }
    }
    nloc = mine > 0u ? mine : 1u; nx = cnt > 0u ? cnt : 1u;
}
__device__ __forceinline__ void xcd_barrier(const XcdBarrier& b) {
    asm volatile("s_waitcnt vmcnt(0)" ::: "memory");
    __syncthreads();
    if (tid_opaque(b.wave) == 0) {
        unsigned* bar = b.bar;
        __builtin_amdgcn_s_waitcnt(0);
        unsigned nloc = b.st[0], nx = b.st[1];
        if (nloc == 0u) { xcd_barrier_complete(bar, b.x, nloc, nx); b.st[0] = nloc; b.st[1] = nx; }
        const unsigned old = xb_add(&bar[XB_XSUB(b.x)], 1u);
        const unsigned gen = old / nloc;
        if (old + 1u == (gen + 1u) * nloc) {
            __builtin_amdgcn_fence(__ATOMIC_RELEASE, "agent");
            asm volatile("s_waitcnt vmcnt(0)" ::: "memory");
            const unsigned og = xb_add(&bar[XB_TOP], 1u);
            const unsigned tg = og / nx;
            if (og + 1u == (tg + 1u) * nx) xb_add(&bar[XB_TOPGEN], 1u);
            else XB_SPIN(xb_ld(&bar[XB_TOPGEN]) == tg, bar);
            __builtin_amdgcn_fence(__ATOMIC_ACQUIRE, "agent");
            xb_add(&bar[XB_XGEN(b.x)], 1u);
            asm volatile("s_waitcnt vmcnt(0)" ::: "memory");
        } else {
            XB_SPIN(xb_ld(&bar[XB_XGEN(b.x)]) == gen, bar);
            __builtin_amdgcn_fence(__ATOMIC_ACQUIRE, "agent");
            asm volatile("s_waitcnt vmcnt(0)" ::: "memory");
        }
    }
    __syncthreads();
}

struct Args { const float* in[23]; float* out; unsigned char* ws; int ph_lo, ph_hi; };
struct Frame {
    LAS unsigned char* lds; int wave, vcu, G;
};
#define LDS_WAIT() asm volatile("s_waitcnt lgkmcnt(0)" ::: "memory")

__device__ __forceinline__ int t5_bucket(int n) {
    if (n < 16) return n;
    const int th[15] = {22, 30, 40, 54, 73, 99, 134, 182, 246, 332, 450, 609, 825, 1117, 1513};
    int b = 16;
#pragma unroll
    for (int k = 0; k < 15; ++k) b += (n >= th[k]) ? 1 : 0;
    return b;
}

__device__ __forceinline__ void transpose_item(const float* W, int K, int N, bf16* WT, int drow0, LAS float* scr, int k0, int n0, int lane, int kdst = 0) {
    const int q = lane & 15, kr = lane >> 4;
    f32x4 v[8];
#pragma unroll
    for (int i = 0; i < 8; ++i) v[i] = *(const f32x4*)(W + (size_t)(k0 + 4 * i + kr) * N + n0 + 4 * q);
#pragma unroll
    for (int i = 0; i < 8; ++i) { LAS float* d = scr + (4 * q) * 33 + 4 * i + kr; d[0] = v[i].x; d[33] = v[i].y; d[66] = v[i].z; d[99] = v[i].w; }
    LDS_WAIT(); asm volatile("" ::: "memory");
    const int c4 = lane & 3, nr = lane >> 2;
#pragma unroll
    for (int j = 0; j < 4; ++j) { const int n = nr + 16 * j; const LAS float* sp = scr + n * 33 + 8 * c4;
        v4u o; o.x = pk2(sp[0], sp[1]); o.y = pk2(sp[2], sp[3]); o.z = pk2(sp[4], sp[5]); o.w = pk2(sp[6], sp[7]);
        *(v4u*)(WT + (size_t)(drow0 + n) * K + kdst + k0 + 8 * c4) = o; }
    LDS_WAIT(); asm volatile("" ::: "memory");
}
constexpr int BG_GU = 32 * 32 * 32, BG_DN = 32 * 32 * 16, BG_N = BG_GU + BG_DN;
constexpr int BG_P1 = 32768;
struct BgItem { const float* W; bf16* WT; int N, k0, n0, drow0, pitch, kdst; };
constexpr int BG_X0 = BG_N, BG_X1 = BG_X0 + 8 * 16, BG_X2 = BG_X1 + 24 * 16, BG_X3 = BG_X2 + 32 * 16, BG_X4 = BG_X3 + 32 * 16, BG_ALL = BG_X4 + 8 * 16;
__device__ __forceinline__ BgItem bg_decode(const Args& A, int r) {
    BgItem it; it.pitch = D; it.kdst = 0;
    if (r < BG_GU) { const int e = r >> 10, q = r & 1023, kb = q >> 5, nb = q & 31, n0 = nb * 64;
        it.W = A.in[15] + (size_t)e * D * 2048; it.WT = (bf16*)(A.ws + WS_WGU) + (size_t)e * 2048 * D; it.N = 2048; it.k0 = kb * 32; it.n0 = n0;
        it.drow0 = n0 < 1024 ? 256 * (n0 >> 7) + (n0 & 127) : 256 * ((n0 - 1024) >> 7) + 128 + (n0 & 127);
    } else if (r < BG_N) { r -= BG_GU; const int e = r >> 9, q = r & 511, kb = q >> 4, nb = q & 15;
        it.W = A.in[17] + (size_t)e * D * D; it.WT = (bf16*)(A.ws + WS_WD) + (size_t)e * D * D; it.N = D; it.k0 = kb * 32; it.n0 = nb * 64; it.drow0 = nb * 64;
    } else { int src; bf16* dst;
        if (r < BG_X1) { r -= BG_X0; src = 5; dst = (bf16*)(A.ws + WS_WCAT); }
        else if (r < BG_X2) { r -= BG_X1; src = 10; dst = (bf16*)(A.ws + WS_WCAT); it.kdst = 256; }
        else if (r < BG_X3) { r -= BG_X2; src = 11; dst = (bf16*)(A.ws + WS_WOUT); }
        else if (r < BG_X4) { r -= BG_X3; src = 20; dst = (bf16*)(A.ws + WS_WPG); }
        else { r -= BG_X4; src = 21; dst = (bf16*)(A.ws + WS_WPP); it.pitch = PLE; }
        it.W = src == 5 ? A.in[5] : src == 10 ? A.in[10] : src == 11 ? A.in[11] : src == 20 ? A.in[20] : A.in[21];
        it.WT = dst; it.N = D; it.k0 = (r >> 4) * 32; it.n0 = (r & 15) * 64; it.drow0 = it.n0; }
    return it;
}
struct BgConv {
    int cur, next, stride, end; f32x4 v[8];
    __device__ __forceinline__ void init(int first, int stride_, int end_ = BG_ALL) { cur = -1; next = first; stride = stride_; end = end_; }
    __device__ __forceinline__ void issue(const Args& A, int lane) {
        if (next < end) { const BgItem it = bg_decode(A, next); const int q = lane & 15, kr = lane >> 4;
#pragma unroll
            for (int i = 0; i < 8; ++i) v[i] = *(const f32x4*)(it.W + (size_t)(it.k0 + 4 * i + kr) * it.N + it.n0 + 4 * q);
            cur = next; next += stride; } else cur = -1;
    }
    __device__ __forceinline__ void finish(const Args& A, LAS float* scr, int lane) {
        if (cur >= 0) { const BgItem it = bg_decode(A, cur); const int q = lane & 15, kr = lane >> 4;
#pragma unroll
            for (int i = 0; i < 8; ++i) { LAS float* d = scr + (4 * q) * 33 + 4 * i + kr; d[0] = v[i].x; d[33] = v[i].y; d[66] = v[i].z; d[99] = v[i].w; }
            LDS_WAIT(); asm volatile("" ::: "memory");
            const int c4 = lane & 3, nr = lane >> 2;
#pragma unroll
            for (int j = 0; j < 4; ++j) { const int n = nr + 16 * j; const LAS float* sp = scr + n * 33 + 8 * c4;
                v4u o; o.x = pk2(sp[0], sp[1]); o.y = pk2(sp[2], sp[3]); o.z = pk2(sp[4], sp[5]); o.w = pk2(sp[6], sp[7]);
                *(v4u*)(it.WT + (size_t)(it.drow0 + n) * it.pitch + it.kdst + it.k0 + 8 * c4) = o; }
            LDS_WAIT(); asm volatile("" ::: "memory");
            cur = -1; }
    }
};
__device__ __forceinline__ void convert_queue(const Frame& F, const Args& A, unsigned* ctr, int lo, int hi) {
    const int tidx_ = tid_opaque(F.wave);
    LAS float* scr = (LAS float*)(F.lds + F.wave * 8448);
    LAS int* qs = (LAS int*)(F.lds + RING_BYTES + 512);
    const int lane = tidx_ & 63;
    BgConv c0, c1;
    for (;;) {
        __syncthreads();
        if (tidx_ == 0) *qs = (int)__hip_atomic_fetch_add(ctr, 64u, __ATOMIC_RELAXED, __HIP_MEMORY_SCOPE_AGENT);
        __syncthreads();
        const int base = __builtin_amdgcn_readfirstlane(*qs) + lo + F.wave * 8;
        if (base - F.wave * 8 >= hi) break;
        c0.init(base, 2, base + 8 < hi ? base + 8 : hi); c1.init(base + 1, 2, base + 8 < hi ? base + 8 : hi);
        c0.issue(A, lane); c1.issue(A, lane);
#pragma unroll 1
        for (int k = 0; k < 4; ++k) { c0.finish(A, scr, lane); c0.issue(A, lane); c1.finish(A, scr, lane); c1.issue(A, lane); }
    }
}
__device__ __forceinline__ void convert_p_queue(const Frame& F, const Args& A, unsigned* ctr) {
    const int tidx_ = tid_opaque(F.wave);
    const int lane = tidx_ & 63; const float* p = A.in[1]; bf16* pb = (bf16*)(A.ws + WS_PB);
    LAS int* qs = (LAS int*)(F.lds + RING_BYTES + 512);
    for (;;) {
        __syncthreads();
        if (tidx_ == 0) *qs = (int)__hip_atomic_fetch_add(ctr, 8u, __ATOMIC_RELAXED, __HIP_MEMORY_SCOPE_AGENT);
        __syncthreads();
        const int ck0 = __builtin_amdgcn_readfirstlane(*qs);
        if (ck0 >= (T * PLE) / 8192) break;
        const size_t base = (size_t)(ck0 + F.wave) * 8192 + 8 * lane;
#pragma unroll 4
        for (int i = 0; i < 16; ++i) { const f32x4 a = *(const f32x4*)(p + base + 512 * i), b = *(const f32x4*)(p + base + 512 * i + 4); st8(pb + base + 512 * i, a, b); }
    }
}
constexpr int BG_SCR_OFF = 45056;
__device__ __forceinline__ int win_dest(int n0) {
    if (n0 < 1536) return n0;
    if (n0 < 2304) return 4352 + (n0 - 1536);
    if (n0 < 3072) return 1536 + (n0 - 2304);
    if (n0 < 3840) return 5120 + (n0 - 3072);
    return 2304 + (n0 - 3840);
}
template <int NR> __device__ __forceinline__ void rms_rows_to_bf16(const float* xrow, const float* gain, bf16* orow, int lane) {
    f32x4 v[NR][4]; float s[NR];
#pragma unroll
    for (int r = 0; r < NR; ++r)
#pragma unroll
        for (int j = 0; j < 4; ++j) v[r][j] = ((const f32x4*)(xrow + (size_t)r * D) + lane)[64 * j];
    f32x4 g[4];
#pragma unroll
    for (int j = 0; j < 4; ++j) g[j] = ((const f32x4*)gain + lane)[64 * j];
#pragma unroll
    for (int r = 0; r < NR; ++r) { float a = 0.f;
#pragma unroll
        for (int j = 0; j < 4; ++j) a += (v[r][j].x * v[r][j].x + v[r][j].y * v[r][j].y) + (v[r][j].z * v[r][j].z + v[r][j].w * v[r][j].w);
        s[r] = a; }
#pragma unroll
    for (int o = 1; o < 64; o <<= 1)
#pragma unroll
        for (int r = 0; r < NR; ++r) s[r] += __shfl_xor(s[r], o);
#pragma unroll
    for (int r = 0; r < NR; ++r) { const float rstd = 1.0f / sqrtf(s[r] * (1.f / D) + EPS);
        unsigned long long* o8 = (unsigned long long*)(orow + (size_t)r * D) + lane;
#pragma unroll
        for (int j = 0; j < 4; ++j) o8[64 * j] = (unsigned long long)pk2(v[r][j].x * rstd * g[j].x, v[r][j].y * rstd * g[j].y) | ((unsigned long long)pk2(v[r][j].z * rstd * g[j].z, v[r][j].w * rstd * g[j].w) << 32); }
}
__device__ __forceinline__ void p0_prologue(const Frame& F, const Args& A) {
    const int tidx_ = tid_opaque(F.wave);
    LAS float* scr = (LAS float*)(F.lds + F.wave * 16384);
    const int gw = F.vcu * 8 + F.wave, NGW = F.G * 8;
    unsigned char* ws = A.ws;
    for (int m = gw * 4; m < T; m += NGW * 4) rms_rows_to_bf16<4>(A.in[0] + (size_t)m * D, A.in[2], (bf16*)(ws + WS_NX) + (size_t)m * D, (tidx_ & 63));
    { const float* wsp = A.in[8]; bf16* o = (bf16*)(ws + WS_WSP);
      for (int i = (blockIdx.x * 512 + tidx_) * 4; i < 12 * 128 * 128; i += F.G * 512 * 4) { const int col = i & 127, row = (i >> 7) & 127; const f32x4 a = *(const f32x4*)(wsp + i);
          v2u w; w.x = pk2(col <= row ? a.x : 0.f, col + 1 <= row ? a.y : 0.f); w.y = pk2(col + 2 <= row ? a.z : 0.f, col + 3 <= row ? a.w : 0.f); *(v2u*)(o + i) = w; } }
    { const float* wrt = A.in[13]; bf16* wh = (bf16*)(ws + WS_WRH); bf16* wl = (bf16*)(ws + WS_WRL);
      for (int i = blockIdx.x * 512 + tidx_; i < 32 * 1024; i += F.G * 512) { const int e = i >> 10, k = i & 1023; const float w = wrt[k * 32 + e]; const unsigned h = f2bf(w); wh[i] = (bf16)h; wl[i] = (bf16)f2bf(w - bflo(h)); } }
    constexpr int I_IN = 32 * 92;
    for (int it = gw; it < I_IN; it += NGW) { const int kb = it / 92, nb = it % 92; transpose_item(A.in[3], D, IN_W, (bf16*)(ws + WS_WIN), win_dest(nb * 64), scr, kb * 32, nb * 64, (tidx_ & 63)); }
}

__device__ __forceinline__ int crow(int r, int hi) { return (r & 3) + 8 * (r >> 2) + 4 * hi; }
struct AtU { int b, g, h, r, qb8, nqb; };
__device__ __forceinline__ AtU at_decode(int pr) { AtU u; const int slot = pr & 15; u.h = (pr >> 4) & 3; const int bgi = pr >> 6; u.g = bgi % 3; u.b = bgi / 3; u.nqb = 128 >> (2 * u.g);
    u.r = slot / (u.nqb >> 3); u.qb8 = slot % (u.nqb >> 3); return u; }
__device__ __forceinline__ void at_load(const AtU& u, const bf16* QT, const bf16* KT, const bf16* VT, int w, int r32, int hi, int q8, int t8, v4u (&stg)[12], bf16x8 (&qf)[4]) {
    const size_t tb0 = (size_t)((u.b * 3 + u.g) * 4 + u.h) * 128 + (size_t)(u.r * u.nqb);
    const bf16* qt = QT + (tb0 + u.qb8 * 8 + w) * 2048 + r32 * 64 + 8 * hi;
#pragma unroll
    for (int s = 0; s < 4; ++s) qf[s] = *(const bf16x8*)(qt + 16 * s);
#pragma unroll
    for (int i = 0; i < 12; ++i) { const int kv = i >= 6 ? 1 : 0, j = 2 * (i - 6 * kv) + t8; int kb = u.qb8 * 8 - 4 + j; kb = kb < 0 ? 0 : kb;
        stg[i] = *(const v4u*)((kv ? VT : KT) + (tb0 + kb) * 2048 + q8 * 8); }
}
__device__ __forceinline__ void attn_phase(const Frame& F, const Args& A) {
    const int tidx_ = tid_opaque(F.wave);
    LAS float* tb = (LAS float*)(F.lds + RING_BYTES + 2048);
    const float* rel_bias = A.in[4];
    for (int i = tidx_; i < 12 * 192; i += 512) { const int gh = i / 192, dist = i % 192 - 31, g = gh >> 2; const int dil = g == 0 ? 1 : (g == 1 ? 4 : 16);
        tb[i] = (dist >= 0 && dist <= 128) ? rel_bias[t5_bucket(dist * dil) * 12 + gh] * LOG2E : -INFINITY; }
    __syncthreads();
    const bf16* QT = (const bf16*)(A.ws + WS_Q); const bf16* KT = (const bf16*)(A.ws + WS_K); const bf16* VT = (const bf16*)(A.ws + WS_VT);
    bf16* OG = (bf16*)(A.ws + WS_OG); float* LSE = (float*)(A.ws + WS_LSE);
    const int lane = (tidx_ & 63), r32 = lane & 31, hi = lane >> 5, w = F.wave;
    const int q8 = tidx_ & 255, t8 = tidx_ >> 8;
    const int NU = NB * 3 * 4 * 16;
    v4u stg[12]; bf16x8 qf[4];
    if (F.vcu < NU) at_load(at_decode(F.vcu), QT, KT, VT, w, r32, hi, q8, t8, stg, qf);
    for (int pr = F.vcu; pr < NU; pr += F.G) {
        const AtU u = at_decode(pr);
        const int dsh = 2 * u.g, dil = 1 << dsh, g = u.g, h = u.h, b = u.b, r = u.r;
        const int qb = u.qb8 * 8 + w, i0 = qb * 32;
        __syncthreads();
        { const int keyk = q8 >> 3, posk = keyk * 8 + ((q8 & 7) ^ ((keyk >> 1) & 7)), dv = q8 >> 2, posv = dv * 4 + ((q8 & 3) ^ ((dv >> 2) & 3));
#pragma unroll
          for (int i = 0; i < 12; ++i) { const int kv = i >= 6 ? 1 : 0, j = 2 * (i - 6 * kv) + t8;
              *(LAS v4u*)(F.lds + kv * 49152 + j * 4096 + (kv ? posv : posk) * 16) = stg[i]; } }
        bf16x8 qc[4];
#pragma unroll
        for (int s = 0; s < 4; ++s) qc[s] = qf[s];
        __syncthreads();
        if (pr + F.G < NU) at_load(at_decode(pr + F.G), QT, KT, VT, w, r32, hi, q8, t8, stg, qf);
        __builtin_amdgcn_sched_barrier(0);
        const LAS unsigned char* kbase = F.lds + w * 4096 + (r32 * 8) * 16;
        const int kx = (r32 >> 1) & 7;
        f32x16 st[5];
#pragma unroll
        for (int kt = 0; kt < 5; ++kt) {
            f32x16 a = {};
#pragma unroll
            for (int s = 0; s < 4; ++s) { const bf16x8 kf = *(const LAS bf16x8*)(kbase + kt * 4096 + (((2 * s + hi) ^ kx) << 4)); a = __builtin_amdgcn_mfma_f32_32x32x16_bf16(kf, qc[s], a, 0, 0, 0); }
            st[kt] = a;
        }
        const LAS float* tbh = tb + (g * 4 + h) * 192;
        float mx = -INFINITY;
#pragma unroll
        for (int kt = 0; kt < 5; ++kt)
#pragma unroll
            for (int i = 0; i < 16; ++i) { const int kr = crow(i, hi), krel = -128 + 32 * kt + kr; const int dist = r32 - krel;
                float v = st[kt][i] + tbh[dist + 31]; v = (i0 + krel >= 0) ? v : -INFINITY; st[kt][i] = v; mx = fmaxf(mx, v); }
        mx = fmaxf(mx, __shfl_xor(mx, 32));
        float l = 0.f;
#pragma unroll
        for (int kt = 0; kt < 5; ++kt)
#pragma unroll
            for (int i = 0; i < 16; ++i) { const float p = __builtin_amdgcn_exp2f(st[kt][i] - mx); st[kt][i] = p; l += p; }
        l += __shfl_xor(l, 32);
        const LAS unsigned char* vbase = F.lds + 49152 + w * 4096;
        f32x16 o[2] = {};
#pragma unroll
        for (int kt = 0; kt < 5; ++kt)
#pragma unroll
            for (int s2 = 0; s2 < 2; ++s2) {
                v4u pw; pw.x = cvt_pk_bf16(st[kt][8 * s2 + 0], st[kt][8 * s2 + 1]); pw.y = cvt_pk_bf16(st[kt][8 * s2 + 2], st[kt][8 * s2 + 3]);
                pw.z = cvt_pk_bf16(st[kt][8 * s2 + 4], st[kt][8 * s2 + 5]); pw.w = cvt_pk_bf16(st[kt][8 * s2 + 6], st[kt][8 * s2 + 7]);
                const bf16x8 pf = __builtin_bit_cast(bf16x8, pw);
#pragma unroll
                for (int dt = 0; dt < 2; ++dt) { const int dd = 32 * dt + r32;
                    const LAS unsigned char* vr = vbase + kt * 4096 + dd * 64 + 8 * hi; const int vx = (dd >> 2) & 3;
                    const v2u p1 = *(const LAS v2u*)(vr + (((2 * s2) ^ vx) << 4)), p2 = *(const LAS v2u*)(vr + (((2 * s2 + 1) ^ vx) << 4));
                    v4u vw; vw.x = p1.x; vw.y = p1.y; vw.z = p2.x; vw.w = p2.y;
                    o[dt] = __builtin_amdgcn_mfma_f32_32x32x16_bf16(__builtin_bit_cast(bf16x8, vw), pf, o[dt], 0, 0, 0); }
            }
        const float rl = 1.0f / l;
        const size_t qrow = (size_t)b * SEQ + (size_t)(i0 + r32) * dil + r;
        bf16* op = OG + ((size_t)g * T + qrow) * 256 + h * 64;
#pragma unroll
        for (int dt = 0; dt < 2; ++dt)
#pragma unroll
            for (int gp = 0; gp < 2; ++gp) { v2u wa, wb;
                wa.x = cvt_pk_bf16(o[dt][8 * gp] * rl, o[dt][8 * gp + 1] * rl); wa.y = cvt_pk_bf16(o[dt][8 * gp + 2] * rl, o[dt][8 * gp + 3] * rl);
                wb.x = cvt_pk_bf16(o[dt][8 * gp + 4] * rl, o[dt][8 * gp + 5] * rl); wb.y = cvt_pk_bf16(o[dt][8 * gp + 6] * rl, o[dt][8 * gp + 7] * rl);
                *(v4u*)(op + 32 * dt + 16 * gp + 8 * hi) = widen_pair(wa, wb); }
        if (hi == 0) LSE[((size_t)g * T + qrow) * 4 + h] = (mx + __builtin_amdgcn_logf(l)) * LN2;
    }
    __syncthreads();
}

__device__ __forceinline__ void spatial_phase(const Frame& F, const Args& A) {
    const int tidx_ = tid_opaque(F.wave);
    const bf16* ZVT = (const bf16*)(A.ws + WS_ZVT); const bf16* ZU = (const bf16*)(A.ws + WS_ZU); const bf16* WSP = (const bf16*)(A.ws + WS_WSP);
    bf16* Gout = (bf16*)(A.ws + WS_AG) + 256;
    const float* lng = A.in[6]; const float* lnb = A.in[7]; const float* bsp = A.in[9];
    LAS float* red = (LAS float*)(F.lds + 10240);
    LAS float* stt = (LAS float*)(F.lds + 43008);
    LAS unsigned char* vn = F.lds + 49152;
    int lane = (tidx_ & 63); asm volatile("" : "+v"(lane));
    const int r32 = lane & 31, hi = lane >> 5, w = F.wave;
    const int dr = 8 * w + (lane >> 3), ck = lane & 7;
    for (int c = F.vcu; c < T / 128; c += F.G) {
        v4u zr[2];
#pragma unroll
        for (int p = 0; p < 2; ++p) zr[p] = *(const v4u*)(ZVT + ((size_t)c * GM_W + dr) * 128 + 8 * (ck + 8 * p));
        {
            const int tg = tidx_ & 15, rg = tidx_ >> 4; float sm[8], q[8];
#pragma unroll
            for (int e = 0; e < 8; ++e) { sm[e] = 0.f; q[e] = 0.f; }
#pragma unroll 4
            for (int ch = rg; ch < GM_W; ch += 32) { const v4u wv = *(const v4u*)(ZVT + ((size_t)c * GM_W + ch) * 128 + 8 * tg);
                const float x[8] = {bflo(wv.x), bfhi(wv.x), bflo(wv.y), bfhi(wv.y), bflo(wv.z), bfhi(wv.z), bflo(wv.w), bfhi(wv.w)};
#pragma unroll
                for (int e = 0; e < 8; ++e) { sm[e] += x[e]; q[e] += x[e] * x[e]; } }
#pragma unroll
            for (int e = 0; e < 8; ++e) { red[(rg * 128 + 8 * tg + e) * 2] = sm[e]; red[(rg * 128 + 8 * tg + e) * 2 + 1] = q[e]; }
            __syncthreads();
            if (tidx_ < 128) { float ss = 0.f, qq = 0.f;
                for (int k = 0; k < 32; ++k) { ss += red[(k * 128 + tidx_) * 2]; qq += red[(k * 128 + tidx_) * 2 + 1]; }
                const float mu = ss * (1.f / GM_W), var = fmaxf(qq * (1.f / GM_W) - mu * mu, 0.f);
                stt[tidx_ * 2] = mu; stt[tidx_ * 2 + 1] = 1.0f / sqrtf(var + EPS); }
            __syncthreads();
        }
#define SP_GROUP(GI, ZR_CUR, ZU_CUR, ZR_NXT, ZU_NXT) do { \
            const int gi_ = (GI); const int dt = w & 1, it = ((w >> 1) + gi_) & 3, ti = 32 * it + r32;       \
              \
            bf16x8 bfr[8]; \
            { const bf16* wp = WSP + ((size_t)gi_ * 128 + ti) * 128 + 8 * hi; \
              _Pragma("unroll") for (int s = 0; s < 8; ++s) bfr[s] = *(const bf16x8*)(wp + 16 * s); } \
            const float bsv = bsp[gi_ * 128 + ti], gch = lng[gi_ * 64 + dr], bch = lnb[gi_ * 64 + dr]; \
            __builtin_amdgcn_sched_barrier(0); \
              \
            LAS unsigned char* tile = vn + (gi_ & 1) * 16384; \
            _Pragma("unroll") for (int p = 0; p < 2; ++p) { const int jb = 8 * (ck + 8 * p); const v4u z = ZR_CUR[p]; \
                float x[8] = {bflo(z.x), bfhi(z.x), bflo(z.y), bfhi(z.y), bflo(z.z), bfhi(z.z), bflo(z.w), bfhi(z.w)}; \
                _Pragma("unroll") for (int e = 0; e < 8; ++e) x[e] = (x[e] - stt[(jb + e) * 2]) * stt[(jb + e) * 2 + 1] * gch + bch; \
                v4u aw; aw.x = cvt_pk_bf16(x[0], x[1]); aw.y = cvt_pk_bf16(x[2], x[3]); aw.z = cvt_pk_bf16(x[4], x[5]); aw.w = cvt_pk_bf16(x[6], x[7]); \
                *(LAS v4u*)(tile + dr * 256 + (((ck + 8 * p) ^ (dr & 15)) << 4)) = aw; } \
            { const int gn = gi_ + 1 < 12 ? gi_ + 1 : 11;        \
              _Pragma("unroll") for (int p = 0; p < 2; ++p) ZR_NXT[p] = *(const v4u*)(ZVT + ((size_t)c * GM_W + gn * 64 + dr) * 128 + 8 * (ck + 8 * p)); \
              const int itn = ((w >> 1) + gn) & 3; const size_t orow = ((size_t)c * 128 + 32 * itn + r32) * GM_W + gn * 64 + 32 * dt + 4 * hi; \
              _Pragma("unroll") for (int gq = 0; gq < 4; ++gq) ZU_NXT[gq] = *(const v2u*)(ZU + orow + 8 * gq); } \
            __syncthreads();                                    \
            f32x16 acc = {}; \
            { const int dd = 32 * dt + r32; const LAS unsigned char* ar = tile + dd * 256; \
              _Pragma("unroll") for (int s = 0; s < 8; ++s) { const bf16x8 af = *(const LAS bf16x8*)(ar + (((2 * s + hi) ^ (dd & 15)) << 4)); acc = __builtin_amdgcn_mfma_f32_32x32x16_bf16(af, bfr[s], acc, 0, 0, 0); } } \
              \
            const size_t groww = ((size_t)c * 128 + ti) * D + gi_ * 64 + 32 * dt + 8 * hi; \
            _Pragma("unroll") for (int gp = 0; gp < 2; ++gp) { v2u oo[2]; \
                _Pragma("unroll") for (int q2 = 0; q2 < 2; ++q2) { const int gq = 2 * gp + q2; const v2u uw = ZU_CUR[gq]; \
                    oo[q2].x = cvt_pk_bf16(bflo(uw.x) * (acc[4 * gq] + bsv), bfhi(uw.x) * (acc[4 * gq + 1] + bsv)); oo[q2].y = cvt_pk_bf16(bflo(uw.y) * (acc[4 * gq + 2] + bsv), bfhi(uw.y) * (acc[4 * gq + 3] + bsv)); } \
                *(v4u*)(Gout + groww + 16 * gp) = widen_pair(oo[0], oo[1]); } \
        } while (0)
        v4u zrb[2]; v2u zua[4], zub[4];
        { const int it0 = (w >> 1) & 3; const size_t orow = ((size_t)c * 128 + 32 * it0 + r32) * GM_W + 32 * (w & 1) + 4 * hi;
#pragma unroll
          for (int gq = 0; gq < 4; ++gq) zua[gq] = *(const v2u*)(ZU + orow + 8 * gq); }
#pragma unroll 1
        for (int gi = 0; gi < 12; gi += 2) {
            SP_GROUP(gi, zr, zua, zrb, zub);
            SP_GROUP(gi + 1, zrb, zub, zr, zua);
        }
#undef SP_GROUP
        __syncthreads();
    }
}

__device__ __forceinline__ void merge_phase(const Frame& F, const Args& A) {
    const int tidx_ = tid_opaque(F.wave);
    const bf16* OG = (const bf16*)(A.ws + WS_OG); const float* LSE = (const float*)(A.ws + WS_LSE); bf16* ATT = (bf16*)(A.ws + WS_AG);
    const int gw = F.vcu * 8 + F.wave, NGW = F.G * 8, lane = (tidx_ & 63), h = lane >> 4;
    for (int t = gw; t < T; t += NGW) {
        const float l0 = LSE[(size_t)t * 4 + h], l1 = LSE[((size_t)T + t) * 4 + h], l2 = LSE[((size_t)2 * T + t) * 4 + h];
        const float m = fmaxf(l0, fmaxf(l1, l2)); float a0 = __expf(l0 - m), a1 = __expf(l1 - m), a2 = __expf(l2 - m); const float inv = 1.0f / (a0 + a1 + a2); a0 *= inv; a1 *= inv; a2 *= inv;
        const v2u w0 = *(const v2u*)(OG + (size_t)t * 256 + 4 * lane), w1 = *(const v2u*)(OG + ((size_t)T + t) * 256 + 4 * lane), w2 = *(const v2u*)(OG + ((size_t)2 * T + t) * 256 + 4 * lane);
        v2u o; o.x = pk2(a0 * bflo(w0.x) + a1 * bflo(w1.x) + a2 * bflo(w2.x), a0 * bfhi(w0.x) + a1 * bfhi(w1.x) + a2 * bfhi(w2.x));
        o.y = pk2(a0 * bflo(w0.y) + a1 * bflo(w1.y) + a2 * bflo(w2.y), a0 * bfhi(w0.y) + a1 * bfhi(w1.y) + a2 * bfhi(w2.y));
        *(v2u*)(ATT + (size_t)t * D + 4 * lane) = o;
    }
}

__device__ __forceinline__ void router_phase(const Frame& F, const Args& A) {
    const int tidx_ = tid_opaque(F.wave);
    LAS unsigned char* L = F.lds;
    LAS int* hist = (LAS int*)(F.lds + RING_BYTES + 2048);
    LAS int* basee = hist + 32;
    LAS int* rec_e = hist + 64;
    LAS int* rec_r = rec_e + 512;
    LAS float* rec_g = (LAS float*)(rec_r + 512);
    LAS float* rec_s = rec_g + 512;
    const float* brt = A.in[14]; const float* gmoe = A.in[12];
    const bf16* H = (const bf16*)A.out; bf16* NX = (bf16*)(A.ws + WS_NX);
    const bf16* WRH = (const bf16*)(A.ws + WS_WRH);
    int* LIST = (int*)(A.ws + WS_LIST); float* SGATE = (float*)(A.ws + WS_SGATE); float* SRSTD = (float*)(A.ws + WS_SRSTD); int* POS = (int*)(A.ws + WS_POS);
    unsigned* CNT = (unsigned*)(A.ws + WS_CTL) + CW_CNT;
    const int lane = (tidx_ & 63), w = F.wave, r32 = lane & 31, hi = lane >> 5;
    for (int c = F.vcu; c < T / 128; c += F.G) {
        for (int q = tidx_; q < 8192; q += 512) { const int mtx = q >> 12, rem = q & 4095, e = rem >> 7, ck = rem & 127;
            const v4u v = *(const v4u*)(WRH + (size_t)mtx * 32768 + e * 1024 + ck * 8);
            *(LAS v4u*)(L + mtx * 65536 + e * 2048 + ((ck ^ (e & 15)) << 4)) = v; }
        if (tidx_ < 32) hist[tidx_] = 0;
        __syncthreads();
        const int tt = w & 3, kh = w >> 2;
        const size_t row = (size_t)c * 128 + tt * 32 + r32;
        const bf16* hrow = H + row * D + kh * 512 + 8 * hi; const float* grow = gmoe + kh * 512 + 8 * hi; bf16* nrow = NX + row * D + kh * 512 + 8 * hi;
        const LAS unsigned char* wb = L + r32 * 2048;
        f32x16 acc = {}; float ss = 0.f;
#pragma unroll 4
        for (int s = 0; s < 32; ++s) {
            const v4u hw_ = *(const v4u*)(hrow + 16 * s); const f32x4 h0 = {bflo(hw_.x), bfhi(hw_.x), bflo(hw_.y), bfhi(hw_.y)}, h1 = {bflo(hw_.z), bfhi(hw_.z), bflo(hw_.w), bfhi(hw_.w)}, g0 = *(const f32x4*)(grow + 16 * s), g1 = *(const f32x4*)(grow + 16 * s + 4);
            ss += (h0.x * h0.x + h0.y * h0.y) + (h0.z * h0.z + h0.w * h0.w) + (h1.x * h1.x + h1.y * h1.y) + (h1.z * h1.z + h1.w * h1.w);
            const f32x4 x0 = h0 * g0, x1 = h1 * g1;
            v4u xh; xh.x = cvt_pk_bf16(x0.x, x0.y); xh.y = cvt_pk_bf16(x0.z, x0.w); xh.z = cvt_pk_bf16(x1.x, x1.y); xh.w = cvt_pk_bf16(x1.z, x1.w);
            v4u xl; xl.x = cvt_pk_bf16(x0.x - bflo(xh.x), x0.y - bfhi(xh.x)); xl.y = cvt_pk_bf16(x0.z - bflo(xh.y), x0.w - bfhi(xh.y));
            xl.z = cvt_pk_bf16(x1.x - bflo(xh.z), x1.y - bfhi(xh.z)); xl.w = cvt_pk_bf16(x1.z - bflo(xh.w), x1.w - bfhi(xh.w));
            *(v4u*)(nrow + 16 * s) = xh;
            const int ck = kh * 64 + 2 * s + hi;
            const bf16x8 wh = *(const LAS bf16x8*)(wb + ((ck ^ (r32 & 15)) << 4)), wl = *(const LAS bf16x8*)(wb + 65536 + ((ck ^ (r32 & 15)) << 4));
            const bf16x8 ah = __builtin_bit_cast(bf16x8, xh), al = __builtin_bit_cast(bf16x8, xl);
            acc = __builtin_amdgcn_mfma_f32_32x32x16_bf16(ah, wh, acc, 0, 0, 0);
            acc = __builtin_amdgcn_mfma_f32_32x32x16_bf16(al, wh, acc, 0, 0, 0);
            acc = __builtin_amdgcn_mfma_f32_32x32x16_bf16(ah, wl, acc, 0, 0, 0);
        }
        __syncthreads();
        { LAS float* LGp = (LAS float*)L + kh * (128 * 33);
#pragma unroll
          for (int i = 0; i < 16; ++i) LGp[(tt * 32 + crow(i, hi)) * 33 + r32] = acc[i];
          ((LAS float*)(L + 36864))[(kh * 2 + hi) * 128 + tt * 32 + r32] = ss; }
        __syncthreads();
        if (tidx_ < 128) {
            const int t = tidx_; const LAS float* SS = (const LAS float*)(L + 36864);
            const float rstd = 1.0f / sqrtf(((SS[t] + SS[128 + t]) + (SS[256 + t] + SS[384 + t])) * (1.f / D) + EPS);
            const LAS float* l0 = (const LAS float*)L + t * 33; const LAS float* l1 = l0 + 128 * 33;
            float lg[32];
#pragma unroll
            for (int e = 0; e < 32; ++e) lg[e] = (l0[e] + l1[e]) * rstd + brt[e];
            unsigned taken = 0u; float tv[4]; int ti[4];
#pragma unroll
            for (int k = 0; k < 4; ++k) { float bv = -INFINITY; int bi = 0;
#pragma unroll
                for (int e = 0; e < 32; ++e) { const float cv = ((taken >> e) & 1u) ? -INFINITY : lg[e]; if (cv > bv) { bv = cv; bi = e; } }
                tv[k] = bv; ti[k] = bi; taken |= 1u << bi; }
            const float e1 = __expf(tv[1] - tv[0]), e2 = __expf(tv[2] - tv[0]), e3 = __expf(tv[3] - tv[0]); const float inv = 1.0f / (1.0f + e1 + e2 + e3);
            const float gk[4] = {inv, e1 * inv, e2 * inv, e3 * inv};
            rec_s[t] = rstd;
#pragma unroll
            for (int k = 0; k < 4; ++k) { const int lr = atomicAdd((int*)&hist[ti[k]], 1); rec_e[t * 4 + k] = ti[k]; rec_r[t * 4 + k] = lr; rec_g[t * 4 + k] = gk[k]; }
        }
        __syncthreads();
        if (tidx_ < 32) basee[tidx_] = (int)__hip_atomic_fetch_add(CNT + tidx_, (unsigned)hist[tidx_], __ATOMIC_RELAXED, __HIP_MEMORY_SCOPE_AGENT);
        __syncthreads();
        { const int lrow = tidx_ >> 2, k = tidx_ & 3; const int e = rec_e[tidx_], slot = basee[e] + rec_r[tidx_]; const int t = c * 128 + lrow;
          LIST[e * 32768 + slot] = t; SGATE[e * 32768 + slot] = rec_g[tidx_]; SRSTD[e * 32768 + slot] = rec_s[lrow]; POS[t * 4 + k] = (e << 16) | slot; }
        __syncthreads();
    }
}

__device__ __forceinline__ void load_tile_starts(const Frame& F, const Args& A) {
    const int tidx_ = tid_opaque(F.wave);
    LAS int* ts = (LAS int*)(F.lds + TS_OFF);
    if (tidx_ == 0) { const unsigned* CNT = (const unsigned*)(A.ws + WS_CTL) + CW_CNT; int acc = 0;
        for (int e = 0; e < 32; ++e) { const int c = (int)__hip_atomic_load(CNT + e, __ATOMIC_RELAXED, __HIP_MEMORY_SCOPE_AGENT); ts[e] = acc; ts[40 + e] = c; acc += (c + 255) >> 8; }
        ts[32] = acc; for (int e = 33; e < 40; ++e) ts[e] = 0x7fffffff; }
    __syncthreads();
}

__device__ __forceinline__ void combine_phase(const Frame& F, const Args& A) {
    const int tidx_ = tid_opaque(F.wave);
    const LAS int* ts = (const LAS int*)(F.lds + TS_OFF);
    const bf16* Y = (const bf16*)(A.ws + WS_Y); const int* POS = (const int*)(A.ws + WS_POS); const bf16* H = (const bf16*)A.out; bf16* NX = (bf16*)(A.ws + WS_NX); bf16* H2 = (bf16*)(A.ws + WS_H2);
    const float* gple = A.in[19];
    const int gw = F.vcu * 8 + F.wave, NGW = F.G * 8, lane = (tidx_ & 63);
    for (int t = gw * 2; t < T; t += NGW * 2) {
        int pz[2][4];
#pragma unroll
        for (int r = 0; r < 2; ++r)
#pragma unroll
            for (int k = 0; k < 4; ++k) pz[r][k] = POS[(t + r) * 4 + k];
        f32x4 v[2][2][2];
#pragma unroll
        for (int r = 0; r < 2; ++r)
#pragma unroll
            for (int hf = 0; hf < 2; ++hf) { const v4u w = *(const v4u*)(H + (size_t)(t + r) * D + hf * 512 + 8 * lane); v[r][hf][0] = (f32x4){bflo(w.x), bfhi(w.x), bflo(w.y), bfhi(w.y)}; v[r][hf][1] = (f32x4){bflo(w.z), bfhi(w.z), bflo(w.w), bfhi(w.w)}; }
        v4u yw[2][4][2];
#pragma unroll
        for (int r = 0; r < 2; ++r)
#pragma unroll
            for (int k = 0; k < 4; ++k) { const int e = pz[r][k] >> 16, slot = pz[r][k] & 0xffff; const bf16* yp = Y + ((size_t)ts[e] * 256 + slot) * D + 8 * lane;
                yw[r][k][0] = *(const v4u*)yp; yw[r][k][1] = *(const v4u*)(yp + 512); }
        float s[2];
#pragma unroll
        for (int r = 0; r < 2; ++r) { float a = 0.f;
#pragma unroll
            for (int hf = 0; hf < 2; ++hf) {
#pragma unroll
                for (int k = 0; k < 4; ++k) { const v4u w = yw[r][k][hf];
                    v[r][hf][0] = v[r][hf][0] + (f32x4){bflo(w.x), bfhi(w.x), bflo(w.y), bfhi(w.y)}; v[r][hf][1] = v[r][hf][1] + (f32x4){bflo(w.z), bfhi(w.z), bflo(w.w), bfhi(w.w)}; }
                st8(H2 + (size_t)(t + r) * D + hf * 512 + 8 * lane, v[r][hf][0], v[r][hf][1]);
#pragma unroll
                for (int p = 0; p < 2; ++p) a += (v[r][hf][p].x * v[r][hf][p].x + v[r][hf][p].y * v[r][hf][p].y) + (v[r][hf][p].z * v[r][hf][p].z + v[r][hf][p].w * v[r][hf][p].w); }
            s[r] = a; }
#pragma unroll
        for (int o = 1; o < 64; o <<= 1) { s[0] += __shfl_xor(s[0], o); s[1] += __shfl_xor(s[1], o); }
#pragma unroll
        for (int r = 0; r < 2; ++r) { const float rstd = 1.0f / sqrtf(s[r] * (1.f / D) + EPS);
#pragma unroll
            for (int hf = 0; hf < 2; ++hf) { const float* gp = gple + hf * 512 + 8 * lane; const f32x4 g0 = *(const f32x4*)gp, g1 = *(const f32x4*)(gp + 4);
                st8(NX + (size_t)(t + r) * D + hf * 512 + 8 * lane, v[r][hf][0] * rstd * g0, v[r][hf][1] * rstd * g1); } }
    }
}
__device__ __forceinline__ void final_phase(const Frame& F, const Args& A) {
    const int tidx_ = tid_opaque(F.wave);
    float* OUT = A.out; const float* gf = A.in[22]; const bf16* T1 = (const bf16*)(A.ws + WS_T1); const bf16* H2 = (const bf16*)(A.ws + WS_H2);
    const int gw = F.vcu * 8 + F.wave, NGW = F.G * 8, lane = (tidx_ & 63);
    f32x4 g[2][2];
#pragma unroll
    for (int hf = 0; hf < 2; ++hf) { const float* gp = gf + hf * 512 + 8 * lane; g[hf][0] = *(const f32x4*)gp; g[hf][1] = *(const f32x4*)(gp + 4); }
    for (int t = gw * 2; t < T; t += NGW * 2) {
        v4u hw[2][2], tw[2][2];
#pragma unroll
        for (int r = 0; r < 2; ++r)
#pragma unroll
            for (int hf = 0; hf < 2; ++hf) { const size_t o = (size_t)(t + r) * D + hf * 512 + 8 * lane; hw[r][hf] = *(const v4u*)(H2 + o); tw[r][hf] = *(const v4u*)(T1 + o); }
        f32x4 v[2][2][2]; float s[2];
#pragma unroll
        for (int r = 0; r < 2; ++r) { float a = 0.f;
#pragma unroll
            for (int hf = 0; hf < 2; ++hf) { const v4u h = hw[r][hf], w = tw[r][hf];
                v[r][hf][0] = (f32x4){bflo(h.x) + bflo(w.x), bfhi(h.x) + bfhi(w.x), bflo(h.y) + bflo(w.y), bfhi(h.y) + bfhi(w.y)};
                v[r][hf][1] = (f32x4){bflo(h.z) + bflo(w.z), bfhi(h.z) + bfhi(w.z), bflo(h.w) + bflo(w.w), bfhi(h.w) + bfhi(w.w)};
#pragma unroll
                for (int p = 0; p < 2; ++p) a += (v[r][hf][p].x * v[r][hf][p].x + v[r][hf][p].y * v[r][hf][p].y) + (v[r][hf][p].z * v[r][hf][p].z + v[r][hf][p].w * v[r][hf][p].w); }
            s[r] = a; }
#pragma unroll
        for (int o = 1; o < 64; o <<= 1) { s[0] += __shfl_xor(s[0], o); s[1] += __shfl_xor(s[1], o); }
#pragma unroll
        for (int r = 0; r < 2; ++r) { const float rstd = 1.0f / sqrtf(s[r] * (1.f / D) + EPS);
#pragma unroll
            for (int hf = 0; hf < 2; ++hf) { float* op = OUT + (size_t)(t + r) * D + hf * 512 + 8 * lane; *(f32x4*)op = v[r][hf][0] * rstd * g[hf][0]; *(f32x4*)(op + 4) = v[r][hf][1] * rstd * g[hf][1]; } }
    }
}

constexpr int NPHASE = 13;
#ifndef ONLY_PH
#define ONLY_PH -1
#endif
#define PH_ON(k) (ONLY_PH < 0 || ONLY_PH == (k))
__global__ void __launch_bounds__(512, 2) fwd_kernel(Args args) {
    extern __shared__ __attribute__((aligned(16))) unsigned char lds[];
    Frame F;
    F.lds = (LAS unsigned char*)lds; F.wave = __builtin_amdgcn_readfirstlane((int)threadIdx.x >> 6);
    F.G = gridDim.x; { const int bx = blockIdx.x; F.vcu = (F.G % 8 == 0) ? (bx % 8) * (F.G / 8) + bx / 8 : bx; }
    unsigned char* ws = args.ws;
    volatile LAS unsigned* MISC = (volatile LAS unsigned*)(F.lds + MISC_OFF);
    for (int u = tid_opaque(F.wave); u < (LDS_BYTES - RING_BYTES) / 4; u += 512) ((LAS unsigned*)(F.lds + RING_BYTES))[u] = 0u;
    __syncthreads();
    const bool multi = (args.ph_hi - args.ph_lo) > 1;
    if (multi) (void)xcd_barrier_post((unsigned*)(ws + WS_CTL) + CW_BAR, MISC + 8, F.wave);
    const int bx = (int)blockIdx.x;
#if MK_N_LAUNCHES == 1
    constexpr int lo = 0, hi = NPHASE;
#else
    const int lo = args.ph_lo, hi = args.ph_hi;
#endif
#ifndef REP_MASK
#define REP_MASK 0
#endif
#define IN(k) (PH_ON(k) && lo <= (k) && (k) < hi)
#define REPS(k) (((REP_MASK >> (k)) & 1) ? 2 : 1)
#define SEAM(k) do { if (lo <= (k) && (k) + 1 < hi) { XcdBarrier b_; b_.bar = (unsigned*)(args.ws + WS_CTL) + CW_BAR; b_.x = xb_xcc_id(); b_.st = (volatile LAS unsigned*)(F.lds + MISC_OFF) + 8; b_.wave = F.wave; xcd_barrier(b_); } } while (0)
    if (IN(0)) for (int rep_ = 0; rep_ < REPS(0); ++rep_) { p0_prologue(F, args); } SEAM(0);
    if (IN(1)) { const int nu1 = (T / 256) * 23, R1 = (nu1 + F.G - 1) / F.G + 1, GG = (nu1 + R1 - 1) / R1;
                 if (bx < GG) { InProjSched S{(const char*)(ws + WS_NX), (const char*)(ws + WS_WIN), GG, bx, REPS(1) - 1};
                 EpiInProj E{(bf16*)(ws + WS_Q), (bf16*)(ws + WS_K), (bf16*)(ws + WS_ZU), (bf16*)(ws + WS_GA), (bf16*)(ws + WS_GG), (bf16*)(ws + WS_VT), (bf16*)(ws + WS_ZVT)};
                 pg8::gemm_phase(F.lds, D, S, E, F.wave); }
                 convert_queue(F, args, (unsigned*)(ws + WS_CTL) + CW_Q1, 0, BG_P1); convert_queue(F, args, (unsigned*)(ws + WS_CTL) + CW_Q3, BG_N, BG_ALL); convert_p_queue(F, args, (unsigned*)(ws + WS_CTL) + CW_Q4); } SEAM(1);
    if (IN(2)) { attn_phase(F, args); spatial_phase(F, args); } SEAM(2);
    if (IN(3)) { merge_phase(F, args); } SEAM(3);
    if (IN(4)) { PlainSched S{(const char*)(ws + WS_AG), (const char*)(ws + WS_WCAT), T / 256, 4, D, F.G, bx, REPS(4) - 1}; EpiMerge E{(bf16*)(ws + WS_MRG), (const bf16*)(ws + WS_GA), (const bf16*)(ws + WS_GG)};
                 pg8::gemm_phase(F.lds, D, S, E, F.wave); } SEAM(5);
    if (IN(6)) { PlainSched S{(const char*)(ws + WS_MRG), (const char*)(ws + WS_WOUT), T / 256, 4, D, F.G, bx, REPS(6) - 1}; EpiH1 E{(bf16*)args.out, args.in[0]};
                 pg8::gemm_phase(F.lds, D, S, E, F.wave); } SEAM(6);
    if (IN(7)) for (int rep_ = 0; rep_ < REPS(7); ++rep_) { router_phase(F, args); } SEAM(7);
    if (IN(8)) { load_tile_starts(F, args); const LAS int* ts = (const LAS int*)(F.lds + TS_OFF);
                 const int nu8 = ts[32] * 8, R8 = (nu8 + F.G - 1) / F.G, GG = R8 > 0 ? (nu8 + R8 - 1) / R8 : 1;
                 if (bx < GG) { MoeSched S{(const char*)(ws + WS_NX), (const char*)(ws + WS_WGU), (const int*)(ws + WS_LIST), ts, 8, D, GG, bx, 1, REPS(8) - 1}; EpiMoeUp E{(bf16*)(ws + WS_ACT), args.in[16], (const float*)(ws + WS_SRSTD), ts};
                 pg8::gemm_phase(F.lds, D, S, E, F.wave); }
                 convert_queue(F, args, (unsigned*)(ws + WS_CTL) + CW_Q2, BG_GU, BG_N); } SEAM(8);
    if (IN(9)) { load_tile_starts(F, args); const LAS int* ts = (const LAS int*)(F.lds + TS_OFF);
                 const int nu9 = ts[32] * 4, R9 = (nu9 + F.G - 1) / F.G, GG = R9 > 0 ? (nu9 + R9 - 1) / R9 : 1, NH = F.G - GG;
                 if (bx < GG) { MoeSched S{(const char*)(ws + WS_ACT), (const char*)(ws + WS_WD), (const int*)(ws + WS_LIST), ts, 4, D, GG, bx, 0, REPS(9) - 1}; EpiMoeDown E{(bf16*)(ws + WS_Y), args.in[18], (const float*)(ws + WS_SGATE), ts};
                 pg8::gemm_phase(F.lds, D, S, E, F.wave); }
                 if (NH >= 8 ? bx >= GG : true) { PlainSched S{(const char*)(ws + WS_PB), (const char*)(ws + WS_WPP), T / 256, 4, PLE, NH >= 8 ? NH : F.G, NH >= 8 ? bx - GG : bx, 0}; EpiBf<0> E{(bf16*)(ws + WS_PP), nullptr, nullptr};
                 pg8::gemm_phase(F.lds, PLE, S, E, F.wave); } } SEAM(9);
    if (IN(10)) for (int rep_ = 0; rep_ < REPS(10); ++rep_) { load_tile_starts(F, args); combine_phase(F, args); } SEAM(10);
    if (IN(11)) { PlainSched S{(const char*)(ws + WS_NX), (const char*)(ws + WS_WPG), T / 256, 4, D, F.G, bx, REPS(11) - 1}; EpiPle E{(bf16*)(ws + WS_T1), (const bf16*)(ws + WS_PP)};
                  pg8::gemm_phase(F.lds, D, S, E, F.wave); } SEAM(11);
    if (IN(12)) for (int rep_ = 0; rep_ < REPS(12); ++rep_) { final_phase(F, args); }
#undef IN
#undef SEAM
}

extern "C" void kernel_launch(void* const* d_in, const int* in_sizes, int n_in, void* d_out, int out_size, void* d_ws, size_t ws_size, hipStream_t stream) {
    static int grid = 0;
    if (grid == 0) {
        if (n_in != 23 || out_size != T * D || ws_size < WS_END) { fprintf(stderr, "kernel_launch: unexpected shapes (n_in %d out %d ws %zu)\n", n_in, out_size, ws_size); grid = -1; return; }
        int dev = 0, cus = 0, per_cu = 0;
        if (hipGetDevice(&dev) != hipSuccess || hipDeviceGetAttribute(&cus, hipDeviceAttributeMultiprocessorCount, dev) != hipSuccess) { grid = -1; return; }
        if (hipFuncSetAttribute((const void*)fwd_kernel, hipFuncAttributeMaxDynamicSharedMemorySize, LDS_BYTES) != hipSuccess) { fprintf(stderr, "kernel_launch: hipFuncSetAttribute failed\n"); grid = -1; return; }
        if (hipOccupancyMaxActiveBlocksPerMultiprocessor(&per_cu, (const void*)fwd_kernel, 512, LDS_BYTES) != hipSuccess || per_cu < 1) { fprintf(stderr, "kernel_launch: occupancy query says %d\n", per_cu); (void)hipGetLastError(); grid = -1; return; }
        grid = cus;
    }
    if (grid < 0) return;
    (void)hipMemsetAsync((char*)d_ws + WS_CTL, 0, CTL_ZERO_BYTES, stream);
    Args a{};
    for (int i = 0; i < 23; ++i) a.in[i] = (const float*)d_in[i];
    a.out = (float*)d_out; a.ws = (unsigned char*)d_ws;
#if MK_N_LAUNCHES == 1
    a.ph_lo = 0; a.ph_hi = NPHASE;
    hipLaunchKernelGGL(fwd_kernel, dim3(grid), dim3(512), LDS_BYTES, stream, a);
#else
    for (int ph = 0; ph < NPHASE; ++ph) { a.ph_lo = ph; a.ph_hi = ph + 1; hipLaunchKernelGGL(fwd_kernel, dim3(grid), dim3(512), LDS_BYTES, stream, a); }
#endif
}
```

```cpp
#include <hip/hip_runtime.h>
#include <cstdio>
#include <cstdint>

#ifndef MK_N_LAUNCHES
#define MK_N_LAUNCHES 1
#endif

constexpr int NB = 8, SEQ = 4096, T = NB * SEQ, D = 1024;
constexpr int ATT_W = 768, GM_W = 768, IN_W = 5888, NE = 32, TOPK = 4, PLE = 256;
constexpr float EPS = 1e-6f;
constexpr float LOG2E = 1.4426950408889634f, LN2 = 0.6931471805599453f;
constexpr float QSCALE = 0.125f * LOG2E;

#define LAS __attribute__((address_space(3)))
#define GAS __attribute__((address_space(1)))
typedef unsigned short bf16;
typedef unsigned v4u __attribute__((ext_vector_type(4)));
typedef unsigned v2u __attribute__((ext_vector_type(2)));
typedef float f32x4 __attribute__((ext_vector_type(4)));
typedef float f32x2 __attribute__((ext_vector_type(2)));
typedef float f32x16 __attribute__((ext_vector_type(16)));
typedef short bf16x8 __attribute__((ext_vector_type(8)));
typedef short s16x4 __attribute__((ext_vector_type(4)));

__device__ __forceinline__ unsigned f2bf(float f) { unsigned u = __builtin_bit_cast(unsigned, f); return (u + 0x7fffu + ((u >> 16) & 1u)) >> 16; }
__device__ __forceinline__ unsigned pk2(float lo, float hi) { return f2bf(lo) | (f2bf(hi) << 16); }
__device__ __forceinline__ float bflo(unsigned w) { return __builtin_bit_cast(float, w << 16); }
__device__ __forceinline__ float bfhi(unsigned w) { return __builtin_bit_cast(float, w & 0xffff0000u); }
typedef __bf16 bf16x2_t __attribute__((ext_vector_type(2)));
__device__ __forceinline__ unsigned cvt_pk_bf16(float lo, float hi) { const f32x2 v = {lo, hi}; const bf16x2_t b = __builtin_convertvector(v, bf16x2_t); return __builtin_bit_cast(unsigned, b); }
__device__ __forceinline__ float sigmoidf_(float x) { return __builtin_amdgcn_rcpf(1.0f + __builtin_amdgcn_exp2f(-x * LOG2E)); }
__device__ __forceinline__ f32x2 gelu_pk(f32x2 v) {
    const f32x2 av = __builtin_elementwise_abs(v), d = av * 0.2316418882f + 1.0f;
    f32x2 t; t.x = __builtin_amdgcn_rcpf(d.x); t.y = __builtin_amdgcn_rcpf(d.y);
    f32x2 q = t * 0.5307027145f + (-0.7265760135f); q = q * t + 0.7107068705f; q = q * t + (-0.142248368f); q = q * t + 0.127414796f; q = q * t;
    const f32x2 s = (v * v) * (-0.72134752044f);
    f32x2 e; e.x = __builtin_amdgcn_exp2f(s.x); e.y = __builtin_amdgcn_exp2f(s.y);
    const f32x2 m = v * (q * e), r = v - m;
    f32x2 o; o.x = v.x < 0.f ? m.x : r.x; o.y = v.y < 0.f ? m.y : r.y; return o;
}
__device__ __forceinline__ f32x4 gelu4(f32x4 v) { f32x2 a = gelu_pk((f32x2){v[0], v[1]}), b = gelu_pk((f32x2){v[2], v[3]}); return (f32x4){a.x, a.y, b.x, b.y}; }
__device__ __forceinline__ f32x4 sigm4(f32x4 v) { return (f32x4){sigmoidf_(v[0]), sigmoidf_(v[1]), sigmoidf_(v[2]), sigmoidf_(v[3])}; }
__device__ __forceinline__ int tid_opaque(int wave) {
    int l; asm volatile("v_mbcnt_lo_u32_b32 %0, -1, 0\n\tv_mbcnt_hi_u32_b32 %0, -1, %0" : "=v"(l));
    return wave * 64 + l;
}
__device__ __forceinline__ float wave_sum(float v) {
#pragma unroll
    for (int o = 1; o < 64; o <<= 1) v += __shfl_xor(v, o);
    return v;
}

constexpr size_t MiB = 1u << 20;
constexpr size_t WS_CTL = 0, CTL_ZERO_BYTES = 1 * MiB;
constexpr size_t WS_WIN = 2 * MiB;
constexpr size_t WS_WCAT = 14 * MiB;
constexpr size_t WS_WOUT = 17 * MiB;
constexpr size_t WS_WPG = 19 * MiB;
constexpr size_t WS_WPP = 21 * MiB;
constexpr size_t WS_WSP = 22 * MiB;
constexpr size_t WS_WRH = 23 * MiB;
constexpr size_t WS_WRL = 23 * MiB + 65536;
constexpr size_t WS_SRSTD = 980 * MiB;
constexpr size_t WS_WGU = 24 * MiB;
constexpr size_t WS_WD = 152 * MiB;
constexpr size_t WS_NX = 216 * MiB;
constexpr size_t WS_PB = 280 * MiB;
constexpr size_t WS_PP = 296 * MiB;
constexpr size_t WS_LIST = 360 * MiB;
constexpr size_t WS_SGATE = 364 * MiB;
constexpr size_t WS_POS = 368 * MiB;
constexpr size_t WS_LSE = 369 * MiB;
constexpr size_t WS_Q = 372 * MiB;
constexpr size_t WS_K = 420 * MiB;
constexpr size_t WS_VT = 468 * MiB;
constexpr size_t WS_ZU = 516 * MiB;
constexpr size_t WS_ZVT = 564 * MiB;
constexpr size_t WS_GA = 612 * MiB;
constexpr size_t WS_GG = 676 * MiB;
constexpr size_t WS_OG = 740 * MiB;
constexpr size_t WS_ATT = 788 * MiB;
constexpr size_t WS_G = 804 * MiB;
constexpr size_t WS_AG = 852 * MiB;
constexpr size_t WS_MRG = 916 * MiB;
constexpr size_t WS_ACT = 372 * MiB;
constexpr size_t WS_Y = 644 * MiB;
constexpr size_t WS_H2 = 436 * MiB;
constexpr size_t WS_T1 = 372 * MiB;
constexpr size_t WS_END = 984 * MiB;
constexpr int PMAX_TILES = 544;

constexpr int CW_CNT = 64;
constexpr int CW_Q1 = 256, CW_Q2 = 320, CW_Q3 = 384, CW_Q4 = 448;
constexpr int CW_BAR = 4096;

constexpr int RING_BYTES = 131072;
constexpr int MISC_OFF = RING_BYTES + 320;
constexpr int TS_OFF = RING_BYTES + 1024;
constexpr int LDS_BYTES = 147456;

namespace pg8 {
typedef unsigned short bf16_t;
constexpr int BM = 256, BK = 64, HALF = 128, HTB = HALF * BK * 2, STAGE_BYTES = 8 * HTB, NXCD = 8, WGM = 8;
__host__ __device__ __forceinline__ int lds_byte(int r, int c) { const int st = (r >> 4) * 2 + (c >> 5), rr = r & 15, cc = c & 31, ob = rr * 64 + cc * 2; return st * 1024 + (ob ^ (((ob >> 9) & 1) << 5)); }
__host__ __device__ __forceinline__ void stage_rc(int b, int& R, int& C) { const int st = b / 1024, sb = b % 1024, swz = sb ^ (((sb >> 9) & 1) << 5); R = (st >> 1) * 16 + swz / 64; C = (st & 1) * 32 + (swz % 64) / 2; }
__host__ __device__ __forceinline__ int perm32(int rho) { const int n = rho >> 4, i = rho & 15; return 8 * (i >> 2) + 4 * n + (i & 3); }

struct Unit { const char* a; const char* b; int pm, pn, x0, x1; };

__device__ __forceinline__ bool static_order(int i, int G, int c, int nM, int nN, int& pm, int& pn) {
    const int nwg = nM * nN; const long L = (long)i * G + c; if (L >= nwg) return false;
    int wgid = (int)L; { const int q = nwg / NXCD, r = nwg % NXCD, xcd = wgid % NXCD, off = wgid / NXCD; wgid = (xcd < r ? xcd * (q + 1) : r * (q + 1) + (xcd - r) * q) + off; }
    const int nig = WGM * nN, gid = wgid / nig, fm = gid * WGM, gsz = (nM - fm) < WGM ? (nM - fm) : WGM;
    pm = fm + ((wgid % nig) % gsz); pn = (wgid % nig) / gsz; return true;
}

template <class Epi, class Sched>
__device__ __forceinline__ void gemm_phase(LAS unsigned char* lds, const int K, const Sched& S, const Epi& E, const int wave) {
    const int wid = wave, tid = tid_opaque(wid), lane = tid & 63, wr = wid >> 2, wc = wid & 3, fr = lane & 15, fq = lane >> 4;
    const int nt = K / BK;
    int RA[2]; unsigned CB2[2], rbk[2];
#pragma unroll
    for (int i = 0; i < 2; ++i) { int R, C; stage_rc(tid * 16 + i * 8192, R, C); const int Rb = Epi::PERM ? ((R & ~31) + perm32(R & 31)) : R;
        RA[i] = R; CB2[i] = (unsigned)C * 2u; rbk[i] = (unsigned)(Rb * K) * 2u; }
    const size_t kstep = (size_t)(BK * 2);
    const size_t hstep = (size_t)HALF * K * 2;
    const unsigned ldsw = (unsigned)wid * 1024u;
    const int aoff = lds_byte(wr * 64 + fr, fq * 8), boff = lds_byte(wc * 32 + fr, fq * 8);
#define PG8_SA(b, h) (((b) * 2 + (h)) * HTB)
#define PG8_SB(b, h) ((4 + (b) * 2 + (h)) * HTB)
#define PG8_STAGE(bufoff, gbase, voff) do { _Pragma("unroll") for (int _i = 0; _i < 2; ++_i) \
        __builtin_amdgcn_global_load_lds((const unsigned*)((const char*)(gbase) + (voff)[_i]), (LAS unsigned*)(lds + (bufoff) + ldsw + _i * 8192), 16, 0, 0); } while (0)
#define PG8_LDA(dst, b, h) do { _Pragma("unroll") for (int m = 0; m < 4; ++m) _Pragma("unroll") for (int k = 0; k < 2; ++k) dst[m][k] = *(const LAS bf16x8*)(lds + PG8_SA(b, h) + aoff + m * 2048 + k * 1024); } while (0)
#define PG8_LDB(dst, b, h) do { _Pragma("unroll") for (int n = 0; n < 2; ++n) _Pragma("unroll") for (int k = 0; k < 2; ++k) dst[n][k] = *(const LAS bf16x8*)(lds + PG8_SB(b, h) + boff + n * 2048 + k * 1024); } while (0)
#define PG8_MMA(ai, bj, At, Bt) do { __builtin_amdgcn_s_setprio(1); _Pragma("unroll") for (int m = 0; m < 4; ++m) _Pragma("unroll") for (int n = 0; n < 2; ++n) _Pragma("unroll") for (int k = 0; k < 2; ++k) \
        acc[ai][bj][m][n] = __builtin_amdgcn_mfma_f32_16x16x32_bf16(Bt[n][k], At[m][k], acc[ai][bj][m][n], 0, 0, 0); __builtin_amdgcn_s_setprio(0); } while (0)
#define PG8_WAIT_V(n) asm volatile("s_waitcnt vmcnt(" #n ")" ::: "memory")
#define PG8_WAIT_L(n) asm volatile("s_waitcnt lgkmcnt(" #n ")" ::: "memory")
#define PG8_BAR __builtin_amdgcn_s_barrier()
#define PG8_SCHED __builtin_amdgcn_sched_barrier(0)
    Unit cur, nxt; int ui = 0;
    if (!S.next(0, cur)) return;
    f32x4 acc[2][2][4][2];
#pragma unroll
    for (int a = 0; a < 2; ++a)
#pragma unroll
        for (int b = 0; b < 2; ++b)
#pragma unroll
            for (int m = 0; m < 4; ++m)
#pragma unroll
                for (int n = 0; n < 2; ++n) acc[a][b][m][n] = (f32x4){0.f, 0.f, 0.f, 0.f};
    bf16x8 At[4][2], B0[2][2], B1[2][2];
    const char* cA = cur.a; const char* cB = cur.b;
    unsigned oA[2][2], nO[2][2];
#pragma unroll
    for (int h = 0; h < 2; ++h)
#pragma unroll
        for (int i = 0; i < 2; ++i) oA[h][i] = S.a_off(cur, h * HALF + RA[i], K) + CB2[i];
    int csh = S.b_shift(cur); unsigned vbc[2] = {(rbk[0] << csh) + CB2[0], (rbk[1] << csh) + CB2[1]}, vbn[2];
    PG8_STAGE(PG8_SB(0, 0), cB, vbc); PG8_STAGE(PG8_SB(0, 1), cB + (hstep << csh), vbc); PG8_STAGE(PG8_SA(0, 0), cA, oA[0]); PG8_STAGE(PG8_SA(0, 1), cA, oA[1]);
    if (wr == 1) PG8_BAR;
    PG8_WAIT_V(2); PG8_BAR;
    PG8_STAGE(PG8_SB(1, 0), cB + kstep, vbc); PG8_STAGE(PG8_SA(1, 0), cA + kstep, oA[0]); PG8_STAGE(PG8_SB(1, 1), cB + (hstep << csh) + kstep, vbc);
    PG8_WAIT_V(6); PG8_BAR;
    for (;;) {
        const bool has_next = S.next(ui + 1, nxt);
        const char* nA = has_next ? nxt.a : cA; const char* nB = has_next ? nxt.b : cB;
        const int nsh = has_next ? S.b_shift(nxt) : csh; vbn[0] = (rbk[0] << nsh) + CB2[0]; vbn[1] = (rbk[1] << nsh) + CB2[1];
#pragma unroll
        for (int h = 0; h < 2; ++h)
#pragma unroll
            for (int i = 0; i < 2; ++i) nO[h][i] = has_next ? (S.a_off(nxt, h * HALF + RA[i], K) + CB2[i]) : oA[h][i];
#pragma unroll 1
        for (int t = 0; t < nt; t += 2) {
            const bool last = (t == nt - 2);
            const char* a1 = cA + (size_t)(t + 1) * kstep;
            const char* a2 = last ? nA : cA + (size_t)(t + 2) * kstep; const char* b2 = last ? nB : cB + (size_t)(t + 2) * kstep;
            const char* a3 = a2 + kstep; const char* b3 = b2 + kstep;
            unsigned o2[2][2]; const unsigned vb2[2] = {last ? vbn[0] : vbc[0], last ? vbn[1] : vbc[1]}; const size_t hs2 = hstep << (last ? nsh : csh);
#pragma unroll
            for (int h = 0; h < 2; ++h)
#pragma unroll
                for (int i = 0; i < 2; ++i) o2[h][i] = last ? nO[h][i] : oA[h][i];
            PG8_LDB(B0, 0, 0); PG8_LDB(B1, 0, 1); PG8_SCHED; PG8_LDA(At, 0, 0); PG8_STAGE(PG8_SA(1, 1), a1, oA[1]);
            PG8_WAIT_V(8); PG8_WAIT_L(0); PG8_BAR; PG8_MMA(0, 0, At, B0); PG8_MMA(0, 1, At, B1); PG8_BAR; PG8_SCHED;
            PG8_LDA(At, 0, 1); PG8_STAGE(PG8_SB(0, 0), b2, vb2); PG8_STAGE(PG8_SB(0, 1), b2 + hs2, vb2); PG8_STAGE(PG8_SA(0, 0), a2, o2[0]);
            PG8_WAIT_V(8); PG8_WAIT_L(0); PG8_BAR; PG8_MMA(1, 0, At, B0); PG8_MMA(1, 1, At, B1); PG8_BAR; PG8_SCHED;
            PG8_LDB(B0, 1, 0); PG8_LDB(B1, 1, 1); PG8_SCHED; PG8_LDA(At, 1, 0); PG8_STAGE(PG8_SA(0, 1), a2, o2[1]);
            PG8_WAIT_V(8); PG8_WAIT_L(0); PG8_BAR; PG8_MMA(0, 0, At, B0); PG8_MMA(0, 1, At, B1); PG8_BAR; PG8_SCHED;
            PG8_LDA(At, 1, 1); PG8_STAGE(PG8_SB(1, 0), b3, vb2); PG8_STAGE(PG8_SB(1, 1), b3 + hs2, vb2); PG8_STAGE(PG8_SA(1, 0), a3, o2[0]);
            PG8_WAIT_V(8); PG8_WAIT_L(0); PG8_BAR; PG8_MMA(1, 0, At, B0); PG8_MMA(1, 1, At, B1); PG8_BAR; PG8_SCHED;
            if constexpr (Epi::HOOK_T >= 0) { if (t == Epi::HOOK_T) { E.mid(acc, cur, wr, wc, fr, fq); PG8_SCHED; } }
        }
        if (wr == 0) PG8_BAR;
        E(acc, cur, wr, wc, fr, fq);
        if (!has_next) break;
#pragma unroll
        for (int a = 0; a < 2; ++a)
#pragma unroll
            for (int b = 0; b < 2; ++b)
#pragma unroll
                for (int m = 0; m < 4; ++m)
#pragma unroll
                    for (int n = 0; n < 2; ++n) acc[a][b][m][n] = (f32x4){0.f, 0.f, 0.f, 0.f};
        cur = nxt; cA = nA; cB = nB; ++ui; csh = nsh; vbc[0] = vbn[0]; vbc[1] = vbn[1];
#pragma unroll
        for (int h = 0; h < 2; ++h)
#pragma unroll
            for (int i = 0; i < 2; ++i) oA[h][i] = nO[h][i];
        if (wr == 1) PG8_BAR;
    }
    PG8_WAIT_V(0);
    PG8_BAR;
#undef PG8_SA
#undef PG8_SB
#undef PG8_STAGE
#undef PG8_LDA
#undef PG8_LDB
#undef PG8_MMA
#undef PG8_WAIT_V
#undef PG8_WAIT_L
#undef PG8_BAR
#undef PG8_SCHED
}
}
using pg8::Unit;
typedef f32x4 Acc[2][2][4][2];

struct PlainSched {
    const char* A; const char* Bt; int nM, nN, K, G, c, rsh;
    __device__ __forceinline__ bool next(int i, Unit& u) const {
        int pm, pn; if (!pg8::static_order(i >> rsh, G, c, nM, nN, pm, pn)) return false;
        u.pm = pm; u.pn = pn; u.x0 = 0; u.x1 = 0; u.a = A + (size_t)pm * 256 * K * 2; u.b = Bt + (size_t)pn * 256 * K * 2; return true;
    }
    __device__ __forceinline__ unsigned a_off(const Unit&, int row, int K_) const { return (unsigned)(row * K_) * 2u; }
    __device__ __forceinline__ int b_shift(const Unit&) const { return 0; }
};
struct InProjSched {
    const char* NX; const char* Wt; int G, c, rsh;
    __device__ __forceinline__ bool next(int i, Unit& u) const {
        int pm, pn; if (!pg8::static_order(i >> rsh, G, c, T / 256, 23, pm, pn)) return false;
        u.pm = pm; u.pn = pn; u.x0 = 0; u.x1 = 0;
        const char* xa = NX + (size_t)pm * 256 * D * 2; const char* wb = Wt + (size_t)pn * 256 * D * 2;
        if (pn < 17) { u.a = xa; u.b = wb; } else { u.a = wb; u.b = xa;
            if (pn < 20) { const int sh = 2 * (pn - 17), j0 = (pm & 15) * 256, r = j0 >> (12 - sh), i0 = j0 & ((SEQ >> sh) - 1);
                u.x0 = sh; u.b = NX + ((size_t)(pm >> 4) * SEQ + ((size_t)i0 << sh) + r) * D * 2; } }
        return true;
    }
    __device__ __forceinline__ unsigned a_off(const Unit&, int row, int K_) const { return (unsigned)(row * K_) * 2u; }
    __device__ __forceinline__ int b_shift(const Unit& u) const { return u.x0; }
};
struct MoeSched {
    const char* A; const char* Bt; const int* list; const LAS int* ts; int nN, K, G, c, gather, rsh;
    __device__ __forceinline__ bool next(int i, Unit& u) const {
        const int MT = ts[32];
        int pm, pn; if (!pg8::static_order(i >> rsh, G, c, MT, nN, pm, pn)) return false;
        int e = 0;
#pragma unroll
        for (int s = 16; s >= 1; s >>= 1) { if (ts[e + s] <= pm) e += s; }
        e = __builtin_amdgcn_readfirstlane(e);
        u.pm = pm; u.pn = pn; u.x0 = e; u.x1 = __builtin_amdgcn_readfirstlane(pm - ts[e]);
        u.a = gather ? A : A + (size_t)pm * 256 * K * 2;
        u.b = Bt + ((size_t)e * nN + pn) * 256 * K * 2;
        return true;
    }
    __device__ __forceinline__ unsigned a_off(const Unit& u, int row, int K_) const {
        if (!gather) return (unsigned)(row * K_) * 2u;
        const int slot = u.x1 * 256 + row, cnt = ts[40 + u.x0];
        const int tok = slot < cnt ? list[u.x0 * 32768 + slot] : 0;
        return (unsigned)(tok * K_) * 2u;
    }
    __device__ __forceinline__ int b_shift(const Unit&) const { return 0; }
};

__device__ __forceinline__ void st8(bf16* p, f32x4 v0, f32x4 v1) { v4u w; w.x = cvt_pk_bf16(v0[0], v0[1]); w.y = cvt_pk_bf16(v0[2], v0[3]); w.z = cvt_pk_bf16(v1[0], v1[1]); w.w = cvt_pk_bf16(v1[2], v1[3]); *(v4u*)p = w; }
__device__ __forceinline__ v4u widen_pair(v2u a, v2u b) {
    auto rx = __builtin_amdgcn_permlane32_swap(a.x, b.x, false, false); auto ry = __builtin_amdgcn_permlane32_swap(a.y, b.y, false, false);
    v4u w; w.x = rx[0]; w.y = ry[0]; w.z = rx[1]; w.w = ry[1]; return w;
}
__device__ __forceinline__ void ld8(const bf16* p, f32x4& v0, f32x4& v1) { const v4u w = *(const v4u*)p; v0 = (f32x4){bflo(w.x), bfhi(w.x), bflo(w.y), bfhi(w.y)}; v1 = (f32x4){bflo(w.z), bfhi(w.z), bflo(w.w), bfhi(w.w)}; }

struct EpiInProj {
    static constexpr bool PERM = true; static constexpr int HOOK_T = -1;
    bf16 *Q, *Kb, *ZU, *GA, *GG, *VT, *ZVT;
    template <int ACT> __device__ __forceinline__ void std_store(const Acc& acc, bf16* base, int ldc, int colt, int pm, int wr, int wc, int fr, int fq) const {
        const int row0 = pm * 256 + wr * 64 + fr, col0 = colt + wc * 32 + 8 * fq;
#pragma unroll
        for (int ai = 0; ai < 2; ++ai)
#pragma unroll
            for (int m = 0; m < 4; ++m) { bf16* rowp = base + (size_t)(row0 + ai * 128 + m * 16) * ldc + col0;
#pragma unroll
                for (int bj = 0; bj < 2; ++bj) { f32x4 v0 = acc[ai][bj][m][0], v1 = acc[ai][bj][m][1];
                    if (ACT == 1) { v0 = v0 * QSCALE; v1 = v1 * QSCALE; }
                    if (ACT == 2) { v0 = gelu4(v0); v1 = gelu4(v1); }
                    if (ACT == 3) { v0 = sigm4(v0); v1 = sigm4(v1); }
                    st8(rowp + bj * 128, v0, v1); } }
    }
    template <int ACT> __device__ __forceinline__ void tile_store(const Acc& acc, bf16* base, int g, int pm, int wr, int wc, int fr, int fq) const {
        const int dsh = 2 * g, row0 = pm * 256 + wr * 64 + fr;
#pragma unroll
        for (int ai = 0; ai < 2; ++ai)
#pragma unroll
            for (int m = 0; m < 4; ++m) { const int t = row0 + ai * 128 + m * 16, bb = t >> 12, sq = t & (SEQ - 1), r = sq & ((1 << dsh) - 1), i = sq >> dsh, kb = i >> 5, key = i & 31;
#pragma unroll
                for (int bj = 0; bj < 2; ++bj) { const int cw = bj * 128 + wc * 32 + 8 * fq, hh = cw >> 6, dd = cw & 63;
                    f32x4 v0 = acc[ai][bj][m][0], v1 = acc[ai][bj][m][1];
                    if (ACT == 1) { v0 = v0 * QSCALE; v1 = v1 * QSCALE; }
                    st8(base + ((size_t)((bb * 3 + g) * 4 + hh) * 128 + (size_t)((r << (7 - dsh)) + kb)) * 2048 + key * 64 + dd, v0, v1); } }
    }
    __device__ __forceinline__ void operator()(const Acc& acc, const Unit& u, int wr, int wc, int fr, int fq) const {
        const int pn = u.pn, pm = u.pm;
        if (pn < 3) tile_store<1>(acc, Q, pn, pm, wr, wc, fr, fq);
        else if (pn < 6) tile_store<0>(acc, Kb, pn - 3, pm, wr, wc, fr, fq);
        else if (pn < 9) std_store<2>(acc, ZU, GM_W, (pn - 6) * 256, pm, wr, wc, fr, fq);
        else if (pn < 13) std_store<3>(acc, GA, D, (pn - 9) * 256, pm, wr, wc, fr, fq);
        else if (pn < 17) std_store<3>(acc, GG, D, (pn - 13) * 256, pm, wr, wc, fr, fq);
        else if (pn < 20) {
            const int g = pn - 17, sh = 2 * g, bb = pm >> 4, j0 = (pm & 15) * 256, r = j0 >> (12 - sh), i0 = j0 & ((SEQ >> sh) - 1), nKB = 128 >> sh;
#pragma unroll
            for (int ai = 0; ai < 2; ++ai)
#pragma unroll
                for (int m = 0; m < 4; ++m) { const int chl = ai * 128 + wr * 64 + m * 16 + fr, hh = chl >> 6, dd = chl & 63;
                    bf16* hb = VT + (size_t)((bb * 3 + g) * 4 + hh) * (128 * 64 * 32) + dd * 32;
#pragma unroll
                    for (int bj = 0; bj < 2; ++bj) { const int i = i0 + bj * 128 + wc * 32 + 8 * fq;
                        st8(hb + (size_t)(r * nKB + (i >> 5)) * 2048 + (i & 31), acc[ai][bj][m][0], acc[ai][bj][m][1]); } }
        } else {
            const int ch0 = (pn - 20) * 256 + wr * 64 + fr, tin = wc * 32 + 8 * fq;
#pragma unroll
            for (int ai = 0; ai < 2; ++ai)
#pragma unroll
                for (int m = 0; m < 4; ++m) { const int ch = ch0 + ai * 128 + m * 16;
#pragma unroll
                    for (int bj = 0; bj < 2; ++bj) st8(ZVT + ((size_t)(2 * pm + bj) * GM_W + ch) * 128 + tin, gelu4(acc[ai][bj][m][0]), gelu4(acc[ai][bj][m][1])); }
        }
    }
};
template <int MODE> struct EpiBf {
    static constexpr bool PERM = true; static constexpr int HOOK_T = -1;
    bf16* O; const bf16* G1; const bf16* Y0;
    __device__ __forceinline__ void operator()(const Acc& acc, const Unit& u, int wr, int wc, int fr, int fq) const {
        const int row0 = u.pm * 256 + wr * 64 + fr, col0 = u.pn * 256 + wc * 32 + 8 * fq;
#pragma unroll
        for (int ai = 0; ai < 2; ++ai) {
            v4u gw[4][2], yw[4][2];
            if (MODE >= 1) {
#pragma unroll
                for (int m = 0; m < 4; ++m)
#pragma unroll
                    for (int bj = 0; bj < 2; ++bj) { const size_t off = (size_t)(row0 + ai * 128 + m * 16) * D + col0 + bj * 128; gw[m][bj] = *(const v4u*)(G1 + off); if (MODE == 2) yw[m][bj] = *(const v4u*)(Y0 + off); }
                __builtin_amdgcn_sched_barrier(0);
            }
#pragma unroll
            for (int m = 0; m < 4; ++m)
#pragma unroll
                for (int bj = 0; bj < 2; ++bj) { const size_t off = (size_t)(row0 + ai * 128 + m * 16) * D + col0 + bj * 128; f32x4 v0 = acc[ai][bj][m][0], v1 = acc[ai][bj][m][1];
                    if (MODE >= 1) { const v4u w = gw[m][bj]; v0 = v0 * (f32x4){bflo(w.x), bfhi(w.x), bflo(w.y), bfhi(w.y)}; v1 = v1 * (f32x4){bflo(w.z), bfhi(w.z), bflo(w.w), bfhi(w.w)}; }
                    if (MODE == 2) { const v4u w = yw[m][bj]; v0 = v0 + (f32x4){bflo(w.x), bfhi(w.x), bflo(w.y), bfhi(w.y)}; v1 = v1 + (f32x4){bflo(w.z), bfhi(w.z), bflo(w.w), bfhi(w.w)}; }
                    st8(O + off, v0, v1); }
            if (MODE >= 1) __builtin_amdgcn_sched_barrier(0);
        }
    }
};
template <int MODE> struct EpiF32 {
    static constexpr bool PERM = false; static constexpr int HOOK_T = -1;
    float* H; const float* X; const bf16* PP;
    __device__ __forceinline__ void operator()(const Acc& acc, const Unit& u, int wr, int wc, int fr, int fq) const {
        const int row0 = u.pm * 256 + wr * 64 + fr, col0 = u.pn * 256 + wc * 32 + 4 * fq;
        const float* src = MODE == 0 ? X : H;
        constexpr int MB = MODE == 0 ? 4 : 2;
#pragma unroll
        for (int ai = 0; ai < 2; ++ai)
#pragma unroll
            for (int mb = 0; mb < 4; mb += MB) {
                f32x4 xv[MB][2][2]; v2u pw[MB][2][2];
#pragma unroll
                for (int m = 0; m < MB; ++m)
#pragma unroll
                    for (int bj = 0; bj < 2; ++bj)
#pragma unroll
                        for (int n = 0; n < 2; ++n) { const size_t o = (size_t)(row0 + ai * 128 + (mb + m) * 16) * D + col0 + bj * 128 + n * 16; xv[m][bj][n] = *(const f32x4*)(src + o); if (MODE == 1) pw[m][bj][n] = *(const v2u*)(PP + o); }
                __builtin_amdgcn_sched_barrier(0);
#pragma unroll
                for (int m = 0; m < MB; ++m)
#pragma unroll
                    for (int bj = 0; bj < 2; ++bj)
#pragma unroll
                        for (int n = 0; n < 2; ++n) { const size_t o = (size_t)(row0 + ai * 128 + (mb + m) * 16) * D + col0 + bj * 128 + n * 16; f32x4 v = acc[ai][bj][mb + m][n];
                            if (MODE == 0) v = v + xv[m][bj][n];
                            else { const v2u w = pw[m][bj][n]; v = xv[m][bj][n] + sigm4(v) * (f32x4){bflo(w.x), bfhi(w.x), bflo(w.y), bfhi(w.y)}; }
                            *(f32x4*)(H + o) = v; }
                __builtin_amdgcn_sched_barrier(0);
            }
    }
};
struct EpiH1 {
    static constexpr bool PERM = true; static constexpr int HOOK_T = -1;
    bf16* O; const float* X;
    __device__ __forceinline__ void operator()(const Acc& acc, const Unit& u, int wr, int wc, int fr, int fq) const {
        const int row0 = u.pm * 256 + wr * 64 + fr, col0 = u.pn * 256 + wc * 32 + 8 * fq;
#pragma unroll
        for (int ai = 0; ai < 2; ++ai) {
            f32x4 xv[4][2][2];
#pragma unroll
            for (int m = 0; m < 4; ++m)
#pragma unroll
                for (int bj = 0; bj < 2; ++bj) { const float* xp = X + (size_t)(row0 + ai * 128 + m * 16) * D + col0 + bj * 128; xv[m][bj][0] = *(const f32x4*)xp; xv[m][bj][1] = *(const f32x4*)(xp + 4); }
            __builtin_amdgcn_sched_barrier(0);
#pragma unroll
            for (int m = 0; m < 4; ++m)
#pragma unroll
                for (int bj = 0; bj < 2; ++bj) st8(O + (size_t)(row0 + ai * 128 + m * 16) * D + col0 + bj * 128, acc[ai][bj][m][0] + xv[m][bj][0], acc[ai][bj][m][1] + xv[m][bj][1]);
            __builtin_amdgcn_sched_barrier(0);
        }
    }
};
struct EpiMerge {
    static constexpr bool PERM = true; static constexpr int HOOK_T = 2;
    bf16* O; const bf16* GA; const bf16* GG;
    __device__ __forceinline__ void mid(Acc& acc, const Unit& u, int wr, int wc, int fr, int fq) const {
        int row0 = u.pm * 256 + wr * 64 + fr; const int col0 = u.pn * 256 + wc * 32 + 8 * fq;
        asm volatile("" : "+v"(row0));
#pragma unroll
        for (int ai = 0; ai < 2; ++ai)
#pragma unroll
            for (int mb = 0; mb < 4; mb += 2) {
                v4u aw[2][2], gw[2][2];
#pragma unroll
                for (int m = 0; m < 2; ++m)
#pragma unroll
                    for (int bj = 0; bj < 2; ++bj) { const size_t off = (size_t)(row0 + ai * 128 + (mb + m) * 16) * D + col0 + bj * 128; aw[m][bj] = *(const v4u*)(GA + off); gw[m][bj] = *(const v4u*)(GG + off); }
                __builtin_amdgcn_sched_barrier(0);
#pragma unroll
                for (int m = 0; m < 2; ++m)
#pragma unroll
                    for (int bj = 0; bj < 2; ++bj) { const v4u a = aw[m][bj], g = gw[m][bj];
                        acc[ai][bj][mb + m][0] = acc[ai][bj][mb + m][0] * (f32x4){bflo(a.x) * __builtin_amdgcn_rcpf(fmaxf(bflo(g.x), 1e-30f)), bfhi(a.x) * __builtin_amdgcn_rcpf(fmaxf(bfhi(g.x), 1e-30f)), bflo(a.y) * __builtin_amdgcn_rcpf(fmaxf(bflo(g.y), 1e-30f)), bfhi(a.y) * __builtin_amdgcn_rcpf(fmaxf(bfhi(g.y), 1e-30f))};
                        acc[ai][bj][mb + m][1] = acc[ai][bj][mb + m][1] * (f32x4){bflo(a.z) * __builtin_amdgcn_rcpf(fmaxf(bflo(g.z), 1e-30f)), bfhi(a.z) * __builtin_amdgcn_rcpf(fmaxf(bfhi(g.z), 1e-30f)), bflo(a.w) * __builtin_amdgcn_rcpf(fmaxf(bflo(g.w), 1e-30f)), bfhi(a.w) * __builtin_amdgcn_rcpf(fmaxf(bfhi(g.w), 1e-30f))}; }
                __builtin_amdgcn_sched_barrier(0);
            }
    }
    __device__ __forceinline__ void operator()(const Acc& acc, const Unit& u, int wr, int wc, int fr, int fq) const {
        const int row0 = u.pm * 256 + wr * 64 + fr, col0 = u.pn * 256 + wc * 32 + 8 * fq;
#pragma unroll
        for (int ai = 0; ai < 2; ++ai) {
            v4u gw[4][2];
#pragma unroll
            for (int m = 0; m < 4; ++m)
#pragma unroll
                for (int bj = 0; bj < 2; ++bj) gw[m][bj] = *(const v4u*)(GG + (size_t)(row0 + ai * 128 + m * 16) * D + col0 + bj * 128);
            __builtin_amdgcn_sched_barrier(0);
#pragma unroll
            for (int m = 0; m < 4; ++m)
#pragma unroll
                for (int bj = 0; bj < 2; ++bj) { const v4u g = gw[m][bj];
                    st8(O + (size_t)(row0 + ai * 128 + m * 16) * D + col0 + bj * 128, acc[ai][bj][m][0] * (f32x4){bflo(g.x), bfhi(g.x), bflo(g.y), bfhi(g.y)}, acc[ai][bj][m][1] * (f32x4){bflo(g.z), bfhi(g.z), bflo(g.w), bfhi(g.w)}); }
            __builtin_amdgcn_sched_barrier(0);
        }
    }
};
struct EpiPle {
    static constexpr bool PERM = true; static constexpr int HOOK_T = -1;
    bf16* O; const bf16* PP; const float* RS;
    __device__ __forceinline__ void operator()(const Acc& acc, const Unit& u, int wr, int wc, int fr, int fq) const {
        const int row0 = u.pm * 256 + wr * 64 + fr, col0 = u.pn * 256 + wc * 32 + 8 * fq;
#pragma unroll
        for (int ai = 0; ai < 2; ++ai) {
            v4u pw[4][2]; float rs[4];
#pragma unroll
            for (int m = 0; m < 4; ++m) rs[m] = RS[row0 + ai * 128 + m * 16];
#pragma unroll
            for (int m = 0; m < 4; ++m)
#pragma unroll
                for (int bj = 0; bj < 2; ++bj) pw[m][bj] = *(const v4u*)(PP + (size_t)(row0 + ai * 128 + m * 16) * D + col0 + bj * 128);
            __builtin_amdgcn_sched_barrier(0);
#pragma unroll
            for (int m = 0; m < 4; ++m)
#pragma unroll
                for (int bj = 0; bj < 2; ++bj) { const v4u w = pw[m][bj];
                    const f32x4 v0 = sigm4(acc[ai][bj][m][0] * rs[m]) * (f32x4){bflo(w.x), bfhi(w.x), bflo(w.y), bfhi(w.y)}, v1 = sigm4(acc[ai][bj][m][1] * rs[m]) * (f32x4){bflo(w.z), bfhi(w.z), bflo(w.w), bfhi(w.w)};
                    st8(O + (size_t)(row0 + ai * 128 + m * 16) * D + col0 + bj * 128, v0, v1); }
            __builtin_amdgcn_sched_barrier(0);
        }
    }
};
struct EpiMoeUp {
    static constexpr bool PERM = true; static constexpr int HOOK_T = -1;
    bf16* ACT; const float* bgu; const float* srstd; const LAS int* ts;
    __device__ __forceinline__ void operator()(const Acc& acc, const Unit& u, int wr, int wc, int fr, int fq) const {
        const int e = u.x0, cnt = ts[40 + e], srow0 = u.x1 * 256 + wr * 64 + fr;
        const int row0 = u.pm * 256 + wr * 64 + fr, hc = u.pn * 128 + wc * 32 + 8 * fq;
        const float* bg = bgu + (size_t)e * 2048 + hc;
        const f32x4 bg0 = *(const f32x4*)bg, bg1 = *(const f32x4*)(bg + 4), bl0 = *(const f32x4*)(bg + 1024), bl1 = *(const f32x4*)(bg + 1028);
        float rsv[2][4];
#pragma unroll
        for (int ai = 0; ai < 2; ++ai)
#pragma unroll
            for (int m = 0; m < 4; ++m) { const int slot = srow0 + ai * 128 + m * 16; rsv[ai][m] = slot < cnt ? srstd[e * 32768 + slot] : 0.f; }
        __builtin_amdgcn_sched_barrier(0);
#pragma unroll
        for (int ai = 0; ai < 2; ++ai)
#pragma unroll
            for (int m = 0; m < 4; ++m) { const float rs = rsv[ai][m];
                f32x4 o[2];
#pragma unroll
                for (int n = 0; n < 2; ++n) { const f32x4 gu = acc[ai][0][m][n] * rs + (n ? bg1 : bg0), li = acc[ai][1][m][n] * rs + (n ? bl1 : bl0);
#pragma unroll
                    for (int e2 = 0; e2 < 4; ++e2) { const float gl = fminf(gu[e2], 7.0f), ln = fminf(fmaxf(li[e2], -7.0f), 7.0f);
                        o[n][e2] = gl * __builtin_amdgcn_rcpf(1.0f + __builtin_amdgcn_exp2f(-1.702f * LOG2E * gl)) * (ln + 1.0f); } }
                st8(ACT + (size_t)(row0 + ai * 128 + m * 16) * D + hc, o[0], o[1]); }
    }
};
struct EpiMoeDown {
    static constexpr bool PERM = true; static constexpr int HOOK_T = -1;
    bf16* Y; const float* bd; const float* sgate; const LAS int* ts;
    __device__ __forceinline__ void operator()(const Acc& acc, const Unit& u, int wr, int wc, int fr, int fq) const {
        const int e = u.x0, cnt = ts[40 + e], srow0 = u.x1 * 256 + wr * 64 + fr, col0 = u.pn * 256 + wc * 32 + 8 * fq;
        const float* bp = bd + (size_t)e * D + col0;
        f32x4 bv[2][2];
#pragma unroll
        for (int bj = 0; bj < 2; ++bj) { bv[bj][0] = *(const f32x4*)(bp + bj * 128); bv[bj][1] = *(const f32x4*)(bp + bj * 128 + 4); }
        float gtv[2][4];
#pragma unroll
        for (int ai = 0; ai < 2; ++ai)
#pragma unroll
            for (int m = 0; m < 4; ++m) { const int slot = srow0 + ai * 128 + m * 16; gtv[ai][m] = slot < cnt ? sgate[e * 32768 + slot] : 0.f; }
        __builtin_amdgcn_sched_barrier(0);
#pragma unroll
        for (int ai = 0; ai < 2; ++ai)
#pragma unroll
            for (int m = 0; m < 4; ++m) { const float gt = gtv[ai][m];
                bf16* rowp = Y + (size_t)(u.pm * 256 + wr * 64 + fr + ai * 128 + m * 16) * D + col0;
#pragma unroll
                for (int bj = 0; bj < 2; ++bj) st8(rowp + bj * 128, (acc[ai][bj][m][0] + bv[bj][0]) * gt, (acc[ai][bj][m][1] + bv[bj][1]) * gt); }
    }
};

#define XB_TMO      128
#define XB_XCNT(j)  (256  + 64 * (j))
#define XB_XSUB(j)  (1280 + 64 * (j))
#define XB_XGEN(j)  (2304 + 64 * (j))
#define XB_TOP      3328
#define XB_TOPGEN   3392
#define XCD_BAR_WORDS 3456
#define XB_SPIN_CAP (1u << 18)
__device__ __forceinline__ unsigned xb_ld(unsigned* p)              { return __hip_atomic_load(p, __ATOMIC_RELAXED, __HIP_MEMORY_SCOPE_AGENT); }
__device__ __forceinline__ unsigned xb_add(unsigned* p, unsigned v) { return __hip_atomic_fetch_add(p, v, __ATOMIC_RELAXED, __HIP_MEMORY_SCOPE_AGENT); }
__device__ __forceinline__ unsigned xb_xcc_id() { return (unsigned)__builtin_amdgcn_s_getreg((3 << 11) | 20) & 0xFu; }
#define XB_SPIN(cond, bar) do { unsigned _sp = 0; while (cond) { __builtin_amdgcn_s_sleep(1); \
    if ((++_sp & 255u) == 0u) { if (xb_ld(&(bar)[XB_TMO])) break; if (_sp > XB_SPIN_CAP) { atomicAdd(&(bar)[XB_TMO], 1u); break; } } } } while (0)
struct XcdBarrier { unsigned* bar; unsigned x; volatile LAS unsigned* st; int wave; };
__device__ __forceinline__ XcdBarrier xcd_barrier_post(unsigned* bar, volatile LAS unsigned* st, int wave) {
    XcdBarrier b; b.bar = bar; b.x = xb_xcc_id(); b.st = st; b.wave = wave;
    if (tid_opaque(wave) == 0) (void)xb_add(&bar[XB_XCNT(b.x)], 1u);
    return b;
}
__device__ __forceinline__ void xcd_barrier_complete(unsigned* bar, unsigned x, unsigned& nloc, unsigned& nx) {
    const unsigned G = gridDim.x * gridDim.y * gridDim.z;
    unsigned sum, cnt, mine, sp = 0u;
    for (;;) {
        sum = 0u; cnt = 0u; mine = 0u;
#pragma unroll
        for (unsigned j = 0; j < 16; ++j) { const unsigned c = xb_ld(&bar[XB_XCNT(j)]); sum += c; cnt += (c > 0u) ? 1u : 0u; mine = (j == x) ? c : mine; }
        if (sum == G) break;
        __builtin_amdgcn_s_sleep(1);
        if ((++sp & 255u) == 0u) { if (xb_ld(&bar[XB_TMO])) break; if (sp > XB_SPIN_CAP) { atomicAdd(&bar[XB_TMO], 1u); break; } }
    }
    nloc = mine > 0u ? mine : 1u; nx = cnt > 0u ? cnt : 1u;
}
__device__ __forceinline__ void xcd_barrier(const XcdBarrier& b) {
    asm volatile("s_waitcnt vmcnt(0)" ::: "memory");
    __syncthreads();
    if (tid_opaque(b.wave) == 0) {
        unsigned* bar = b.bar;
        __builtin_amdgcn_s_waitcnt(0);
        unsigned nloc = b.st[0], nx = b.st[1];
        if (nloc == 0u) { xcd_barrier_complete(bar, b.x, nloc, nx); b.st[0] = nloc; b.st[1] = nx; }
        const unsigned old = xb_add(&bar[XB_XSUB(b.x)], 1u);
        const unsigned gen = old / nloc;
        if (old + 1u == (gen + 1u) * nloc) {
            __builtin_amdgcn_fence(__ATOMIC_RELEASE, "agent");
            asm volatile("s_waitcnt vmcnt(0)" ::: "memory");
            const unsigned og = xb_add(&bar[XB_TOP], 1u);
            const unsigned tg = og / nx;
            if (og + 1u == (tg + 1u) * nx) xb_add(&bar[XB_TOPGEN], 1u);
            else XB_SPIN(xb_ld(&bar[XB_TOPGEN]) == tg, bar);
            __builtin_amdgcn_fence(__ATOMIC_ACQUIRE, "agent");
            xb_add(&bar[XB_XGEN(b.x)], 1u);
            asm volatile("s_waitcnt vmcnt(0)" ::: "memory");
        } else {
            XB_SPIN(xb_ld(&bar[XB_XGEN(b.x)]) == gen, bar);
            __builtin_amdgcn_fence(__ATOMIC_ACQUIRE, "agent");
            asm volatile("s_waitcnt vmcnt(0)" ::: "memory");
        }
    }
    __syncthreads();
}

struct Args { const float* in[23]; float* out; unsigned char* ws; int ph_lo, ph_hi; };
struct Frame {
    LAS unsigned char* lds; int wave, vcu, G;
};
#define LDS_WAIT() asm volatile("s_waitcnt lgkmcnt(0)" ::: "memory")

__device__ __forceinline__ int t5_bucket(int n) {
    if (n < 16) return n;
    const int th[15] = {22, 30, 40, 54, 73, 99, 134, 182, 246, 332, 450, 609, 825, 1117, 1513};
    int b = 16;
#pragma unroll
    for (int k = 0; k < 15; ++k) b += (n >= th[k]) ? 1 : 0;
    return b;
}

__device__ __forceinline__ void transpose_item(const float* W, int K, int N, bf16* WT, int drow0, LAS float* scr, int k0, int n0, int lane, int kdst = 0) {
    const int q = lane & 15, kr = lane >> 4;
    f32x4 v[8];
#pragma unroll
    for (int i = 0; i < 8; ++i) v[i] = *(const f32x4*)(W + (size_t)(k0 + 4 * i + kr) * N + n0 + 4 * q);
#pragma unroll
    for (int i = 0; i < 8; ++i) { LAS float* d = scr + (4 * q) * 33 + 4 * i + kr; d[0] = v[i].x; d[33] = v[i].y; d[66] = v[i].z; d[99] = v[i].w; }
    LDS_WAIT(); asm volatile("" ::: "memory");
    const int c4 = lane & 3, nr = lane >> 2;
#pragma unroll
    for (int j = 0; j < 4; ++j) { const int n = nr + 16 * j; const LAS float* sp = scr + n * 33 + 8 * c4;
        v4u o; o.x = pk2(sp[0], sp[1]); o.y = pk2(sp[2], sp[3]); o.z = pk2(sp[4], sp[5]); o.w = pk2(sp[6], sp[7]);
        *(v4u*)(WT + (size_t)(drow0 + n) * K + kdst + k0 + 8 * c4) = o; }
    LDS_WAIT(); asm volatile("" ::: "memory");
}
constexpr int BG_GU = 32 * 32 * 32, BG_DN = 32 * 32 * 16, BG_N = BG_GU + BG_DN;
constexpr int BG_P1 = 32768;
struct BgItem { const float* W; bf16* WT; const float* sc; int N, k0, n0, drow0, pitch, kdst; };
constexpr int BG_X0 = BG_N, BG_X1 = BG_X0 + 8 * 16, BG_X2 = BG_X1 + 24 * 16, BG_X3 = BG_X2 + 32 * 16, BG_X4 = BG_X3 + 32 * 16, BG_ALL = BG_X4 + 8 * 16;
__device__ __forceinline__ BgItem bg_decode(const Args& A, int r) {
    BgItem it; it.pitch = D; it.kdst = 0; it.sc = nullptr;
    if (r < BG_GU) { const int e = r >> 10, q = r & 1023, kb = q >> 5, nb = q & 31, n0 = nb * 64;
        it.W = A.in[15] + (size_t)e * D * 2048; it.WT = (bf16*)(A.ws + WS_WGU) + (size_t)e * 2048 * D; it.N = 2048; it.sc = A.in[12]; it.k0 = kb * 32; it.n0 = n0;
        it.drow0 = n0 < 1024 ? 256 * (n0 >> 7) + (n0 & 127) : 256 * ((n0 - 1024) >> 7) + 128 + (n0 & 127);
    } else if (r < BG_N) { r -= BG_GU; const int e = r >> 9, q = r & 511, kb = q >> 4, nb = q & 15;
        it.W = A.in[17] + (size_t)e * D * D; it.WT = (bf16*)(A.ws + WS_WD) + (size_t)e * D * D; it.N = D; it.k0 = kb * 32; it.n0 = nb * 64; it.drow0 = nb * 64;
    } else { int src; bf16* dst;
        if (r < BG_X1) { r -= BG_X0; src = 5; dst = (bf16*)(A.ws + WS_WCAT); }
        else if (r < BG_X2) { r -= BG_X1; src = 10; dst = (bf16*)(A.ws + WS_WCAT); it.kdst = 256; }
        else if (r < BG_X3) { r -= BG_X2; src = 11; dst = (bf16*)(A.ws + WS_WOUT); }
        else if (r < BG_X4) { r -= BG_X3; src = 20; dst = (bf16*)(A.ws + WS_WPG); }
        else { r -= BG_X4; src = 21; dst = (bf16*)(A.ws + WS_WPP); it.pitch = PLE; }
        it.W = src == 5 ? A.in[5] : src == 10 ? A.in[10] : src == 11 ? A.in[11] : src == 20 ? A.in[20] : A.in[21];
        if (src == 20) it.sc = A.in[19];
        it.WT = dst; it.N = D; it.k0 = (r >> 4) * 32; it.n0 = (r & 15) * 64; it.drow0 = it.n0; }
    return it;
}
struct BgConv {
    int cur, next, stride, end; f32x4 v[8]; float gs[8];
    __device__ __forceinline__ void init(int first, int stride_, int end_ = BG_ALL) { cur = -1; next = first; stride = stride_; end = end_; }
    __device__ __forceinline__ void issue(const Args& A, int lane) {
        if (next < end) { const BgItem it = bg_decode(A, next); const int q = lane & 15, kr = lane >> 4;
#pragma unroll
            for (int i = 0; i < 8; ++i) v[i] = *(const f32x4*)(it.W + (size_t)(it.k0 + 4 * i + kr) * it.N + it.n0 + 4 * q);
            if (it.sc) {
#pragma unroll
                for (int i = 0; i < 8; ++i) gs[i] = it.sc[it.k0 + 4 * i + kr]; } else {
#pragma unroll
                for (int i = 0; i < 8; ++i) gs[i] = 1.0f; }
            cur = next; next += stride; } else cur = -1;
    }
    __device__ __forceinline__ void finish(const Args& A, LAS float* scr, int lane) {
        if (cur >= 0) { const BgItem it = bg_decode(A, cur); const int q = lane & 15, kr = lane >> 4;
#pragma unroll
            for (int i = 0; i < 8; ++i) { LAS float* d = scr + (4 * q) * 33 + 4 * i + kr; const float g = gs[i]; d[0] = v[i].x * g; d[33] = v[i].y * g; d[66] = v[i].z * g; d[99] = v[i].w * g; }
            LDS_WAIT(); asm volatile("" ::: "memory");
            const int c4 = lane & 3, nr = lane >> 2;
#pragma unroll
            for (int j = 0; j < 4; ++j) { const int n = nr + 16 * j; const LAS float* sp = scr + n * 33 + 8 * c4;
                v4u o; o.x = pk2(sp[0], sp[1]); o.y = pk2(sp[2], sp[3]); o.z = pk2(sp[4], sp[5]); o.w = pk2(sp[6], sp[7]);
                *(v4u*)(it.WT + (size_t)(it.drow0 + n) * it.pitch + it.kdst + it.k0 + 8 * c4) = o; }
            LDS_WAIT(); asm volatile("" ::: "memory");
            cur = -1; }
    }
};
__device__ __forceinline__ void convert_queue(const Frame& F, const Args& A, unsigned* ctr, int lo, int hi) {
    const int tidx_ = tid_opaque(F.wave);
    LAS float* scr = (LAS float*)(F.lds + F.wave * 8448);
    LAS int* qs = (LAS int*)(F.lds + RING_BYTES + 512);
    const int lane = tidx_ & 63;
    BgConv c0, c1;
    for (;;) {
        __syncthreads();
        if (tidx_ == 0) *qs = (int)__hip_atomic_fetch_add(ctr, 64u, __ATOMIC_RELAXED, __HIP_MEMORY_SCOPE_AGENT);
        __syncthreads();
        const int base = __builtin_amdgcn_readfirstlane(*qs) + lo + F.wave * 8;
        if (base - F.wave * 8 >= hi) break;
        c0.init(base, 2, base + 8 < hi ? base + 8 : hi); c1.init(base + 1, 2, base + 8 < hi ? base + 8 : hi);
        c0.issue(A, lane); c1.issue(A, lane);
#pragma unroll 1
        for (int k = 0; k < 4; ++k) { c0.finish(A, scr, lane); c0.issue(A, lane); c1.finish(A, scr, lane); c1.issue(A, lane); }
    }
}
__device__ __forceinline__ void convert_p_queue(const Frame& F, const Args& A, unsigned* ctr) {
    const int tidx_ = tid_opaque(F.wave);
    const int lane = tidx_ & 63; const float* p = A.in[1]; bf16* pb = (bf16*)(A.ws + WS_PB);
    LAS int* qs = (LAS int*)(F.lds + RING_BYTES + 512);
    for (;;) {
        __syncthreads();
        if (tidx_ == 0) *qs = (int)__hip_atomic_fetch_add(ctr, 8u, __ATOMIC_RELAXED, __HIP_MEMORY_SCOPE_AGENT);
        __syncthreads();
        const int ck0 = __builtin_amdgcn_readfirstlane(*qs);
        if (ck0 >= (T * PLE) / 8192) break;
        const size_t base = (size_t)(ck0 + F.wave) * 8192 + 8 * lane;
#pragma unroll 4
        for (int i = 0; i < 16; ++i) { const f32x4 a = *(const f32x4*)(p + base + 512 * i), b = *(const f32x4*)(p + base + 512 * i + 4); st8(pb + base + 512 * i, a, b); }
    }
}
constexpr int BG_SCR_OFF = 45056;
__device__ __forceinline__ int win_dest(int n0) {
    if (n0 < 1536) return n0;
    if (n0 < 2304) return 4352 + (n0 - 1536);
    if (n0 < 3072) return 1536 + (n0 - 2304);
    if (n0 < 3840) return 5120 + (n0 - 3072);
    return 2304 + (n0 - 3840);
}
template <int NR> __device__ __forceinline__ void rms_rows_to_bf16(const float* xrow, const float* gain, bf16* orow, int lane) {
    f32x4 v[NR][4]; float s[NR];
#pragma unroll
    for (int r = 0; r < NR; ++r)
#pragma unroll
        for (int j = 0; j < 4; ++j) v[r][j] = ((const f32x4*)(xrow + (size_t)r * D) + lane)[64 * j];
    f32x4 g[4];
#pragma unroll
    for (int j = 0; j < 4; ++j) g[j] = ((const f32x4*)gain + lane)[64 * j];
#pragma unroll
    for (int r = 0; r < NR; ++r) { float a = 0.f;
#pragma unroll
        for (int j = 0; j < 4; ++j) a += (v[r][j].x * v[r][j].x + v[r][j].y * v[r][j].y) + (v[r][j].z * v[r][j].z + v[r][j].w * v[r][j].w);
        s[r] = a; }
#pragma unroll
    for (int o = 1; o < 64; o <<= 1)
#pragma unroll
        for (int r = 0; r < NR; ++r) s[r] += __shfl_xor(s[r], o);
#pragma unroll
    for (int r = 0; r < NR; ++r) { const float rstd = 1.0f / sqrtf(s[r] * (1.f / D) + EPS);
        unsigned long long* o8 = (unsigned long long*)(orow + (size_t)r * D) + lane;
#pragma unroll
        for (int j = 0; j < 4; ++j) o8[64 * j] = (unsigned long long)pk2(v[r][j].x * rstd * g[j].x, v[r][j].y * rstd * g[j].y) | ((unsigned long long)pk2(v[r][j].z * rstd * g[j].z, v[r][j].w * rstd * g[j].w) << 32); }
}
__device__ __forceinline__ void p0_prologue(const Frame& F, const Args& A) {
    const int tidx_ = tid_opaque(F.wave);
    LAS float* scr = (LAS float*)(F.lds + F.wave * 16384);
    const int gw = F.vcu * 8 + F.wave, NGW = F.G * 8;
    unsigned char* ws = A.ws;
    for (int m = gw * 4; m < T; m += NGW * 4) rms_rows_to_bf16<4>(A.in[0] + (size_t)m * D, A.in[2], (bf16*)(ws + WS_NX) + (size_t)m * D, (tidx_ & 63));
    { const float* wsp = A.in[8]; bf16* o = (bf16*)(ws + WS_WSP);
      for (int i = (blockIdx.x * 512 + tidx_) * 4; i < 12 * 128 * 128; i += F.G * 512 * 4) { const int col = i & 127, row = (i >> 7) & 127; const f32x4 a = *(const f32x4*)(wsp + i);
          v2u w; w.x = pk2(col <= row ? a.x : 0.f, col + 1 <= row ? a.y : 0.f); w.y = pk2(col + 2 <= row ? a.z : 0.f, col + 3 <= row ? a.w : 0.f); *(v2u*)(o + i) = w; } }
    { const float* wrt = A.in[13]; bf16* wh = (bf16*)(ws + WS_WRH); bf16* wl = (bf16*)(ws + WS_WRL);
      for (int i = blockIdx.x * 512 + tidx_; i < 32 * 1024; i += F.G * 512) { const int e = i >> 10, k = i & 1023; const float w = wrt[k * 32 + e]; const unsigned h = f2bf(w); wh[i] = (bf16)h; wl[i] = (bf16)f2bf(w - bflo(h)); } }
    constexpr int I_IN = 32 * 92;
    for (int it = gw; it < I_IN; it += NGW) { const int kb = it / 92, nb = it % 92; transpose_item(A.in[3], D, IN_W, (bf16*)(ws + WS_WIN), win_dest(nb * 64), scr, kb * 32, nb * 64, (tidx_ & 63)); }
}

__device__ __forceinline__ int crow(int r, int hi) { return (r & 3) + 8 * (r >> 2) + 4 * hi; }
struct AtU { int b, g, h, r, qb8, nqb; };
__device__ __forceinline__ AtU at_decode(int pr) { AtU u; const int slot = pr & 15; u.h = (pr >> 4) & 3; const int bgi = pr >> 6; u.g = bgi % 3; u.b = bgi / 3; u.nqb = 128 >> (2 * u.g);
    u.r = slot / (u.nqb >> 3); u.qb8 = slot % (u.nqb >> 3); return u; }
__device__ __forceinline__ void at_load(const AtU& u, const bf16* QT, const bf16* KT, const bf16* VT, int w, int r32, int hi, int q8, int t8, v4u (&stg)[12], bf16x8 (&qf)[4]) {
    const size_t tb0 = (size_t)((u.b * 3 + u.g) * 4 + u.h) * 128 + (size_t)(u.r * u.nqb);
    const bf16* qt = QT + (tb0 + u.qb8 * 8 + w) * 2048 + r32 * 64 + 8 * hi;
#pragma unroll
    for (int s = 0; s < 4; ++s) qf[s] = *(const bf16x8*)(qt + 16 * s);
#pragma unroll
    for (int i = 0; i < 12; ++i) { const int kv = i >= 6 ? 1 : 0, j = 2 * (i - 6 * kv) + t8; int kb = u.qb8 * 8 - 4 + j; kb = kb < 0 ? 0 : kb;
        stg[i] = *(const v4u*)((kv ? VT : KT) + (tb0 + kb) * 2048 + q8 * 8); }
}
__device__ __forceinline__ void attn_phase(const Frame& F, const Args& A) {
    const int tidx_ = tid_opaque(F.wave);
    LAS float* tb = (LAS float*)(F.lds + RING_BYTES + 2048);
    const float* rel_bias = A.in[4];
    for (int i = tidx_; i < 12 * 192; i += 512) { const int gh = i / 192, dist = i % 192 - 31, g = gh >> 2; const int dil = g == 0 ? 1 : (g == 1 ? 4 : 16);
        tb[i] = (dist >= 0 && dist <= 128) ? rel_bias[t5_bucket(dist * dil) * 12 + gh] * LOG2E : -INFINITY; }
    __syncthreads();
    const bf16* QT = (const bf16*)(A.ws + WS_Q); const bf16* KT = (const bf16*)(A.ws + WS_K); const bf16* VT = (const bf16*)(A.ws + WS_VT);
    bf16* OG = (bf16*)(A.ws + WS_OG); float* LSE = (float*)(A.ws + WS_LSE);
    const int lane = (tidx_ & 63), r32 = lane & 31, hi = lane >> 5, w = F.wave;
    const int q8 = tidx_ & 255, t8 = tidx_ >> 8;
    const int NU = NB * 3 * 4 * 16;
    v4u stg[12]; bf16x8 qf[4];
    if (F.vcu < NU) at_load(at_decode(F.vcu), QT, KT, VT, w, r32, hi, q8, t8, stg, qf);
    for (int pr = F.vcu; pr < NU; pr += F.G) {
        const AtU u = at_decode(pr);
        const int dsh = 2 * u.g, dil = 1 << dsh, g = u.g, h = u.h, b = u.b, r = u.r;
        const int qb = u.qb8 * 8 + w, i0 = qb * 32;
        __syncthreads();
        { const int keyk = q8 >> 3, posk = keyk * 8 + ((q8 & 7) ^ ((keyk >> 1) & 7)), dv = q8 >> 2, posv = dv * 4 + ((q8 & 3) ^ ((dv >> 2) & 3));
#pragma unroll
          for (int i = 0; i < 12; ++i) { const int kv = i >= 6 ? 1 : 0, j = 2 * (i - 6 * kv) + t8;
              *(LAS v4u*)(F.lds + kv * 49152 + j * 4096 + (kv ? posv : posk) * 16) = stg[i]; } }
        bf16x8 qc[4];
#pragma unroll
        for (int s = 0; s < 4; ++s) qc[s] = qf[s];
        __syncthreads();
        if (pr + F.G < NU) at_load(at_decode(pr + F.G), QT, KT, VT, w, r32, hi, q8, t8, stg, qf);
        __builtin_amdgcn_sched_barrier(0);
        const LAS unsigned char* kbase = F.lds + w * 4096 + (r32 * 8) * 16;
        const int kx = (r32 >> 1) & 7;
        f32x16 st[5];
#pragma unroll
        for (int kt = 0; kt < 5; ++kt) {
            f32x16 a = {};
#pragma unroll
            for (int s = 0; s < 4; ++s) { const bf16x8 kf = *(const LAS bf16x8*)(kbase + kt * 4096 + (((2 * s + hi) ^ kx) << 4)); a = __builtin_amdgcn_mfma_f32_32x32x16_bf16(kf, qc[s], a, 0, 0, 0); }
            st[kt] = a;
        }
        const LAS float* tbh = tb + (g * 4 + h) * 192;
        float mx = -INFINITY;
#pragma unroll
        for (int kt = 0; kt < 5; ++kt)
#pragma unroll
            for (int i = 0; i < 16; ++i) { const int kr = crow(i, hi), krel = -128 + 32 * kt + kr; const int dist = r32 - krel;
                float v = st[kt][i] + tbh[dist + 31]; v = (i0 + krel >= 0) ? v : -INFINITY; st[kt][i] = v; mx = fmaxf(mx, v); }
        mx = fmaxf(mx, __shfl_xor(mx, 32));
        float l = 0.f;
#pragma unroll
        for (int kt = 0; kt < 5; ++kt)
#pragma unroll
            for (int i = 0; i < 16; ++i) { const float p = __builtin_amdgcn_exp2f(st[kt][i] - mx); st[kt][i] = p; l += p; }
        l += __shfl_xor(l, 32);
        const LAS unsigned char* vbase = F.lds + 49152 + w * 4096;
        f32x16 o[2] = {};
#pragma unroll
        for (int kt = 0; kt < 5; ++kt)
#pragma unroll
            for (int s2 = 0; s2 < 2; ++s2) {
                v4u pw; pw.x = cvt_pk_bf16(st[kt][8 * s2 + 0], st[kt][8 * s2 + 1]); pw.y = cvt_pk_bf16(st[kt][8 * s2 + 2], st[kt][8 * s2 + 3]);
                pw.z = cvt_pk_bf16(st[kt][8 * s2 + 4], st[kt][8 * s2 + 5]); pw.w = cvt_pk_bf16(st[kt][8 * s2 + 6], st[kt][8 * s2 + 7]);
                const bf16x8 pf = __builtin_bit_cast(bf16x8, pw);
#pragma unroll
                for (int dt = 0; dt < 2; ++dt) { const int dd = 32 * dt + r32;
                    const LAS unsigned char* vr = vbase + kt * 4096 + dd * 64 + 8 * hi; const int vx = (dd >> 2) & 3;
                    const v2u p1 = *(const LAS v2u*)(vr + (((2 * s2) ^ vx) << 4)), p2 = *(const LAS v2u*)(vr + (((2 * s2 + 1) ^ vx) << 4));
                    v4u vw; vw.x = p1.x; vw.y = p1.y; vw.z = p2.x; vw.w = p2.y;
                    o[dt] = __builtin_amdgcn_mfma_f32_32x32x16_bf16(__builtin_bit_cast(bf16x8, vw), pf, o[dt], 0, 0, 0); }
            }
        const float rl = 1.0f / l;
        const size_t qrow = (size_t)b * SEQ + (size_t)(i0 + r32) * dil + r;
        bf16* op = OG + ((size_t)g * T + qrow) * 256 + h * 64;
#pragma unroll
        for (int dt = 0; dt < 2; ++dt)
#pragma unroll
            for (int gp = 0; gp < 2; ++gp) { v2u wa, wb;
                wa.x = cvt_pk_bf16(o[dt][8 * gp] * rl, o[dt][8 * gp + 1] * rl); wa.y = cvt_pk_bf16(o[dt][8 * gp + 2] * rl, o[dt][8 * gp + 3] * rl);
                wb.x = cvt_pk_bf16(o[dt][8 * gp + 4] * rl, o[dt][8 * gp + 5] * rl); wb.y = cvt_pk_bf16(o[dt][8 * gp + 6] * rl, o[dt][8 * gp + 7] * rl);
                *(v4u*)(op + 32 * dt + 16 * gp + 8 * hi) = widen_pair(wa, wb); }
        if (hi == 0) LSE[((size_t)g * T + qrow) * 4 + h] = (mx + __builtin_amdgcn_logf(l)) * LN2;
    }
    __syncthreads();
}

__device__ __forceinline__ void spatial_phase(const Frame& F, const Args& A) {
    const int tidx_ = tid_opaque(F.wave);
    const bf16* ZVT = (const bf16*)(A.ws + WS_ZVT); const bf16* ZU = (const bf16*)(A.ws + WS_ZU); const bf16* WSP = (const bf16*)(A.ws + WS_WSP);
    bf16* Gout = (bf16*)(A.ws + WS_AG) + 256;
    const float* lng = A.in[6]; const float* lnb = A.in[7]; const float* bsp = A.in[9];
    LAS float* red = (LAS float*)(F.lds + 10240);
    LAS float* stt = (LAS float*)(F.lds + 43008);
    LAS unsigned char* vn = F.lds + 49152;
    int lane = (tidx_ & 63); asm volatile("" : "+v"(lane));
    const int r32 = lane & 31, hi = lane >> 5, w = F.wave;
    const int dr = 8 * w + (lane >> 3), ck = lane & 7;
    for (int c = F.vcu; c < T / 128; c += F.G) {
        v4u zr[2];
#pragma unroll
        for (int p = 0; p < 2; ++p) zr[p] = *(const v4u*)(ZVT + ((size_t)c * GM_W + dr) * 128 + 8 * (ck + 8 * p));
        {
            const int tg = tidx_ & 15, rg = tidx_ >> 4; float sm[8], q[8];
#pragma unroll
            for (int e = 0; e < 8; ++e) { sm[e] = 0.f; q[e] = 0.f; }
#pragma unroll 4
            for (int ch = rg; ch < GM_W; ch += 32) { const v4u wv = *(const v4u*)(ZVT + ((size_t)c * GM_W + ch) * 128 + 8 * tg);
                const float x[8] = {bflo(wv.x), bfhi(wv.x), bflo(wv.y), bfhi(wv.y), bflo(wv.z), bfhi(wv.z), bflo(wv.w), bfhi(wv.w)};
#pragma unroll
                for (int e = 0; e < 8; ++e) { sm[e] += x[e]; q[e] += x[e] * x[e]; } }
#pragma unroll
            for (int e = 0; e < 8; ++e) { red[(rg * 128 + 8 * tg + e) * 2] = sm[e]; red[(rg * 128 + 8 * tg + e) * 2 + 1] = q[e]; }
            __syncthreads();
            if (tidx_ < 128) { float ss = 0.f, qq = 0.f;
                for (int k = 0; k < 32; ++k) { ss += red[(k * 128 + tidx_) * 2]; qq += red[(k * 128 + tidx_) * 2 + 1]; }
                const float mu = ss * (1.f / GM_W), var = fmaxf(qq * (1.f / GM_W) - mu * mu, 0.f);
                stt[tidx_ * 2] = mu; stt[tidx_ * 2 + 1] = 1.0f / sqrtf(var + EPS); }
            __syncthreads();
        }
#define SP_GROUP(GI, ZR_CUR, ZU_CUR, ZR_NXT, ZU_NXT) do { \
            const int gi_ = (GI); const int dt = w & 1, it = ((w >> 1) + gi_) & 3, ti = 32 * it + r32;       \
              \
            bf16x8 bfr[8]; \
            { const bf16* wp = WSP + ((size_t)gi_ * 128 + ti) * 128 + 8 * hi; \
              _Pragma("unroll") for (int s = 0; s < 8; ++s) bfr[s] = *(const bf16x8*)(wp + 16 * s); } \
            const float bsv = bsp[gi_ * 128 + ti], gch = lng[gi_ * 64 + dr], bch = lnb[gi_ * 64 + dr]; \
            __builtin_amdgcn_sched_barrier(0); \
              \
            LAS unsigned char* tile = vn + (gi_ & 1) * 16384; \
            _Pragma("unroll") for (int p = 0; p < 2; ++p) { const int jb = 8 * (ck + 8 * p); const v4u z = ZR_CUR[p]; \
                float x[8] = {bflo(z.x), bfhi(z.x), bflo(z.y), bfhi(z.y), bflo(z.z), bfhi(z.z), bflo(z.w), bfhi(z.w)}; \
                _Pragma("unroll") for (int e = 0; e < 8; ++e) x[e] = (x[e] - stt[(jb + e) * 2]) * stt[(jb + e) * 2 + 1] * gch + bch; \
                v4u aw; aw.x = cvt_pk_bf16(x[0], x[1]); aw.y = cvt_pk_bf16(x[2], x[3]); aw.z = cvt_pk_bf16(x[4], x[5]); aw.w = cvt_pk_bf16(x[6], x[7]); \
                *(LAS v4u*)(tile + dr * 256 + (((ck + 8 * p) ^ (dr & 15)) << 4)) = aw; } \
            { const int gn = gi_ + 1 < 12 ? gi_ + 1 : 11;        \
              _Pragma("unroll") for (int p = 0; p < 2; ++p) ZR_NXT[p] = *(const v4u*)(ZVT + ((size_t)c * GM_W + gn * 64 + dr) * 128 + 8 * (ck + 8 * p)); \
              const int itn = ((w >> 1) + gn) & 3; const size_t orow = ((size_t)c * 128 + 32 * itn + r32) * GM_W + gn * 64 + 32 * dt + 4 * hi; \
              _Pragma("unroll") for (int gq = 0; gq < 4; ++gq) ZU_NXT[gq] = *(const v2u*)(ZU + orow + 8 * gq); } \
            __syncthreads();                                    \
            f32x16 acc = {}; \
            { const int dd = 32 * dt + r32; const LAS unsigned char* ar = tile + dd * 256; \
              _Pragma("unroll") for (int s = 0; s < 8; ++s) { const bf16x8 af = *(const LAS bf16x8*)(ar + (((2 * s + hi) ^ (dd & 15)) << 4)); acc = __builtin_amdgcn_mfma_f32_32x32x16_bf16(af, bfr[s], acc, 0, 0, 0); } } \
              \
            const size_t groww = ((size_t)c * 128 + ti) * D + gi_ * 64 + 32 * dt + 8 * hi; \
            _Pragma("unroll") for (int gp = 0; gp < 2; ++gp) { v2u oo[2]; \
                _Pragma("unroll") for (int q2 = 0; q2 < 2; ++q2) { const int gq = 2 * gp + q2; const v2u uw = ZU_CUR[gq]; \
                    oo[q2].x = cvt_pk_bf16(bflo(uw.x) * (acc[4 * gq] + bsv), bfhi(uw.x) * (acc[4 * gq + 1] + bsv)); oo[q2].y = cvt_pk_bf16(bflo(uw.y) * (acc[4 * gq + 2] + bsv), bfhi(uw.y) * (acc[4 * gq + 3] + bsv)); } \
                *(v4u*)(Gout + groww + 16 * gp) = widen_pair(oo[0], oo[1]); } \
        } while (0)
        v4u zrb[2]; v2u zua[4], zub[4];
        { const int it0 = (w >> 1) & 3; const size_t orow = ((size_t)c * 128 + 32 * it0 + r32) * GM_W + 32 * (w & 1) + 4 * hi;
#pragma unroll
          for (int gq = 0; gq < 4; ++gq) zua[gq] = *(const v2u*)(ZU + orow + 8 * gq); }
#pragma unroll 1
        for (int gi = 0; gi < 12; gi += 2) {
            SP_GROUP(gi, zr, zua, zrb, zub);
            SP_GROUP(gi + 1, zrb, zub, zr, zua);
        }
#undef SP_GROUP
        __syncthreads();
    }
}

__device__ __forceinline__ void merge_phase(const Frame& F, const Args& A) {
    const int tidx_ = tid_opaque(F.wave);
    const bf16* OG = (const bf16*)(A.ws + WS_OG); const float* LSE = (const float*)(A.ws + WS_LSE); bf16* ATT = (bf16*)(A.ws + WS_AG);
    const int gw = F.vcu * 8 + F.wave, NGW = F.G * 8, lane = (tidx_ & 63), h = lane >> 4;
    for (int t = gw; t < T; t += NGW) {
        const float l0 = LSE[(size_t)t * 4 + h], l1 = LSE[((size_t)T + t) * 4 + h], l2 = LSE[((size_t)2 * T + t) * 4 + h];
        const float m = fmaxf(l0, fmaxf(l1, l2)); float a0 = __expf(l0 - m), a1 = __expf(l1 - m), a2 = __expf(l2 - m); const float inv = 1.0f / (a0 + a1 + a2); a0 *= inv; a1 *= inv; a2 *= inv;
        const v2u w0 = *(const v2u*)(OG + (size_t)t * 256 + 4 * lane), w1 = *(const v2u*)(OG + ((size_t)T + t) * 256 + 4 * lane), w2 = *(const v2u*)(OG + ((size_t)2 * T + t) * 256 + 4 * lane);
        v2u o; o.x = pk2(a0 * bflo(w0.x) + a1 * bflo(w1.x) + a2 * bflo(w2.x), a0 * bfhi(w0.x) + a1 * bfhi(w1.x) + a2 * bfhi(w2.x));
        o.y = pk2(a0 * bflo(w0.y) + a1 * bflo(w1.y) + a2 * bflo(w2.y), a0 * bfhi(w0.y) + a1 * bfhi(w1.y) + a2 * bfhi(w2.y));
        *(v2u*)(ATT + (size_t)t * D + 4 * lane) = o;
    }
}

__device__ __forceinline__ void router_phase(const Frame& F, const Args& A) {
    const int tidx_ = tid_opaque(F.wave);
    LAS unsigned char* L = F.lds;
    LAS int* hist = (LAS int*)(F.lds + RING_BYTES + 2048);
    LAS int* basee = hist + 32;
    LAS int* rec_e = hist + 64;
    LAS int* rec_r = rec_e + 512;
    LAS float* rec_g = (LAS float*)(rec_r + 512);
    LAS float* rec_s = rec_g + 512;
    LAS float* gl = (LAS float*)(F.lds + RING_BYTES + 9216);
    const float* brt = A.in[14]; const float* gmoe = A.in[12];
    const bf16* H = (const bf16*)A.out;
    const bf16* WRH = (const bf16*)(A.ws + WS_WRH);
    int* LIST = (int*)(A.ws + WS_LIST); float* SGATE = (float*)(A.ws + WS_SGATE); float* SRSTD = (float*)(A.ws + WS_SRSTD); int* POS = (int*)(A.ws + WS_POS);
    unsigned* CNT = (unsigned*)(A.ws + WS_CTL) + CW_CNT;
    const int lane = (tidx_ & 63), w = F.wave, r32 = lane & 31, hi = lane >> 5;
    for (int c = F.vcu; c < T / 128; c += F.G) {
        const int tt = w & 3, kh = w >> 2;
        const size_t row = (size_t)c * 128 + tt * 32 + r32;
        const bf16* hrow = H + row * D + kh * 512 + 8 * hi;
        v4u hq[16];
#pragma unroll
        for (int s = 0; s < 16; ++s) hq[s] = *(const v4u*)(hrow + 16 * s);
        __builtin_amdgcn_sched_barrier(0);
        for (int q = tidx_; q < 8192; q += 512) { const int mtx = q >> 12, rem = q & 4095, e = rem >> 7, ck = rem & 127;
            const v4u v = *(const v4u*)(WRH + (size_t)mtx * 32768 + e * 1024 + ck * 8);
            *(LAS v4u*)(L + mtx * 65536 + e * 2048 + ((ck ^ (e & 15)) << 4)) = v; }
        if (tidx_ < 256) *(LAS f32x4*)(gl + tidx_ * 4) = *(const f32x4*)(gmoe + tidx_ * 4);
        if (tidx_ < 32) hist[tidx_] = 0;
        __syncthreads();
        const LAS float* grow = gl + kh * 512 + 8 * hi;
        const LAS unsigned char* wb = L + r32 * 2048;
        f32x16 acc = {}; float ss = 0.f;
#pragma unroll
        for (int s = 0; s < 32; ++s) {
            const v4u hw_ = hq[s & 15];
            if (s < 16) hq[s] = *(const v4u*)(hrow + 16 * (s + 16));
            const f32x4 h0 = {bflo(hw_.x), bfhi(hw_.x), bflo(hw_.y), bfhi(hw_.y)}, h1 = {bflo(hw_.z), bfhi(hw_.z), bflo(hw_.w), bfhi(hw_.w)}, g0 = *(const LAS f32x4*)(grow + 16 * s), g1 = *(const LAS f32x4*)(grow + 16 * s + 4);
            ss += (h0.x * h0.x + h0.y * h0.y) + (h0.z * h0.z + h0.w * h0.w) + (h1.x * h1.x + h1.y * h1.y) + (h1.z * h1.z + h1.w * h1.w);
            const f32x4 x0 = h0 * g0, x1 = h1 * g1;
            v4u xh; xh.x = cvt_pk_bf16(x0.x, x0.y); xh.y = cvt_pk_bf16(x0.z, x0.w); xh.z = cvt_pk_bf16(x1.x, x1.y); xh.w = cvt_pk_bf16(x1.z, x1.w);
            v4u xl; xl.x = cvt_pk_bf16(x0.x - bflo(xh.x), x0.y - bfhi(xh.x)); xl.y = cvt_pk_bf16(x0.z - bflo(xh.y), x0.w - bfhi(xh.y));
            xl.z = cvt_pk_bf16(x1.x - bflo(xh.z), x1.y - bfhi(xh.z)); xl.w = cvt_pk_bf16(x1.z - bflo(xh.w), x1.w - bfhi(xh.w));
            const int ck = kh * 64 + 2 * s + hi;
            const bf16x8 wh = *(const LAS bf16x8*)(wb + ((ck ^ (r32 & 15)) << 4)), wl = *(const LAS bf16x8*)(wb + 65536 + ((ck ^ (r32 & 15)) << 4));
            const bf16x8 ah = __builtin_bit_cast(bf16x8, xh), al = __builtin_bit_cast(bf16x8, xl);
            acc = __builtin_amdgcn_mfma_f32_32x32x16_bf16(ah, wh, acc, 0, 0, 0);
            acc = __builtin_amdgcn_mfma_f32_32x32x16_bf16(al, wh, acc, 0, 0, 0);
            acc = __builtin_amdgcn_mfma_f32_32x32x16_bf16(ah, wl, acc, 0, 0, 0);
        }
        __syncthreads();
        { LAS float* LGp = (LAS float*)L + kh * (128 * 33);
#pragma unroll
          for (int i = 0; i < 16; ++i) LGp[(tt * 32 + crow(i, hi)) * 33 + r32] = acc[i];
          ((LAS float*)(L + 36864))[(kh * 2 + hi) * 128 + tt * 32 + r32] = ss; }
        __syncthreads();
        if (tidx_ < 128) {
            const int t = tidx_; const LAS float* SS = (const LAS float*)(L + 36864);
            const float rstd = 1.0f / sqrtf(((SS[t] + SS[128 + t]) + (SS[256 + t] + SS[384 + t])) * (1.f / D) + EPS);
            const LAS float* l0 = (const LAS float*)L + t * 33; const LAS float* l1 = l0 + 128 * 33;
            float lg[32];
#pragma unroll
            for (int e = 0; e < 32; ++e) lg[e] = (l0[e] + l1[e]) * rstd + brt[e];
            unsigned taken = 0u; float tv[4]; int ti[4];
#pragma unroll
            for (int k = 0; k < 4; ++k) { float bv = -INFINITY; int bi = 0;
#pragma unroll
                for (int e = 0; e < 32; ++e) { const float cv = ((taken >> e) & 1u) ? -INFINITY : lg[e]; if (cv > bv) { bv = cv; bi = e; } }
                tv[k] = bv; ti[k] = bi; taken |= 1u << bi; }
            const float e1 = __expf(tv[1] - tv[0]), e2 = __expf(tv[2] - tv[0]), e3 = __expf(tv[3] - tv[0]); const float inv = 1.0f / (1.0f + e1 + e2 + e3);
            const float gk[4] = {inv, e1 * inv, e2 * inv, e3 * inv};
            rec_s[t] = rstd;
#pragma unroll
            for (int k = 0; k < 4; ++k) { const int lr = atomicAdd((int*)&hist[ti[k]], 1); rec_e[t * 4 + k] = ti[k]; rec_r[t * 4 + k] = lr; rec_g[t * 4 + k] = gk[k]; }
        }
        __syncthreads();
        if (tidx_ < 32) basee[tidx_] = (int)__hip_atomic_fetch_add(CNT + tidx_, (unsigned)hist[tidx_], __ATOMIC_RELAXED, __HIP_MEMORY_SCOPE_AGENT);
        __syncthreads();
        { const int lrow = tidx_ >> 2, k = tidx_ & 3; const int e = rec_e[tidx_], slot = basee[e] + rec_r[tidx_]; const int t = c * 128 + lrow;
          LIST[e * 32768 + slot] = t; SGATE[e * 32768 + slot] = rec_g[tidx_]; SRSTD[e * 32768 + slot] = rec_s[lrow]; POS[t * 4 + k] = (e << 16) | slot; }
        __syncthreads();
    }
}

__device__ __forceinline__ void load_tile_starts(const Frame& F, const Args& A) {
    const int tidx_ = tid_opaque(F.wave);
    LAS int* ts = (LAS int*)(F.lds + TS_OFF);
    if (tidx_ == 0) { const unsigned* CNT = (const unsigned*)(A.ws + WS_CTL) + CW_CNT; int acc = 0;
        for (int e = 0; e < 32; ++e) { const int c = (int)__hip_atomic_load(CNT + e, __ATOMIC_RELAXED, __HIP_MEMORY_SCOPE_AGENT); ts[e] = acc; ts[40 + e] = c; acc += (c + 255) >> 8; }
        ts[32] = acc; for (int e = 33; e < 40; ++e) ts[e] = 0x7fffffff; }
    __syncthreads();
}

__device__ __forceinline__ void combine_phase(const Frame& F, const Args& A) {
    const int tidx_ = tid_opaque(F.wave);
    const LAS int* ts = (const LAS int*)(F.lds + TS_OFF);
    const bf16* Y = (const bf16*)(A.ws + WS_Y); const int* POS = (const int*)(A.ws + WS_POS); const bf16* H = (const bf16*)A.out; bf16* H2 = (bf16*)(A.ws + WS_H2); float* RS = (float*)(A.ws + WS_SRSTD);
    const int gw = F.vcu * 8 + F.wave, NGW = F.G * 8, lane = (tidx_ & 63);
    for (int t = gw * 2; t < T; t += NGW * 2) {
        int pz[2][4];
#pragma unroll
        for (int r = 0; r < 2; ++r)
#pragma unroll
            for (int k = 0; k < 4; ++k) pz[r][k] = POS[(t + r) * 4 + k];
        f32x4 v[2][2][2];
#pragma unroll
        for (int r = 0; r < 2; ++r)
#pragma unroll
            for (int hf = 0; hf < 2; ++hf) { const v4u w = *(const v4u*)(H + (size_t)(t + r) * D + hf * 512 + 8 * lane); v[r][hf][0] = (f32x4){bflo(w.x), bfhi(w.x), bflo(w.y), bfhi(w.y)}; v[r][hf][1] = (f32x4){bflo(w.z), bfhi(w.z), bflo(w.w), bfhi(w.w)}; }
        v4u yw[2][4][2];
#pragma unroll
        for (int r = 0; r < 2; ++r)
#pragma unroll
            for (int k = 0; k < 4; ++k) { const int e = pz[r][k] >> 16, slot = pz[r][k] & 0xffff; const bf16* yp = Y + ((size_t)ts[e] * 256 + slot) * D + 8 * lane;
                yw[r][k][0] = *(const v4u*)yp; yw[r][k][1] = *(const v4u*)(yp + 512); }
        float s[2];
#pragma unroll
        for (int r = 0; r < 2; ++r) { float a = 0.f;
#pragma unroll
            for (int hf = 0; hf < 2; ++hf) {
#pragma unroll
                for (int k = 0; k < 4; ++k) { const v4u w = yw[r][k][hf];
                    v[r][hf][0] = v[r][hf][0] + (f32x4){bflo(w.x), bfhi(w.x), bflo(w.y), bfhi(w.y)}; v[r][hf][1] = v[r][hf][1] + (f32x4){bflo(w.z), bfhi(w.z), bflo(w.w), bfhi(w.w)}; }
                st8(H2 + (size_t)(t + r) * D + hf * 512 + 8 * lane, v[r][hf][0], v[r][hf][1]);
#pragma unroll
                for (int p = 0; p < 2; ++p) a += (v[r][hf][p].x * v[r][hf][p].x + v[r][hf][p].y * v[r][hf][p].y) + (v[r][hf][p].z * v[r][hf][p].z + v[r][hf][p].w * v[r][hf][p].w); }
            s[r] = a; }
#pragma unroll
        for (int o = 1; o < 64; o <<= 1) { s[0] += __shfl_xor(s[0], o); s[1] += __shfl_xor(s[1], o); }
#pragma unroll
        for (int r = 0; r < 2; ++r) if (lane == r) RS[t + r] = 1.0f / sqrtf(s[r] * (1.f / D) + EPS);
    }
}
__device__ __forceinline__ void final_phase(const Frame& F, const Args& A) {
    const int tidx_ = tid_opaque(F.wave);
    float* OUT = A.out; const float* gf = A.in[22]; const bf16* T1 = (const bf16*)(A.ws + WS_T1); const bf16* H2 = (const bf16*)(A.ws + WS_H2);
    const int gw = F.vcu * 8 + F.wave, NGW = F.G * 8, lane = (tidx_ & 63);
    f32x4 g[2][2];
#pragma unroll
    for (int hf = 0; hf < 2; ++hf) { const float* gp = gf + hf * 512 + 8 * lane; g[hf][0] = *(const f32x4*)gp; g[hf][1] = *(const f32x4*)(gp + 4); }
    for (int t = gw * 2; t < T; t += NGW * 2) {
        v4u hw[2][2], tw[2][2];
#pragma unroll
        for (int r = 0; r < 2; ++r)
#pragma unroll
            for (int hf = 0; hf < 2; ++hf) { const size_t o = (size_t)(t + r) * D + hf * 512 + 8 * lane; hw[r][hf] = *(const v4u*)(H2 + o); tw[r][hf] = *(const v4u*)(T1 + o); }
        f32x4 v[2][2][2]; float s[2];
#pragma unroll
        for (int r = 0; r < 2; ++r) { float a = 0.f;
#pragma unroll
            for (int hf = 0; hf < 2; ++hf) { const v4u h = hw[r][hf], w = tw[r][hf];
                v[r][hf][0] = (f32x4){bflo(h.x) + bflo(w.x), bfhi(h.x) + bfhi(w.x), bflo(h.y) + bflo(w.y), bfhi(h.y) + bfhi(w.y)};
                v[r][hf][1] = (f32x4){bflo(h.z) + bflo(w.z), bfhi(h.z) + bfhi(w.z), bflo(h.w) + bflo(w.w), bfhi(h.w) + bfhi(w.w)};
#pragma unroll
                for (int p = 0; p < 2; ++p) a += (v[r][hf][p].x * v[r][hf][p].x + v[r][hf][p].y * v[r][hf][p].y) + (v[r][hf][p].z * v[r][hf][p].z + v[r][hf][p].w * v[r][hf][p].w); }
            s[r] = a; }
#pragma unroll
        for (int o = 1; o < 64; o <<= 1) { s[0] += __shfl_xor(s[0], o); s[1] += __shfl_xor(s[1], o); }
#pragma unroll
        for (int r = 0; r < 2; ++r) { const float rstd = 1.0f / sqrtf(s[r] * (1.f / D) + EPS);
#pragma unroll
            for (int hf = 0; hf < 2; ++hf) { float* op = OUT + (size_t)(t + r) * D + hf * 512 + 8 * lane; *(f32x4*)op = v[r][hf][0] * rstd * g[hf][0]; *(f32x4*)(op + 4) = v[r][hf][1] * rstd * g[hf][1]; } }
    }
}

constexpr int NPHASE = 13;
#ifndef ONLY_PH
#define ONLY_PH -1
#endif
#define PH_ON(k) (ONLY_PH < 0 || ONLY_PH == (k))
__global__ void __launch_bounds__(512, 2) fwd_kernel(Args args) {
    extern __shared__ __attribute__((aligned(16))) unsigned char lds[];
    Frame F;
    F.lds = (LAS unsigned char*)lds; F.wave = __builtin_amdgcn_readfirstlane((int)threadIdx.x >> 6);
    F.G = gridDim.x; { const int bx = blockIdx.x; F.vcu = (F.G % 8 == 0) ? (bx % 8) * (F.G / 8) + bx / 8 : bx; }
    unsigned char* ws = args.ws;
    volatile LAS unsigned* MISC = (volatile LAS unsigned*)(F.lds + MISC_OFF);
    for (int u = tid_opaque(F.wave); u < (LDS_BYTES - RING_BYTES) / 4; u += 512) ((LAS unsigned*)(F.lds + RING_BYTES))[u] = 0u;
    __syncthreads();
    const bool multi = (args.ph_hi - args.ph_lo) > 1;
    if (multi) (void)xcd_barrier_post((unsigned*)(ws + WS_CTL) + CW_BAR, MISC + 8, F.wave);
    const int bx = (int)blockIdx.x;
#if MK_N_LAUNCHES == 1
    constexpr int lo = 0, hi = NPHASE;
#else
    const int lo = args.ph_lo, hi = args.ph_hi;
#endif
#ifndef REP_MASK
#define REP_MASK 0
#endif
#define IN(k) (PH_ON(k) && lo <= (k) && (k) < hi)
#define REPS(k) (((REP_MASK >> (k)) & 1) ? 2 : 1)
#define SEAM(k) do { if (lo <= (k) && (k) + 1 < hi) { XcdBarrier b_; b_.bar = (unsigned*)(args.ws + WS_CTL) + CW_BAR; b_.x = xb_xcc_id(); b_.st = (volatile LAS unsigned*)(F.lds + MISC_OFF) + 8; b_.wave = F.wave; xcd_barrier(b_); } } while (0)
    if (IN(0)) for (int rep_ = 0; rep_ < REPS(0); ++rep_) { p0_prologue(F, args); } SEAM(0);
    if (IN(1)) { const int nu1 = (T / 256) * 23, R1 = (nu1 + F.G - 1) / F.G + 1, GG = (nu1 + R1 - 1) / R1;
                 if (bx < GG) { InProjSched S{(const char*)(ws + WS_NX), (const char*)(ws + WS_WIN), GG, bx, REPS(1) - 1};
                 EpiInProj E{(bf16*)(ws + WS_Q), (bf16*)(ws + WS_K), (bf16*)(ws + WS_ZU), (bf16*)(ws + WS_GA), (bf16*)(ws + WS_GG), (bf16*)(ws + WS_VT), (bf16*)(ws + WS_ZVT)};
                 pg8::gemm_phase(F.lds, D, S, E, F.wave); }
                 convert_queue(F, args, (unsigned*)(ws + WS_CTL) + CW_Q1, 0, BG_P1); convert_queue(F, args, (unsigned*)(ws + WS_CTL) + CW_Q3, BG_N, BG_ALL); convert_p_queue(F, args, (unsigned*)(ws + WS_CTL) + CW_Q4); } SEAM(1);
    if (IN(2)) { attn_phase(F, args); spatial_phase(F, args); } SEAM(2);
    if (IN(3)) { merge_phase(F, args); } SEAM(3);
    if (IN(4)) { PlainSched S{(const char*)(ws + WS_AG), (const char*)(ws + WS_WCAT), T / 256, 4, D, F.G, bx, REPS(4) - 1}; EpiMerge E{(bf16*)(ws + WS_MRG), (const bf16*)(ws + WS_GA), (const bf16*)(ws + WS_GG)};
                 pg8::gemm_phase(F.lds, D, S, E, F.wave); } SEAM(5);
    if (IN(6)) { PlainSched S{(const char*)(ws + WS_MRG), (const char*)(ws + WS_WOUT), T / 256, 4, D, F.G, bx, REPS(6) - 1}; EpiH1 E{(bf16*)args.out, args.in[0]};
                 pg8::gemm_phase(F.lds, D, S, E, F.wave); } SEAM(6);
    if (IN(7)) for (int rep_ = 0; rep_ < REPS(7); ++rep_) { router_phase(F, args); } SEAM(7);
    if (IN(8)) { load_tile_starts(F, args); const LAS int* ts = (const LAS int*)(F.lds + TS_OFF);
                 const int nu8 = ts[32] * 8, R8 = (nu8 + F.G - 1) / F.G, GG = R8 > 0 ? (nu8 + R8 - 1) / R8 : 1;
                 if (bx < GG) { MoeSched S{(const char*)args.out, (const char*)(ws + WS_WGU), (const int*)(ws + WS_LIST), ts, 8, D, GG, bx, 1, REPS(8) - 1}; EpiMoeUp E{(bf16*)(ws + WS_ACT), args.in[16], (const float*)(ws + WS_SRSTD), ts};
                 pg8::gemm_phase(F.lds, D, S, E, F.wave); }
                 convert_queue(F, args, (unsigned*)(ws + WS_CTL) + CW_Q2, BG_GU, BG_N); } SEAM(8);
    if (IN(9)) { load_tile_starts(F, args); const LAS int* ts = (const LAS int*)(F.lds + TS_OFF);
                 const int nu9 = ts[32] * 4, R9 = (nu9 + F.G - 1) / F.G, GG = R9 > 0 ? (nu9 + R9 - 1) / R9 : 1, NH = F.G - GG;
                 if (bx < GG) { MoeSched S{(const char*)(ws + WS_ACT), (const char*)(ws + WS_WD), (const int*)(ws + WS_LIST), ts, 4, D, GG, bx, 0, REPS(9) - 1}; EpiMoeDown E{(bf16*)(ws + WS_Y), args.in[18], (const float*)(ws + WS_SGATE), ts};
                 pg8::gemm_phase(F.lds, D, S, E, F.wave); }
                 if (NH >= 8 ? bx >= GG : true) { PlainSched S{(const char*)(ws + WS_PB), (const char*)(ws + WS_WPP), T / 256, 4, PLE, NH >= 8 ? NH : F.G, NH >= 8 ? bx - GG : bx, 0}; EpiBf<0> E{(bf16*)(ws + WS_PP), nullptr, nullptr};
                 pg8::gemm_phase(F.lds, PLE, S, E, F.wave); } } SEAM(9);
    if (IN(10)) for (int rep_ = 0; rep_ < REPS(10); ++rep_) { load_tile_starts(F, args); combine_phase(F, args); } SEAM(10);
    if (IN(11)) { PlainSched S{(const char*)(ws + WS_H2), (const char*)(ws + WS_WPG), T / 256, 4, D, F.G, bx, REPS(11) - 1}; EpiPle E{(bf16*)(ws + WS_T1), (const bf16*)(ws + WS_PP), (const float*)(ws + WS_SRSTD)};
                  pg8::gemm_phase(F.lds, D, S, E, F.wave); } SEAM(11);
    if (IN(12)) for (int rep_ = 0; rep_ < REPS(12); ++rep_) { final_phase(F, args); }
#undef IN
#undef SEAM
}

extern "C" void kernel_launch(void* const* d_in, const int* in_sizes, int n_in, void* d_out, int out_size, void* d_ws, size_t ws_size, hipStream_t stream) {
    static int grid = 0;
    if (grid == 0) {
        if (n_in != 23 || out_size != T * D || ws_size < WS_END) { fprintf(stderr, "kernel_launch: unexpected shapes (n_in %d out %d ws %zu)\n", n_in, out_size, ws_size); grid = -1; return; }
        int dev = 0, cus = 0, per_cu = 0;
        if (hipGetDevice(&dev) != hipSuccess || hipDeviceGetAttribute(&cus, hipDeviceAttributeMultiprocessorCount, dev) != hipSuccess) { grid = -1; return; }
        if (hipFuncSetAttribute((const void*)fwd_kernel, hipFuncAttributeMaxDynamicSharedMemorySize, LDS_BYTES) != hipSuccess) { fprintf(stderr, "kernel_launch: hipFuncSetAttribute failed\n"); grid = -1; return; }
        if (hipOccupancyMaxActiveBlocksPerMultiprocessor(&per_cu, (const void*)fwd_kernel, 512, LDS_BYTES) != hipSuccess || per_cu < 1) { fprintf(stderr, "kernel_launch: occupancy query says %d\n", per_cu); (void)hipGetLastError(); grid = -1; return; }
        grid = cus;
    }
    if (grid < 0) return;
    (void)hipMemsetAsync((char*)d_ws + WS_CTL, 0, CTL_ZERO_BYTES, stream);
    Args a{};
    for (int i = 0; i < 23; ++i) a.in[i] = (const float*)d_in[i];
    a.out = (float*)d_out; a.ws = (unsigned char*)d_ws;
#if MK_N_LAUNCHES == 1
    a.ph_lo = 0; a.ph_hi = NPHASE;
    hipLaunchKernelGGL(fwd_kernel, dim3(grid), dim3(512), LDS_BYTES, stream, a);
#else
    for (int ph = 0; ph < NPHASE; ++ph) { a.ph_lo = ph; a.ph_hi = ph + 1; hipLaunchKernelGGL(fwd_kernel, dim3(grid), dim3(512), LDS_BYTES, stream, a); }
#endif
}
```

```cpp
#include <hip/hip_runtime.h>
#include <cstdio>
#include <cstdint>

#ifndef MK_N_LAUNCHES
#define MK_N_LAUNCHES 1
#endif

constexpr int NB = 8, SEQ = 4096, T = NB * SEQ, D = 1024;
constexpr int ATT_W = 768, GM_W = 768, IN_W = 5888, NE = 32, TOPK = 4, PLE = 256;
constexpr float EPS = 1e-6f;
constexpr float LOG2E = 1.4426950408889634f, LN2 = 0.6931471805599453f;
constexpr float QSCALE = 0.125f * LOG2E;

#define LAS __attribute__((address_space(3)))
#define GAS __attribute__((address_space(1)))
typedef unsigned short bf16;
typedef unsigned v4u __attribute__((ext_vector_type(4)));
typedef unsigned v2u __attribute__((ext_vector_type(2)));
typedef float f32x4 __attribute__((ext_vector_type(4)));
typedef float f32x2 __attribute__((ext_vector_type(2)));
typedef float f32x16 __attribute__((ext_vector_type(16)));
typedef short bf16x8 __attribute__((ext_vector_type(8)));
typedef short s16x4 __attribute__((ext_vector_type(4)));

__device__ __forceinline__ unsigned f2bf(float f) { unsigned u = __builtin_bit_cast(unsigned, f); return (u + 0x7fffu + ((u >> 16) & 1u)) >> 16; }
__device__ __forceinline__ unsigned pk2(float lo, float hi) { return f2bf(lo) | (f2bf(hi) << 16); }
__device__ __forceinline__ float bflo(unsigned w) { return __builtin_bit_cast(float, w << 16); }
__device__ __forceinline__ float bfhi(unsigned w) { return __builtin_bit_cast(float, w & 0xffff0000u); }
typedef __bf16 bf16x2_t __attribute__((ext_vector_type(2)));
__device__ __forceinline__ unsigned cvt_pk_bf16(float lo, float hi) { const f32x2 v = {lo, hi}; const bf16x2_t b = __builtin_convertvector(v, bf16x2_t); return __builtin_bit_cast(unsigned, b); }
__device__ __forceinline__ float sigmoidf_(float x) { return __builtin_amdgcn_rcpf(1.0f + __builtin_amdgcn_exp2f(-x * LOG2E)); }
__device__ __forceinline__ f32x2 gelu_pk(f32x2 v) {
    const f32x2 av = __builtin_elementwise_abs(v), d = av * 0.2316418882f + 1.0f;
    f32x2 t; t.x = __builtin_amdgcn_rcpf(d.x); t.y = __builtin_amdgcn_rcpf(d.y);
    f32x2 q = t * 0.5307027145f + (-0.7265760135f); q = q * t + 0.7107068705f; q = q * t + (-0.142248368f); q = q * t + 0.127414796f; q = q * t;
    const f32x2 s = (v * v) * (-0.72134752044f);
    f32x2 e; e.x = __builtin_amdgcn_exp2f(s.x); e.y = __builtin_amdgcn_exp2f(s.y);
    const f32x2 m = v * (q * e), r = v - m;
    f32x2 o; o.x = v.x < 0.f ? m.x : r.x; o.y = v.y < 0.f ? m.y : r.y; return o;
}
__device__ __forceinline__ f32x4 gelu4(f32x4 v) { f32x2 a = gelu_pk((f32x2){v[0], v[1]}), b = gelu_pk((f32x2){v[2], v[3]}); return (f32x4){a.x, a.y, b.x, b.y}; }
__device__ __forceinline__ f32x4 sigm4(f32x4 v) { return (f32x4){sigmoidf_(v[0]), sigmoidf_(v[1]), sigmoidf_(v[2]), sigmoidf_(v[3])}; }
__device__ __forceinline__ int tid_opaque(int wave) {
    int l; asm volatile("v_mbcnt_lo_u32_b32 %0, -1, 0\n\tv_mbcnt_hi_u32_b32 %0, -1, %0" : "=v"(l));
    return wave * 64 + l;
}
__device__ __forceinline__ float wave_sum(float v) {
#pragma unroll
    for (int o = 1; o < 64; o <<= 1) v += __shfl_xor(v, o);
    return v;
}

constexpr size_t MiB = 1u << 20;
constexpr size_t WS_CTL = 0, CTL_ZERO_BYTES = 1 * MiB;
constexpr size_t WS_WIN = 2 * MiB;
constexpr size_t WS_WCAT = 14 * MiB;
constexpr size_t WS_WOUT = 17 * MiB;
constexpr size_t WS_WPG = 19 * MiB;
constexpr size_t WS_WPP = 21 * MiB;
constexpr size_t WS_WSP = 22 * MiB;
constexpr size_t WS_WRH = 23 * MiB;
constexpr size_t WS_WRL = 23 * MiB + 65536;
constexpr size_t WS_SRSTD = 980 * MiB;
constexpr size_t WS_WGU = 24 * MiB;
constexpr size_t WS_WD = 152 * MiB;
constexpr size_t WS_NX = 216 * MiB;
constexpr size_t WS_PB = 280 * MiB;
constexpr size_t WS_PP = 296 * MiB;
constexpr size_t WS_LIST = 360 * MiB;
constexpr size_t WS_SGATE = 364 * MiB;
constexpr size_t WS_POS = 368 * MiB;
constexpr size_t WS_LSE = 369 * MiB;
constexpr size_t WS_Q = 372 * MiB;
constexpr size_t WS_K = 420 * MiB;
constexpr size_t WS_VT = 468 * MiB;
constexpr size_t WS_ZU = 516 * MiB;
constexpr size_t WS_ZVT = 564 * MiB;
constexpr size_t WS_GA = 612 * MiB;
constexpr size_t WS_GG = 676 * MiB;
constexpr size_t WS_OG = 740 * MiB;
constexpr size_t WS_ATT = 788 * MiB;
constexpr size_t WS_G = 804 * MiB;
constexpr size_t WS_AG = 852 * MiB;
constexpr size_t WS_MRG = 916 * MiB;
constexpr size_t WS_ACT = 372 * MiB;
constexpr size_t WS_Y = 644 * MiB;
constexpr size_t WS_H2 = 436 * MiB;
constexpr size_t WS_T1 = 372 * MiB;
constexpr size_t WS_END = 984 * MiB;
constexpr int PMAX_TILES = 544;

constexpr int CW_CNT = 64;
constexpr int CW_Q1 = 256, CW_Q2 = 320, CW_Q3 = 384, CW_Q4 = 448;
constexpr int CW_BAR = 4096;

constexpr int RING_BYTES = 131072;
constexpr int MISC_OFF = RING_BYTES + 320;
constexpr int TS_OFF = RING_BYTES + 1024;
constexpr int LDS_BYTES = 147456;

namespace pg8 {
typedef unsigned short bf16_t;
constexpr int BM = 256, BK = 64, HALF = 128, HTB = HALF * BK * 2, STAGE_BYTES = 8 * HTB, NXCD = 8, WGM = 8;
__host__ __device__ __forceinline__ int lds_byte(int r, int c) { const int st = (r >> 4) * 2 + (c >> 5), rr = r & 15, cc = c & 31, ob = rr * 64 + cc * 2; return st * 1024 + (ob ^ (((ob >> 9) & 1) << 5)); }
__host__ __device__ __forceinline__ void stage_rc(int b, int& R, int& C) { const int st = b / 1024, sb = b % 1024, swz = sb ^ (((sb >> 9) & 1) << 5); R = (st >> 1) * 16 + swz / 64; C = (st & 1) * 32 + (swz % 64) / 2; }
__host__ __device__ __forceinline__ int perm32(int rho) { const int n = rho >> 4, i = rho & 15; return 8 * (i >> 2) + 4 * n + (i & 3); }

struct Unit { const char* a; const char* b; int pm, pn, x0, x1; };

__device__ __forceinline__ bool static_order(int i, int G, int c, int nM, int nN, int& pm, int& pn) {
    const int nwg = nM * nN; const long L = (long)i * G + c; if (L >= nwg) return false;
    int wgid = (int)L; { const int q = nwg / NXCD, r = nwg % NXCD, xcd = wgid % NXCD, off = wgid / NXCD; wgid = (xcd < r ? xcd * (q + 1) : r * (q + 1) + (xcd - r) * q) + off; }
    const int nig = WGM * nN, gid = wgid / nig, fm = gid * WGM, gsz = (nM - fm) < WGM ? (nM - fm) : WGM;
    pm = fm + ((wgid % nig) % gsz); pn = (wgid % nig) / gsz; return true;
}

template <class Epi, class Sched>
__device__ __forceinline__ void gemm_phase(LAS unsigned char* lds, const int K, const Sched& S, const Epi& E, const int wave) {
    const int wid = wave, tid = tid_opaque(wid), lane = tid & 63, wr = wid >> 2, wc = wid & 3, fr = lane & 15, fq = lane >> 4;
    const int nt = K / BK;
    int RA[2]; unsigned CB2[2], rbk[2];
#pragma unroll
    for (int i = 0; i < 2; ++i) { int R, C; stage_rc(tid * 16 + i * 8192, R, C); const int Rb = Epi::PERM ? ((R & ~31) + perm32(R & 31)) : R;
        RA[i] = R; CB2[i] = (unsigned)C * 2u; rbk[i] = (unsigned)(Rb * K) * 2u; }
    const size_t kstep = (size_t)(BK * 2);
    const size_t hstep = (size_t)HALF * K * 2;
    const unsigned ldsw = (unsigned)wid * 1024u;
    const int aoff = lds_byte(wr * 64 + fr, fq * 8), boff = lds_byte(wc * 32 + fr, fq * 8);
#define PG8_SA(b, h) (((b) * 2 + (h)) * HTB)
#define PG8_SB(b, h) ((4 + (b) * 2 + (h)) * HTB)
#define PG8_STAGE(bufoff, gbase, voff) do { _Pragma("unroll") for (int _i = 0; _i < 2; ++_i) \
        __builtin_amdgcn_global_load_lds((const unsigned*)((const char*)(gbase) + (voff)[_i]), (LAS unsigned*)(lds + (bufoff) + ldsw + _i * 8192), 16, 0, 0); } while (0)
#define PG8_LDA(dst, b, h) do { _Pragma("unroll") for (int m = 0; m < 4; ++m) _Pragma("unroll") for (int k = 0; k < 2; ++k) dst[m][k] = *(const LAS bf16x8*)(lds + PG8_SA(b, h) + aoff + m * 2048 + k * 1024); } while (0)
#define PG8_LDB(dst, b, h) do { _Pragma("unroll") for (int n = 0; n < 2; ++n) _Pragma("unroll") for (int k = 0; k < 2; ++k) dst[n][k] = *(const LAS bf16x8*)(lds + PG8_SB(b, h) + boff + n * 2048 + k * 1024); } while (0)
#define PG8_MMA(ai, bj, At, Bt) do { __builtin_amdgcn_s_setprio(1); _Pragma("unroll") for (int m = 0; m < 4; ++m) _Pragma("unroll") for (int n = 0; n < 2; ++n) _Pragma("unroll") for (int k = 0; k < 2; ++k) \
        acc[ai][bj][m][n] = __builtin_amdgcn_mfma_f32_16x16x32_bf16(Bt[n][k], At[m][k], acc[ai][bj][m][n], 0, 0, 0); __builtin_amdgcn_s_setprio(0); } while (0)
#define PG8_WAIT_V(n) asm volatile("s_waitcnt vmcnt(" #n ")" ::: "memory")
#define PG8_WAIT_L(n) asm volatile("s_waitcnt lgkmcnt(" #n ")" ::: "memory")
#define PG8_BAR __builtin_amdgcn_s_barrier()
#define PG8_SCHED __builtin_amdgcn_sched_barrier(0)
    Unit cur, nxt; int ui = 0;
    if (!S.next(0, cur)) return;
    f32x4 acc[2][2][4][2];
#pragma unroll
    for (int a = 0; a < 2; ++a)
#pragma unroll
        for (int b = 0; b < 2; ++b)
#pragma unroll
            for (int m = 0; m < 4; ++m)
#pragma unroll
                for (int n = 0; n < 2; ++n) acc[a][b][m][n] = (f32x4){0.f, 0.f, 0.f, 0.f};
    bf16x8 At[4][2], B0[2][2], B1[2][2];
    const char* cA = cur.a; const char* cB = cur.b;
    unsigned oA[2][2], nO[2][2];
#pragma unroll
    for (int h = 0; h < 2; ++h)
#pragma unroll
        for (int i = 0; i < 2; ++i) oA[h][i] = S.a_off(cur, h * HALF + RA[i], K) + CB2[i];
    int csh = S.b_shift(cur); unsigned vbc[2] = {(rbk[0] << csh) + CB2[0], (rbk[1] << csh) + CB2[1]}, vbn[2];
    PG8_STAGE(PG8_SB(0, 0), cB, vbc); PG8_STAGE(PG8_SB(0, 1), cB + (hstep << csh), vbc); PG8_STAGE(PG8_SA(0, 0), cA, oA[0]); PG8_STAGE(PG8_SA(0, 1), cA, oA[1]);
    if (wr == 1) PG8_BAR;
    PG8_WAIT_V(2); PG8_BAR;
    PG8_STAGE(PG8_SB(1, 0), cB + kstep, vbc); PG8_STAGE(PG8_SA(1, 0), cA + kstep, oA[0]); PG8_STAGE(PG8_SB(1, 1), cB + (hstep << csh) + kstep, vbc);
    PG8_WAIT_V(6); PG8_BAR;
    for (;;) {
        const bool has_next = S.next(ui + 1, nxt);
        const char* nA = has_next ? nxt.a : cA; const char* nB = has_next ? nxt.b : cB;
        const int nsh = has_next ? S.b_shift(nxt) : csh; vbn[0] = (rbk[0] << nsh) + CB2[0]; vbn[1] = (rbk[1] << nsh) + CB2[1];
#pragma unroll
        for (int h = 0; h < 2; ++h)
#pragma unroll
            for (int i = 0; i < 2; ++i) nO[h][i] = has_next ? (S.a_off(nxt, h * HALF + RA[i], K) + CB2[i]) : oA[h][i];
#pragma unroll 1
        for (int t = 0; t < nt; t += 2) {
            const bool last = (t == nt - 2);
            const char* a1 = cA + (size_t)(t + 1) * kstep;
            const char* a2 = last ? nA : cA + (size_t)(t + 2) * kstep; const char* b2 = last ? nB : cB + (size_t)(t + 2) * kstep;
            const char* a3 = a2 + kstep; const char* b3 = b2 + kstep;
            unsigned o2[2][2]; const unsigned vb2[2] = {last ? vbn[0] : vbc[0], last ? vbn[1] : vbc[1]}; const size_t hs2 = hstep << (last ? nsh : csh);
#pragma unroll
            for (int h = 0; h < 2; ++h)
#pragma unroll
                for (int i = 0; i < 2; ++i) o2[h][i] = last ? nO[h][i] : oA[h][i];
            PG8_LDB(B0, 0, 0); PG8_LDB(B1, 0, 1); PG8_SCHED; PG8_LDA(At, 0, 0); PG8_STAGE(PG8_SA(1, 1), a1, oA[1]);
            PG8_WAIT_V(8); PG8_WAIT_L(0); PG8_BAR; PG8_MMA(0, 0, At, B0); PG8_MMA(0, 1, At, B1); PG8_BAR; PG8_SCHED;
            PG8_LDA(At, 0, 1); PG8_STAGE(PG8_SB(0, 0), b2, vb2); PG8_STAGE(PG8_SB(0, 1), b2 + hs2, vb2); PG8_STAGE(PG8_SA(0, 0), a2, o2[0]);
            PG8_WAIT_V(8); PG8_WAIT_L(0); PG8_BAR; PG8_MMA(1, 0, At, B0); PG8_MMA(1, 1, At, B1); PG8_BAR; PG8_SCHED;
            PG8_LDB(B0, 1, 0); PG8_LDB(B1, 1, 1); PG8_SCHED; PG8_LDA(At, 1, 0); PG8_STAGE(PG8_SA(0, 1), a2, o2[1]);
            PG8_WAIT_V(8); PG8_WAIT_L(0); PG8_BAR; PG8_MMA(0, 0, At, B0); PG8_MMA(0, 1, At, B1); PG8_BAR; PG8_SCHED;
            PG8_LDA(At, 1, 1); PG8_STAGE(PG8_SB(1, 0), b3, vb2); PG8_STAGE(PG8_SB(1, 1), b3 + hs2, vb2); PG8_STAGE(PG8_SA(1, 0), a3, o2[0]);
            PG8_WAIT_V(8); PG8_WAIT_L(0); PG8_BAR; PG8_MMA(1, 0, At, B0); PG8_MMA(1, 1, At, B1); PG8_BAR; PG8_SCHED;
            if constexpr (Epi::HOOK_T >= 0) { if (t == Epi::HOOK_T) { E.mid(acc, cur, wr, wc, fr, fq); PG8_SCHED; } }
        }
        if (wr == 0) PG8_BAR;
        E(acc, cur, wr, wc, fr, fq);
        if (!has_next) break;
#pragma unroll
        for (int a = 0; a < 2; ++a)
#pragma unroll
            for (int b = 0; b < 2; ++b)
#pragma unroll
                for (int m = 0; m < 4; ++m)
#pragma unroll
                    for (int n = 0; n < 2; ++n) acc[a][b][m][n] = (f32x4){0.f, 0.f, 0.f, 0.f};
        cur = nxt; cA = nA; cB = nB; ++ui; csh = nsh; vbc[0] = vbn[0]; vbc[1] = vbn[1];
#pragma unroll
        for (int h = 0; h < 2; ++h)
#pragma unroll
            for (int i = 0; i < 2; ++i) oA[h][i] = nO[h][i];
        if (wr == 1) PG8_BAR;
    }
    PG8_WAIT_V(0);
    PG8_BAR;
#undef PG8_SA
#undef PG8_SB
#undef PG8_STAGE
#undef PG8_LDA
#undef PG8_LDB
#undef PG8_MMA
#undef PG8_WAIT_V
#undef PG8_WAIT_L
#undef PG8_BAR
#undef PG8_SCHED
}
}
using pg8::Unit;
typedef f32x4 Acc[2][2][4][2];

struct PlainSched {
    const char* A; const char* Bt; int nM, nN, K, G, c, rsh;
    __device__ __forceinline__ bool next(int i, Unit& u) const {
        int pm, pn; if (!pg8::static_order(i >> rsh, G, c, nM, nN, pm, pn)) return false;
        u.pm = pm; u.pn = pn; u.x0 = 0; u.x1 = 0; u.a = A + (size_t)pm * 256 * K * 2; u.b = Bt + (size_t)pn * 256 * K * 2; return true;
    }
    __device__ __forceinline__ unsigned a_off(const Unit&, int row, int K_) const { return (unsigned)(row * K_) * 2u; }
    __device__ __forceinline__ int b_shift(const Unit&) const { return 0; }
};
struct InProjSched {
    const char* NX; const char* Wt; int G, c, rsh;
    __device__ __forceinline__ bool next(int i, Unit& u) const {
        int pm, pn; if (!pg8::static_order(i >> rsh, G, c, T / 256, 23, pm, pn)) return false;
        u.pm = pm; u.pn = pn; u.x0 = 0; u.x1 = 0;
        const char* xa = NX + (size_t)pm * 256 * D * 2; const char* wb = Wt + (size_t)pn * 256 * D * 2;
        if (pn < 17) { u.a = xa; u.b = wb; } else { u.a = wb; u.b = xa;
            if (pn < 20) { const int sh = 2 * (pn - 17), j0 = (pm & 15) * 256, r = j0 >> (12 - sh), i0 = j0 & ((SEQ >> sh) - 1);
                u.x0 = sh; u.b = NX + ((size_t)(pm >> 4) * SEQ + ((size_t)i0 << sh) + r) * D * 2; } }
        return true;
    }
    __device__ __forceinline__ unsigned a_off(const Unit&, int row, int K_) const { return (unsigned)(row * K_) * 2u; }
    __device__ __forceinline__ int b_shift(const Unit& u) const { return u.x0; }
};
struct MoeSched {
    const char* A; const char* Bt; const int* list; const LAS int* ts; int nN, K, G, c, gather, rsh;
    __device__ __forceinline__ bool next(int i, Unit& u) const {
        const int MT = ts[32];
        int pm, pn; if (!pg8::static_order(i >> rsh, G, c, MT, nN, pm, pn)) return false;
        int e = 0;
#pragma unroll
        for (int s = 16; s >= 1; s >>= 1) { if (ts[e + s] <= pm) e += s; }
        e = __builtin_amdgcn_readfirstlane(e);
        u.pm = pm; u.pn = pn; u.x0 = e; u.x1 = __builtin_amdgcn_readfirstlane(pm - ts[e]);
        u.a = gather ? A : A + (size_t)pm * 256 * K * 2;
        u.b = Bt + ((size_t)e * nN + pn) * 256 * K * 2;
        return true;
    }
    __device__ __forceinline__ unsigned a_off(const Unit& u, int row, int K_) const {
        if (!gather) return (unsigned)(row * K_) * 2u;
        const int slot = u.x1 * 256 + row, cnt = ts[40 + u.x0];
        const int tok = slot < cnt ? list[u.x0 * 32768 + slot] : 0;
        return (unsigned)(tok * K_) * 2u;
    }
    __device__ __forceinline__ int b_shift(const Unit&) const { return 0; }
};

__device__ __forceinline__ void st8(bf16* p, f32x4 v0, f32x4 v1) { v4u w; w.x = cvt_pk_bf16(v0[0], v0[1]); w.y = cvt_pk_bf16(v0[2], v0[3]); w.z = cvt_pk_bf16(v1[0], v1[1]); w.w = cvt_pk_bf16(v1[2], v1[3]); *(v4u*)p = w; }
__device__ __forceinline__ v4u widen_pair(v2u a, v2u b) {
    auto rx = __builtin_amdgcn_permlane32_swap(a.x, b.x, false, false); auto ry = __builtin_amdgcn_permlane32_swap(a.y, b.y, false, false);
    v4u w; w.x = rx[0]; w.y = ry[0]; w.z = rx[1]; w.w = ry[1]; return w;
}
__device__ __forceinline__ void ld8(const bf16* p, f32x4& v0, f32x4& v1) { const v4u w = *(const v4u*)p; v0 = (f32x4){bflo(w.x), bfhi(w.x), bflo(w.y), bfhi(w.y)}; v1 = (f32x4){bflo(w.z), bfhi(w.z), bflo(w.w), bfhi(w.w)}; }

struct EpiInProj {
    static constexpr bool PERM = true; static constexpr int HOOK_T = -1;
    bf16 *Q, *Kb, *ZU, *GA, *GG, *VT, *ZVT;
    template <int ACT> __device__ __forceinline__ void std_store(const Acc& acc, bf16* base, int ldc, int colt, int pm, int wr, int wc, int fr, int fq) const {
        const int row0 = pm * 256 + wr * 64 + fr, col0 = colt + wc * 32 + 8 * fq;
#pragma unroll
        for (int ai = 0; ai < 2; ++ai)
#pragma unroll
            for (int m = 0; m < 4; ++m) { bf16* rowp = base + (size_t)(row0 + ai * 128 + m * 16) * ldc + col0;
#pragma unroll
                for (int bj = 0; bj < 2; ++bj) { f32x4 v0 = acc[ai][bj][m][0], v1 = acc[ai][bj][m][1];
                    if (ACT == 1) { v0 = v0 * QSCALE; v1 = v1 * QSCALE; }
                    if (ACT == 2) { v0 = gelu4(v0); v1 = gelu4(v1); }
                    if (ACT == 3) { v0 = sigm4(v0); v1 = sigm4(v1); }
                    st8(rowp + bj * 128, v0, v1); } }
    }
    template <int ACT> __device__ __forceinline__ void tile_store(const Acc& acc, bf16* base, int g, int pm, int wr, int wc, int fr, int fq) const {
        const int dsh = 2 * g, row0 = pm * 256 + wr * 64 + fr;
#pragma unroll
        for (int ai = 0; ai < 2; ++ai)
#pragma unroll
            for (int m = 0; m < 4; ++m) { const int t = row0 + ai * 128 + m * 16, bb = t >> 12, sq = t & (SEQ - 1), r = sq & ((1 << dsh) - 1), i = sq >> dsh, kb = i >> 5, key = i & 31;
#pragma unroll
                for (int bj = 0; bj < 2; ++bj) { const int cw = bj * 128 + wc * 32 + 8 * fq, hh = cw >> 6, dd = cw & 63;
                    f32x4 v0 = acc[ai][bj][m][0], v1 = acc[ai][bj][m][1];
                    if (ACT == 1) { v0 = v0 * QSCALE; v1 = v1 * QSCALE; }
                    st8(base + ((size_t)((bb * 3 + g) * 4 + hh) * 128 + (size_t)((r << (7 - dsh)) + kb)) * 2048 + key * 64 + dd, v0, v1); } }
    }
    __device__ __forceinline__ void operator()(const Acc& acc, const Unit& u, int wr, int wc, int fr, int fq) const {
        const int pn = u.pn, pm = u.pm;
        if (pn < 3) tile_store<1>(acc, Q, pn, pm, wr, wc, fr, fq);
        else if (pn < 6) tile_store<0>(acc, Kb, pn - 3, pm, wr, wc, fr, fq);
        else if (pn < 9) std_store<2>(acc, ZU, GM_W, (pn - 6) * 256, pm, wr, wc, fr, fq);
        else if (pn < 13) std_store<3>(acc, GA, D, (pn - 9) * 256, pm, wr, wc, fr, fq);
        else if (pn < 17) std_store<3>(acc, GG, D, (pn - 13) * 256, pm, wr, wc, fr, fq);
        else if (pn < 20) {
            const int g = pn - 17, sh = 2 * g, bb = pm >> 4, j0 = (pm & 15) * 256, r = j0 >> (12 - sh), i0 = j0 & ((SEQ >> sh) - 1), nKB = 128 >> sh;
#pragma unroll
            for (int ai = 0; ai < 2; ++ai)
#pragma unroll
                for (int m = 0; m < 4; ++m) { const int chl = ai * 128 + wr * 64 + m * 16 + fr, hh = chl >> 6, dd = chl & 63;
                    bf16* hb = VT + (size_t)((bb * 3 + g) * 4 + hh) * (128 * 64 * 32) + dd * 32;
#pragma unroll
                    for (int bj = 0; bj < 2; ++bj) { const int i = i0 + bj * 128 + wc * 32 + 8 * fq;
                        st8(hb + (size_t)(r * nKB + (i >> 5)) * 2048 + (i & 31), acc[ai][bj][m][0], acc[ai][bj][m][1]); } }
        } else {
            const int ch0 = (pn - 20) * 256 + wr * 64 + fr, tin = wc * 32 + 8 * fq;
#pragma unroll
            for (int ai = 0; ai < 2; ++ai)
#pragma unroll
                for (int m = 0; m < 4; ++m) { const int ch = ch0 + ai * 128 + m * 16;
#pragma unroll
                    for (int bj = 0; bj < 2; ++bj) st8(ZVT + ((size_t)(2 * pm + bj) * GM_W + ch) * 128 + tin, gelu4(acc[ai][bj][m][0]), gelu4(acc[ai][bj][m][1])); }
        }
    }
};
template <int MODE> struct EpiBf {
    static constexpr bool PERM = true; static constexpr int HOOK_T = -1;
    bf16* O; const bf16* G1; const bf16* Y0;
    __device__ __forceinline__ void operator()(const Acc& acc, const Unit& u, int wr, int wc, int fr, int fq) const {
        const int row0 = u.pm * 256 + wr * 64 + fr, col0 = u.pn * 256 + wc * 32 + 8 * fq;
#pragma unroll
        for (int ai = 0; ai < 2; ++ai) {
            v4u gw[4][2], yw[4][2];
            if (MODE >= 1) {
#pragma unroll
                for (int m = 0; m < 4; ++m)
#pragma unroll
                    for (int bj = 0; bj < 2; ++bj) { const size_t off = (size_t)(row0 + ai * 128 + m * 16) * D + col0 + bj * 128; gw[m][bj] = *(const v4u*)(G1 + off); if (MODE == 2) yw[m][bj] = *(const v4u*)(Y0 + off); }
                __builtin_amdgcn_sched_barrier(0);
            }
#pragma unroll
            for (int m = 0; m < 4; ++m)
#pragma unroll
                for (int bj = 0; bj < 2; ++bj) { const size_t off = (size_t)(row0 + ai * 128 + m * 16) * D + col0 + bj * 128; f32x4 v0 = acc[ai][bj][m][0], v1 = acc[ai][bj][m][1];
                    if (MODE >= 1) { const v4u w = gw[m][bj]; v0 = v0 * (f32x4){bflo(w.x), bfhi(w.x), bflo(w.y), bfhi(w.y)}; v1 = v1 * (f32x4){bflo(w.z), bfhi(w.z), bflo(w.w), bfhi(w.w)}; }
                    if (MODE == 2) { const v4u w = yw[m][bj]; v0 = v0 + (f32x4){bflo(w.x), bfhi(w.x), bflo(w.y), bfhi(w.y)}; v1 = v1 + (f32x4){bflo(w.z), bfhi(w.z), bflo(w.w), bfhi(w.w)}; }
                    st8(O + off, v0, v1); }
            if (MODE >= 1) __builtin_amdgcn_sched_barrier(0);
        }
    }
};
template <int MODE> struct EpiF32 {
    static constexpr bool PERM = false; static constexpr int HOOK_T = -1;
    float* H; const float* X; const bf16* PP;
    __device__ __forceinline__ void operator()(const Acc& acc, const Unit& u, int wr, int wc, int fr, int fq) const {
        const int row0 = u.pm * 256 + wr * 64 + fr, col0 = u.pn * 256 + wc * 32 + 4 * fq;
        const float* src = MODE == 0 ? X : H;
        constexpr int MB = MODE == 0 ? 4 : 2;
#pragma unroll
        for (int ai = 0; ai < 2; ++ai)
#pragma unroll
            for (int mb = 0; mb < 4; mb += MB) {
                f32x4 xv[MB][2][2]; v2u pw[MB][2][2];
#pragma unroll
                for (int m = 0; m < MB; ++m)
#pragma unroll
                    for (int bj = 0; bj < 2; ++bj)
#pragma unroll
                        for (int n = 0; n < 2; ++n) { const size_t o = (size_t)(row0 + ai * 128 + (mb + m) * 16) * D + col0 + bj * 128 + n * 16; xv[m][bj][n] = *(const f32x4*)(src + o); if (MODE == 1) pw[m][bj][n] = *(const v2u*)(PP + o); }
                __builtin_amdgcn_sched_barrier(0);
#pragma unroll
                for (int m = 0; m < MB; ++m)
#pragma unroll
                    for (int bj = 0; bj < 2; ++bj)
#pragma unroll
                        for (int n = 0; n < 2; ++n) { const size_t o = (size_t)(row0 + ai * 128 + (mb + m) * 16) * D + col0 + bj * 128 + n * 16; f32x4 v = acc[ai][bj][mb + m][n];
                            if (MODE == 0) v = v + xv[m][bj][n];
                            else { const v2u w = pw[m][bj][n]; v = xv[m][bj][n] + sigm4(v) * (f32x4){bflo(w.x), bfhi(w.x), bflo(w.y), bfhi(w.y)}; }
                            *(f32x4*)(H + o) = v; }
                __builtin_amdgcn_sched_barrier(0);
            }
    }
};
struct EpiH1 {
    static constexpr bool PERM = true; static constexpr int HOOK_T = -1;
    bf16* O; const float* X;
    __device__ __forceinline__ void operator()(const Acc& acc, const Unit& u, int wr, int wc, int fr, int fq) const {
        const int row0 = u.pm * 256 + wr * 64 + fr, col0 = u.pn * 256 + wc * 32 + 8 * fq;
#pragma unroll
        for (int ai = 0; ai < 2; ++ai) {
            f32x4 xv[4][2][2];
#pragma unroll
            for (int m = 0; m < 4; ++m)
#pragma unroll
                for (int bj = 0; bj < 2; ++bj) { const float* xp = X + (size_t)(row0 + ai * 128 + m * 16) * D + col0 + bj * 128; xv[m][bj][0] = *(const f32x4*)xp; xv[m][bj][1] = *(const f32x4*)(xp + 4); }
            __builtin_amdgcn_sched_barrier(0);
#pragma unroll
            for (int m = 0; m < 4; ++m)
#pragma unroll
                for (int bj = 0; bj < 2; ++bj) st8(O + (size_t)(row0 + ai * 128 + m * 16) * D + col0 + bj * 128, acc[ai][bj][m][0] + xv[m][bj][0], acc[ai][bj][m][1] + xv[m][bj][1]);
            __builtin_amdgcn_sched_barrier(0);
        }
    }
};
struct EpiMerge {
    static constexpr bool PERM = true; static constexpr int HOOK_T = 2;
    bf16* O; const bf16* GA; const bf16* GG;
    __device__ __forceinline__ void mid(Acc& acc, const Unit& u, int wr, int wc, int fr, int fq) const {
        int row0 = u.pm * 256 + wr * 64 + fr; const int col0 = u.pn * 256 + wc * 32 + 8 * fq;
        asm volatile("" : "+v"(row0));
#pragma unroll
        for (int ai = 0; ai < 2; ++ai)
#pragma unroll
            for (int mb = 0; mb < 4; mb += 2) {
                v4u aw[2][2], gw[2][2];
#pragma unroll
                for (int m = 0; m < 2; ++m)
#pragma unroll
                    for (int bj = 0; bj < 2; ++bj) { const size_t off = (size_t)(row0 + ai * 128 + (mb + m) * 16) * D + col0 + bj * 128; aw[m][bj] = *(const v4u*)(GA + off); gw[m][bj] = *(const v4u*)(GG + off); }
                __builtin_amdgcn_sched_barrier(0);
#pragma unroll
                for (int m = 0; m < 2; ++m)
#pragma unroll
                    for (int bj = 0; bj < 2; ++bj) { const v4u a = aw[m][bj], g = gw[m][bj];
                        acc[ai][bj][mb + m][0] = acc[ai][bj][mb + m][0] * (f32x4){bflo(a.x) * __builtin_amdgcn_rcpf(fmaxf(bflo(g.x), 1e-30f)), bfhi(a.x) * __builtin_amdgcn_rcpf(fmaxf(bfhi(g.x), 1e-30f)), bflo(a.y) * __builtin_amdgcn_rcpf(fmaxf(bflo(g.y), 1e-30f)), bfhi(a.y) * __builtin_amdgcn_rcpf(fmaxf(bfhi(g.y), 1e-30f))};
                        acc[ai][bj][mb + m][1] = acc[ai][bj][mb + m][1] * (f32x4){bflo(a.z) * __builtin_amdgcn_rcpf(fmaxf(bflo(g.z), 1e-30f)), bfhi(a.z) * __builtin_amdgcn_rcpf(fmaxf(bfhi(g.z), 1e-30f)), bflo(a.w) * __builtin_amdgcn_rcpf(fmaxf(bflo(g.w), 1e-30f)), bfhi(a.w) * __builtin_amdgcn_rcpf(fmaxf(bfhi(g.w), 1e-30f))}; }
                __builtin_amdgcn_sched_barrier(0);
            }
    }
    __device__ __forceinline__ void operator()(const Acc& acc, const Unit& u, int wr, int wc, int fr, int fq) const {
        const int row0 = u.pm * 256 + wr * 64 + fr, col0 = u.pn * 256 + wc * 32 + 8 * fq;
#pragma unroll
        for (int ai = 0; ai < 2; ++ai) {
            v4u gw[4][2];
#pragma unroll
            for (int m = 0; m < 4; ++m)
#pragma unroll
                for (int bj = 0; bj < 2; ++bj) gw[m][bj] = *(const v4u*)(GG + (size_t)(row0 + ai * 128 + m * 16) * D + col0 + bj * 128);
            __builtin_amdgcn_sched_barrier(0);
#pragma unroll
            for (int m = 0; m < 4; ++m)
#pragma unroll
                for (int bj = 0; bj < 2; ++bj) { const v4u g = gw[m][bj];
                    st8(O + (size_t)(row0 + ai * 128 + m * 16) * D + col0 + bj * 128, acc[ai][bj][m][0] * (f32x4){bflo(g.x), bfhi(g.x), bflo(g.y), bfhi(g.y)}, acc[ai][bj][m][1] * (f32x4){bflo(g.z), bfhi(g.z), bflo(g.w), bfhi(g.w)}); }
            __builtin_amdgcn_sched_barrier(0);
        }
    }
};
struct EpiPle {
    static constexpr bool PERM = true; static constexpr int HOOK_T = -1;
    bf16* O; const bf16* PP; const float* RS;
    __device__ __forceinline__ void operator()(const Acc& acc, const Unit& u, int wr, int wc, int fr, int fq) const {
        const int row0 = u.pm * 256 + wr * 64 + fr, col0 = u.pn * 256 + wc * 32 + 8 * fq;
#pragma unroll
        for (int ai = 0; ai < 2; ++ai) {
            v4u pw[4][2]; float rs[4];
#pragma unroll
            for (int m = 0; m < 4; ++m) rs[m] = RS[row0 + ai * 128 + m * 16];
#pragma unroll
            for (int m = 0; m < 4; ++m)
#pragma unroll
                for (int bj = 0; bj < 2; ++bj) pw[m][bj] = *(const v4u*)(PP + (size_t)(row0 + ai * 128 + m * 16) * D + col0 + bj * 128);
            __builtin_amdgcn_sched_barrier(0);
#pragma unroll
            for (int m = 0; m < 4; ++m)
#pragma unroll
                for (int bj = 0; bj < 2; ++bj) { const v4u w = pw[m][bj];
                    const f32x4 v0 = sigm4(acc[ai][bj][m][0] * rs[m]) * (f32x4){bflo(w.x), bfhi(w.x), bflo(w.y), bfhi(w.y)}, v1 = sigm4(acc[ai][bj][m][1] * rs[m]) * (f32x4){bflo(w.z), bfhi(w.z), bflo(w.w), bfhi(w.w)};
                    st8(O + (size_t)(row0 + ai * 128 + m * 16) * D + col0 + bj * 128, v0, v1); }
            __builtin_amdgcn_sched_barrier(0);
        }
    }
};
struct EpiMoeUp {
    static constexpr bool PERM = true; static constexpr int HOOK_T = -1;
    bf16* ACT; const float* bgu; const float* srstd; const LAS int* ts;
    __device__ __forceinline__ void operator()(const Acc& acc, const Unit& u, int wr, int wc, int fr, int fq) const {
        const int e = u.x0, cnt = ts[40 + e], srow0 = u.x1 * 256 + wr * 64 + fr;
        const int row0 = u.pm * 256 + wr * 64 + fr, hc = u.pn * 128 + wc * 32 + 8 * fq;
        const float* bg = bgu + (size_t)e * 2048 + hc;
        const f32x4 bg0 = *(const f32x4*)bg, bg1 = *(const f32x4*)(bg + 4), bl0 = *(const f32x4*)(bg + 1024), bl1 = *(const f32x4*)(bg + 1028);
        float rsv[2][4];
#pragma unroll
        for (int ai = 0; ai < 2; ++ai)
#pragma unroll
            for (int m = 0; m < 4; ++m) { const int slot = srow0 + ai * 128 + m * 16; rsv[ai][m] = slot < cnt ? srstd[e * 32768 + slot] : 0.f; }
        __builtin_amdgcn_sched_barrier(0);
#pragma unroll
        for (int ai = 0; ai < 2; ++ai)
#pragma unroll
            for (int m = 0; m < 4; ++m) { const float rs = rsv[ai][m];
                f32x4 o[2];
#pragma unroll
                for (int n = 0; n < 2; ++n) { const f32x4 gu = acc[ai][0][m][n] * rs + (n ? bg1 : bg0), li = acc[ai][1][m][n] * rs + (n ? bl1 : bl0);
#pragma unroll
                    for (int e2 = 0; e2 < 4; ++e2) { const float gl = fminf(gu[e2], 7.0f), ln = fminf(fmaxf(li[e2], -7.0f), 7.0f);
                        o[n][e2] = gl * __builtin_amdgcn_rcpf(1.0f + __builtin_amdgcn_exp2f(-1.702f * LOG2E * gl)) * (ln + 1.0f); } }
                st8(ACT + (size_t)(row0 + ai * 128 + m * 16) * D + hc, o[0], o[1]); }
    }
};
struct EpiMoeDown {
    static constexpr bool PERM = true; static constexpr int HOOK_T = -1;
    bf16* Y; const float* bd; const float* sgate; const LAS int* ts;
    __device__ __forceinline__ void operator()(const Acc& acc, const Unit& u, int wr, int wc, int fr, int fq) const {
        const int e = u.x0, cnt = ts[40 + e], srow0 = u.x1 * 256 + wr * 64 + fr, col0 = u.pn * 256 + wc * 32 + 8 * fq;
        const float* bp = bd + (size_t)e * D + col0;
        f32x4 bv[2][2];
#pragma unroll
        for (int bj = 0; bj < 2; ++bj) { bv[bj][0] = *(const f32x4*)(bp + bj * 128); bv[bj][1] = *(const f32x4*)(bp + bj * 128 + 4); }
        float gtv[2][4];
#pragma unroll
        for (int ai = 0; ai < 2; ++ai)
#pragma unroll
            for (int m = 0; m < 4; ++m) { const int slot = srow0 + ai * 128 + m * 16; gtv[ai][m] = slot < cnt ? sgate[e * 32768 + slot] : 0.f; }
        __builtin_amdgcn_sched_barrier(0);
#pragma unroll
        for (int ai = 0; ai < 2; ++ai)
#pragma unroll
            for (int m = 0; m < 4; ++m) { const float gt = gtv[ai][m];
                bf16* rowp = Y + (size_t)(u.pm * 256 + wr * 64 + fr + ai * 128 + m * 16) * D + col0;
#pragma unroll
                for (int bj = 0; bj < 2; ++bj) st8(rowp + bj * 128, (acc[ai][bj][m][0] + bv[bj][0]) * gt, (acc[ai][bj][m][1] + bv[bj][1]) * gt); }
    }
};

#define XB_TMO      128
#define XB_XCNT(j)  (256  + 64 * (j))
#define XB_XSUB(j)  (1280 + 64 * (j))
#define XB_XGEN(j)  (2304 + 64 * (j))
#define XB_TOP      3328
#define XB_TOPGEN   3392
#define XCD_BAR_WORDS 3456
#define XB_SPIN_CAP (1u << 18)
__device__ __forceinline__ unsigned xb_ld(unsigned* p)              { return __hip_atomic_load(p, __ATOMIC_RELAXED, __HIP_MEMORY_SCOPE_AGENT); }
__device__ __forceinline__ unsigned xb_add(unsigned* p, unsigned v) { return __hip_atomic_fetch_add(p, v, __ATOMIC_RELAXED, __HIP_MEMORY_SCOPE_AGENT); }
__device__ __forceinline__ unsigned xb_xcc_id() { return (unsigned)__builtin_amdgcn_s_getreg((3 << 11) | 20) & 0xFu; }
#define XB_SPIN(cond, bar) do { unsigned _sp = 0; while (cond) { __builtin_amdgcn_s_sleep(1); \
    if ((++_sp & 255u) == 0u) { if (xb_ld(&(bar)[XB_TMO])) break; if (_sp > XB_SPIN_CAP) { atomicAdd(&(bar)[XB_TMO], 1u); break; } } } } while (0)
struct XcdBarrier { unsigned* bar; unsigned x; volatile LAS unsigned* st; int wave; };
__device__ __forceinline__ XcdBarrier xcd_barrier_post(unsigned* bar, volatile LAS unsigned* st, int wave) {
    XcdBarrier b; b.bar = bar; b.x = xb_xcc_id(); b.st = st; b.wave = wave;
    if (tid_opaque(wave) == 0) (void)xb_add(&bar[XB_XCNT(b.x)], 1u);
    return b;
}
__device__ __forceinline__ void xcd_barrier_complete(unsigned* bar, unsigned x, unsigned& nloc, unsigned& nx) {
    const unsigned G = gridDim.x * gridDim.y * gridDim.z;
    unsigned sum, cnt, mine, sp = 0u;
    for (;;) {
        sum = 0u; cnt = 0u; mine = 0u;
#pragma unroll
        for (unsigned j = 0; j < 16; ++j) { const unsigned c = xb_ld(&bar[XB_XCNT(j)]); sum += c; cnt += (c > 0u) ? 1u : 0u; mine = (j == x) ? c : mine; }
        if (sum == G) break;
        __builtin_amdgcn_s_sleep(1);
        if ((++sp & 255u) == 0u) { if (xb_ld(&bar[XB_TMO])) break; if (sp > XB_SPIN_CAP) { atomicAdd(&bar[XB_TMO], 1u); break; } }
    }
    nloc = mine > 0u ? mine : 1u; nx = cnt > 0u ? cnt : 1u;
}
__device__ __forceinline__ void xcd_barrier(const XcdBarrier& b) {
    asm volatile("s_waitcnt vmcnt(0)" ::: "memory");
    __syncthreads();
    if (tid_opaque(b.wave) == 0) {
        unsigned* bar = b.bar;
        __builtin_amdgcn_s_waitcnt(0);
        unsigned nloc = b.st[0], nx = b.st[1];
        if (nloc == 0u) { xcd_barrier_complete(bar, b.x, nloc, nx); b.st[0] = nloc; b.st[1] = nx; }
        const unsigned old = xb_add(&bar[XB_XSUB(b.x)], 1u);
        const unsigned gen = old / nloc;
        if (old + 1u == (gen + 1u) * nloc) {
            __builtin_amdgcn_fence(__ATOMIC_RELEASE, "agent");
            asm volatile("s_waitcnt vmcnt(0)" ::: "memory");
            const unsigned og = xb_add(&bar[XB_TOP], 1u);
            const unsigned tg = og / nx;
            if (og + 1u == (tg + 1u) * nx) xb_add(&bar[XB_TOPGEN], 1u);
            else XB_SPIN(xb_ld(&bar[XB_TOPGEN]) == tg, bar);
            __builtin_amdgcn_fence(__ATOMIC_ACQUIRE, "agent");
            xb_add(&bar[XB_XGEN(b.x)], 1u);
            asm volatile("s_waitcnt vmcnt(0)" ::: "memory");
        } else {
            XB_SPIN(xb_ld(&bar[XB_XGEN(b.x)]) == gen, bar);
            __builtin_amdgcn_fence(__ATOMIC_ACQUIRE, "agent");
            asm volatile("s_waitcnt vmcnt(0)" ::: "memory");
        }
    }
    __syncthreads();
}

struct Args { const float* in[23]; float* out; unsigned char* ws; int ph_lo, ph_hi; };
struct Frame {
    LAS unsigned char* lds; int wave, vcu, G;
};
#define LDS_WAIT() asm volatile("s_waitcnt lgkmcnt(0)" ::: "memory")

__device__ __forceinline__ int t5_bucket(int n) {
    if (n < 16) return n;
    const int th[15] = {22, 30, 40, 54, 73, 99, 134, 182, 246, 332, 450, 609, 825, 1117, 1513};
    int b = 16;
#pragma unroll
    for (int k = 0; k < 15; ++k) b += (n >= th[k]) ? 1 : 0;
    return b;
}

__device__ __forceinline__ void transpose_item(const float* W, int K, int N, bf16* WT, int drow0, LAS float* scr, int k0, int n0, int lane, int kdst = 0) {
    const int q = lane & 15, kr = lane >> 4;
    f32x4 v[8];
#pragma unroll
    for (int i = 0; i < 8; ++i) v[i] = *(const f32x4*)(W + (size_t)(k0 + 4 * i + kr) * N + n0 + 4 * q);
#pragma unroll
    for (int i = 0; i < 8; ++i) { LAS float* d = scr + (4 * q) * 33 + 4 * i + kr; d[0] = v[i].x; d[33] = v[i].y; d[66] = v[i].z; d[99] = v[i].w; }
    LDS_WAIT(); asm volatile("" ::: "memory");
    const int c4 = lane & 3, nr = lane >> 2;
#pragma unroll
    for (int j = 0; j < 4; ++j) { const int n = nr + 16 * j; const LAS float* sp = scr + n * 33 + 8 * c4;
        v4u o; o.x = pk2(sp[0], sp[1]); o.y = pk2(sp[2], sp[3]); o.z = pk2(sp[4], sp[5]); o.w = pk2(sp[6], sp[7]);
        *(v4u*)(WT + (size_t)(drow0 + n) * K + kdst + k0 + 8 * c4) = o; }
    LDS_WAIT(); asm volatile("" ::: "memory");
}
constexpr int BG_GU = 32 * 32 * 32, BG_DN = 32 * 32 * 16, BG_N = BG_GU + BG_DN;
constexpr int BG_P1 = 32768;
struct BgItem { const float* W; bf16* WT; const float* sc; int N, k0, n0, drow0, pitch, kdst; };
constexpr int BG_X0 = BG_N, BG_X1 = BG_X0 + 8 * 16, BG_X2 = BG_X1 + 24 * 16, BG_X3 = BG_X2 + 32 * 16, BG_X4 = BG_X3 + 32 * 16, BG_ALL = BG_X4 + 8 * 16;
__device__ __forceinline__ BgItem bg_decode(const Args& A, int r) {
    BgItem it; it.pitch = D; it.kdst = 0; it.sc = nullptr;
    if (r < BG_GU) { const int e = r >> 10, q = r & 1023, kb = q >> 5, nb = q & 31, n0 = nb * 64;
        it.W = A.in[15] + (size_t)e * D * 2048; it.WT = (bf16*)(A.ws + WS_WGU) + (size_t)e * 2048 * D; it.N = 2048; it.sc = A.in[12]; it.k0 = kb * 32; it.n0 = n0;
        it.drow0 = n0 < 1024 ? 256 * (n0 >> 7) + (n0 & 127) : 256 * ((n0 - 1024) >> 7) + 128 + (n0 & 127);
    } else if (r < BG_N) { r -= BG_GU; const int e = r >> 9, q = r & 511, kb = q >> 4, nb = q & 15;
        it.W = A.in[17] + (size_t)e * D * D; it.WT = (bf16*)(A.ws + WS_WD) + (size_t)e * D * D; it.N = D; it.k0 = kb * 32; it.n0 = nb * 64; it.drow0 = nb * 64;
    } else { int src; bf16* dst;
        if (r < BG_X1) { r -= BG_X0; src = 5; dst = (bf16*)(A.ws + WS_WCAT); }
        else if (r < BG_X2) { r -= BG_X1; src = 10; dst = (bf16*)(A.ws + WS_WCAT); it.kdst = 256; }
        else if (r < BG_X3) { r -= BG_X2; src = 11; dst = (bf16*)(A.ws + WS_WOUT); }
        else if (r < BG_X4) { r -= BG_X3; src = 20; dst = (bf16*)(A.ws + WS_WPG); }
        else { r -= BG_X4; src = 21; dst = (bf16*)(A.ws + WS_WPP); it.pitch = PLE; }
        it.W = src == 5 ? A.in[5] : src == 10 ? A.in[10] : src == 11 ? A.in[11] : src == 20 ? A.in[20] : A.in[21];
        if (src == 20) it.sc = A.in[19];
        it.WT = dst; it.N = D; it.k0 = (r >> 4) * 32; it.n0 = (r & 15) * 64; it.drow0 = it.n0; }
    return it;
}
struct BgConv {
    int cur, next, stride, end; f32x4 v[8]; float gs[8];
    __device__ __forceinline__ void init(int first, int stride_, int end_ = BG_ALL) { cur = -1; next = first; stride = stride_; end = end_; }
    __device__ __forceinline__ void issue(const Args& A, int lane) {
        if (next < end) { const BgItem it = bg_decode(A, next); const int q = lane & 15, kr = lane >> 4;
#pragma unroll
            for (int i = 0; i < 8; ++i) v[i] = *(const f32x4*)(it.W + (size_t)(it.k0 + 4 * i + kr) * it.N + it.n0 + 4 * q);
            if (it.sc) {
#pragma unroll
                for (int i = 0; i < 8; ++i) gs[i] = it.sc[it.k0 + 4 * i + kr]; } else {
#pragma unroll
                for (int i = 0; i < 8; ++i) gs[i] = 1.0f; }
            cur = next; next += stride; } else cur = -1;
    }
    __device__ __forceinline__ void finish(const Args& A, LAS float* scr, int lane) {
        if (cur >= 0) { const BgItem it = bg_decode(A, cur); const int q = lane & 15, kr = lane >> 4;
#pragma unroll
            for (int i = 0; i < 8; ++i) { LAS float* d = scr + (4 * q) * 33 + 4 * i + kr; const float g = gs[i]; d[0] = v[i].x * g; d[33] = v[i].y * g; d[66] = v[i].z * g; d[99] = v[i].w * g; }
            LDS_WAIT(); asm volatile("" ::: "memory");
            const int c4 = lane & 3, nr = lane >> 2;
#pragma unroll
            for (int j = 0; j < 4; ++j) { const int n = nr + 16 * j; const LAS float* sp = scr + n * 33 + 8 * c4;
                v4u o; o.x = pk2(sp[0], sp[1]); o.y = pk2(sp[2], sp[3]); o.z = pk2(sp[4], sp[5]); o.w = pk2(sp[6], sp[7]);
                *(v4u*)(it.WT + (size_t)(it.drow0 + n) * it.pitch + it.kdst + it.k0 + 8 * c4) = o; }
            LDS_WAIT(); asm volatile("" ::: "memory");
            cur = -1; }
    }
};
__device__ __forceinline__ void convert_queue(const Frame& F, const Args& A, unsigned* ctr, int lo, int hi) {
    const int tidx_ = tid_opaque(F.wave);
    LAS float* scr = (LAS float*)(F.lds + F.wave * 8448);
    LAS int* qs = (LAS int*)(F.lds + RING_BYTES + 512);
    const int lane = tidx_ & 63;
    BgConv c0, c1;
    for (;;) {
        __syncthreads();
        if (tidx_ == 0) *qs = (int)__hip_atomic_fetch_add(ctr, 64u, __ATOMIC_RELAXED, __HIP_MEMORY_SCOPE_AGENT);
        __syncthreads();
        const int base = __builtin_amdgcn_readfirstlane(*qs) + lo + F.wave * 8;
        if (base - F.wave * 8 >= hi) break;
        c0.init(base, 2, base + 8 < hi ? base + 8 : hi); c1.init(base + 1, 2, base + 8 < hi ? base + 8 : hi);
        c0.issue(A, lane); c1.issue(A, lane);
#pragma unroll 1
        for (int k = 0; k < 4; ++k) { c0.finish(A, scr, lane); c0.issue(A, lane); c1.finish(A, scr, lane); c1.issue(A, lane); }
    }
}
__device__ __forceinline__ void convert_p_queue(const Frame& F, const Args& A, unsigned* ctr) {
    const int tidx_ = tid_opaque(F.wave);
    const int lane = tidx_ & 63; const float* p = A.in[1]; bf16* pb = (bf16*)(A.ws + WS_PB);
    LAS int* qs = (LAS int*)(F.lds + RING_BYTES + 512);
    for (;;) {
        __syncthreads();
        if (tidx_ == 0) *qs = (int)__hip_atomic_fetch_add(ctr, 8u, __ATOMIC_RELAXED, __HIP_MEMORY_SCOPE_AGENT);
        __syncthreads();
        const int ck0 = __builtin_amdgcn_readfirstlane(*qs);
        if (ck0 >= (T * PLE) / 8192) break;
        const size_t base = (size_t)(ck0 + F.wave) * 8192 + 8 * lane;
#pragma unroll 4
        for (int i = 0; i < 16; ++i) { const f32x4 a = *(const f32x4*)(p + base + 512 * i), b = *(const f32x4*)(p + base + 512 * i + 4); st8(pb + base + 512 * i, a, b); }
    }
}
constexpr int BG_SCR_OFF = 45056;
__device__ __forceinline__ int win_dest(int n0) {
    if (n0 < 1536) return n0;
    if (n0 < 2304) return 4352 + (n0 - 1536);
    if (n0 < 3072) return 1536 + (n0 - 2304);
    if (n0 < 3840) return 5120 + (n0 - 3072);
    return 2304 + (n0 - 3840);
}
template <int NR> __device__ __forceinline__ void rms_rows_to_bf16(const float* xrow, const float* gain, bf16* orow, int lane) {
    f32x4 v[NR][4]; float s[NR];
#pragma unroll
    for (int r = 0; r < NR; ++r)
#pragma unroll
        for (int j = 0; j < 4; ++j) v[r][j] = ((const f32x4*)(xrow + (size_t)r * D) + lane)[64 * j];
    f32x4 g[4];
#pragma unroll
    for (int j = 0; j < 4; ++j) g[j] = ((const f32x4*)gain + lane)[64 * j];
#pragma unroll
    for (int r = 0; r < NR; ++r) { float a = 0.f;
#pragma unroll
        for (int j = 0; j < 4; ++j) a += (v[r][j].x * v[r][j].x + v[r][j].y * v[r][j].y) + (v[r][j].z * v[r][j].z + v[r][j].w * v[r][j].w);
        s[r] = a; }
#pragma unroll
    for (int o = 1; o < 64; o <<= 1)
#pragma unroll
        for (int r = 0; r < NR; ++r) s[r] += __shfl_xor(s[r], o);
#pragma unroll
    for (int r = 0; r < NR; ++r) { const float rstd = 1.0f / sqrtf(s[r] * (1.f / D) + EPS);
        unsigned long long* o8 = (unsigned long long*)(orow + (size_t)r * D) + lane;
#pragma unroll
        for (int j = 0; j < 4; ++j) o8[64 * j] = (unsigned long long)pk2(v[r][j].x * rstd * g[j].x, v[r][j].y * rstd * g[j].y) | ((unsigned long long)pk2(v[r][j].z * rstd * g[j].z, v[r][j].w * rstd * g[j].w) << 32); }
}
__device__ __forceinline__ void p0_prologue(const Frame& F, const Args& A) {
    const int tidx_ = tid_opaque(F.wave);
    LAS float* scr = (LAS float*)(F.lds + F.wave * 16384);
    const int gw = F.vcu * 8 + F.wave, NGW = F.G * 8;
    unsigned char* ws = A.ws;
    for (int m = gw * 4; m < T; m += NGW * 4) rms_rows_to_bf16<4>(A.in[0] + (size_t)m * D, A.in[2], (bf16*)(ws + WS_NX) + (size_t)m * D, (tidx_ & 63));
    { const float* wsp = A.in[8]; bf16* o = (bf16*)(ws + WS_WSP);
      for (int i = (blockIdx.x * 512 + tidx_) * 4; i < 12 * 128 * 128; i += F.G * 512 * 4) { const int col = i & 127, row = (i >> 7) & 127; const f32x4 a = *(const f32x4*)(wsp + i);
          v2u w; w.x = pk2(col <= row ? a.x : 0.f, col + 1 <= row ? a.y : 0.f); w.y = pk2(col + 2 <= row ? a.z : 0.f, col + 3 <= row ? a.w : 0.f); *(v2u*)(o + i) = w; } }
    { const float* wrt = A.in[13]; bf16* wh = (bf16*)(ws + WS_WRH); bf16* wl = (bf16*)(ws + WS_WRL);
      for (int i = blockIdx.x * 512 + tidx_; i < 32 * 1024; i += F.G * 512) { const int e = i >> 10, k = i & 1023; const float w = wrt[k * 32 + e]; const unsigned h = f2bf(w); wh[i] = (bf16)h; wl[i] = (bf16)f2bf(w - bflo(h)); } }
    constexpr int I_IN = 32 * 92;
    for (int it = gw; it < I_IN; it += NGW) { const int kb = it / 92, nb = it % 92; transpose_item(A.in[3], D, IN_W, (bf16*)(ws + WS_WIN), win_dest(nb * 64), scr, kb * 32, nb * 64, (tidx_ & 63)); }
}

__device__ __forceinline__ int crow(int r, int hi) { return (r & 3) + 8 * (r >> 2) + 4 * hi; }
struct AtU { int b, g, h, r, qb8, nqb; };
__device__ __forceinline__ AtU at_decode(int pr) { AtU u; const int slot = pr & 15; u.h = (pr >> 4) & 3; const int bgi = pr >> 6; u.g = bgi % 3; u.b = bgi / 3; u.nqb = 128 >> (2 * u.g);
    u.r = slot / (u.nqb >> 3); u.qb8 = slot % (u.nqb >> 3); return u; }
__device__ __forceinline__ void at_load(const AtU& u, const bf16* QT, const bf16* KT, const bf16* VT, int w, int r32, int hi, int q8, int t8, v4u (&stg)[12], bf16x8 (&qf)[4]) {
    const size_t tb0 = (size_t)((u.b * 3 + u.g) * 4 + u.h) * 128 + (size_t)(u.r * u.nqb);
    const bf16* qt = QT + (tb0 + u.qb8 * 8 + w) * 2048 + r32 * 64 + 8 * hi;
#pragma unroll
    for (int s = 0; s < 4; ++s) qf[s] = *(const bf16x8*)(qt + 16 * s);
#pragma unroll
    for (int i = 0; i < 12; ++i) { const int kv = i >= 6 ? 1 : 0, j = 2 * (i - 6 * kv) + t8; int kb = u.qb8 * 8 - 4 + j; kb = kb < 0 ? 0 : kb;
        stg[i] = *(const v4u*)((kv ? VT : KT) + (tb0 + kb) * 2048 + q8 * 8); }
}
__device__ __forceinline__ void attn_phase(const Frame& F, const Args& A) {
    const int tidx_ = tid_opaque(F.wave);
    LAS float* tb = (LAS float*)(F.lds + RING_BYTES + 2048);
    const float* rel_bias = A.in[4];
    for (int i = tidx_; i < 12 * 192; i += 512) { const int gh = i / 192, dist = i % 192 - 31, g = gh >> 2; const int dil = g == 0 ? 1 : (g == 1 ? 4 : 16);
        tb[i] = (dist >= 0 && dist <= 128) ? rel_bias[t5_bucket(dist * dil) * 12 + gh] * LOG2E : -INFINITY; }
    __syncthreads();
    const bf16* QT = (const bf16*)(A.ws + WS_Q); const bf16* KT = (const bf16*)(A.ws + WS_K); const bf16* VT = (const bf16*)(A.ws + WS_VT);
    bf16* OG = (bf16*)(A.ws + WS_OG); float* LSE = (float*)(A.ws + WS_LSE);
    const int lane = (tidx_ & 63), r32 = lane & 31, hi = lane >> 5, w = F.wave;
    const int q8 = tidx_ & 255, t8 = tidx_ >> 8;
    const int NU = NB * 3 * 4 * 16;
    v4u stg[12]; bf16x8 qf[4];
    if (F.vcu < NU) at_load(at_decode(F.vcu), QT, KT, VT, w, r32, hi, q8, t8, stg, qf);
    for (int pr = F.vcu; pr < NU; pr += F.G) {
        const AtU u = at_decode(pr);
        const int dsh = 2 * u.g, dil = 1 << dsh, g = u.g, h = u.h, b = u.b, r = u.r;
        const int qb = u.qb8 * 8 + w, i0 = qb * 32;
        __syncthreads();
        { const int keyk = q8 >> 3, posk = keyk * 8 + ((q8 & 7) ^ ((keyk >> 1) & 7)), dv = q8 >> 2, posv = dv * 4 + ((q8 & 3) ^ ((dv >> 2) & 3));
#pragma unroll
          for (int i = 0; i < 12; ++i) { const int kv = i >= 6 ? 1 : 0, j = 2 * (i - 6 * kv) + t8;
              *(LAS v4u*)(F.lds + kv * 49152 + j * 4096 + (kv ? posv : posk) * 16) = stg[i]; } }
        bf16x8 qc[4];
#pragma unroll
        for (int s = 0; s < 4; ++s) qc[s] = qf[s];
        __syncthreads();
        if (pr + F.G < NU) at_load(at_decode(pr + F.G), QT, KT, VT, w, r32, hi, q8, t8, stg, qf);
        __builtin_amdgcn_sched_barrier(0);
        const LAS unsigned char* kbase = F.lds + w * 4096 + (r32 * 8) * 16;
        const int kx = (r32 >> 1) & 7;
        f32x16 st[5];
#pragma unroll
        for (int kt = 0; kt < 5; ++kt) {
            f32x16 a = {};
#pragma unroll
            for (int s = 0; s < 4; ++s) { const bf16x8 kf = *(const LAS bf16x8*)(kbase + kt * 4096 + (((2 * s + hi) ^ kx) << 4)); a = __builtin_amdgcn_mfma_f32_32x32x16_bf16(kf, qc[s], a, 0, 0, 0); }
            st[kt] = a;
        }
        const LAS float* tbh = tb + (g * 4 + h) * 192;
        float mx = -INFINITY;
#pragma unroll
        for (int kt = 0; kt < 5; ++kt)
#pragma unroll
            for (int i = 0; i < 16; ++i) { const int kr = crow(i, hi), krel = -128 + 32 * kt + kr; const int dist = r32 - krel;
                float v = st[kt][i] + tbh[dist + 31]; v = (i0 + krel >= 0) ? v : -INFINITY; st[kt][i] = v; mx = fmaxf(mx, v); }
        mx = fmaxf(mx, __shfl_xor(mx, 32));
        float l = 0.f;
#pragma unroll
        for (int kt = 0; kt < 5; ++kt)
#pragma unroll
            for (int i = 0; i < 16; ++i) { const float p = __builtin_amdgcn_exp2f(st[kt][i] - mx); st[kt][i] = p; l += p; }
        l += __shfl_xor(l, 32);
        const LAS unsigned char* vbase = F.lds + 49152 + w * 4096;
        f32x16 o[2] = {};
#pragma unroll
        for (int kt = 0; kt < 5; ++kt)
#pragma unroll
            for (int s2 = 0; s2 < 2; ++s2) {
                v4u pw; pw.x = cvt_pk_bf16(st[kt][8 * s2 + 0], st[kt][8 * s2 + 1]); pw.y = cvt_pk_bf16(st[kt][8 * s2 + 2], st[kt][8 * s2 + 3]);
                pw.z = cvt_pk_bf16(st[kt][8 * s2 + 4], st[kt][8 * s2 + 5]); pw.w = cvt_pk_bf16(st[kt][8 * s2 + 6], st[kt][8 * s2 + 7]);
                const bf16x8 pf = __builtin_bit_cast(bf16x8, pw);
#pragma unroll
                for (int dt = 0; dt < 2; ++dt) { const int dd = 32 * dt + r32;
                    const LAS unsigned char* vr = vbase + kt * 4096 + dd * 64 + 8 * hi; const int vx = (dd >> 2) & 3;
                    const v2u p1 = *(const LAS v2u*)(vr + (((2 * s2) ^ vx) << 4)), p2 = *(const LAS v2u*)(vr + (((2 * s2 + 1) ^ vx) << 4));
                    v4u vw; vw.x = p1.x; vw.y = p1.y; vw.z = p2.x; vw.w = p2.y;
                    o[dt] = __builtin_amdgcn_mfma_f32_32x32x16_bf16(__builtin_bit_cast(bf16x8, vw), pf, o[dt], 0, 0, 0); }
            }
        const float rl = 1.0f / l;
        const size_t qrow = (size_t)b * SEQ + (size_t)(i0 + r32) * dil + r;
        bf16* op = OG + ((size_t)g * T + qrow) * 256 + h * 64;
#pragma unroll
        for (int dt = 0; dt < 2; ++dt)
#pragma unroll
            for (int gp = 0; gp < 2; ++gp) { v2u wa, wb;
                wa.x = cvt_pk_bf16(o[dt][8 * gp] * rl, o[dt][8 * gp + 1] * rl); wa.y = cvt_pk_bf16(o[dt][8 * gp + 2] * rl, o[dt][8 * gp + 3] * rl);
                wb.x = cvt_pk_bf16(o[dt][8 * gp + 4] * rl, o[dt][8 * gp + 5] * rl); wb.y = cvt_pk_bf16(o[dt][8 * gp + 6] * rl, o[dt][8 * gp + 7] * rl);
                *(v4u*)(op + 32 * dt + 16 * gp + 8 * hi) = widen_pair(wa, wb); }
        if (hi == 0) LSE[((size_t)g * T + qrow) * 4 + h] = (mx + __builtin_amdgcn_logf(l)) * LN2;
    }
    __syncthreads();
}

__device__ __forceinline__ void spatial_phase(const Frame& F, const Args& A) {
    const int tidx_ = tid_opaque(F.wave);
    const bf16* ZVT = (const bf16*)(A.ws + WS_ZVT); const bf16* ZU = (const bf16*)(A.ws + WS_ZU); const bf16* WSP = (const bf16*)(A.ws + WS_WSP);
    bf16* Gout = (bf16*)(A.ws + WS_AG) + 256;
    const float* lng = A.in[6]; const float* lnb = A.in[7]; const float* bsp = A.in[9];
    LAS float* red = (LAS float*)(F.lds + 10240);
    LAS float* stt = (LAS float*)(F.lds + 43008);
    LAS unsigned char* vn = F.lds + 49152;
    int lane = (tidx_ & 63); asm volatile("" : "+v"(lane));
    const int r32 = lane & 31, hi = lane >> 5, w = F.wave;
    const int dr = 8 * w + (lane >> 3), ck = lane & 7;
    for (int c = F.vcu; c < T / 128; c += F.G) {
        v4u zr[2];
#pragma unroll
        for (int p = 0; p < 2; ++p) zr[p] = *(const v4u*)(ZVT + ((size_t)c * GM_W + dr) * 128 + 8 * (ck + 8 * p));
        {
            const int tg = tidx_ & 15, rg = tidx_ >> 4; float sm[8], q[8];
#pragma unroll
            for (int e = 0; e < 8; ++e) { sm[e] = 0.f; q[e] = 0.f; }
#pragma unroll 4
            for (int ch = rg; ch < GM_W; ch += 32) { const v4u wv = *(const v4u*)(ZVT + ((size_t)c * GM_W + ch) * 128 + 8 * tg);
                const float x[8] = {bflo(wv.x), bfhi(wv.x), bflo(wv.y), bfhi(wv.y), bflo(wv.z), bfhi(wv.z), bflo(wv.w), bfhi(wv.w)};
#pragma unroll
                for (int e = 0; e < 8; ++e) { sm[e] += x[e]; q[e] += x[e] * x[e]; } }
#pragma unroll
            for (int e = 0; e < 8; ++e) { red[(rg * 128 + 8 * tg + e) * 2] = sm[e]; red[(rg * 128 + 8 * tg + e) * 2 + 1] = q[e]; }
            __syncthreads();
            if (tidx_ < 128) { float ss = 0.f, qq = 0.f;
                for (int k = 0; k < 32; ++k) { ss += red[(k * 128 + tidx_) * 2]; qq += red[(k * 128 + tidx_) * 2 + 1]; }
                const float mu = ss * (1.f / GM_W), var = fmaxf(qq * (1.f / GM_W) - mu * mu, 0.f);
                stt[tidx_ * 2] = mu; stt[tidx_ * 2 + 1] = 1.0f / sqrtf(var + EPS); }
            __syncthreads();
        }
#define SP_GROUP(GI, ZR_CUR, ZU_CUR, ZR_NXT, ZU_NXT) do { \
            const int gi_ = (GI); const int dt = w & 1, it = ((w >> 1) + gi_) & 3, ti = 32 * it + r32;       \
              \
            bf16x8 bfr[8]; \
            { const bf16* wp = WSP + ((size_t)gi_ * 128 + ti) * 128 + 8 * hi; \
              _Pragma("unroll") for (int s = 0; s < 8; ++s) bfr[s] = *(const bf16x8*)(wp + 16 * s); } \
            const float bsv = bsp[gi_ * 128 + ti], gch = lng[gi_ * 64 + dr], bch = lnb[gi_ * 64 + dr]; \
            __builtin_amdgcn_sched_barrier(0); \
              \
            LAS unsigned char* tile = vn + (gi_ & 1) * 16384; \
            _Pragma("unroll") for (int p = 0; p < 2; ++p) { const int jb = 8 * (ck + 8 * p); const v4u z = ZR_CUR[p]; \
                float x[8] = {bflo(z.x), bfhi(z.x), bflo(z.y), bfhi(z.y), bflo(z.z), bfhi(z.z), bflo(z.w), bfhi(z.w)}; \
                _Pragma("unroll") for (int e = 0; e < 8; ++e) x[e] = (x[e] - stt[(jb + e) * 2]) * stt[(jb + e) * 2 + 1] * gch + bch; \
                v4u aw; aw.x = cvt_pk_bf16(x[0], x[1]); aw.y = cvt_pk_bf16(x[2], x[3]); aw.z = cvt_pk_bf16(x[4], x[5]); aw.w = cvt_pk_bf16(x[6], x[7]); \
                *(LAS v4u*)(tile + dr * 256 + (((ck + 8 * p) ^ (dr & 15)) << 4)) = aw; } \
            { const int gn = gi_ + 1 < 12 ? gi_ + 1 : 11;        \
              _Pragma("unroll") for (int p = 0; p < 2; ++p) ZR_NXT[p] = *(const v4u*)(ZVT + ((size_t)c * GM_W + gn * 64 + dr) * 128 + 8 * (ck + 8 * p)); \
              const int itn = ((w >> 1) + gn) & 3; const size_t orow = ((size_t)c * 128 + 32 * itn + r32) * GM_W + gn * 64 + 32 * dt + 4 * hi; \
              _Pragma("unroll") for (int gq = 0; gq < 4; ++gq) ZU_NXT[gq] = *(const v2u*)(ZU + orow + 8 * gq); } \
            __syncthreads();                                    \
            f32x16 acc = {}; \
            { const int dd = 32 * dt + r32; const LAS unsigned char* ar = tile + dd * 256; \
              _Pragma("unroll") for (int s = 0; s < 8; ++s) { const bf16x8 af = *(const LAS bf16x8*)(ar + (((2 * s + hi) ^ (dd & 15)) << 4)); acc = __builtin_amdgcn_mfma_f32_32x32x16_bf16(af, bfr[s], acc, 0, 0, 0); } } \
              \
            const size_t groww = ((size_t)c * 128 + ti) * D + gi_ * 64 + 32 * dt + 8 * hi; \
            _Pragma("unroll") for (int gp = 0; gp < 2; ++gp) { v2u oo[2]; \
                _Pragma("unroll") for (int q2 = 0; q2 < 2; ++q2) { const int gq = 2 * gp + q2; const v2u uw = ZU_CUR[gq]; \
                    oo[q2].x = cvt_pk_bf16(bflo(uw.x) * (acc[4 * gq] + bsv), bfhi(uw.x) * (acc[4 * gq + 1] + bsv)); oo[q2].y = cvt_pk_bf16(bflo(uw.y) * (acc[4 * gq + 2] + bsv), bfhi(uw.y) * (acc[4 * gq + 3] + bsv)); } \
                *(v4u*)(Gout + groww + 16 * gp) = widen_pair(oo[0], oo[1]); } \
        } while (0)
        v4u zrb[2]; v2u zua[4], zub[4];
        { const int it0 = (w >> 1) & 3; const size_t orow = ((size_t)c * 128 + 32 * it0 + r32) * GM_W + 32 * (w & 1) + 4 * hi;
#pragma unroll
          for (int gq = 0; gq < 4; ++gq) zua[gq] = *(const v2u*)(ZU + orow + 8 * gq); }
#pragma unroll 1
        for (int gi = 0; gi < 12; gi += 2) {
            SP_GROUP(gi, zr, zua, zrb, zub);
            SP_GROUP(gi + 1, zrb, zub, zr, zua);
        }
#undef SP_GROUP
        __syncthreads();
    }
}

__device__ __forceinline__ void merge_phase(const Frame& F, const Args& A) {
    const int tidx_ = tid_opaque(F.wave);
    const bf16* OG = (const bf16*)(A.ws + WS_OG); const float* LSE = (const float*)(A.ws + WS_LSE); bf16* ATT = (bf16*)(A.ws + WS_AG);
    const int gw = F.vcu * 8 + F.wave, NGW = F.G * 8, lane = (tidx_ & 63), h = lane >> 4;
    for (int t = gw; t < T; t += NGW) {
        const float l0 = LSE[(size_t)t * 4 + h], l1 = LSE[((size_t)T + t) * 4 + h], l2 = LSE[((size_t)2 * T + t) * 4 + h];
        const float m = fmaxf(l0, fmaxf(l1, l2)); float a0 = __expf(l0 - m), a1 = __expf(l1 - m), a2 = __expf(l2 - m); const float inv = 1.0f / (a0 + a1 + a2); a0 *= inv; a1 *= inv; a2 *= inv;
        const v2u w0 = *(const v2u*)(OG + (size_t)t * 256 + 4 * lane), w1 = *(const v2u*)(OG + ((size_t)T + t) * 256 + 4 * lane), w2 = *(const v2u*)(OG + ((size_t)2 * T + t) * 256 + 4 * lane);
        v2u o; o.x = pk2(a0 * bflo(w0.x) + a1 * bflo(w1.x) + a2 * bflo(w2.x), a0 * bfhi(w0.x) + a1 * bfhi(w1.x) + a2 * bfhi(w2.x));
        o.y = pk2(a0 * bflo(w0.y) + a1 * bflo(w1.y) + a2 * bflo(w2.y), a0 * bfhi(w0.y) + a1 * bfhi(w1.y) + a2 * bfhi(w2.y));
        *(v2u*)(ATT + (size_t)t * D + 4 * lane) = o;
    }
}

__device__ __forceinline__ void router_phase(const Frame& F, const Args& A) {
    const int tidx_ = tid_opaque(F.wave);
    LAS unsigned char* L = F.lds;
    LAS int* hist = (LAS int*)(F.lds + RING_BYTES + 2048);
    LAS int* basee = hist + 32;
    LAS int* rec_e = hist + 64;
    LAS int* rec_r = rec_e + 512;
    LAS float* rec_g = (LAS float*)(rec_r + 512);
    LAS float* rec_s = rec_g + 512;
    LAS float* gl = (LAS float*)(F.lds + RING_BYTES + 9216);
    const float* brt = A.in[14]; const float* gmoe = A.in[12];
    const bf16* H = (const bf16*)A.out;
    const bf16* WRH = (const bf16*)(A.ws + WS_WRH);
    int* LIST = (int*)(A.ws + WS_LIST); float* SGATE = (float*)(A.ws + WS_SGATE); float* SRSTD = (float*)(A.ws + WS_SRSTD); int* POS = (int*)(A.ws + WS_POS);
    unsigned* CNT = (unsigned*)(A.ws + WS_CTL) + CW_CNT;
    const int lane = (tidx_ & 63), w = F.wave, r32 = lane & 31, hi = lane >> 5;
    for (int c = F.vcu; c < T / 128; c += F.G) {
        const int tt = w & 3, kh = w >> 2;
        const size_t row = (size_t)c * 128 + tt * 32 + r32;
        const bf16* hrow = H + row * D + kh * 512 + 8 * hi;
        v4u hq[16];
#pragma unroll
        for (int s = 0; s < 16; ++s) hq[s] = *(const v4u*)(hrow + 16 * s);
        __builtin_amdgcn_sched_barrier(0);
        for (int q = tidx_; q < 8192; q += 512) { const int mtx = q >> 12, rem = q & 4095, e = rem >> 7, ck = rem & 127;
            const v4u v = *(const v4u*)(WRH + (size_t)mtx * 32768 + e * 1024 + ck * 8);
            *(LAS v4u*)(L + mtx * 65536 + e * 2048 + ((ck ^ (e & 15)) << 4)) = v; }
        if (tidx_ < 256) *(LAS f32x4*)(gl + tidx_ * 4) = *(const f32x4*)(gmoe + tidx_ * 4);
        if (tidx_ < 32) hist[tidx_] = 0;
        __syncthreads();
        const LAS float* grow = gl + kh * 512 + 8 * hi;
        const LAS unsigned char* wb = L + r32 * 2048;
        f32x16 acc = {}; float ss = 0.f;
#pragma unroll
        for (int s = 0; s < 32; ++s) {
            const v4u hw_ = hq[s & 15];
            if (s < 16) hq[s] = *(const v4u*)(hrow + 16 * (s + 16));
            const f32x4 h0 = {bflo(hw_.x), bfhi(hw_.x), bflo(hw_.y), bfhi(hw_.y)}, h1 = {bflo(hw_.z), bfhi(hw_.z), bflo(hw_.w), bfhi(hw_.w)}, g0 = *(const LAS f32x4*)(grow + 16 * s), g1 = *(const LAS f32x4*)(grow + 16 * s + 4);
            ss += (h0.x * h0.x + h0.y * h0.y) + (h0.z * h0.z + h0.w * h0.w) + (h1.x * h1.x + h1.y * h1.y) + (h1.z * h1.z + h1.w * h1.w);
            const f32x4 x0 = h0 * g0, x1 = h1 * g1;
            v4u xh; xh.x = cvt_pk_bf16(x0.x, x0.y); xh.y = cvt_pk_bf16(x0.z, x0.w); xh.z = cvt_pk_bf16(x1.x, x1.y); xh.w = cvt_pk_bf16(x1.z, x1.w);
            v4u xl; xl.x = cvt_pk_bf16(x0.x - bflo(xh.x), x0.y - bfhi(xh.x)); xl.y = cvt_pk_bf16(x0.z - bflo(xh.y), x0.w - bfhi(xh.y));
            xl.z = cvt_pk_bf16(x1.x - bflo(xh.z), x1.y - bfhi(xh.z)); xl.w = cvt_pk_bf16(x1.z - bflo(xh.w), x1.w - bfhi(xh.w));
            const int ck = kh * 64 + 2 * s + hi;
            const bf16x8 wh = *(const LAS bf16x8*)(wb + ((ck ^ (r32 & 15)) << 4)), wl = *(const LAS bf16x8*)(wb + 65536 + ((ck ^ (r32 & 15)) << 4));
            const bf16x8 ah = __builtin_bit_cast(bf16x8, xh), al = __builtin_bit_cast(bf16x8, xl);
            acc = __builtin_amdgcn_mfma_f32_32x32x16_bf16(ah, wh, acc, 0, 0, 0);
            acc = __builtin_amdgcn_mfma_f32_32x32x16_bf16(al, wh, acc, 0, 0, 0);
            acc = __builtin_amdgcn_mfma_f32_32x32x16_bf16(ah, wl, acc, 0, 0, 0);
        }
        __syncthreads();
        { LAS float* LGp = (LAS float*)L + kh * (128 * 33);
#pragma unroll
          for (int i = 0; i < 16; ++i) LGp[(tt * 32 + crow(i, hi)) * 33 + r32] = acc[i];
          ((LAS float*)(L + 36864))[(kh * 2 + hi) * 128 + tt * 32 + r32] = ss; }
        __syncthreads();
        if (tidx_ < 128) {
            const int t = tidx_; const LAS float* SS = (const LAS float*)(L + 36864);
            const float rstd = 1.0f / sqrtf(((SS[t] + SS[128 + t]) + (SS[256 + t] + SS[384 + t])) * (1.f / D) + EPS);
            const LAS float* l0 = (const LAS float*)L + t * 33; const LAS float* l1 = l0 + 128 * 33;
            float lg[32];
#pragma unroll
            for (int e = 0; e < 32; ++e) lg[e] = (l0[e] + l1[e]) * rstd + brt[e];
            unsigned taken = 0u; float tv[4]; int ti[4];
#pragma unroll
            for (int k = 0; k < 4; ++k) { float bv = -INFINITY; int bi = 0;
#pragma unroll
                for (int e = 0; e < 32; ++e) { const float cv = ((taken >> e) & 1u) ? -INFINITY : lg[e]; if (cv > bv) { bv = cv; bi = e; } }
                tv[k] = bv; ti[k] = bi; taken |= 1u << bi; }
            const float e1 = __expf(tv[1] - tv[0]), e2 = __expf(tv[2] - tv[0]), e3 = __expf(tv[3] - tv[0]); const float inv = 1.0f / (1.0f + e1 + e2 + e3);
            const float gk[4] = {inv, e1 * inv, e2 * inv, e3 * inv};
            rec_s[t] = rstd;
#pragma unroll
            for (int k = 0; k < 4; ++k) { const int lr = atomicAdd((int*)&hist[ti[k]], 1); rec_e[t * 4 + k] = ti[k]; rec_r[t * 4 + k] = lr; rec_g[t * 4 + k] = gk[k]; }
        }
        __syncthreads();
        if (tidx_ < 32) basee[tidx_] = (int)__hip_atomic_fetch_add(CNT + tidx_, (unsigned)hist[tidx_], __ATOMIC_RELAXED, __HIP_MEMORY_SCOPE_AGENT);
        __syncthreads();
        { const int lrow = tidx_ >> 2, k = tidx_ & 3; const int e = rec_e[tidx_], slot = basee[e] + rec_r[tidx_]; const int t = c * 128 + lrow;
          LIST[e * 32768 + slot] = t; SGATE[e * 32768 + slot] = rec_g[tidx_]; SRSTD[e * 32768 + slot] = rec_s[lrow]; POS[t * 4 + k] = (e << 16) | slot; }
        __syncthreads();
    }
}

__device__ __forceinline__ void load_tile_starts(const Frame& F, const Args& A) {
    const int tidx_ = tid_opaque(F.wave);
    LAS int* ts = (LAS int*)(F.lds + TS_OFF);
    if (tidx_ == 0) { const unsigned* CNT = (const unsigned*)(A.ws + WS_CTL) + CW_CNT; int acc = 0;
        for (int e = 0; e < 32; ++e) { const int c = (int)__hip_atomic_load(CNT + e, __ATOMIC_RELAXED, __HIP_MEMORY_SCOPE_AGENT); ts[e] = acc; ts[40 + e] = c; acc += (c + 255) >> 8; }
        ts[32] = acc; for (int e = 33; e < 40; ++e) ts[e] = 0x7fffffff; }
    __syncthreads();
}

__device__ __forceinline__ void combine_phase(const Frame& F, const Args& A) {
    const int tidx_ = tid_opaque(F.wave);
    const LAS int* ts = (const LAS int*)(F.lds + TS_OFF);
    const bf16* Y = (const bf16*)(A.ws + WS_Y); const int* POS = (const int*)(A.ws + WS_POS); const bf16* H = (const bf16*)A.out; bf16* H2 = (bf16*)(A.ws + WS_H2); float* RS = (float*)(A.ws + WS_SRSTD);
    const int gw = F.vcu * 8 + F.wave, NGW = F.G * 8, lane = (tidx_ & 63);
    for (int t = gw * 2; t < T; t += NGW * 2) {
        int pz[2][4];
#pragma unroll
        for (int r = 0; r < 2; ++r)
#pragma unroll
            for (int k = 0; k < 4; ++k) pz[r][k] = POS[(t + r) * 4 + k];
        f32x4 v[2][2][2];
#pragma unroll
        for (int r = 0; r < 2; ++r)
#pragma unroll
            for (int hf = 0; hf < 2; ++hf) { const v4u w = *(const v4u*)(H + (size_t)(t + r) * D + hf * 512 + 8 * lane); v[r][hf][0] = (f32x4){bflo(w.x), bfhi(w.x), bflo(w.y), bfhi(w.y)}; v[r][hf][1] = (f32x4){bflo(w.z), bfhi(w.z), bflo(w.w), bfhi(w.w)}; }
        v4u yw[2][4][2];
#pragma unroll
        for (int r = 0; r < 2; ++r)
#pragma unroll
            for (int k = 0; k < 4; ++k) { const int e = pz[r][k] >> 16, slot = pz[r][k] & 0xffff; const bf16* yp = Y + ((size_t)ts[e] * 256 + slot) * D + 8 * lane;
                yw[r][k][0] = *(const v4u*)yp; yw[r][k][1] = *(const v4u*)(yp + 512); }
        float s[2];
#pragma unroll
        for (int r = 0; r < 2; ++r) { float a = 0.f;
#pragma unroll
            for (int hf = 0; hf < 2; ++hf) {
#pragma unroll
                for (int k = 0; k < 4; ++k) { const v4u w = yw[r][k][hf];
                    v[r][hf][0] = v[r][hf][0] + (f32x4){bflo(w.x), bfhi(w.x), bflo(w.y), bfhi(w.y)}; v[r][hf][1] = v[r][hf][1] + (f32x4){bflo(w.z), bfhi(w.z), bflo(w.w), bfhi(w.w)}; }
                st8(H2 + (size_t)(t + r) * D + hf * 512 + 8 * lane, v[r][hf][0], v[r][hf][1]);
#pragma unroll
                for (int p = 0; p < 2; ++p) a += (v[r][hf][p].x * v[r][hf][p].x + v[r][hf][p].y * v[r][hf][p].y) + (v[r][hf][p].z * v[r][hf][p].z + v[r][hf][p].w * v[r][hf][p].w); }
            s[r] = a; }
#pragma unroll
        for (int o = 1; o < 64; o <<= 1) { s[0] += __shfl_xor(s[0], o); s[1] += __shfl_xor(s[1], o); }
#pragma unroll
        for (int r = 0; r < 2; ++r) if (lane == r) RS[t + r] = 1.0f / sqrtf(s[r] * (1.f / D) + EPS);
    }
}
__device__ __forceinline__ void final_phase(const Frame& F, const Args& A) {
    const int tidx_ = tid_opaque(F.wave);
    float* OUT = A.out; const float* gf = A.in[22]; const bf16* T1 = (const bf16*)(A.ws + WS_T1); const bf16* H2 = (const bf16*)(A.ws + WS_H2);
    const int gw = F.vcu * 8 + F.wave, NGW = F.G * 8, lane = (tidx_ & 63);
    f32x4 g[2][2];
#pragma unroll
    for (int hf = 0; hf < 2; ++hf) { const float* gp = gf + hf * 512 + 8 * lane; g[hf][0] = *(const f32x4*)gp; g[hf][1] = *(const f32x4*)(gp + 4); }
    for (int t = gw * 2; t < T; t += NGW * 2) {
        v4u hw[2][2], tw[2][2];
#pragma unroll
        for (int r = 0; r < 2; ++r)
#pragma unroll
            for (int hf = 0; hf < 2; ++hf) { const size_t o = (size_t)(t + r) * D + hf * 512 + 8 * lane; hw[r][hf] = *(const v4u*)(H2 + o); tw[r][hf] = *(const v4u*)(T1 + o); }
        f32x4 v[2][2][2]; float s[2];
#pragma unroll
        for (int r = 0; r < 2; ++r) { float a = 0.f;
#pragma unroll
            for (int hf = 0; hf < 2; ++hf) { const v4u h = hw[r][hf], w = tw[r][hf];
                v[r][hf][0] = (f32x4){bflo(h.x) + bflo(w.x), bfhi(h.x) + bfhi(w.x), bflo(h.y) + bflo(w.y), bfhi(h.y) + bfhi(w.y)};
                v[r][hf][1] = (f32x4){bflo(h.z) + bflo(w.z), bfhi(h.z) + bfhi(w.z), bflo(h.w) + bflo(w.w), bfhi(h.w) + bfhi(w.w)};
#pragma unroll
                for (int p = 0; p < 2; ++p) a += (v[r][hf][p].x * v[r][hf][p].x + v[r][hf][p].y * v[r][hf][p].y) + (v[r][hf][p].z * v[r][hf][p].z + v[r][hf][p].w * v[r][hf][p].w); }
            s[r] = a; }
#pragma unroll
        for (int o = 1; o < 64; o <<= 1) { s[0] += __shfl_xor(s[0], o); s[1] += __shfl_xor(s[1], o); }
#pragma unroll
        for (int r = 0; r < 2; ++r) { const float rstd = 1.0f / sqrtf(s[r] * (1.f / D) + EPS);
#pragma unroll
            for (int hf = 0; hf < 2; ++hf) { float* op = OUT + (size_t)(t + r) * D + hf * 512 + 8 * lane; *(f32x4*)op = v[r][hf][0] * rstd * g[hf][0]; *(f32x4*)(op + 4) = v[r][hf][1] * rstd * g[hf][1]; } }
    }
}

constexpr int NPHASE = 13;
#ifndef ONLY_PH
#define ONLY_PH -1
#endif
#define PH_ON(k) (ONLY_PH < 0 || ONLY_PH == (k))
__global__ void __launch_bounds__(512, 2) fwd_kernel(Args args) {
    extern __shared__ __attribute__((aligned(16))) unsigned char lds[];
    Frame F;
    F.lds = (LAS unsigned char*)lds; F.wave = __builtin_amdgcn_readfirstlane((int)threadIdx.x >> 6);
    F.G = gridDim.x; { const int bx = blockIdx.x; F.vcu = (F.G % 8 == 0) ? (bx % 8) * (F.G / 8) + bx / 8 : bx; }
    unsigned char* ws = args.ws;
    volatile LAS unsigned* MISC = (volatile LAS unsigned*)(F.lds + MISC_OFF);
    for (int u = tid_opaque(F.wave); u < (LDS_BYTES - RING_BYTES) / 4; u += 512) ((LAS unsigned*)(F.lds + RING_BYTES))[u] = 0u;
    __syncthreads();
    const bool multi = (args.ph_hi - args.ph_lo) > 1;
    if (multi) (void)xcd_barrier_post((unsigned*)(ws + WS_CTL) + CW_BAR, MISC + 8, F.wave);
    const int bx = (int)blockIdx.x;
#if MK_N_LAUNCHES == 1
    constexpr int lo = 0, hi = NPHASE;
#else
    const int lo = args.ph_lo, hi = args.ph_hi;
#endif
#ifndef REP_MASK
#define REP_MASK 0
#endif
#define IN(k) (PH_ON(k) && lo <= (k) && (k) < hi)
#define REPS(k) (((REP_MASK >> (k)) & 1) ? 2 : 1)
#define SEAM(k) do { if (lo <= (k) && (k) + 1 < hi) { XcdBarrier b_; b_.bar = (unsigned*)(args.ws + WS_CTL) + CW_BAR; b_.x = xb_xcc_id(); b_.st = (volatile LAS unsigned*)(F.lds + MISC_OFF) + 8; b_.wave = F.wave; xcd_barrier(b_); } } while (0)
    if (IN(0)) for (int rep_ = 0; rep_ < REPS(0); ++rep_) { p0_prologue(F, args); } SEAM(0);
    if (IN(1)) { const int nu1 = (T / 256) * 23, R1 = (nu1 + F.G - 1) / F.G + 1, GG = (nu1 + R1 - 1) / R1;
                 if (bx < GG) { InProjSched S{(const char*)(ws + WS_NX), (const char*)(ws + WS_WIN), GG, bx, REPS(1) - 1};
                 EpiInProj E{(bf16*)(ws + WS_Q), (bf16*)(ws + WS_K), (bf16*)(ws + WS_ZU), (bf16*)(ws + WS_GA), (bf16*)(ws + WS_GG), (bf16*)(ws + WS_VT), (bf16*)(ws + WS_ZVT)};
                 pg8::gemm_phase(F.lds, D, S, E, F.wave); }
                 convert_queue(F, args, (unsigned*)(ws + WS_CTL) + CW_Q1, 0, BG_P1); convert_queue(F, args, (unsigned*)(ws + WS_CTL) + CW_Q3, BG_N, BG_ALL); convert_p_queue(F, args, (unsigned*)(ws + WS_CTL) + CW_Q4); } SEAM(1);
    if (IN(2)) { if ((bx >> 3) & 1) { spatial_phase(F, args); __syncthreads(); attn_phase(F, args); } else { attn_phase(F, args); __syncthreads(); spatial_phase(F, args); } } SEAM(2);
    if (IN(3)) { merge_phase(F, args); } SEAM(3);
    if (IN(4)) { PlainSched S{(const char*)(ws + WS_AG), (const char*)(ws + WS_WCAT), T / 256, 4, D, F.G, bx, REPS(4) - 1}; EpiMerge E{(bf16*)(ws + WS_MRG), (const bf16*)(ws + WS_GA), (const bf16*)(ws + WS_GG)};
                 pg8::gemm_phase(F.lds, D, S, E, F.wave); } SEAM(5);
    if (IN(6)) { PlainSched S{(const char*)(ws + WS_MRG), (const char*)(ws + WS_WOUT), T / 256, 4, D, F.G, bx, REPS(6) - 1}; EpiH1 E{(bf16*)args.out, args.in[0]};
                 pg8::gemm_phase(F.lds, D, S, E, F.wave); } SEAM(6);
    if (IN(7)) for (int rep_ = 0; rep_ < REPS(7); ++rep_) { router_phase(F, args); } SEAM(7);
    if (IN(8)) { load_tile_starts(F, args); const LAS int* ts = (const LAS int*)(F.lds + TS_OFF);
                 const int nu8 = ts[32] * 8, R8 = (nu8 + F.G - 1) / F.G, GG = R8 > 0 ? (nu8 + R8 - 1) / R8 : 1;
                 if (bx < GG) { MoeSched S{(const char*)args.out, (const char*)(ws + WS_WGU), (const int*)(ws + WS_LIST), ts, 8, D, GG, bx, 1, REPS(8) - 1}; EpiMoeUp E{(bf16*)(ws + WS_ACT), args.in[16], (const float*)(ws + WS_SRSTD), ts};
                 pg8::gemm_phase(F.lds, D, S, E, F.wave); }
                 convert_queue(F, args, (unsigned*)(ws + WS_CTL) + CW_Q2, BG_GU, BG_N); } SEAM(8);
    if (IN(9)) { load_tile_starts(F, args); const LAS int* ts = (const LAS int*)(F.lds + TS_OFF);
                 const int nu9 = ts[32] * 4, R9 = (nu9 + F.G - 1) / F.G, GG = R9 > 0 ? (nu9 + R9 - 1) / R9 : 1, NH = F.G - GG;
                 if (bx < GG) { MoeSched S{(const char*)(ws + WS_ACT), (const char*)(ws + WS_WD), (const int*)(ws + WS_LIST), ts, 4, D, GG, bx, 0, REPS(9) - 1}; EpiMoeDown E{(bf16*)(ws + WS_Y), args.in[18], (const float*)(ws + WS_SGATE), ts};
                 pg8::gemm_phase(F.lds, D, S, E, F.wave); }
                 if (NH >= 8 ? bx >= GG : true) { PlainSched S{(const char*)(ws + WS_PB), (const char*)(ws + WS_WPP), T / 256, 4, PLE, NH >= 8 ? NH : F.G, NH >= 8 ? bx - GG : bx, 0}; EpiBf<0> E{(bf16*)(ws + WS_PP), nullptr, nullptr};
                 pg8::gemm_phase(F.lds, PLE, S, E, F.wave); } } SEAM(9);
    if (IN(10)) for (int rep_ = 0; rep_ < REPS(10); ++rep_) { load_tile_starts(F, args); combine_phase(F, args); } SEAM(10);
    if (IN(11)) { PlainSched S{(const char*)(ws + WS_H2), (const char*)(ws + WS_WPG), T / 256, 4, D, F.G, bx, REPS(11) - 1}; EpiPle E{(bf16*)(ws + WS_T1), (const bf16*)(ws + WS_PP), (const float*)(ws + WS_SRSTD)};
                  pg8::gemm_phase(F.lds, D, S, E, F.wave); } SEAM(11);
    if (IN(12)) for (int rep_ = 0; rep_ < REPS(12); ++rep_) { final_phase(F, args); }
#undef IN
#undef SEAM
}

extern "C" void kernel_launch(void* const* d_in, const int* in_sizes, int n_in, void* d_out, int out_size, void* d_ws, size_t ws_size, hipStream_t stream) {
    static int grid = 0;
    if (grid == 0) {
        if (n_in != 23 || out_size != T * D || ws_size < WS_END) { fprintf(stderr, "kernel_launch: unexpected shapes (n_in %d out %d ws %zu)\n", n_in, out_size, ws_size); grid = -1; return; }
        int dev = 0, cus = 0, per_cu = 0;
        if (hipGetDevice(&dev) != hipSuccess || hipDeviceGetAttribute(&cus, hipDeviceAttributeMultiprocessorCount, dev) != hipSuccess) { grid = -1; return; }
        if (hipFuncSetAttribute((const void*)fwd_kernel, hipFuncAttributeMaxDynamicSharedMemorySize, LDS_BYTES) != hipSuccess) { fprintf(stderr, "kernel_launch: hipFuncSetAttribute failed\n"); grid = -1; return; }
        if (hipOccupancyMaxActiveBlocksPerMultiprocessor(&per_cu, (const void*)fwd_kernel, 512, LDS_BYTES) != hipSuccess || per_cu < 1) { fprintf(stderr, "kernel_launch: occupancy query says %d\n", per_cu); (void)hipGetLastError(); grid = -1; return; }
        grid = cus;
    }
    if (grid < 0) return;
    (void)hipMemsetAsync((char*)d_ws + WS_CTL, 0, CTL_ZERO_BYTES, stream);
    Args a{};
    for (int i = 0; i < 23; ++i) a.in[i] = (const float*)d_in[i];
    a.out = (float*)d_out; a.ws = (unsigned char*)d_ws;
#if MK_N_LAUNCHES == 1
    a.ph_lo = 0; a.ph_hi = NPHASE;
    hipLaunchKernelGGL(fwd_kernel, dim3(grid), dim3(512), LDS_BYTES, stream, a);
#else
    for (int ph = 0; ph < NPHASE; ++ph) { a.ph_lo = ph; a.ph_hi = ph + 1; hipLaunchKernelGGL(fwd_kernel, dim3(grid), dim3(512), LDS_BYTES, stream, a); }
#endif
}
```

```cpp
#include <hip/hip_runtime.h>
#include <cstdio>
#include <cstdint>

#ifndef MK_N_LAUNCHES
#define MK_N_LAUNCHES 1
#endif

constexpr int NB = 8, SEQ = 4096, T = NB * SEQ, D = 1024;
constexpr int ATT_W = 768, GM_W = 768, IN_W = 5888, NE = 32, TOPK = 4, PLE = 256;
constexpr float EPS = 1e-6f;
constexpr float LOG2E = 1.4426950408889634f, LN2 = 0.6931471805599453f;
constexpr float QSCALE = 0.125f * LOG2E;

#define LAS __attribute__((address_space(3)))
#define GAS __attribute__((address_space(1)))
typedef unsigned short bf16;
typedef unsigned v4u __attribute__((ext_vector_type(4)));
typedef unsigned v2u __attribute__((ext_vector_type(2)));
typedef float f32x4 __attribute__((ext_vector_type(4)));
typedef float f32x2 __attribute__((ext_vector_type(2)));
typedef float f32x16 __attribute__((ext_vector_type(16)));
typedef short bf16x8 __attribute__((ext_vector_type(8)));
typedef short s16x4 __attribute__((ext_vector_type(4)));

__device__ __forceinline__ unsigned f2bf(float f) { unsigned u = __builtin_bit_cast(unsigned, f); return (u + 0x7fffu + ((u >> 16) & 1u)) >> 16; }
__device__ __forceinline__ unsigned pk2(float lo, float hi) { return f2bf(lo) | (f2bf(hi) << 16); }
__device__ __forceinline__ float bflo(unsigned w) { return __builtin_bit_cast(float, w << 16); }
__device__ __forceinline__ float bfhi(unsigned w) { return __builtin_bit_cast(float, w & 0xffff0000u); }
typedef __bf16 bf16x2_t __attribute__((ext_vector_type(2)));
__device__ __forceinline__ unsigned cvt_pk_bf16(float lo, float hi) { const f32x2 v = {lo, hi}; const bf16x2_t b = __builtin_convertvector(v, bf16x2_t); return __builtin_bit_cast(unsigned, b); }
__device__ __forceinline__ float sigmoidf_(float x) { return __builtin_amdgcn_rcpf(1.0f + __builtin_amdgcn_exp2f(-x * LOG2E)); }
__device__ __forceinline__ f32x2 gelu_pk(f32x2 v) {
    const f32x2 av = __builtin_elementwise_abs(v), d = av * 0.2316418882f + 1.0f;
    f32x2 t; t.x = __builtin_amdgcn_rcpf(d.x); t.y = __builtin_amdgcn_rcpf(d.y);
    f32x2 q = t * 0.5307027145f + (-0.7265760135f); q = q * t + 0.7107068705f; q = q * t + (-0.142248368f); q = q * t + 0.127414796f; q = q * t;
    const f32x2 s = (v * v) * (-0.72134752044f);
    f32x2 e; e.x = __builtin_amdgcn_exp2f(s.x); e.y = __builtin_amdgcn_exp2f(s.y);
    const f32x2 m = v * (q * e), r = v - m;
    f32x2 o; o.x = v.x < 0.f ? m.x : r.x; o.y = v.y < 0.f ? m.y : r.y; return o;
}
__device__ __forceinline__ f32x4 gelu4(f32x4 v) { f32x2 a = gelu_pk((f32x2){v[0], v[1]}), b = gelu_pk((f32x2){v[2], v[3]}); return (f32x4){a.x, a.y, b.x, b.y}; }
__device__ __forceinline__ f32x4 sigm4(f32x4 v) { return (f32x4){sigmoidf_(v[0]), sigmoidf_(v[1]), sigmoidf_(v[2]), sigmoidf_(v[3])}; }
__device__ __forceinline__ int tid_opaque(int wave) {
    int l; asm volatile("v_mbcnt_lo_u32_b32 %0, -1, 0\n\tv_mbcnt_hi_u32_b32 %0, -1, %0" : "=v"(l));
    return wave * 64 + l;
}
__device__ __forceinline__ float wave_sum(float v) {
#pragma unroll
    for (int o = 1; o < 64; o <<= 1) v += __shfl_xor(v, o);
    return v;
}

constexpr size_t MiB = 1u << 20;
constexpr size_t WS_CTL = 0, CTL_ZERO_BYTES = 1 * MiB;
constexpr size_t WS_WIN = 2 * MiB;
constexpr size_t WS_WCAT = 14 * MiB;
constexpr size_t WS_WOUT = 17 * MiB;
constexpr size_t WS_WPG = 19 * MiB;
constexpr size_t WS_WPP = 21 * MiB;
constexpr size_t WS_WSP = 22 * MiB;
constexpr size_t WS_WRH = 23 * MiB;
constexpr size_t WS_WRL = 23 * MiB + 65536;
constexpr size_t WS_SRSTD = 980 * MiB;
constexpr size_t WS_WGU = 24 * MiB;
constexpr size_t WS_WD = 152 * MiB;
constexpr size_t WS_NX = 216 * MiB;
constexpr size_t WS_PB = 280 * MiB;
constexpr size_t WS_PP = 296 * MiB;
constexpr size_t WS_LIST = 360 * MiB;
constexpr size_t WS_SGATE = 364 * MiB;
constexpr size_t WS_POS = 368 * MiB;
constexpr size_t WS_LSE = 369 * MiB;
constexpr size_t WS_Q = 372 * MiB;
constexpr size_t WS_K = 420 * MiB;
constexpr size_t WS_VT = 468 * MiB;
constexpr size_t WS_ZU = 516 * MiB;
constexpr size_t WS_ZVT = 564 * MiB;
constexpr size_t WS_GA = 612 * MiB;
constexpr size_t WS_GG = 676 * MiB;
constexpr size_t WS_OG = 740 * MiB;
constexpr size_t WS_ATT = 788 * MiB;
constexpr size_t WS_G = 804 * MiB;
constexpr size_t WS_AG = 852 * MiB;
constexpr size_t WS_MRG = 916 * MiB;
constexpr size_t WS_ACT = 372 * MiB;
constexpr size_t WS_Y = 644 * MiB;
constexpr size_t WS_H2 = 436 * MiB;
constexpr size_t WS_T1 = 372 * MiB;
constexpr size_t WS_END = 984 * MiB;
constexpr int PMAX_TILES = 544;
constexpr int PP_EARLY = 32;

constexpr int CW_CNT = 64;
constexpr int CW_Q1 = 256, CW_Q2 = 320, CW_Q3 = 384, CW_Q4 = 448;
constexpr int CW_BAR = 4096;

constexpr int RING_BYTES = 131072;
constexpr int MISC_OFF = RING_BYTES + 320;
constexpr int TS_OFF = RING_BYTES + 1024;
constexpr int LDS_BYTES = 147456;

namespace pg8 {
typedef unsigned short bf16_t;
constexpr int BM = 256, BK = 64, HALF = 128, HTB = HALF * BK * 2, STAGE_BYTES = 8 * HTB, NXCD = 8, WGM = 8;
__host__ __device__ __forceinline__ int lds_byte(int r, int c) { const int st = (r >> 4) * 2 + (c >> 5), rr = r & 15, cc = c & 31, ob = rr * 64 + cc * 2; return st * 1024 + (ob ^ (((ob >> 9) & 1) << 5)); }
__host__ __device__ __forceinline__ void stage_rc(int b, int& R, int& C) { const int st = b / 1024, sb = b % 1024, swz = sb ^ (((sb >> 9) & 1) << 5); R = (st >> 1) * 16 + swz / 64; C = (st & 1) * 32 + (swz % 64) / 2; }
__host__ __device__ __forceinline__ int perm32(int rho) { const int n = rho >> 4, i = rho & 15; return 8 * (i >> 2) + 4 * n + (i & 3); }

struct Unit { const char* a; const char* b; int pm, pn, x0, x1; };

__device__ __forceinline__ bool static_order(int i, int G, int c, int nM, int nN, int& pm, int& pn, int l0 = 0, int l1 = 0) {
    const int nwg = nM * nN; const long L = (long)i * G + c + l0; if (L >= (l1 > 0 ? l1 : nwg)) return false;
    int wgid = (int)L; { const int q = nwg / NXCD, r = nwg % NXCD, xcd = wgid % NXCD, off = wgid / NXCD; wgid = (xcd < r ? xcd * (q + 1) : r * (q + 1) + (xcd - r) * q) + off; }
    const int nig = WGM * nN, gid = wgid / nig, fm = gid * WGM, gsz = (nM - fm) < WGM ? (nM - fm) : WGM;
    pm = fm + ((wgid % nig) % gsz); pn = (wgid % nig) / gsz; return true;
}

template <class Epi, class Sched>
__device__ __forceinline__ void gemm_phase(LAS unsigned char* lds, const int K, const Sched& S, const Epi& E, const int wave) {
    const int wid = wave, tid = tid_opaque(wid), lane = tid & 63, wr = wid >> 2, wc = wid & 3, fr = lane & 15, fq = lane >> 4;
    const int nt = K / BK;
    int RA[2]; unsigned CB2[2], rbk[2];
#pragma unroll
    for (int i = 0; i < 2; ++i) { int R, C; stage_rc(tid * 16 + i * 8192, R, C); const int Rb = Epi::PERM ? ((R & ~31) + perm32(R & 31)) : R;
        RA[i] = R; CB2[i] = (unsigned)C * 2u; rbk[i] = (unsigned)(Rb * K) * 2u; }
    const size_t kstep = (size_t)(BK * 2);
    const size_t hstep = (size_t)HALF * K * 2;
    const unsigned ldsw = (unsigned)wid * 1024u;
    const int aoff = lds_byte(wr * 64 + fr, fq * 8), boff = lds_byte(wc * 32 + fr, fq * 8);
#define PG8_SA(b, h) (((b) * 2 + (h)) * HTB)
#define PG8_SB(b, h) ((4 + (b) * 2 + (h)) * HTB)
#define PG8_STAGE(bufoff, gbase, voff) do { _Pragma("unroll") for (int _i = 0; _i < 2; ++_i) \
        __builtin_amdgcn_global_load_lds((const unsigned*)((const char*)(gbase) + (voff)[_i]), (LAS unsigned*)(lds + (bufoff) + ldsw + _i * 8192), 16, 0, 0); } while (0)
#define PG8_LDA(dst, b, h) do { _Pragma("unroll") for (int m = 0; m < 4; ++m) _Pragma("unroll") for (int k = 0; k < 2; ++k) dst[m][k] = *(const LAS bf16x8*)(lds + PG8_SA(b, h) + aoff + m * 2048 + k * 1024); } while (0)
#define PG8_LDB(dst, b, h) do { _Pragma("unroll") for (int n = 0; n < 2; ++n) _Pragma("unroll") for (int k = 0; k < 2; ++k) dst[n][k] = *(const LAS bf16x8*)(lds + PG8_SB(b, h) + boff + n * 2048 + k * 1024); } while (0)
#define PG8_MMA(ai, bj, At, Bt) do { __builtin_amdgcn_s_setprio(1); _Pragma("unroll") for (int m = 0; m < 4; ++m) _Pragma("unroll") for (int n = 0; n < 2; ++n) _Pragma("unroll") for (int k = 0; k < 2; ++k) \
        acc[ai][bj][m][n] = __builtin_amdgcn_mfma_f32_16x16x32_bf16(Bt[n][k], At[m][k], acc[ai][bj][m][n], 0, 0, 0); __builtin_amdgcn_s_setprio(0); } while (0)
#define PG8_WAIT_V(n) asm volatile("s_waitcnt vmcnt(" #n ")" ::: "memory")
#define PG8_WAIT_L(n) asm volatile("s_waitcnt lgkmcnt(" #n ")" ::: "memory")
#define PG8_BAR __builtin_amdgcn_s_barrier()
#define PG8_SCHED __builtin_amdgcn_sched_barrier(0)
    Unit cur, nxt; int ui = 0;
    if (!S.next(0, cur)) return;
    f32x4 acc[2][2][4][2];
#pragma unroll
    for (int a = 0; a < 2; ++a)
#pragma unroll
        for (int b = 0; b < 2; ++b)
#pragma unroll
            for (int m = 0; m < 4; ++m)
#pragma unroll
                for (int n = 0; n < 2; ++n) acc[a][b][m][n] = (f32x4){0.f, 0.f, 0.f, 0.f};
    bf16x8 At[4][2], B0[2][2], B1[2][2];
    const char* cA = cur.a; const char* cB = cur.b;
    unsigned oA[2][2], nO[2][2];
#pragma unroll
    for (int h = 0; h < 2; ++h)
#pragma unroll
        for (int i = 0; i < 2; ++i) oA[h][i] = S.a_off(cur, h * HALF + RA[i], K) + CB2[i];
    int csh = S.b_shift(cur); unsigned vbc[2] = {(rbk[0] << csh) + CB2[0], (rbk[1] << csh) + CB2[1]}, vbn[2];
    PG8_STAGE(PG8_SB(0, 0), cB, vbc); PG8_STAGE(PG8_SB(0, 1), cB + (hstep << csh), vbc); PG8_STAGE(PG8_SA(0, 0), cA, oA[0]); PG8_STAGE(PG8_SA(0, 1), cA, oA[1]);
    if (wr == 1) PG8_BAR;
    PG8_WAIT_V(2); PG8_BAR;
    PG8_STAGE(PG8_SB(1, 0), cB + kstep, vbc); PG8_STAGE(PG8_SA(1, 0), cA + kstep, oA[0]); PG8_STAGE(PG8_SB(1, 1), cB + (hstep << csh) + kstep, vbc);
    PG8_WAIT_V(6); PG8_BAR;
    for (;;) {
        const bool has_next = S.next(ui + 1, nxt);
        const char* nA = has_next ? nxt.a : cA; const char* nB = has_next ? nxt.b : cB;
        const int nsh = has_next ? S.b_shift(nxt) : csh; vbn[0] = (rbk[0] << nsh) + CB2[0]; vbn[1] = (rbk[1] << nsh) + CB2[1];
#pragma unroll
        for (int h = 0; h < 2; ++h)
#pragma unroll
            for (int i = 0; i < 2; ++i) nO[h][i] = has_next ? (S.a_off(nxt, h * HALF + RA[i], K) + CB2[i]) : oA[h][i];
#pragma unroll 1
        for (int t = 0; t < nt; t += 2) {
            const bool last = (t == nt - 2);
            const char* a1 = cA + (size_t)(t + 1) * kstep;
            const char* a2 = last ? nA : cA + (size_t)(t + 2) * kstep; const char* b2 = last ? nB : cB + (size_t)(t + 2) * kstep;
            const char* a3 = a2 + kstep; const char* b3 = b2 + kstep;
            unsigned o2[2][2]; const unsigned vb2[2] = {last ? vbn[0] : vbc[0], last ? vbn[1] : vbc[1]}; const size_t hs2 = hstep << (last ? nsh : csh);
#pragma unroll
            for (int h = 0; h < 2; ++h)
#pragma unroll
                for (int i = 0; i < 2; ++i) o2[h][i] = last ? nO[h][i] : oA[h][i];
            PG8_LDB(B0, 0, 0); PG8_LDB(B1, 0, 1); PG8_SCHED; PG8_LDA(At, 0, 0); PG8_STAGE(PG8_SA(1, 1), a1, oA[1]);
            PG8_WAIT_V(8); PG8_WAIT_L(0); PG8_BAR; PG8_MMA(0, 0, At, B0); PG8_MMA(0, 1, At, B1); PG8_BAR; PG8_SCHED;
            PG8_LDA(At, 0, 1); PG8_STAGE(PG8_SB(0, 0), b2, vb2); PG8_STAGE(PG8_SB(0, 1), b2 + hs2, vb2); PG8_STAGE(PG8_SA(0, 0), a2, o2[0]);
            PG8_WAIT_V(8); PG8_WAIT_L(0); PG8_BAR; PG8_MMA(1, 0, At, B0); PG8_MMA(1, 1, At, B1); PG8_BAR; PG8_SCHED;
            PG8_LDB(B0, 1, 0); PG8_LDB(B1, 1, 1); PG8_SCHED; PG8_LDA(At, 1, 0); PG8_STAGE(PG8_SA(0, 1), a2, o2[1]);
            PG8_WAIT_V(8); PG8_WAIT_L(0); PG8_BAR; PG8_MMA(0, 0, At, B0); PG8_MMA(0, 1, At, B1); PG8_BAR; PG8_SCHED;
            PG8_LDA(At, 1, 1); PG8_STAGE(PG8_SB(1, 0), b3, vb2); PG8_STAGE(PG8_SB(1, 1), b3 + hs2, vb2); PG8_STAGE(PG8_SA(1, 0), a3, o2[0]);
            PG8_WAIT_V(8); PG8_WAIT_L(0); PG8_BAR; PG8_MMA(1, 0, At, B0); PG8_MMA(1, 1, At, B1); PG8_BAR; PG8_SCHED;
            if constexpr (Epi::HOOK_T >= 0) { if (t == Epi::HOOK_T) { E.mid(acc, cur, wr, wc, fr, fq); PG8_SCHED; } }
        }
        if (wr == 0) PG8_BAR;
        E(acc, cur, wr, wc, fr, fq);
        if (!has_next) break;
#pragma unroll
        for (int a = 0; a < 2; ++a)
#pragma unroll
            for (int b = 0; b < 2; ++b)
#pragma unroll
                for (int m = 0; m < 4; ++m)
#pragma unroll
                    for (int n = 0; n < 2; ++n) acc[a][b][m][n] = (f32x4){0.f, 0.f, 0.f, 0.f};
        cur = nxt; cA = nA; cB = nB; ++ui; csh = nsh; vbc[0] = vbn[0]; vbc[1] = vbn[1];
#pragma unroll
        for (int h = 0; h < 2; ++h)
#pragma unroll
            for (int i = 0; i < 2; ++i) oA[h][i] = nO[h][i];
        if (wr == 1) PG8_BAR;
    }
    PG8_WAIT_V(0);
    PG8_BAR;
#undef PG8_SA
#undef PG8_SB
#undef PG8_STAGE
#undef PG8_LDA
#undef PG8_LDB
#undef PG8_MMA
#undef PG8_WAIT_V
#undef PG8_WAIT_L
#undef PG8_BAR
#undef PG8_SCHED
}
}
using pg8::Unit;
typedef f32x4 Acc[2][2][4][2];

struct PlainSched {
    const char* A; const char* Bt; int nM, nN, K, G, c, rsh, l0, l1;
    __device__ __forceinline__ bool next(int i, Unit& u) const {
        int pm, pn; if (!pg8::static_order(i >> rsh, G, c, nM, nN, pm, pn, l0, l1)) return false;
        u.pm = pm; u.pn = pn; u.x0 = 0; u.x1 = 0; u.a = A + (size_t)pm * 256 * K * 2; u.b = Bt + (size_t)pn * 256 * K * 2; return true;
    }
    __device__ __forceinline__ unsigned a_off(const Unit&, int row, int K_) const { return (unsigned)(row * K_) * 2u; }
    __device__ __forceinline__ int b_shift(const Unit&) const { return 0; }
};
struct InProjSched {
    const char* NX; const char* Wt; int G, c, rsh;
    __device__ __forceinline__ bool next(int i, Unit& u) const {
        int pm, pn; if (!pg8::static_order(i >> rsh, G, c, T / 256, 23, pm, pn)) return false;
        u.pm = pm; u.pn = pn; u.x0 = 0; u.x1 = 0;
        const char* xa = NX + (size_t)pm * 256 * D * 2; const char* wb = Wt + (size_t)pn * 256 * D * 2;
        if (pn < 17) { u.a = xa; u.b = wb; } else { u.a = wb; u.b = xa;
            if (pn < 20) { const int sh = 2 * (pn - 17), j0 = (pm & 15) * 256, r = j0 >> (12 - sh), i0 = j0 & ((SEQ >> sh) - 1);
                u.x0 = sh; u.b = NX + ((size_t)(pm >> 4) * SEQ + ((size_t)i0 << sh) + r) * D * 2; } }
        return true;
    }
    __device__ __forceinline__ unsigned a_off(const Unit&, int row, int K_) const { return (unsigned)(row * K_) * 2u; }
    __device__ __forceinline__ int b_shift(const Unit& u) const { return u.x0; }
};
struct MoeSched {
    const char* A; const char* Bt; const int* list; const LAS int* ts; int nN, K, G, c, gather, rsh;
    __device__ __forceinline__ bool next(int i, Unit& u) const {
        const int MT = ts[32];
        int pm, pn; if (!pg8::static_order(i >> rsh, G, c, MT, nN, pm, pn)) return false;
        int e = 0;
#pragma unroll
        for (int s = 16; s >= 1; s >>= 1) { if (ts[e + s] <= pm) e += s; }
        e = __builtin_amdgcn_readfirstlane(e);
        u.pm = pm; u.pn = pn; u.x0 = e; u.x1 = __builtin_amdgcn_readfirstlane(pm - ts[e]);
        u.a = gather ? A : A + (size_t)pm * 256 * K * 2;
        u.b = Bt + ((size_t)e * nN + pn) * 256 * K * 2;
        return true;
    }
    __device__ __forceinline__ unsigned a_off(const Unit& u, int row, int K_) const {
        if (!gather) return (unsigned)(row * K_) * 2u;
        const int slot = u.x1 * 256 + row, cnt = ts[40 + u.x0];
        const int tok = slot < cnt ? list[u.x0 * 32768 + slot] : 0;
        return (unsigned)(tok * K_) * 2u;
    }
    __device__ __forceinline__ int b_shift(const Unit&) const { return 0; }
};

__device__ __forceinline__ void st8(bf16* p, f32x4 v0, f32x4 v1) { v4u w; w.x = cvt_pk_bf16(v0[0], v0[1]); w.y = cvt_pk_bf16(v0[2], v0[3]); w.z = cvt_pk_bf16(v1[0], v1[1]); w.w = cvt_pk_bf16(v1[2], v1[3]); *(v4u*)p = w; }
__device__ __forceinline__ v4u widen_pair(v2u a, v2u b) {
    auto rx = __builtin_amdgcn_permlane32_swap(a.x, b.x, false, false); auto ry = __builtin_amdgcn_permlane32_swap(a.y, b.y, false, false);
    v4u w; w.x = rx[0]; w.y = ry[0]; w.z = rx[1]; w.w = ry[1]; return w;
}
__device__ __forceinline__ void ld8(const bf16* p, f32x4& v0, f32x4& v1) { const v4u w = *(const v4u*)p; v0 = (f32x4){bflo(w.x), bfhi(w.x), bflo(w.y), bfhi(w.y)}; v1 = (f32x4){bflo(w.z), bfhi(w.z), bflo(w.w), bfhi(w.w)}; }

struct EpiInProj {
    static constexpr bool PERM = true; static constexpr int HOOK_T = -1;
    bf16 *Q, *Kb, *ZU, *GA, *GG, *VT, *ZVT;
    template <int ACT> __device__ __forceinline__ void std_store(const Acc& acc, bf16* base, int ldc, int colt, int pm, int wr, int wc, int fr, int fq) const {
        const int row0 = pm * 256 + wr * 64 + fr, col0 = colt + wc * 32 + 8 * fq;
#pragma unroll
        for (int ai = 0; ai < 2; ++ai)
#pragma unroll
            for (int m = 0; m < 4; ++m) { bf16* rowp = base + (size_t)(row0 + ai * 128 + m * 16) * ldc + col0;
#pragma unroll
                for (int bj = 0; bj < 2; ++bj) { f32x4 v0 = acc[ai][bj][m][0], v1 = acc[ai][bj][m][1];
                    if (ACT == 1) { v0 = v0 * QSCALE; v1 = v1 * QSCALE; }
                    if (ACT == 2) { v0 = gelu4(v0); v1 = gelu4(v1); }
                    if (ACT == 3) { v0 = sigm4(v0); v1 = sigm4(v1); }
                    st8(rowp + bj * 128, v0, v1); } }
    }
    template <int ACT> __device__ __forceinline__ void tile_store(const Acc& acc, bf16* base, int g, int pm, int wr, int wc, int fr, int fq) const {
        const int dsh = 2 * g, row0 = pm * 256 + wr * 64 + fr;
#pragma unroll
        for (int ai = 0; ai < 2; ++ai)
#pragma unroll
            for (int m = 0; m < 4; ++m) { const int t = row0 + ai * 128 + m * 16, bb = t >> 12, sq = t & (SEQ - 1), r = sq & ((1 << dsh) - 1), i = sq >> dsh, kb = i >> 5, key = i & 31;
#pragma unroll
                for (int bj = 0; bj < 2; ++bj) { const int cw = bj * 128 + wc * 32 + 8 * fq, hh = cw >> 6, dd = cw & 63;
                    f32x4 v0 = acc[ai][bj][m][0], v1 = acc[ai][bj][m][1];
                    if (ACT == 1) { v0 = v0 * QSCALE; v1 = v1 * QSCALE; }
                    st8(base + ((size_t)((bb * 3 + g) * 4 + hh) * 128 + (size_t)((r << (7 - dsh)) + kb)) * 2048 + key * 64 + dd, v0, v1); } }
    }
    __device__ __forceinline__ void operator()(const Acc& acc, const Unit& u, int wr, int wc, int fr, int fq) const {
        const int pn = u.pn, pm = u.pm;
        if (pn < 3) tile_store<1>(acc, Q, pn, pm, wr, wc, fr, fq);
        else if (pn < 6) tile_store<0>(acc, Kb, pn - 3, pm, wr, wc, fr, fq);
        else if (pn < 9) std_store<2>(acc, ZU, GM_W, (pn - 6) * 256, pm, wr, wc, fr, fq);
        else if (pn < 13) std_store<3>(acc, GA, D, (pn - 9) * 256, pm, wr, wc, fr, fq);
        else if (pn < 17) std_store<3>(acc, GG, D, (pn - 13) * 256, pm, wr, wc, fr, fq);
        else if (pn < 20) {
            const int g = pn - 17, sh = 2 * g, bb = pm >> 4, j0 = (pm & 15) * 256, r = j0 >> (12 - sh), i0 = j0 & ((SEQ >> sh) - 1), nKB = 128 >> sh;
#pragma unroll
            for (int ai = 0; ai < 2; ++ai)
#pragma unroll
                for (int m = 0; m < 4; ++m) { const int chl = ai * 128 + wr * 64 + m * 16 + fr, hh = chl >> 6, dd = chl & 63;
                    bf16* hb = VT + (size_t)((bb * 3 + g) * 4 + hh) * (128 * 64 * 32) + dd * 32;
#pragma unroll
                    for (int bj = 0; bj < 2; ++bj) { const int i = i0 + bj * 128 + wc * 32 + 8 * fq;
                        st8(hb + (size_t)(r * nKB + (i >> 5)) * 2048 + (i & 31), acc[ai][bj][m][0], acc[ai][bj][m][1]); } }
        } else {
            const int ch0 = (pn - 20) * 256 + wr * 64 + fr, tin = wc * 32 + 8 * fq;
#pragma unroll
            for (int ai = 0; ai < 2; ++ai)
#pragma unroll
                for (int m = 0; m < 4; ++m) { const int ch = ch0 + ai * 128 + m * 16;
#pragma unroll
                    for (int bj = 0; bj < 2; ++bj) st8(ZVT + ((size_t)(2 * pm + bj) * GM_W + ch) * 128 + tin, gelu4(acc[ai][bj][m][0]), gelu4(acc[ai][bj][m][1])); }
        }
    }
};
template <int MODE> struct EpiBf {
    static constexpr bool PERM = true; static constexpr int HOOK_T = -1;
    bf16* O; const bf16* G1; const bf16* Y0;
    __device__ __forceinline__ void operator()(const Acc& acc, const Unit& u, int wr, int wc, int fr, int fq) const {
        const int row0 = u.pm * 256 + wr * 64 + fr, col0 = u.pn * 256 + wc * 32 + 8 * fq;
#pragma unroll
        for (int ai = 0; ai < 2; ++ai) {
            v4u gw[4][2], yw[4][2];
            if (MODE >= 1) {
#pragma unroll
                for (int m = 0; m < 4; ++m)
#pragma unroll
                    for (int bj = 0; bj < 2; ++bj) { const size_t off = (size_t)(row0 + ai * 128 + m * 16) * D + col0 + bj * 128; gw[m][bj] = *(const v4u*)(G1 + off); if (MODE == 2) yw[m][bj] = *(const v4u*)(Y0 + off); }
                __builtin_amdgcn_sched_barrier(0);
            }
#pragma unroll
            for (int m = 0; m < 4; ++m)
#pragma unroll
                for (int bj = 0; bj < 2; ++bj) { const size_t off = (size_t)(row0 + ai * 128 + m * 16) * D + col0 + bj * 128; f32x4 v0 = acc[ai][bj][m][0], v1 = acc[ai][bj][m][1];
                    if (MODE >= 1) { const v4u w = gw[m][bj]; v0 = v0 * (f32x4){bflo(w.x), bfhi(w.x), bflo(w.y), bfhi(w.y)}; v1 = v1 * (f32x4){bflo(w.z), bfhi(w.z), bflo(w.w), bfhi(w.w)}; }
                    if (MODE == 2) { const v4u w = yw[m][bj]; v0 = v0 + (f32x4){bflo(w.x), bfhi(w.x), bflo(w.y), bfhi(w.y)}; v1 = v1 + (f32x4){bflo(w.z), bfhi(w.z), bflo(w.w), bfhi(w.w)}; }
                    st8(O + off, v0, v1); }
            if (MODE >= 1) __builtin_amdgcn_sched_barrier(0);
        }
    }
};
template <int MODE> struct EpiF32 {
    static constexpr bool PERM = false; static constexpr int HOOK_T = -1;
    float* H; const float* X; const bf16* PP;
    __device__ __forceinline__ void operator()(const Acc& acc, const Unit& u, int wr, int wc, int fr, int fq) const {
        const int row0 = u.pm * 256 + wr * 64 + fr, col0 = u.pn * 256 + wc * 32 + 4 * fq;
        const float* src = MODE == 0 ? X : H;
        constexpr int MB = MODE == 0 ? 4 : 2;
#pragma unroll
        for (int ai = 0; ai < 2; ++ai)
#pragma unroll
            for (int mb = 0; mb < 4; mb += MB) {
                f32x4 xv[MB][2][2]; v2u pw[MB][2][2];
#pragma unroll
                for (int m = 0; m < MB; ++m)
#pragma unroll
                    for (int bj = 0; bj < 2; ++bj)
#pragma unroll
                        for (int n = 0; n < 2; ++n) { const size_t o = (size_t)(row0 + ai * 128 + (mb + m) * 16) * D + col0 + bj * 128 + n * 16; xv[m][bj][n] = *(const f32x4*)(src + o); if (MODE == 1) pw[m][bj][n] = *(const v2u*)(PP + o); }
                __builtin_amdgcn_sched_barrier(0);
#pragma unroll
                for (int m = 0; m < MB; ++m)
#pragma unroll
                    for (int bj = 0; bj < 2; ++bj)
#pragma unroll
                        for (int n = 0; n < 2; ++n) { const size_t o = (size_t)(row0 + ai * 128 + (mb + m) * 16) * D + col0 + bj * 128 + n * 16; f32x4 v = acc[ai][bj][mb + m][n];
                            if (MODE == 0) v = v + xv[m][bj][n];
                            else { const v2u w = pw[m][bj][n]; v = xv[m][bj][n] + sigm4(v) * (f32x4){bflo(w.x), bfhi(w.x), bflo(w.y), bfhi(w.y)}; }
                            *(f32x4*)(H + o) = v; }
                __builtin_amdgcn_sched_barrier(0);
            }
    }
};
struct EpiH1 {
    static constexpr bool PERM = true; static constexpr int HOOK_T = -1;
    bf16* O; const float* X;
    __device__ __forceinline__ void operator()(const Acc& acc, const Unit& u, int wr, int wc, int fr, int fq) const {
        const int row0 = u.pm * 256 + wr * 64 + fr, col0 = u.pn * 256 + wc * 32 + 8 * fq;
#pragma unroll
        for (int ai = 0; ai < 2; ++ai) {
            f32x4 xv[4][2][2];
#pragma unroll
            for (int m = 0; m < 4; ++m)
#pragma unroll
                for (int bj = 0; bj < 2; ++bj) { const float* xp = X + (size_t)(row0 + ai * 128 + m * 16) * D + col0 + bj * 128; xv[m][bj][0] = *(const f32x4*)xp; xv[m][bj][1] = *(const f32x4*)(xp + 4); }
            __builtin_amdgcn_sched_barrier(0);
#pragma unroll
            for (int m = 0; m < 4; ++m)
#pragma unroll
                for (int bj = 0; bj < 2; ++bj) st8(O + (size_t)(row0 + ai * 128 + m * 16) * D + col0 + bj * 128, acc[ai][bj][m][0] + xv[m][bj][0], acc[ai][bj][m][1] + xv[m][bj][1]);
            __builtin_amdgcn_sched_barrier(0);
        }
    }
};
struct EpiMerge {
    static constexpr bool PERM = true; static constexpr int HOOK_T = 2;
    bf16* O; const bf16* GA; const bf16* GG;
    __device__ __forceinline__ void mid(Acc& acc, const Unit& u, int wr, int wc, int fr, int fq) const {
        int row0 = u.pm * 256 + wr * 64 + fr; const int col0 = u.pn * 256 + wc * 32 + 8 * fq;
        asm volatile("" : "+v"(row0));
#pragma unroll
        for (int ai = 0; ai < 2; ++ai)
#pragma unroll
            for (int mb = 0; mb < 4; mb += 2) {
                v4u aw[2][2], gw[2][2];
#pragma unroll
                for (int m = 0; m < 2; ++m)
#pragma unroll
                    for (int bj = 0; bj < 2; ++bj) { const size_t off = (size_t)(row0 + ai * 128 + (mb + m) * 16) * D + col0 + bj * 128; aw[m][bj] = *(const v4u*)(GA + off); gw[m][bj] = *(const v4u*)(GG + off); }
                __builtin_amdgcn_sched_barrier(0);
#pragma unroll
                for (int m = 0; m < 2; ++m)
#pragma unroll
                    for (int bj = 0; bj < 2; ++bj) { const v4u a = aw[m][bj], g = gw[m][bj];
                        acc[ai][bj][mb + m][0] = acc[ai][bj][mb + m][0] * (f32x4){bflo(a.x) * __builtin_amdgcn_rcpf(fmaxf(bflo(g.x), 1e-30f)), bfhi(a.x) * __builtin_amdgcn_rcpf(fmaxf(bfhi(g.x), 1e-30f)), bflo(a.y) * __builtin_amdgcn_rcpf(fmaxf(bflo(g.y), 1e-30f)), bfhi(a.y) * __builtin_amdgcn_rcpf(fmaxf(bfhi(g.y), 1e-30f))};
                        acc[ai][bj][mb + m][1] = acc[ai][bj][mb + m][1] * (f32x4){bflo(a.z) * __builtin_amdgcn_rcpf(fmaxf(bflo(g.z), 1e-30f)), bfhi(a.z) * __builtin_amdgcn_rcpf(fmaxf(bfhi(g.z), 1e-30f)), bflo(a.w) * __builtin_amdgcn_rcpf(fmaxf(bflo(g.w), 1e-30f)), bfhi(a.w) * __builtin_amdgcn_rcpf(fmaxf(bfhi(g.w), 1e-30f))}; }
                __builtin_amdgcn_sched_barrier(0);
            }
    }
    __device__ __forceinline__ void operator()(const Acc& acc, const Unit& u, int wr, int wc, int fr, int fq) const {
        const int row0 = u.pm * 256 + wr * 64 + fr, col0 = u.pn * 256 + wc * 32 + 8 * fq;
#pragma unroll
        for (int ai = 0; ai < 2; ++ai) {
            v4u gw[4][2];
#pragma unroll
            for (int m = 0; m < 4; ++m)
#pragma unroll
                for (int bj = 0; bj < 2; ++bj) gw[m][bj] = *(const v4u*)(GG + (size_t)(row0 + ai * 128 + m * 16) * D + col0 + bj * 128);
            __builtin_amdgcn_sched_barrier(0);
#pragma unroll
            for (int m = 0; m < 4; ++m)
#pragma unroll
                for (int bj = 0; bj < 2; ++bj) { const v4u g = gw[m][bj];
                    st8(O + (size_t)(row0 + ai * 128 + m * 16) * D + col0 + bj * 128, acc[ai][bj][m][0] * (f32x4){bflo(g.x), bfhi(g.x), bflo(g.y), bfhi(g.y)}, acc[ai][bj][m][1] * (f32x4){bflo(g.z), bfhi(g.z), bflo(g.w), bfhi(g.w)}); }
            __builtin_amdgcn_sched_barrier(0);
        }
    }
};
struct EpiPle {
    static constexpr bool PERM = true; static constexpr int HOOK_T = -1;
    bf16* O; const bf16* PP; const float* RS;
    __device__ __forceinline__ void operator()(const Acc& acc, const Unit& u, int wr, int wc, int fr, int fq) const {
        const int row0 = u.pm * 256 + wr * 64 + fr, col0 = u.pn * 256 + wc * 32 + 8 * fq;
#pragma unroll
        for (int ai = 0; ai < 2; ++ai) {
            v4u pw[4][2]; float rs[4];
#pragma unroll
            for (int m = 0; m < 4; ++m) rs[m] = RS[row0 + ai * 128 + m * 16];
#pragma unroll
            for (int m = 0; m < 4; ++m)
#pragma unroll
                for (int bj = 0; bj < 2; ++bj) pw[m][bj] = *(const v4u*)(PP + (size_t)(row0 + ai * 128 + m * 16) * D + col0 + bj * 128);
            __builtin_amdgcn_sched_barrier(0);
#pragma unroll
            for (int m = 0; m < 4; ++m)
#pragma unroll
                for (int bj = 0; bj < 2; ++bj) { const v4u w = pw[m][bj];
                    const f32x4 v0 = sigm4(acc[ai][bj][m][0] * rs[m]) * (f32x4){bflo(w.x), bfhi(w.x), bflo(w.y), bfhi(w.y)}, v1 = sigm4(acc[ai][bj][m][1] * rs[m]) * (f32x4){bflo(w.z), bfhi(w.z), bflo(w.w), bfhi(w.w)};
                    st8(O + (size_t)(row0 + ai * 128 + m * 16) * D + col0 + bj * 128, v0, v1); }
            __builtin_amdgcn_sched_barrier(0);
        }
    }
};
struct EpiMoeUp {
    static constexpr bool PERM = true; static constexpr int HOOK_T = -1;
    bf16* ACT; const float* bgu; const float* srstd; const LAS int* ts;
    __device__ __forceinline__ void operator()(const Acc& acc, const Unit& u, int wr, int wc, int fr, int fq) const {
        const int e = u.x0, cnt = ts[40 + e], srow0 = u.x1 * 256 + wr * 64 + fr;
        const int row0 = u.pm * 256 + wr * 64 + fr, hc = u.pn * 128 + wc * 32 + 8 * fq;
        const float* bg = bgu + (size_t)e * 2048 + hc;
        const f32x4 bg0 = *(const f32x4*)bg, bg1 = *(const f32x4*)(bg + 4), bl0 = *(const f32x4*)(bg + 1024), bl1 = *(const f32x4*)(bg + 1028);
        float rsv[2][4];
#pragma unroll
        for (int ai = 0; ai < 2; ++ai)
#pragma unroll
            for (int m = 0; m < 4; ++m) { const int slot = srow0 + ai * 128 + m * 16; rsv[ai][m] = slot < cnt ? srstd[e * 32768 + slot] : 0.f; }
        __builtin_amdgcn_sched_barrier(0);
#pragma unroll
        for (int ai = 0; ai < 2; ++ai)
#pragma unroll
            for (int m = 0; m < 4; ++m) { const float rs = rsv[ai][m];
                f32x4 o[2];
#pragma unroll
                for (int n = 0; n < 2; ++n) { const f32x4 gu = acc[ai][0][m][n] * rs + (n ? bg1 : bg0), li = acc[ai][1][m][n] * rs + (n ? bl1 : bl0);
#pragma unroll
                    for (int e2 = 0; e2 < 4; ++e2) { const float gl = fminf(gu[e2], 7.0f), ln = fminf(fmaxf(li[e2], -7.0f), 7.0f);
                        o[n][e2] = gl * __builtin_amdgcn_rcpf(1.0f + __builtin_amdgcn_exp2f(-1.702f * LOG2E * gl)) * (ln + 1.0f); } }
                st8(ACT + (size_t)(row0 + ai * 128 + m * 16) * D + hc, o[0], o[1]); }
    }
};
struct EpiMoeDown {
    static constexpr bool PERM = true; static constexpr int HOOK_T = -1;
    bf16* Y; const float* bd; const float* sgate; const LAS int* ts;
    __device__ __forceinline__ void operator()(const Acc& acc, const Unit& u, int wr, int wc, int fr, int fq) const {
        const int e = u.x0, cnt = ts[40 + e], srow0 = u.x1 * 256 + wr * 64 + fr, col0 = u.pn * 256 + wc * 32 + 8 * fq;
        const float* bp = bd + (size_t)e * D + col0;
        f32x4 bv[2][2];
#pragma unroll
        for (int bj = 0; bj < 2; ++bj) { bv[bj][0] = *(const f32x4*)(bp + bj * 128); bv[bj][1] = *(const f32x4*)(bp + bj * 128 + 4); }
        float gtv[2][4];
#pragma unroll
        for (int ai = 0; ai < 2; ++ai)
#pragma unroll
            for (int m = 0; m < 4; ++m) { const int slot = srow0 + ai * 128 + m * 16; gtv[ai][m] = slot < cnt ? sgate[e * 32768 + slot] : 0.f; }
        __builtin_amdgcn_sched_barrier(0);
#pragma unroll
        for (int ai = 0; ai < 2; ++ai)
#pragma unroll
            for (int m = 0; m < 4; ++m) { const float gt = gtv[ai][m];
                bf16* rowp = Y + (size_t)(u.pm * 256 + wr * 64 + fr + ai * 128 + m * 16) * D + col0;
#pragma unroll
                for (int bj = 0; bj < 2; ++bj) st8(rowp + bj * 128, (acc[ai][bj][m][0] + bv[bj][0]) * gt, (acc[ai][bj][m][1] + bv[bj][1]) * gt); }
    }
};

#define XB_TMO      128
#define XB_XCNT(j)  (256  + 64 * (j))
#define XB_XSUB(j)  (1280 + 64 * (j))
#define XB_XGEN(j)  (2304 + 64 * (j))
#define XB_TOP      3328
#define XB_TOPGEN   3392
#define XCD_BAR_WORDS 3456
#define XB_SPIN_CAP (1u << 18)
__device__ __forceinline__ unsigned xb_ld(unsigned* p)              { return __hip_atomic_load(p, __ATOMIC_RELAXED, __HIP_MEMORY_SCOPE_AGENT); }
__device__ __forceinline__ unsigned xb_add(unsigned* p, unsigned v) { return __hip_atomic_fetch_add(p, v, __ATOMIC_RELAXED, __HIP_MEMORY_SCOPE_AGENT); }
__device__ __forceinline__ unsigned xb_xcc_id() { return (unsigned)__builtin_amdgcn_s_getreg((3 << 11) | 20) & 0xFu; }
#define XB_SPIN(cond, bar) do { unsigned _sp = 0; while (cond) { __builtin_amdgcn_s_sleep(1); \
    if ((++_sp & 255u) == 0u) { if (xb_ld(&(bar)[XB_TMO])) break; if (_sp > XB_SPIN_CAP) { atomicAdd(&(bar)[XB_TMO], 1u); break; } } } } while (0)
struct XcdBarrier { unsigned* bar; unsigned x; volatile LAS unsigned* st; int wave; };
__device__ __forceinline__ XcdBarrier xcd_barrier_post(unsigned* bar, volatile LAS unsigned* st, int wave) {
    XcdBarrier b; b.bar = bar; b.x = xb_xcc_id(); b.st = st; b.wave = wave;
    if (tid_opaque(wave) == 0) (void)xb_add(&bar[XB_XCNT(b.x)], 1u);
    return b;
}
__device__ __forceinline__ void xcd_barrier_complete(unsigned* bar, unsigned x, unsigned& nloc, unsigned& nx) {
    const unsigned G = gridDim.x * gridDim.y * gridDim.z;
    unsigned sum, cnt, mine, sp = 0u;
    for (;;) {
        sum = 0u; cnt = 0u; mine = 0u;
#pragma unroll
        for (unsigned j = 0; j < 16; ++j) { const unsigned c = xb_ld(&bar[XB_XCNT(j)]); sum += c; cnt += (c > 0u) ? 1u : 0u; mine = (j == x) ? c : mine; }
        if (sum == G) break;
        __builtin_amdgcn_s_sleep(1);
        if ((++sp & 255u) == 0u) { if (xb_ld(&bar[XB_TMO])) break; if (sp > XB_SPIN_CAP) { atomicAdd(&bar[XB_TMO], 1u); break; } }
    }
    nloc = mine > 0u ? mine : 1u; nx = cnt > 0u ? cnt : 1u;
}
__device__ __forceinline__ void xcd_barrier(const XcdBarrier& b) {
    asm volatile("s_waitcnt vmcnt(0)" ::: "memory");
    __syncthreads();
    if (tid_opaque(b.wave) == 0) {
        unsigned* bar = b.bar;
        __builtin_amdgcn_s_waitcnt(0);
        unsigned nloc = b.st[0], nx = b.st[1];
        if (nloc == 0u) { xcd_barrier_complete(bar, b.x, nloc, nx); b.st[0] = nloc; b.st[1] = nx; }
        const unsigned old = xb_add(&bar[XB_XSUB(b.x)], 1u);
        const unsigned gen = old / nloc;
        if (old + 1u == (gen + 1u) * nloc) {
            __builtin_amdgcn_fence(__ATOMIC_RELEASE, "agent");
            asm volatile("s_waitcnt vmcnt(0)" ::: "memory");
            const unsigned og = xb_add(&bar[XB_TOP], 1u);
            const unsigned tg = og / nx;
            if (og + 1u == (tg + 1u) * nx) xb_add(&bar[XB_TOPGEN], 1u);
            else XB_SPIN(xb_ld(&bar[XB_TOPGEN]) == tg, bar);
            __builtin_amdgcn_fence(__ATOMIC_ACQUIRE, "agent");
            xb_add(&bar[XB_XGEN(b.x)], 1u);
            asm volatile("s_waitcnt vmcnt(0)" ::: "memory");
        } else {
            XB_SPIN(xb_ld(&bar[XB_XGEN(b.x)]) == gen, bar);
            __builtin_amdgcn_fence(__ATOMIC_ACQUIRE, "agent");
            asm volatile("s_waitcnt vmcnt(0)" ::: "memory");
        }
    }
    __syncthreads();
}

struct Args { const float* in[23]; float* out; unsigned char* ws; int ph_lo, ph_hi; };
struct Frame {
    LAS unsigned char* lds; int wave, vcu, G;
};
#define LDS_WAIT() asm volatile("s_waitcnt lgkmcnt(0)" ::: "memory")

__device__ __forceinline__ int t5_bucket(int n) {
    if (n < 16) return n;
    const int th[15] = {22, 30, 40, 54, 73, 99, 134, 182, 246, 332, 450, 609, 825, 1117, 1513};
    int b = 16;
#pragma unroll
    for (int k = 0; k < 15; ++k) b += (n >= th[k]) ? 1 : 0;
    return b;
}

__device__ __forceinline__ void transpose_item(const float* W, int K, int N, bf16* WT, int drow0, LAS float* scr, int k0, int n0, int lane, int kdst = 0) {
    const int q = lane & 15, kr = lane >> 4;
    f32x4 v[8];
#pragma unroll
    for (int i = 0; i < 8; ++i) v[i] = *(const f32x4*)(W + (size_t)(k0 + 4 * i + kr) * N + n0 + 4 * q);
#pragma unroll
    for (int i = 0; i < 8; ++i) { LAS float* d = scr + (4 * q) * 33 + 4 * i + kr; d[0] = v[i].x; d[33] = v[i].y; d[66] = v[i].z; d[99] = v[i].w; }
    LDS_WAIT(); asm volatile("" ::: "memory");
    const int c4 = lane & 3, nr = lane >> 2;
#pragma unroll
    for (int j = 0; j < 4; ++j) { const int n = nr + 16 * j; const LAS float* sp = scr + n * 33 + 8 * c4;
        v4u o; o.x = pk2(sp[0], sp[1]); o.y = pk2(sp[2], sp[3]); o.z = pk2(sp[4], sp[5]); o.w = pk2(sp[6], sp[7]);
        *(v4u*)(WT + (size_t)(drow0 + n) * K + kdst + k0 + 8 * c4) = o; }
    LDS_WAIT(); asm volatile("" ::: "memory");
}
constexpr int BG_GU = 32 * 32 * 32, BG_DN = 32 * 32 * 16, BG_N = BG_GU + BG_DN;
constexpr int BG_P1 = 32768;
struct BgItem { const float* W; bf16* WT; const float* sc; int N, k0, n0, drow0, pitch, kdst; };
constexpr int BG_X0 = BG_N, BG_X1 = BG_X0 + 8 * 16, BG_X2 = BG_X1 + 24 * 16, BG_X3 = BG_X2 + 32 * 16, BG_X4 = BG_X3 + 32 * 16, BG_ALL = BG_X4 + 8 * 16;
__device__ __forceinline__ BgItem bg_decode(const Args& A, int r) {
    BgItem it; it.pitch = D; it.kdst = 0; it.sc = nullptr;
    if (r < BG_GU) { const int e = r >> 10, q = r & 1023, kb = q >> 5, nb = q & 31, n0 = nb * 64;
        it.W = A.in[15] + (size_t)e * D * 2048; it.WT = (bf16*)(A.ws + WS_WGU) + (size_t)e * 2048 * D; it.N = 2048; it.sc = A.in[12]; it.k0 = kb * 32; it.n0 = n0;
        it.drow0 = n0 < 1024 ? 256 * (n0 >> 7) + (n0 & 127) : 256 * ((n0 - 1024) >> 7) + 128 + (n0 & 127);
    } else if (r < BG_N) { r -= BG_GU; const int e = r >> 9, q = r & 511, kb = q >> 4, nb = q & 15;
        it.W = A.in[17] + (size_t)e * D * D; it.WT = (bf16*)(A.ws + WS_WD) + (size_t)e * D * D; it.N = D; it.k0 = kb * 32; it.n0 = nb * 64; it.drow0 = nb * 64;
    } else { int src; bf16* dst;
        if (r < BG_X1) { r -= BG_X0; src = 5; dst = (bf16*)(A.ws + WS_WCAT); }
        else if (r < BG_X2) { r -= BG_X1; src = 10; dst = (bf16*)(A.ws + WS_WCAT); it.kdst = 256; }
        else if (r < BG_X3) { r -= BG_X2; src = 11; dst = (bf16*)(A.ws + WS_WOUT); }
        else if (r < BG_X4) { r -= BG_X3; src = 20; dst = (bf16*)(A.ws + WS_WPG); }
        else { r -= BG_X4; src = 21; dst = (bf16*)(A.ws + WS_WPP); it.pitch = PLE; }
        it.W = src == 5 ? A.in[5] : src == 10 ? A.in[10] : src == 11 ? A.in[11] : src == 20 ? A.in[20] : A.in[21];
        if (src == 20) it.sc = A.in[19];
        it.WT = dst; it.N = D; it.k0 = (r >> 4) * 32; it.n0 = (r & 15) * 64; it.drow0 = it.n0; }
    return it;
}
struct BgConv {
    int cur, next, stride, end; f32x4 v[8]; float gs[8];
    __device__ __forceinline__ void init(int first, int stride_, int end_ = BG_ALL) { cur = -1; next = first; stride = stride_; end = end_; }
    __device__ __forceinline__ void issue(const Args& A, int lane) {
        if (next < end) { const BgItem it = bg_decode(A, next); const int q = lane & 15, kr = lane >> 4;
#pragma unroll
            for (int i = 0; i < 8; ++i) v[i] = *(const f32x4*)(it.W + (size_t)(it.k0 + 4 * i + kr) * it.N + it.n0 + 4 * q);
            if (it.sc) {
#pragma unroll
                for (int i = 0; i < 8; ++i) gs[i] = it.sc[it.k0 + 4 * i + kr]; } else {
#pragma unroll
                for (int i = 0; i < 8; ++i) gs[i] = 1.0f; }
            cur = next; next += stride; } else cur = -1;
    }
    __device__ __forceinline__ void finish(const Args& A, LAS float* scr, int lane) {
        if (cur >= 0) { const BgItem it = bg_decode(A, cur); const int q = lane & 15, kr = lane >> 4;
#pragma unroll
            for (int i = 0; i < 8; ++i) { LAS float* d = scr + (4 * q) * 33 + 4 * i + kr; const float g = gs[i]; d[0] = v[i].x * g; d[33] = v[i].y * g; d[66] = v[i].z * g; d[99] = v[i].w * g; }
            LDS_WAIT(); asm volatile("" ::: "memory");
            const int c4 = lane & 3, nr = lane >> 2;
#pragma unroll
            for (int j = 0; j < 4; ++j) { const int n = nr + 16 * j; const LAS float* sp = scr + n * 33 + 8 * c4;
                v4u o; o.x = pk2(sp[0], sp[1]); o.y = pk2(sp[2], sp[3]); o.z = pk2(sp[4], sp[5]); o.w = pk2(sp[6], sp[7]);
                *(v4u*)(it.WT + (size_t)(it.drow0 + n) * it.pitch + it.kdst + it.k0 + 8 * c4) = o; }
            LDS_WAIT(); asm volatile("" ::: "memory");
            cur = -1; }
    }
};
__device__ __forceinline__ void convert_queue(const Frame& F, const Args& A, unsigned* ctr, int lo, int hi) {
    const int tidx_ = tid_opaque(F.wave);
    LAS float* scr = (LAS float*)(F.lds + F.wave * 8448);
    LAS int* qs = (LAS int*)(F.lds + RING_BYTES + 512);
    const int lane = tidx_ & 63;
    BgConv c0, c1;
    for (;;) {
        __syncthreads();
        if (tidx_ == 0) *qs = (int)__hip_atomic_fetch_add(ctr, 64u, __ATOMIC_RELAXED, __HIP_MEMORY_SCOPE_AGENT);
        __syncthreads();
        const int base = __builtin_amdgcn_readfirstlane(*qs) + lo + F.wave * 8;
        if (base - F.wave * 8 >= hi) break;
        c0.init(base, 2, base + 8 < hi ? base + 8 : hi); c1.init(base + 1, 2, base + 8 < hi ? base + 8 : hi);
        c0.issue(A, lane); c1.issue(A, lane);
#pragma unroll 1
        for (int k = 0; k < 4; ++k) { c0.finish(A, scr, lane); c0.issue(A, lane); c1.finish(A, scr, lane); c1.issue(A, lane); }
    }
}
__device__ __forceinline__ void convert_p_queue(const Frame& F, const Args& A, unsigned* ctr) {
    const int tidx_ = tid_opaque(F.wave);
    const int lane = tidx_ & 63; const float* p = A.in[1]; bf16* pb = (bf16*)(A.ws + WS_PB);
    LAS int* qs = (LAS int*)(F.lds + RING_BYTES + 512);
    for (;;) {
        __syncthreads();
        if (tidx_ == 0) *qs = (int)__hip_atomic_fetch_add(ctr, 8u, __ATOMIC_RELAXED, __HIP_MEMORY_SCOPE_AGENT);
        __syncthreads();
        const int ck0 = __builtin_amdgcn_readfirstlane(*qs);
        if (ck0 >= (T * PLE) / 8192) break;
        const size_t base = (size_t)(ck0 + F.wave) * 8192 + 8 * lane;
#pragma unroll 4
        for (int i = 0; i < 16; ++i) { const f32x4 a = *(const f32x4*)(p + base + 512 * i), b = *(const f32x4*)(p + base + 512 * i + 4); st8(pb + base + 512 * i, a, b); }
    }
}
constexpr int BG_SCR_OFF = 45056;
__device__ __forceinline__ int win_dest(int n0) {
    if (n0 < 1536) return n0;
    if (n0 < 2304) return 4352 + (n0 - 1536);
    if (n0 < 3072) return 1536 + (n0 - 2304);
    if (n0 < 3840) return 5120 + (n0 - 3072);
    return 2304 + (n0 - 3840);
}
template <int NR> __device__ __forceinline__ void rms_rows_to_bf16(const float* xrow, const float* gain, bf16* orow, int lane) {
    f32x4 v[NR][4]; float s[NR];
#pragma unroll
    for (int r = 0; r < NR; ++r)
#pragma unroll
        for (int j = 0; j < 4; ++j) v[r][j] = ((const f32x4*)(xrow + (size_t)r * D) + lane)[64 * j];
    f32x4 g[4];
#pragma unroll
    for (int j = 0; j < 4; ++j) g[j] = ((const f32x4*)gain + lane)[64 * j];
#pragma unroll
    for (int r = 0; r < NR; ++r) { float a = 0.f;
#pragma unroll
        for (int j = 0; j < 4; ++j) a += (v[r][j].x * v[r][j].x + v[r][j].y * v[r][j].y) + (v[r][j].z * v[r][j].z + v[r][j].w * v[r][j].w);
        s[r] = a; }
#pragma unroll
    for (int o = 1; o < 64; o <<= 1)
#pragma unroll
        for (int r = 0; r < NR; ++r) s[r] += __shfl_xor(s[r], o);
#pragma unroll
    for (int r = 0; r < NR; ++r) { const float rstd = 1.0f / sqrtf(s[r] * (1.f / D) + EPS);
        unsigned long long* o8 = (unsigned long long*)(orow + (size_t)r * D) + lane;
#pragma unroll
        for (int j = 0; j < 4; ++j) o8[64 * j] = (unsigned long long)pk2(v[r][j].x * rstd * g[j].x, v[r][j].y * rstd * g[j].y) | ((unsigned long long)pk2(v[r][j].z * rstd * g[j].z, v[r][j].w * rstd * g[j].w) << 32); }
}
__device__ __forceinline__ void p0_prologue(const Frame& F, const Args& A) {
    const int tidx_ = tid_opaque(F.wave);
    LAS float* scr = (LAS float*)(F.lds + F.wave * 16384);
    const int gw = F.vcu * 8 + F.wave, NGW = F.G * 8;
    unsigned char* ws = A.ws;
    for (int m = gw * 4; m < T; m += NGW * 4) rms_rows_to_bf16<4>(A.in[0] + (size_t)m * D, A.in[2], (bf16*)(ws + WS_NX) + (size_t)m * D, (tidx_ & 63));
    { const float* wsp = A.in[8]; bf16* o = (bf16*)(ws + WS_WSP);
      for (int i = (blockIdx.x * 512 + tidx_) * 4; i < 12 * 128 * 128; i += F.G * 512 * 4) { const int col = i & 127, row = (i >> 7) & 127; const f32x4 a = *(const f32x4*)(wsp + i);
          v2u w; w.x = pk2(col <= row ? a.x : 0.f, col + 1 <= row ? a.y : 0.f); w.y = pk2(col + 2 <= row ? a.z : 0.f, col + 3 <= row ? a.w : 0.f); *(v2u*)(o + i) = w; } }
    { const float* wrt = A.in[13]; bf16* wh = (bf16*)(ws + WS_WRH); bf16* wl = (bf16*)(ws + WS_WRL);
      for (int i = blockIdx.x * 512 + tidx_; i < 32 * 1024; i += F.G * 512) { const int e = i >> 10, k = i & 1023; const float w = wrt[k * 32 + e]; const unsigned h = f2bf(w); wh[i] = (bf16)h; wl[i] = (bf16)f2bf(w - bflo(h)); } }
    constexpr int I_IN = 32 * 92;
    for (int it = gw; it < I_IN; it += NGW) { const int kb = it / 92, nb = it % 92; transpose_item(A.in[3], D, IN_W, (bf16*)(ws + WS_WIN), win_dest(nb * 64), scr, kb * 32, nb * 64, (tidx_ & 63)); }
}

__device__ __forceinline__ int crow(int r, int hi) { return (r & 3) + 8 * (r >> 2) + 4 * hi; }
struct AtU { int b, g, h, r, qb8, nqb; };
__device__ __forceinline__ AtU at_decode(int pr) { AtU u; const int slot = pr & 15; u.h = (pr >> 4) & 3; const int bgi = pr >> 6; u.g = bgi % 3; u.b = bgi / 3; u.nqb = 128 >> (2 * u.g);
    u.r = slot / (u.nqb >> 3); u.qb8 = slot % (u.nqb >> 3); return u; }
__device__ __forceinline__ void at_load(const AtU& u, const bf16* QT, const bf16* KT, const bf16* VT, int w, int r32, int hi, int q8, int t8, v4u (&stg)[12], bf16x8 (&qf)[4]) {
    const size_t tb0 = (size_t)((u.b * 3 + u.g) * 4 + u.h) * 128 + (size_t)(u.r * u.nqb);
    const bf16* qt = QT + (tb0 + u.qb8 * 8 + w) * 2048 + r32 * 64 + 8 * hi;
#pragma unroll
    for (int s = 0; s < 4; ++s) qf[s] = *(const bf16x8*)(qt + 16 * s);
#pragma unroll
    for (int i = 0; i < 12; ++i) { const int kv = i >= 6 ? 1 : 0, j = 2 * (i - 6 * kv) + t8; int kb = u.qb8 * 8 - 4 + j; kb = kb < 0 ? 0 : kb;
        stg[i] = *(const v4u*)((kv ? VT : KT) + (tb0 + kb) * 2048 + q8 * 8); }
}
__device__ __forceinline__ void attn_phase(const Frame& F, const Args& A) {
    const int tidx_ = tid_opaque(F.wave);
    LAS float* tb = (LAS float*)(F.lds + RING_BYTES + 2048);
    const float* rel_bias = A.in[4];
    for (int i = tidx_; i < 12 * 192; i += 512) { const int gh = i / 192, dist = i % 192 - 31, g = gh >> 2; const int dil = g == 0 ? 1 : (g == 1 ? 4 : 16);
        tb[i] = (dist >= 0 && dist <= 128) ? rel_bias[t5_bucket(dist * dil) * 12 + gh] * LOG2E : -INFINITY; }
    __syncthreads();
    const bf16* QT = (const bf16*)(A.ws + WS_Q); const bf16* KT = (const bf16*)(A.ws + WS_K); const bf16* VT = (const bf16*)(A.ws + WS_VT);
    bf16* OG = (bf16*)(A.ws + WS_OG); float* LSE = (float*)(A.ws + WS_LSE);
    const int lane = (tidx_ & 63), r32 = lane & 31, hi = lane >> 5, w = F.wave;
    const int q8 = tidx_ & 255, t8 = tidx_ >> 8;
    const int NU = NB * 3 * 4 * 16;
    v4u stg[12]; bf16x8 qf[4];
    if (F.vcu < NU) at_load(at_decode(F.vcu), QT, KT, VT, w, r32, hi, q8, t8, stg, qf);
    for (int pr = F.vcu; pr < NU; pr += F.G) {
        const AtU u = at_decode(pr);
        const int dsh = 2 * u.g, dil = 1 << dsh, g = u.g, h = u.h, b = u.b, r = u.r;
        const int qb = u.qb8 * 8 + w, i0 = qb * 32;
        __syncthreads();
        { const int keyk = q8 >> 3, posk = keyk * 8 + ((q8 & 7) ^ ((keyk >> 1) & 7)), dv = q8 >> 2, posv = dv * 4 + ((q8 & 3) ^ ((dv >> 2) & 3));
#pragma unroll
          for (int i = 0; i < 12; ++i) { const int kv = i >= 6 ? 1 : 0, j = 2 * (i - 6 * kv) + t8;
              *(LAS v4u*)(F.lds + kv * 49152 + j * 4096 + (kv ? posv : posk) * 16) = stg[i]; } }
        bf16x8 qc[4];
#pragma unroll
        for (int s = 0; s < 4; ++s) qc[s] = qf[s];
        __syncthreads();
        if (pr + F.G < NU) at_load(at_decode(pr + F.G), QT, KT, VT, w, r32, hi, q8, t8, stg, qf);
        __builtin_amdgcn_sched_barrier(0);
        const LAS unsigned char* kbase = F.lds + w * 4096 + (r32 * 8) * 16;
        const int kx = (r32 >> 1) & 7;
        f32x16 st[5];
#pragma unroll
        for (int kt = 0; kt < 5; ++kt) {
            f32x16 a = {};
#pragma unroll
            for (int s = 0; s < 4; ++s) { const bf16x8 kf = *(const LAS bf16x8*)(kbase + kt * 4096 + (((2 * s + hi) ^ kx) << 4)); a = __builtin_amdgcn_mfma_f32_32x32x16_bf16(kf, qc[s], a, 0, 0, 0); }
            st[kt] = a;
        }
        const LAS float* tbh = tb + (g * 4 + h) * 192;
        float mx = -INFINITY;
#pragma unroll
        for (int kt = 0; kt < 5; ++kt)
#pragma unroll
            for (int i = 0; i < 16; ++i) { const int kr = crow(i, hi), krel = -128 + 32 * kt + kr; const int dist = r32 - krel;
                float v = st[kt][i] + tbh[dist + 31]; v = (i0 + krel >= 0) ? v : -INFINITY; st[kt][i] = v; mx = fmaxf(mx, v); }
        mx = fmaxf(mx, __shfl_xor(mx, 32));
        float l = 0.f;
#pragma unroll
        for (int kt = 0; kt < 5; ++kt)
#pragma unroll
            for (int i = 0; i < 16; ++i) { const float p = __builtin_amdgcn_exp2f(st[kt][i] - mx); st[kt][i] = p; l += p; }
        l += __shfl_xor(l, 32);
        const LAS unsigned char* vbase = F.lds + 49152 + w * 4096;
        f32x16 o[2] = {};
#pragma unroll
        for (int kt = 0; kt < 5; ++kt)
#pragma unroll
            for (int s2 = 0; s2 < 2; ++s2) {
                v4u pw; pw.x = cvt_pk_bf16(st[kt][8 * s2 + 0], st[kt][8 * s2 + 1]); pw.y = cvt_pk_bf16(st[kt][8 * s2 + 2], st[kt][8 * s2 + 3]);
                pw.z = cvt_pk_bf16(st[kt][8 * s2 + 4], st[kt][8 * s2 + 5]); pw.w = cvt_pk_bf16(st[kt][8 * s2 + 6], st[kt][8 * s2 + 7]);
                const bf16x8 pf = __builtin_bit_cast(bf16x8, pw);
#pragma unroll
                for (int dt = 0; dt < 2; ++dt) { const int dd = 32 * dt + r32;
                    const LAS unsigned char* vr = vbase + kt * 4096 + dd * 64 + 8 * hi; const int vx = (dd >> 2) & 3;
                    const v2u p1 = *(const LAS v2u*)(vr + (((2 * s2) ^ vx) << 4)), p2 = *(const LAS v2u*)(vr + (((2 * s2 + 1) ^ vx) << 4));
                    v4u vw; vw.x = p1.x; vw.y = p1.y; vw.z = p2.x; vw.w = p2.y;
                    o[dt] = __builtin_amdgcn_mfma_f32_32x32x16_bf16(__builtin_bit_cast(bf16x8, vw), pf, o[dt], 0, 0, 0); }
            }
        const float rl = 1.0f / l;
        const size_t qrow = (size_t)b * SEQ + (size_t)(i0 + r32) * dil + r;
        bf16* op = OG + ((size_t)g * T + qrow) * 256 + h * 64;
#pragma unroll
        for (int dt = 0; dt < 2; ++dt)
#pragma unroll
            for (int gp = 0; gp < 2; ++gp) { v2u wa, wb;
                wa.x = cvt_pk_bf16(o[dt][8 * gp] * rl, o[dt][8 * gp + 1] * rl); wa.y = cvt_pk_bf16(o[dt][8 * gp + 2] * rl, o[dt][8 * gp + 3] * rl);
                wb.x = cvt_pk_bf16(o[dt][8 * gp + 4] * rl, o[dt][8 * gp + 5] * rl); wb.y = cvt_pk_bf16(o[dt][8 * gp + 6] * rl, o[dt][8 * gp + 7] * rl);
                *(v4u*)(op + 32 * dt + 16 * gp + 8 * hi) = widen_pair(wa, wb); }
        if (hi == 0) LSE[((size_t)g * T + qrow) * 4 + h] = (mx + __builtin_amdgcn_logf(l)) * LN2;
    }
    __syncthreads();
}

__device__ __forceinline__ void spatial_phase(const Frame& F, const Args& A) {
    const int tidx_ = tid_opaque(F.wave);
    const bf16* ZVT = (const bf16*)(A.ws + WS_ZVT); const bf16* ZU = (const bf16*)(A.ws + WS_ZU); const bf16* WSP = (const bf16*)(A.ws + WS_WSP);
    bf16* Gout = (bf16*)(A.ws + WS_AG) + 256;
    const float* lng = A.in[6]; const float* lnb = A.in[7]; const float* bsp = A.in[9];
    LAS float* red = (LAS float*)(F.lds + 10240);
    LAS float* stt = (LAS float*)(F.lds + 43008);
    LAS unsigned char* vn = F.lds + 49152;
    int lane = (tidx_ & 63); asm volatile("" : "+v"(lane));
    const int r32 = lane & 31, hi = lane >> 5, w = F.wave;
    const int dr = 8 * w + (lane >> 3), ck = lane & 7;
    for (int c = F.vcu; c < T / 128; c += F.G) {
        v4u zr[2];
#pragma unroll
        for (int p = 0; p < 2; ++p) zr[p] = *(const v4u*)(ZVT + ((size_t)c * GM_W + dr) * 128 + 8 * (ck + 8 * p));
        {
            const int tg = tidx_ & 15, rg = tidx_ >> 4; float sm[8], q[8];
#pragma unroll
            for (int e = 0; e < 8; ++e) { sm[e] = 0.f; q[e] = 0.f; }
#pragma unroll 4
            for (int ch = rg; ch < GM_W; ch += 32) { const v4u wv = *(const v4u*)(ZVT + ((size_t)c * GM_W + ch) * 128 + 8 * tg);
                const float x[8] = {bflo(wv.x), bfhi(wv.x), bflo(wv.y), bfhi(wv.y), bflo(wv.z), bfhi(wv.z), bflo(wv.w), bfhi(wv.w)};
#pragma unroll
                for (int e = 0; e < 8; ++e) { sm[e] += x[e]; q[e] += x[e] * x[e]; } }
#pragma unroll
            for (int e = 0; e < 8; ++e) { red[(rg * 128 + 8 * tg + e) * 2] = sm[e]; red[(rg * 128 + 8 * tg + e) * 2 + 1] = q[e]; }
            __syncthreads();
            if (tidx_ < 128) { float ss = 0.f, qq = 0.f;
                for (int k = 0; k < 32; ++k) { ss += red[(k * 128 + tidx_) * 2]; qq += red[(k * 128 + tidx_) * 2 + 1]; }
                const float mu = ss * (1.f / GM_W), var = fmaxf(qq * (1.f / GM_W) - mu * mu, 0.f);
                stt[tidx_ * 2] = mu; stt[tidx_ * 2 + 1] = 1.0f / sqrtf(var + EPS); }
            __syncthreads();
        }
#define SP_GROUP(GI, ZR_CUR, ZU_CUR, ZR_NXT, ZU_NXT) do { \
            const int gi_ = (GI); const int dt = w & 1, it = ((w >> 1) + gi_) & 3, ti = 32 * it + r32;       \
              \
            bf16x8 bfr[8]; \
            { const bf16* wp = WSP + ((size_t)gi_ * 128 + ti) * 128 + 8 * hi; \
              _Pragma("unroll") for (int s = 0; s < 8; ++s) bfr[s] = *(const bf16x8*)(wp + 16 * s); } \
            const float bsv = bsp[gi_ * 128 + ti], gch = lng[gi_ * 64 + dr], bch = lnb[gi_ * 64 + dr]; \
            __builtin_amdgcn_sched_barrier(0); \
              \
            LAS unsigned char* tile = vn + (gi_ & 1) * 16384; \
            _Pragma("unroll") for (int p = 0; p < 2; ++p) { const int jb = 8 * (ck + 8 * p); const v4u z = ZR_CUR[p]; \
                float x[8] = {bflo(z.x), bfhi(z.x), bflo(z.y), bfhi(z.y), bflo(z.z), bfhi(z.z), bflo(z.w), bfhi(z.w)}; \
                _Pragma("unroll") for (int e = 0; e < 8; ++e) x[e] = (x[e] - stt[(jb + e) * 2]) * stt[(jb + e) * 2 + 1] * gch + bch; \
                v4u aw; aw.x = cvt_pk_bf16(x[0], x[1]); aw.y = cvt_pk_bf16(x[2], x[3]); aw.z = cvt_pk_bf16(x[4], x[5]); aw.w = cvt_pk_bf16(x[6], x[7]); \
                *(LAS v4u*)(tile + dr * 256 + (((ck + 8 * p) ^ (dr & 15)) << 4)) = aw; } \
            { const int gn = gi_ + 1 < 12 ? gi_ + 1 : 11;        \
              _Pragma("unroll") for (int p = 0; p < 2; ++p) ZR_NXT[p] = *(const v4u*)(ZVT + ((size_t)c * GM_W + gn * 64 + dr) * 128 + 8 * (ck + 8 * p)); \
              const int itn = ((w >> 1) + gn) & 3; const size_t orow = ((size_t)c * 128 + 32 * itn + r32) * GM_W + gn * 64 + 32 * dt + 4 * hi; \
              _Pragma("unroll") for (int gq = 0; gq < 4; ++gq) ZU_NXT[gq] = *(const v2u*)(ZU + orow + 8 * gq); } \
            __syncthreads();                                    \
            f32x16 acc = {}; \
            { const int dd = 32 * dt + r32; const LAS unsigned char* ar = tile + dd * 256; \
              _Pragma("unroll") for (int s = 0; s < 8; ++s) { const bf16x8 af = *(const LAS bf16x8*)(ar + (((2 * s + hi) ^ (dd & 15)) << 4)); acc = __builtin_amdgcn_mfma_f32_32x32x16_bf16(af, bfr[s], acc, 0, 0, 0); } } \
              \
            const size_t groww = ((size_t)c * 128 + ti) * D + gi_ * 64 + 32 * dt + 8 * hi; \
            _Pragma("unroll") for (int gp = 0; gp < 2; ++gp) { v2u oo[2]; \
                _Pragma("unroll") for (int q2 = 0; q2 < 2; ++q2) { const int gq = 2 * gp + q2; const v2u uw = ZU_CUR[gq]; \
                    oo[q2].x = cvt_pk_bf16(bflo(uw.x) * (acc[4 * gq] + bsv), bfhi(uw.x) * (acc[4 * gq + 1] + bsv)); oo[q2].y = cvt_pk_bf16(bflo(uw.y) * (acc[4 * gq + 2] + bsv), bfhi(uw.y) * (acc[4 * gq + 3] + bsv)); } \
                *(v4u*)(Gout + groww + 16 * gp) = widen_pair(oo[0], oo[1]); } \
        } while (0)
        v4u zrb[2]; v2u zua[4], zub[4];
        { const int it0 = (w >> 1) & 3; const size_t orow = ((size_t)c * 128 + 32 * it0 + r32) * GM_W + 32 * (w & 1) + 4 * hi;
#pragma unroll
          for (int gq = 0; gq < 4; ++gq) zua[gq] = *(const v2u*)(ZU + orow + 8 * gq); }
#pragma unroll 1
        for (int gi = 0; gi < 12; gi += 2) {
            SP_GROUP(gi, zr, zua, zrb, zub);
            SP_GROUP(gi + 1, zrb, zub, zr, zua);
        }
#undef SP_GROUP
        __syncthreads();
    }
}

__device__ __forceinline__ void merge_phase(const Frame& F, const Args& A, const int gw, const int NGW) {
    const int tidx_ = tid_opaque(F.wave);
    const bf16* OG = (const bf16*)(A.ws + WS_OG); const float* LSE = (const float*)(A.ws + WS_LSE); bf16* ATT = (bf16*)(A.ws + WS_AG);
    const int lane = (tidx_ & 63), h = lane >> 4;
    for (int t0 = gw; t0 < T; t0 += 4 * NGW) {
        float l[4][3]; v2u w[4][3];
#pragma unroll
        for (int j = 0; j < 4; ++j) { const int t = t0 + j * NGW < T ? t0 + j * NGW : t0;
#pragma unroll
            for (int g = 0; g < 3; ++g) { l[j][g] = LSE[((size_t)g * T + t) * 4 + h]; w[j][g] = *(const v2u*)(OG + ((size_t)g * T + t) * 256 + 4 * lane); } }
#pragma unroll
        for (int j = 0; j < 4; ++j) { const int t = t0 + j * NGW; if (t < T) {
            const float m = fmaxf(l[j][0], fmaxf(l[j][1], l[j][2])); float a0 = __expf(l[j][0] - m), a1 = __expf(l[j][1] - m), a2 = __expf(l[j][2] - m); const float inv = 1.0f / (a0 + a1 + a2); a0 *= inv; a1 *= inv; a2 *= inv;
            const v2u w0 = w[j][0], w1 = w[j][1], w2 = w[j][2];
            v2u o; o.x = pk2(a0 * bflo(w0.x) + a1 * bflo(w1.x) + a2 * bflo(w2.x), a0 * bfhi(w0.x) + a1 * bfhi(w1.x) + a2 * bfhi(w2.x));
            o.y = pk2(a0 * bflo(w0.y) + a1 * bflo(w1.y) + a2 * bflo(w2.y), a0 * bfhi(w0.y) + a1 * bfhi(w1.y) + a2 * bfhi(w2.y));
            *(v2u*)(ATT + (size_t)t * D + 4 * lane) = o; } }
    }
}

__device__ __forceinline__ void router_phase(const Frame& F, const Args& A) {
    const int tidx_ = tid_opaque(F.wave);
    LAS unsigned char* L = F.lds;
    LAS int* hist = (LAS int*)(F.lds + RING_BYTES + 2048);
    LAS int* basee = hist + 32;
    LAS int* rec_e = hist + 64;
    LAS int* rec_r = rec_e + 512;
    LAS float* rec_g = (LAS float*)(rec_r + 512);
    LAS float* rec_s = rec_g + 512;
    LAS float* gl = (LAS float*)(F.lds + RING_BYTES + 9216);
    const float* brt = A.in[14]; const float* gmoe = A.in[12];
    const bf16* H = (const bf16*)A.out;
    const bf16* WRH = (const bf16*)(A.ws + WS_WRH);
    int* LIST = (int*)(A.ws + WS_LIST); float* SGATE = (float*)(A.ws + WS_SGATE); float* SRSTD = (float*)(A.ws + WS_SRSTD); int* POS = (int*)(A.ws + WS_POS);
    unsigned* CNT = (unsigned*)(A.ws + WS_CTL) + CW_CNT;
    const int lane = (tidx_ & 63), w = F.wave, r32 = lane & 31, hi = lane >> 5;
    for (int c = F.vcu; c < T / 128; c += F.G) {
        const int tt = w & 3, kh = w >> 2;
        const size_t row = (size_t)c * 128 + tt * 32 + r32;
        const bf16* hrow = H + row * D + kh * 512 + 8 * hi;
        v4u hq[16];
#pragma unroll
        for (int s = 0; s < 16; ++s) hq[s] = *(const v4u*)(hrow + 16 * s);
        __builtin_amdgcn_sched_barrier(0);
        for (int q = tidx_; q < 8192; q += 512) { const int mtx = q >> 12, rem = q & 4095, e = rem >> 7, ck = rem & 127;
            const v4u v = *(const v4u*)(WRH + (size_t)mtx * 32768 + e * 1024 + ck * 8);
            *(LAS v4u*)(L + mtx * 65536 + e * 2048 + ((ck ^ (e & 15)) << 4)) = v; }
        if (tidx_ < 256) *(LAS f32x4*)(gl + tidx_ * 4) = *(const f32x4*)(gmoe + tidx_ * 4);
        if (tidx_ < 32) hist[tidx_] = 0;
        __syncthreads();
        const LAS float* grow = gl + kh * 512 + 8 * hi;
        const LAS unsigned char* wb = L + r32 * 2048;
        f32x16 acc = {}; float ss = 0.f;
#pragma unroll
        for (int s = 0; s < 32; ++s) {
            const v4u hw_ = hq[s & 15];
            if (s < 16) hq[s] = *(const v4u*)(hrow + 16 * (s + 16));
            const f32x4 h0 = {bflo(hw_.x), bfhi(hw_.x), bflo(hw_.y), bfhi(hw_.y)}, h1 = {bflo(hw_.z), bfhi(hw_.z), bflo(hw_.w), bfhi(hw_.w)}, g0 = *(const LAS f32x4*)(grow + 16 * s), g1 = *(const LAS f32x4*)(grow + 16 * s + 4);
            ss += (h0.x * h0.x + h0.y * h0.y) + (h0.z * h0.z + h0.w * h0.w) + (h1.x * h1.x + h1.y * h1.y) + (h1.z * h1.z + h1.w * h1.w);
            const f32x4 x0 = h0 * g0, x1 = h1 * g1;
            v4u xh; xh.x = cvt_pk_bf16(x0.x, x0.y); xh.y = cvt_pk_bf16(x0.z, x0.w); xh.z = cvt_pk_bf16(x1.x, x1.y); xh.w = cvt_pk_bf16(x1.z, x1.w);
            v4u xl; xl.x = cvt_pk_bf16(x0.x - bflo(xh.x), x0.y - bfhi(xh.x)); xl.y = cvt_pk_bf16(x0.z - bflo(xh.y), x0.w - bfhi(xh.y));
            xl.z = cvt_pk_bf16(x1.x - bflo(xh.z), x1.y - bfhi(xh.z)); xl.w = cvt_pk_bf16(x1.z - bflo(xh.w), x1.w - bfhi(xh.w));
            const int ck = kh * 64 + 2 * s + hi;
            const bf16x8 wh = *(const LAS bf16x8*)(wb + ((ck ^ (r32 & 15)) << 4)), wl = *(const LAS bf16x8*)(wb + 65536 + ((ck ^ (r32 & 15)) << 4));
            const bf16x8 ah = __builtin_bit_cast(bf16x8, xh), al = __builtin_bit_cast(bf16x8, xl);
            acc = __builtin_amdgcn_mfma_f32_32x32x16_bf16(ah, wh, acc, 0, 0, 0);
            acc = __builtin_amdgcn_mfma_f32_32x32x16_bf16(al, wh, acc, 0, 0, 0);
            acc = __builtin_amdgcn_mfma_f32_32x32x16_bf16(ah, wl, acc, 0, 0, 0);
        }
        __syncthreads();
        { LAS float* LGp = (LAS float*)L + kh * (128 * 33);
#pragma unroll
          for (int i = 0; i < 16; ++i) LGp[(tt * 32 + crow(i, hi)) * 33 + r32] = acc[i];
          ((LAS float*)(L + 36864))[(kh * 2 + hi) * 128 + tt * 32 + r32] = ss; }
        __syncthreads();
        if (tidx_ < 128) {
            const int t = tidx_; const LAS float* SS = (const LAS float*)(L + 36864);
            const float rstd = 1.0f / sqrtf(((SS[t] + SS[128 + t]) + (SS[256 + t] + SS[384 + t])) * (1.f / D) + EPS);
            const LAS float* l0 = (const LAS float*)L + t * 33; const LAS float* l1 = l0 + 128 * 33;
            float lg[32];
#pragma unroll
            for (int e = 0; e < 32; ++e) lg[e] = (l0[e] + l1[e]) * rstd + brt[e];
            unsigned taken = 0u; float tv[4]; int ti[4];
#pragma unroll
            for (int k = 0; k < 4; ++k) { float bv = -INFINITY; int bi = 0;
#pragma unroll
                for (int e = 0; e < 32; ++e) { const float cv = ((taken >> e) & 1u) ? -INFINITY : lg[e]; if (cv > bv) { bv = cv; bi = e; } }
                tv[k] = bv; ti[k] = bi; taken |= 1u << bi; }
            const float e1 = __expf(tv[1] - tv[0]), e2 = __expf(tv[2] - tv[0]), e3 = __expf(tv[3] - tv[0]); const float inv = 1.0f / (1.0f + e1 + e2 + e3);
            const float gk[4] = {inv, e1 * inv, e2 * inv, e3 * inv};
            rec_s[t] = rstd;
#pragma unroll
            for (int k = 0; k < 4; ++k) { const int lr = atomicAdd((int*)&hist[ti[k]], 1); rec_e[t * 4 + k] = ti[k]; rec_r[t * 4 + k] = lr; rec_g[t * 4 + k] = gk[k]; }
        }
        __syncthreads();
        if (tidx_ < 32) basee[tidx_] = (int)__hip_atomic_fetch_add(CNT + tidx_, (unsigned)hist[tidx_], __ATOMIC_RELAXED, __HIP_MEMORY_SCOPE_AGENT);
        __syncthreads();
        { const int lrow = tidx_ >> 2, k = tidx_ & 3; const int e = rec_e[tidx_], slot = basee[e] + rec_r[tidx_]; const int t = c * 128 + lrow;
          LIST[e * 32768 + slot] = t; SGATE[e * 32768 + slot] = rec_g[tidx_]; SRSTD[e * 32768 + slot] = rec_s[lrow]; POS[t * 4 + k] = (e << 16) | slot; }
        __syncthreads();
    }
}

__device__ __forceinline__ void load_tile_starts(const Frame& F, const Args& A) {
    const int tidx_ = tid_opaque(F.wave);
    LAS int* ts = (LAS int*)(F.lds + TS_OFF);
    if (tidx_ == 0) { const unsigned* CNT = (const unsigned*)(A.ws + WS_CTL) + CW_CNT; int acc = 0;
        for (int e = 0; e < 32; ++e) { const int c = (int)__hip_atomic_load(CNT + e, __ATOMIC_RELAXED, __HIP_MEMORY_SCOPE_AGENT); ts[e] = acc; ts[40 + e] = c; acc += (c + 255) >> 8; }
        ts[32] = acc; for (int e = 33; e < 40; ++e) ts[e] = 0x7fffffff; }
    __syncthreads();
}

__device__ __forceinline__ void combine_phase(const Frame& F, const Args& A) {
    const int tidx_ = tid_opaque(F.wave);
    const LAS int* ts = (const LAS int*)(F.lds + TS_OFF);
    const bf16* Y = (const bf16*)(A.ws + WS_Y); const int* POS = (const int*)(A.ws + WS_POS); const bf16* H = (const bf16*)A.out; bf16* H2 = (bf16*)(A.ws + WS_H2); float* RS = (float*)(A.ws + WS_SRSTD);
    const int gw = F.vcu * 8 + F.wave, NGW = F.G * 8, lane = (tidx_ & 63);
    for (int t = gw * 2; t < T; t += NGW * 2) {
        int pz[2][4];
#pragma unroll
        for (int r = 0; r < 2; ++r)
#pragma unroll
            for (int k = 0; k < 4; ++k) pz[r][k] = POS[(t + r) * 4 + k];
        f32x4 v[2][2][2];
#pragma unroll
        for (int r = 0; r < 2; ++r)
#pragma unroll
            for (int hf = 0; hf < 2; ++hf) { const v4u w = *(const v4u*)(H + (size_t)(t + r) * D + hf * 512 + 8 * lane); v[r][hf][0] = (f32x4){bflo(w.x), bfhi(w.x), bflo(w.y), bfhi(w.y)}; v[r][hf][1] = (f32x4){bflo(w.z), bfhi(w.z), bflo(w.w), bfhi(w.w)}; }
        v4u yw[2][4][2];
#pragma unroll
        for (int r = 0; r < 2; ++r)
#pragma unroll
            for (int k = 0; k < 4; ++k) { const int e = pz[r][k] >> 16, slot = pz[r][k] & 0xffff; const bf16* yp = Y + ((size_t)ts[e] * 256 + slot) * D + 8 * lane;
                yw[r][k][0] = *(const v4u*)yp; yw[r][k][1] = *(const v4u*)(yp + 512); }
        float s[2];
#pragma unroll
        for (int r = 0; r < 2; ++r) { float a = 0.f;
#pragma unroll
            for (int hf = 0; hf < 2; ++hf) {
#pragma unroll
                for (int k = 0; k < 4; ++k) { const v4u w = yw[r][k][hf];
                    v[r][hf][0] = v[r][hf][0] + (f32x4){bflo(w.x), bfhi(w.x), bflo(w.y), bfhi(w.y)}; v[r][hf][1] = v[r][hf][1] + (f32x4){bflo(w.z), bfhi(w.z), bflo(w.w), bfhi(w.w)}; }
                st8(H2 + (size_t)(t + r) * D + hf * 512 + 8 * lane, v[r][hf][0], v[r][hf][1]);
#pragma unroll
                for (int p = 0; p < 2; ++p) a += (v[r][hf][p].x * v[r][hf][p].x + v[r][hf][p].y * v[r][hf][p].y) + (v[r][hf][p].z * v[r][hf][p].z + v[r][hf][p].w * v[r][hf][p].w); }
            s[r] = a; }
#pragma unroll
        for (int o = 1; o < 64; o <<= 1) { s[0] += __shfl_xor(s[0], o); s[1] += __shfl_xor(s[1], o); }
#pragma unroll
        for (int r = 0; r < 2; ++r) if (lane == r) RS[t + r] = 1.0f / sqrtf(s[r] * (1.f / D) + EPS);
    }
}
__device__ __forceinline__ void final_phase(const Frame& F, const Args& A) {
    const int tidx_ = tid_opaque(F.wave);
    float* OUT = A.out; const float* gf = A.in[22]; const bf16* T1 = (const bf16*)(A.ws + WS_T1); const bf16* H2 = (const bf16*)(A.ws + WS_H2);
    const int gw = F.vcu * 8 + F.wave, NGW = F.G * 8, lane = (tidx_ & 63);
    f32x4 g[2][2];
#pragma unroll
    for (int hf = 0; hf < 2; ++hf) { const float* gp = gf + hf * 512 + 8 * lane; g[hf][0] = *(const f32x4*)gp; g[hf][1] = *(const f32x4*)(gp + 4); }
    for (int t = gw * 2; t < T; t += NGW * 2) {
        v4u hw[2][2], tw[2][2];
#pragma unroll
        for (int r = 0; r < 2; ++r)
#pragma unroll
            for (int hf = 0; hf < 2; ++hf) { const size_t o = (size_t)(t + r) * D + hf * 512 + 8 * lane; hw[r][hf] = *(const v4u*)(H2 + o); tw[r][hf] = *(const v4u*)(T1 + o); }
        f32x4 v[2][2][2]; float s[2];
#pragma unroll
        for (int r = 0; r < 2; ++r) { float a = 0.f;
#pragma unroll
            for (int hf = 0; hf < 2; ++hf) { const v4u h = hw[r][hf], w = tw[r][hf];
                v[r][hf][0] = (f32x4){bflo(h.x) + bflo(w.x), bfhi(h.x) + bfhi(w.x), bflo(h.y) + bflo(w.y), bfhi(h.y) + bfhi(w.y)};
                v[r][hf][1] = (f32x4){bflo(h.z) + bflo(w.z), bfhi(h.z) + bfhi(w.z), bflo(h.w) + bflo(w.w), bfhi(h.w) + bfhi(w.w)};
#pragma unroll
                for (int p = 0; p < 2; ++p) a += (v[r][hf][p].x * v[r][hf][p].x + v[r][hf][p].y * v[r][hf][p].y) + (v[r][hf][p].z * v[r][hf][p].z + v[r][hf][p].w * v[r][hf][p].w); }
            s[r] = a; }
#pragma unroll
        for (int o = 1; o < 64; o <<= 1) { s[0] += __shfl_xor(s[0], o); s[1] += __shfl_xor(s[1], o); }
#pragma unroll
        for (int r = 0; r < 2; ++r) { const float rstd = 1.0f / sqrtf(s[r] * (1.f / D) + EPS);
#pragma unroll
            for (int hf = 0; hf < 2; ++hf) { float* op = OUT + (size_t)(t + r) * D + hf * 512 + 8 * lane; *(f32x4*)op = v[r][hf][0] * rstd * g[hf][0]; *(f32x4*)(op + 4) = v[r][hf][1] * rstd * g[hf][1]; } }
    }
}

constexpr int NPHASE = 13;
#ifndef ONLY_PH
#define ONLY_PH -1
#endif
#define PH_ON(k) (ONLY_PH < 0 || ONLY_PH == (k))
__global__ void __launch_bounds__(512, 2) fwd_kernel(Args args) {
    extern __shared__ __attribute__((aligned(16))) unsigned char lds[];
    Frame F;
    F.lds = (LAS unsigned char*)lds; F.wave = __builtin_amdgcn_readfirstlane((int)threadIdx.x >> 6);
    F.G = gridDim.x; { const int bx = blockIdx.x; F.vcu = (F.G % 8 == 0) ? (bx % 8) * (F.G / 8) + bx / 8 : bx; }
    unsigned char* ws = args.ws;
    volatile LAS unsigned* MISC = (volatile LAS unsigned*)(F.lds + MISC_OFF);
    for (int u = tid_opaque(F.wave); u < (LDS_BYTES - RING_BYTES) / 4; u += 512) ((LAS unsigned*)(F.lds + RING_BYTES))[u] = 0u;
    __syncthreads();
    const bool multi = (args.ph_hi - args.ph_lo) > 1;
    if (multi) (void)xcd_barrier_post((unsigned*)(ws + WS_CTL) + CW_BAR, MISC + 8, F.wave);
    const int bx = (int)blockIdx.x;
#if MK_N_LAUNCHES == 1
    constexpr int lo = 0, hi = NPHASE;
#else
    const int lo = args.ph_lo, hi = args.ph_hi;
#endif
#ifndef REP_MASK
#define REP_MASK 0
#endif
#define IN(k) (PH_ON(k) && lo <= (k) && (k) < hi)
#define REPS(k) (((REP_MASK >> (k)) & 1) ? 2 : 1)
#define SEAM(k) do { if (lo <= (k) && (k) + 1 < hi) { XcdBarrier b_; b_.bar = (unsigned*)(args.ws + WS_CTL) + CW_BAR; b_.x = xb_xcc_id(); b_.st = (volatile LAS unsigned*)(F.lds + MISC_OFF) + 8; b_.wave = F.wave; xcd_barrier(b_); } } while (0)
    if (IN(0)) for (int rep_ = 0; rep_ < REPS(0); ++rep_) { p0_prologue(F, args); } SEAM(0);
    if (IN(1)) { const int nu1 = (T / 256) * 23, R1 = (nu1 + F.G - 1) / F.G + 1, GG = (nu1 + R1 - 1) / R1;
                 if (bx < GG) { InProjSched S{(const char*)(ws + WS_NX), (const char*)(ws + WS_WIN), GG, bx, REPS(1) - 1};
                 EpiInProj E{(bf16*)(ws + WS_Q), (bf16*)(ws + WS_K), (bf16*)(ws + WS_ZU), (bf16*)(ws + WS_GA), (bf16*)(ws + WS_GG), (bf16*)(ws + WS_VT), (bf16*)(ws + WS_ZVT)};
                 pg8::gemm_phase(F.lds, D, S, E, F.wave); }
                 convert_queue(F, args, (unsigned*)(ws + WS_CTL) + CW_Q1, 0, BG_P1); convert_queue(F, args, (unsigned*)(ws + WS_CTL) + CW_Q3, BG_N, BG_ALL); convert_p_queue(F, args, (unsigned*)(ws + WS_CTL) + CW_Q4); } SEAM(1);
    if (IN(2)) { if ((bx >> 3) & 1) { spatial_phase(F, args); __syncthreads(); attn_phase(F, args); } else { attn_phase(F, args); __syncthreads(); spatial_phase(F, args); } } SEAM(2);
    if (IN(3)) { const int N3 = F.G >= 128 ? PP_EARLY : 0;
                 if (bx < N3) { PlainSched S{(const char*)(ws + WS_PB), (const char*)(ws + WS_WPP), T / 256, 4, PLE, N3, bx, 0, 0, N3}; EpiBf<0> E{(bf16*)(ws + WS_PP), nullptr, nullptr};
                 pg8::gemm_phase(F.lds, PLE, S, E, F.wave); }
                 else merge_phase(F, args, (bx - N3) * 8 + F.wave, (F.G - N3) * 8); } SEAM(3);
    if (IN(4)) { PlainSched S{(const char*)(ws + WS_AG), (const char*)(ws + WS_WCAT), T / 256, 4, D, F.G, bx, REPS(4) - 1}; EpiMerge E{(bf16*)(ws + WS_MRG), (const bf16*)(ws + WS_GA), (const bf16*)(ws + WS_GG)};
                 pg8::gemm_phase(F.lds, D, S, E, F.wave); } SEAM(5);
    if (IN(6)) { PlainSched S{(const char*)(ws + WS_MRG), (const char*)(ws + WS_WOUT), T / 256, 4, D, F.G, bx, REPS(6) - 1}; EpiH1 E{(bf16*)args.out, args.in[0]};
                 pg8::gemm_phase(F.lds, D, S, E, F.wave); } SEAM(6);
    if (IN(7)) for (int rep_ = 0; rep_ < REPS(7); ++rep_) { router_phase(F, args); } SEAM(7);
    if (IN(8)) { load_tile_starts(F, args); const LAS int* ts = (const LAS int*)(F.lds + TS_OFF);
                 const int nu8 = ts[32] * 8, R8 = (nu8 + F.G - 1) / F.G, GG = R8 > 0 ? (nu8 + R8 - 1) / R8 : 1;
                 if (bx < GG) { MoeSched S{(const char*)args.out, (const char*)(ws + WS_WGU), (const int*)(ws + WS_LIST), ts, 8, D, GG, bx, 1, REPS(8) - 1}; EpiMoeUp E{(bf16*)(ws + WS_ACT), args.in[16], (const float*)(ws + WS_SRSTD), ts};
                 pg8::gemm_phase(F.lds, D, S, E, F.wave); }
                 convert_queue(F, args, (unsigned*)(ws + WS_CTL) + CW_Q2, BG_GU, BG_N); } SEAM(8);
    if (IN(9)) { load_tile_starts(F, args); const LAS int* ts = (const LAS int*)(F.lds + TS_OFF);
                 const int nu9 = ts[32] * 4, R9 = (nu9 + F.G - 1) / F.G, GG = R9 > 0 ? (nu9 + R9 - 1) / R9 : 1, NH = F.G - GG;
                 if (bx < GG) { MoeSched S{(const char*)(ws + WS_ACT), (const char*)(ws + WS_WD), (const int*)(ws + WS_LIST), ts, 4, D, GG, bx, 0, REPS(9) - 1}; EpiMoeDown E{(bf16*)(ws + WS_Y), args.in[18], (const float*)(ws + WS_SGATE), ts};
                 pg8::gemm_phase(F.lds, D, S, E, F.wave); }
                 if (NH >= 8 ? bx >= GG : true) { PlainSched S{(const char*)(ws + WS_PB), (const char*)(ws + WS_WPP), T / 256, 4, PLE, NH >= 8 ? NH : F.G, NH >= 8 ? bx - GG : bx, 0, F.G >= 128 ? PP_EARLY : 0, 0}; EpiBf<0> E{(bf16*)(ws + WS_PP), nullptr, nullptr};
                 pg8::gemm_phase(F.lds, PLE, S, E, F.wave); } } SEAM(9);
    if (IN(10)) for (int rep_ = 0; rep_ < REPS(10); ++rep_) { load_tile_starts(F, args); combine_phase(F, args); } SEAM(10);
    if (IN(11)) { PlainSched S{(const char*)(ws + WS_H2), (const char*)(ws + WS_WPG), T / 256, 4, D, F.G, bx, REPS(11) - 1}; EpiPle E{(bf16*)(ws + WS_T1), (const bf16*)(ws + WS_PP), (const float*)(ws + WS_SRSTD)};
                  pg8::gemm_phase(F.lds, D, S, E, F.wave); } SEAM(11);
    if (IN(12)) for (int rep_ = 0; rep_ < REPS(12); ++rep_) { final_phase(F, args); }
#undef IN
#undef SEAM
}

extern "C" void kernel_launch(void* const* d_in, const int* in_sizes, int n_in, void* d_out, int out_size, void* d_ws, size_t ws_size, hipStream_t stream) {
    static int grid = 0;
    if (grid == 0) {
        if (n_in != 23 || out_size != T * D || ws_size < WS_END) { fprintf(stderr, "kernel_launch: unexpected shapes (n_in %d out %d ws %zu)\n", n_in, out_size, ws_size); grid = -1; return; }
        int dev = 0, cus = 0, per_cu = 0;
        if (hipGetDevice(&dev) != hipSuccess || hipDeviceGetAttribute(&cus, hipDeviceAttributeMultiprocessorCount, dev) != hipSuccess) { grid = -1; return; }
        if (hipFuncSetAttribute((const void*)fwd_kernel, hipFuncAttributeMaxDynamicSharedMemorySize, LDS_BYTES) != hipSuccess) { fprintf(stderr, "kernel_launch: hipFuncSetAttribute failed\n"); grid = -1; return; }
        if (hipOccupancyMaxActiveBlocksPerMultiprocessor(&per_cu, (const void*)fwd_kernel, 512, LDS_BYTES) != hipSuccess || per_cu < 1) { fprintf(stderr, "kernel_launch: occupancy query says %d\n", per_cu); (void)hipGetLastError(); grid = -1; return; }
        grid = cus;
    }
    if (grid < 0) return;
    (void)hipMemsetAsync((char*)d_ws + WS_CTL, 0, CTL_ZERO_BYTES, stream);
    Args a{};
    for (int i = 0; i < 23; ++i) a.in[i] = (const float*)d_in[i];
    a.out = (float*)d_out; a.ws = (unsigned char*)d_ws;
#if MK_N_LAUNCHES == 1
    a.ph_lo = 0; a.ph_hi = NPHASE;
    hipLaunchKernelGGL(fwd_kernel, dim3(grid), dim3(512), LDS_BYTES, stream, a);
#else
    for (int ph = 0; ph < NPHASE; ++ph) { a.ph_lo = ph; a.ph_hi = ph + 1; hipLaunchKernelGGL(fwd_kernel, dim3(grid), dim3(512), LDS_BYTES, stream, a); }
#endif
}
```
